# Optimizing an MI355X kernel written in HIP

```python
import math
import jax, jax.numpy as jnp
from jax import lax
import numpy as np

D_MODEL = 1024
BATCH = 2
SEQ = 8192
DEPTH = 4

HEAD_DIM = 64
SWA_HEADS = 6
SWA_WIDTH = SWA_HEADS * HEAD_DIM
DILATED_BRANCHES = ((128, 1), (512, 4), (2048, 16))
SWA_BLOCK = 128
S5_CHANNELS = 256
S5_GROUP = 16
S5_GROUPS = S5_CHANNELS // S5_GROUP
S5_STATE = 64
S5_DT_MIN = 1e-3
S5_DT_MAX = 1e-1
MLA_HEADS = 6
MLA_NOPE = 64
MLA_ROPE = 32
MLA_QK = MLA_NOPE + MLA_ROPE
MLA_V = 64
MLA_WIDTH = MLA_HEADS * MLA_V
MLA_Q_LORA = 256
MLA_KV_LORA = 128
ROPE_THETA = 10000.0
ATTN_BLOCK = 128
D_MIX = SWA_WIDTH + S5_CHANNELS + MLA_WIDTH
IN_SPLITS = (SWA_WIDTH, SWA_WIDTH, SWA_WIDTH, S5_CHANNELS, MLA_Q_LORA, MLA_KV_LORA, MLA_ROPE)
IN_COLS = 3 * SWA_WIDTH + S5_CHANNELS + MLA_Q_LORA + MLA_KV_LORA + MLA_ROPE
T5_BUCKETS = 32
T5_MAX_DISTANCE = 2048
PEER_KEYS = 128
PEER_EXPERTS = PEER_KEYS * PEER_KEYS
PEER_HEADS = 8
PEER_TOPK = 16
PEER_DKEY = 256
PEER_BLOCK = 128
EPS = 1e-6

kernel_name = "hybrid_swa_s5_mla_peer_trunk"


def rms_norm(x, gain):
    xf = x.astype(jnp.float32)
    y = xf * lax.rsqrt(jnp.mean(xf * xf, axis=-1, keepdims=True) + EPS)
    return (y * gain.astype(jnp.float32)).astype(x.dtype)


def t5_bucket(dist):
    max_exact = T5_BUCKETS // 2
    d_f = jnp.maximum(dist, 1).astype(jnp.float32)
    large = max_exact + (jnp.log(d_f / max_exact) / math.log(T5_MAX_DISTANCE / max_exact)
                         * (T5_BUCKETS - max_exact)).astype(jnp.int32)
    large = jnp.minimum(large, T5_BUCKETS - 1)
    return jnp.where(dist < max_exact, dist, large)


def rope(x, cos, sin):
    half = x.shape[-1] // 2
    x1, x2 = x[..., :half], x[..., half:]
    return jnp.concatenate([x1 * cos - x2 * sin, x1 * sin + x2 * cos], axis=-1)


def dilated_branch(q, k, v, bias_j, dil):
    B, H, S, hd = q.shape
    n_back = bias_j.shape[-1] - 1
    L = S // dil
    nb = -(-L // SWA_BLOCK)
    Lp = nb * SWA_BLOCK

    def to_blocks(t):
        t = t.reshape(B, H, L, dil, hd).transpose(0, 1, 3, 2, 4)
        t = jnp.pad(t, ((0, 0), (0, 0), (0, 0), (0, Lp - L), (0, 0)))
        return t.reshape(B, H, dil, nb, SWA_BLOCK, hd)

    def with_prev(t):
        prev = jnp.pad(t[:, :, :, :-1], ((0, 0), (0, 0), (0, 0), (1, 0), (0, 0), (0, 0)))
        return jnp.concatenate([prev, t], axis=4)

    qb = to_blocks(q)
    kc = with_prev(to_blocks(k))
    vc = with_prev(to_blocks(v)).astype(jnp.float32)
    logits = jnp.einsum('bhrnqd,bhrnkd->bhrnqk', qb, kc).astype(jnp.float32)
    qi = jnp.arange(SWA_BLOCK)[:, None]
    kj = jnp.arange(2 * SWA_BLOCK)[None, :]
    delta = SWA_BLOCK + qi - kj
    band = (delta >= 0) & (delta <= n_back)
    has_prev = (jnp.arange(nb)[:, None, None] > 0) | (kj >= SWA_BLOCK)[None]
    valid = band[None] & has_prev
    bias = bias_j.astype(jnp.float32)[:, jnp.clip(delta, 0, n_back)]
    logits = jnp.where(valid, logits + bias[:, None, None], -jnp.inf)
    mx = jnp.max(logits, axis=-1)
    p = jnp.exp(logits - mx[..., None])
    den = jnp.sum(p, axis=-1)
    num = jnp.einsum('bhrnqk,bhrnkd->bhrnqd', p, vc)

    def from_blocks(t):
        t = t.reshape((B, H, dil, Lp) + t.shape[5:])[:, :, :, :L]
        t = jnp.swapaxes(t, 2, 3)
        return t.reshape((B, H, S) + t.shape[4:])

    return from_blocks(num), from_blocks(den), from_blocks(mx)


def dilated_attention(q, k, v, branch_biases):
    nums, dens, mxs = [], [], []
    for (window, dil), bias_j in zip(DILATED_BRANCHES, branch_biases):
        n_i, d_i, m_i = dilated_branch(q, k, v, bias_j, dil)
        nums.append(n_i)
        dens.append(d_i)
        mxs.append(m_i)
    mx = jnp.stack(mxs)
    w = jnp.exp(mx - jnp.max(mx, axis=0, keepdims=True))
    num = jnp.sum(w[..., None] * jnp.stack(nums), axis=0)
    den = jnp.sum(w * jnp.stack(dens), axis=0)
    return num / den[..., None]


def mla_attention(q, k, v):
    B, H, S, _ = q.shape
    nq = S // ATTN_BLOCK
    qb = q.reshape(B, H, nq, ATTN_BLOCK, MLA_QK).transpose(2, 0, 1, 3, 4)
    k_pos = jnp.arange(S)
    vf = v.astype(jnp.float32)

    def block(args):
        qblk, n = args
        logits = jnp.einsum('bhqd,bhkd->bhqk', qblk, k).astype(jnp.float32)
        q_pos = n * ATTN_BLOCK + jnp.arange(ATTN_BLOCK)
        logits = jnp.where(k_pos[None, :] <= q_pos[:, None], logits, -jnp.inf)
        p = jax.nn.softmax(logits, axis=-1)
        return jnp.einsum('bhqk,bhkd->bhqd', p, vf)

    out = lax.map(block, (qb, jnp.arange(nq)))
    return out.transpose(1, 2, 0, 3, 4).reshape(B, H, S, MLA_V)


def s5_combine(e1, e2):
    a1r, a1i, b1r, b1i = e1
    a2r, a2i, b2r, b2i = e2
    return (a2r * a1r - a2i * a1i,
            a2r * a1i + a2i * a1r,
            a2r * b1r - a2i * b1i + b2r,
            a2r * b1i + a2i * b1r + b2i)


def s5_mixer(u, a_re, a_im, b_re, b_im, c_re, c_im, d_skip, log_dt, w_glu, b_glu):
    B, S, _ = u.shape
    f32 = jnp.float32
    uf = u.astype(f32)
    ug = uf.reshape(B, S, S5_GROUPS, S5_GROUP)
    a_re, a_im = a_re.astype(f32), a_im.astype(f32)
    b_re, b_im = b_re.astype(f32), b_im.astype(f32)
    dt = jnp.exp(log_dt.astype(f32))[:, None]
    mag = jnp.exp(a_re * dt)
    lam_re, lam_im = mag * jnp.cos(a_im * dt), mag * jnp.sin(a_im * dt)
    den = a_re * a_re + a_im * a_im
    nr, ni = lam_re - 1.0, lam_im
    coef_re = (nr * a_re + ni * a_im) / den
    coef_im = (ni * a_re - nr * a_im) / den
    bb_re = coef_re[..., None] * b_re - coef_im[..., None] * b_im
    bb_im = coef_re[..., None] * b_im + coef_im[..., None] * b_re
    bu_re = jnp.einsum('gpc,bsgc->bsgp', bb_re, ug)
    bu_im = jnp.einsum('gpc,bsgc->bsgp', bb_im, ug)
    shape = bu_re.shape
    elems = (jnp.broadcast_to(lam_re, shape), jnp.broadcast_to(lam_im, shape), bu_re, bu_im)
    _, _, xr, xi = lax.associative_scan(s5_combine, elems, axis=1)
    y = (jnp.einsum('gcp,bsgp->bsgc', c_re.astype(f32), xr)
         - jnp.einsum('gcp,bsgp->bsgc', c_im.astype(f32), xi))
    y = y.reshape(B, S, S5_CHANNELS) + d_skip.astype(f32) * uf
    g = jax.nn.gelu(y)
    return g * jax.nn.sigmoid(g @ w_glu.astype(f32) + b_glu.astype(f32))


def token_mixer(h, w_in, w_out, mix_gain, swa_q_gain, swa_k_gain, branch_biases,
                mla_q_lora_gain, mla_kv_lora_gain, w_uq, w_ukv, mla_q_gain, mla_k_gain,
                cos, sin, s5_params):
    B, S, _ = h.shape
    proj = h @ w_in
    cuts = [sum(IN_SPLITS[:i + 1]) for i in range(len(IN_SPLITS) - 1)]
    qa, ka, va, u, cq, ckv, kr = jnp.split(proj, cuts, axis=-1)

    def heads(t, n):
        return t.reshape(B, S, n, -1).transpose(0, 2, 1, 3)
    qa = rms_norm(heads(qa, SWA_HEADS), swa_q_gain) * (HEAD_DIM ** -0.5)
    ka = rms_norm(heads(ka, SWA_HEADS), swa_k_gain)
    ya = dilated_attention(qa, ka, heads(va, SWA_HEADS), branch_biases)
    ya = ya.transpose(0, 2, 1, 3).reshape(B, S, SWA_WIDTH)

    yb = s5_mixer(u, *s5_params)

    q = (rms_norm(cq, mla_q_lora_gain) @ w_uq).reshape(B, S, MLA_HEADS, MLA_QK)
    kv = (rms_norm(ckv, mla_kv_lora_gain) @ w_ukv).reshape(B, S, MLA_HEADS, MLA_NOPE + MLA_V)
    k_nope, vc = kv[..., :MLA_NOPE], kv[..., MLA_NOPE:]
    q_nope = rms_norm(q[..., :MLA_NOPE], mla_q_gain[:MLA_NOPE])
    q_rope = rope(rms_norm(q[..., MLA_NOPE:], mla_q_gain[MLA_NOPE:]), cos, sin)
    k_nope = rms_norm(k_nope, mla_k_gain[:MLA_NOPE])
    k_rope = rope(rms_norm(kr[:, :, None, :], mla_k_gain[MLA_NOPE:]), cos, sin)
    qc = jnp.concatenate([q_nope, q_rope], axis=-1) * (MLA_QK ** -0.5)
    kc = jnp.concatenate([k_nope, jnp.broadcast_to(k_rope, (B, S, MLA_HEADS, MLA_ROPE))], axis=-1)
    yc = mla_attention(qc.transpose(0, 2, 1, 3), kc.transpose(0, 2, 1, 3), vc.transpose(0, 2, 1, 3))
    yc = yc.transpose(0, 2, 1, 3).reshape(B, S, MLA_WIDTH)

    y = jnp.concatenate([
        rms_norm(ya, mix_gain[:SWA_WIDTH]),
        rms_norm(yb, mix_gain[SWA_WIDTH:SWA_WIDTH + S5_CHANNELS]),
        rms_norm(yc, mix_gain[SWA_WIDTH + S5_CHANNELS:]),
    ], axis=-1)
    return y @ w_out


def peer_ffn(h, wq, subkeys, u_tab, v_tab):
    B, S, D = h.shape
    T = B * S
    hf = h.reshape(T, D)
    q = (hf @ wq).reshape(T, PEER_HEADS, 2, PEER_DKEY // 2)
    scores = jnp.einsum('thjd,hjkd->thjk', q, subkeys).astype(jnp.float32)
    top_s, top_i = lax.top_k(scores, PEER_TOPK)
    cand = top_s[:, :, 0, :, None] + top_s[:, :, 1, None, :]
    best_s, best_c = lax.top_k(cand.reshape(T, PEER_HEADS, PEER_TOPK * PEER_TOPK), PEER_TOPK)
    i1 = jnp.take_along_axis(top_i[:, :, 0], best_c // PEER_TOPK, axis=-1)
    i2 = jnp.take_along_axis(top_i[:, :, 1], best_c % PEER_TOPK, axis=-1)
    nblk = T // PEER_BLOCK
    experts = (i1 * PEER_KEYS + i2).reshape(nblk, PEER_BLOCK, PEER_HEADS * PEER_TOPK)
    gates = jax.nn.softmax(best_s, axis=-1).reshape(nblk, PEER_BLOCK, PEER_HEADS * PEER_TOPK)
    xb = hf.reshape(nblk, PEER_BLOCK, D)

    def block(args):
        xt, et, gt = args
        act = jax.nn.gelu(jnp.einsum('td,tkd->tk', xt, u_tab[et]).astype(jnp.float32))
        return jnp.einsum('tk,tkd->td', gt * act, v_tab[et].astype(jnp.float32))

    out = lax.map(block, (xb, experts, gates))
    return out.reshape(B, S, D)


def setup_inputs(seed: int = 0) -> dict:
    key = jax.random.key(seed)
    ks = jax.random.split(key, 40)
    f32 = jnp.float32

    def nrm(k, shape, scale):
        return jax.random.normal(k, shape, f32) * scale

    def gain(k, shape):
        return 1.0 + 0.02 * jax.random.normal(k, shape, f32)

    L, D = DEPTH, D_MODEL
    return {
        "x": nrm(ks[0], (BATCH, SEQ, D), 1.0),
        "c": nrm(ks[1], (BATCH, D), 1.0),
        "w_in": nrm(ks[2], (L, D, IN_COLS), D ** -0.5),
        "w_out": nrm(ks[3], (L, D_MIX, D), D_MIX ** -0.5),
        "mix_gain": gain(ks[4], (L, D_MIX)),
        "norm1_gain": gain(ks[5], (L, D)),
        "norm2_gain": gain(ks[6], (L, D)),
        "w_ada": nrm(ks[7], (L, D, 6 * D), 0.5 * D ** -0.5),
        "b_ada": nrm(ks[8], (L, 6 * D), 0.02),
        "rel_bias": nrm(ks[9], (SWA_HEADS, T5_BUCKETS), 0.5),
        "swa_q_gain": gain(ks[10], (L, HEAD_DIM)),
        "swa_k_gain": gain(ks[11], (L, HEAD_DIM)),
        "mla_q_lora_gain": gain(ks[12], (L, MLA_Q_LORA)),
        "mla_kv_lora_gain": gain(ks[13], (L, MLA_KV_LORA)),
        "w_uq": nrm(ks[14], (L, MLA_Q_LORA, MLA_HEADS * MLA_QK), MLA_Q_LORA ** -0.5),
        "w_ukv": nrm(ks[15], (L, MLA_KV_LORA, MLA_HEADS * (MLA_NOPE + MLA_V)), MLA_KV_LORA ** -0.5),
        "mla_q_gain": gain(ks[16], (L, MLA_QK)),
        "mla_k_gain": gain(ks[17], (L, MLA_QK)),
        "s5_a_re": -0.5 + nrm(ks[18], (L, S5_GROUPS, S5_STATE), 0.01),
        "s5_a_im": math.pi * jnp.arange(S5_STATE, dtype=f32) + nrm(ks[19], (L, S5_GROUPS, S5_STATE), 0.01),
        "s5_b_re": nrm(ks[20], (L, S5_GROUPS, S5_STATE, S5_GROUP), (2 * S5_GROUP) ** -0.5),
        "s5_b_im": nrm(ks[21], (L, S5_GROUPS, S5_STATE, S5_GROUP), (2 * S5_GROUP) ** -0.5),
        "s5_c_re": nrm(ks[22], (L, S5_GROUPS, S5_GROUP, S5_STATE), (2 * S5_STATE) ** -0.5),
        "s5_c_im": nrm(ks[23], (L, S5_GROUPS, S5_GROUP, S5_STATE), (2 * S5_STATE) ** -0.5),
        "s5_d": nrm(ks[24], (L, S5_CHANNELS), 1.0),
        "s5_log_dt": jax.random.uniform(ks[25], (L, S5_GROUPS), f32, math.log(S5_DT_MIN), math.log(S5_DT_MAX)),
        "w_glu": nrm(ks[26], (L, S5_CHANNELS, S5_CHANNELS), S5_CHANNELS ** -0.5),
        "b_glu": nrm(ks[27], (L, S5_CHANNELS), 0.02),
        "peer_wq": nrm(ks[28], (L, D, PEER_HEADS * PEER_DKEY), D ** -0.5),
        "peer_subkeys": nrm(ks[29], (L, PEER_HEADS, 2, PEER_KEYS, PEER_DKEY // 2), (PEER_DKEY // 2) ** -0.5),
        "peer_u": nrm(ks[30], (L, PEER_EXPERTS, D), D ** -0.5),
        "peer_v": nrm(ks[31], (L, PEER_EXPERTS, D), 0.5),
    }


def reference(x, c, w_in, w_out, mix_gain, norm1_gain, norm2_gain, w_ada, b_ada, rel_bias,
              swa_q_gain, swa_k_gain, mla_q_lora_gain, mla_kv_lora_gain, w_uq, w_ukv,
              mla_q_gain, mla_k_gain, s5_a_re, s5_a_im, s5_b_re, s5_b_im, s5_c_re, s5_c_im,
              s5_d, s5_log_dt, w_glu, b_glu, peer_wq, peer_subkeys, peer_u, peer_v):
    B, S, _ = x.shape
    f32 = jnp.float32
    pos = jnp.arange(S, dtype=f32)
    inv_freq = ROPE_THETA ** (-jnp.arange(0, MLA_ROPE, 2, dtype=f32) / MLA_ROPE)
    ang = pos[:, None] * inv_freq[None, :]
    cos, sin = jnp.cos(ang)[:, None, :], jnp.sin(ang)[:, None, :]
    branch_biases = [rel_bias[:, t5_bucket(dil * jnp.arange(window // dil + 1))]
                     for window, dil in DILATED_BRANCHES]
    c_act = jax.nn.silu(c)
    for l in range(DEPTH):
        mod = c_act @ w_ada[l] + b_ada[l]
        sh1, sc1, g1, sh2, sc2, g2 = jnp.split(mod, 6, axis=-1)
        h = rms_norm(x, norm1_gain[l]) * (1.0 + sc1[:, None]) + sh1[:, None]
        s5_params = (s5_a_re[l], s5_a_im[l], s5_b_re[l], s5_b_im[l], s5_c_re[l], s5_c_im[l],
                     s5_d[l], s5_log_dt[l], w_glu[l], b_glu[l])
        y = token_mixer(h, w_in[l], w_out[l], mix_gain[l], swa_q_gain[l], swa_k_gain[l], branch_biases,
                        mla_q_lora_gain[l], mla_kv_lora_gain[l], w_uq[l], w_ukv[l],
                        mla_q_gain[l], mla_k_gain[l], cos, sin, s5_params)
        x = x + g1[:, None] * y
        h = rms_norm(x, norm2_gain[l]) * (1.0 + sc2[:, None]) + sh2[:, None]
        x = x + g2[:, None] * peer_ffn(h, peer_wq[l], peer_subkeys[l], peer_u[l], peer_v[l])
    return x
```

```cpp
#include <hip/hip_runtime.h>
#include <cstdint>
#include <cstdio>
#include <cstring>
namespace pg8 {
#define PG8_LAS __attribute__((address_space(3)))
typedef unsigned short bf16_t;
typedef short bf16x8 __attribute__((ext_vector_type(8)));
typedef float f32x4 __attribute__((ext_vector_type(4)));
typedef unsigned u32x4 __attribute__((ext_vector_type(4)));
constexpr int BM = 256, BK = 64, HALF = 128, HTB = HALF * BK * 2  , STAGE_BYTES = 8 * HTB, NXCD = 8, WGM = 8;

__host__ __device__ __forceinline__ int lds_byte(int r, int c) { const int st = (r >> 4) * 2 + (c >> 5), rr = r & 15, cc = c & 31, ob = rr * 64 + cc * 2; return st * 1024 + (ob ^ (((ob >> 9) & 1) << 5)); }
__host__ __device__ __forceinline__ void stage_rc(int b, int& R, int& C) { const int st = b / 1024, sb = b % 1024, swz = sb ^ (((sb >> 9) & 1) << 5); R = (st >> 1) * 16 + swz / 64; C = (st & 1) * 32 + (swz % 64) / 2; }
__host__ __device__ __forceinline__ int perm32(int rho) { const int n = rho >> 4, i = rho & 15; return 8 * (i >> 2) + 4 * n + (i & 3); }

struct Unit { int pm, pn; };
struct Gemm { const bf16_t* A; const bf16_t* Bt; int M, N, K; };

struct StaticOrder {
    int nM, nN, nwg, G, c;
    __host__ __device__ void init(int M, int N, int G_, int c_) { nM = M / BM; nN = N / BM; nwg = nM * nN; G = G_; c = c_; }
    __host__ __device__ bool next(int i, Unit& u) const {
        const long L = (long)i * G + c; if (L >= nwg) return false;
        int wgid = (int)L; { const int q = nwg / NXCD, r = nwg % NXCD, xcd = wgid % NXCD, off = wgid / NXCD; wgid = (xcd < r ? xcd * (q + 1) : r * (q + 1) + (xcd - r) * q) + off; }
        const int nig = WGM * nN, gid = wgid / nig, fm = gid * WGM, gsz = (nM - fm) < WGM ? (nM - fm) : WGM;
        u.pm = fm + ((wgid % nig) % gsz); u.pn = (wgid % nig) / gsz; return true;
    }
    __device__ __forceinline__ void a_ready(const Unit&) const {}
    __device__ __forceinline__ void done(const Unit&) const {}
};

__device__ __forceinline__ unsigned cvt_pk_bf16(float lo, float hi) { unsigned r; asm volatile("v_cvt_pk_bf16_f32 %0, %1, %2" : "=v"(r) : "v"(lo), "v"(hi)); return r; }
typedef float f32x2 __attribute__((ext_vector_type(2)));
__device__ __forceinline__ f32x2 gelu_pk(f32x2 v) {
    const f32x2 av = __builtin_elementwise_abs(v), d = av * 0.2316418882f + 1.0f;
    f32x2 t; t.x = __builtin_amdgcn_rcpf(d.x); t.y = __builtin_amdgcn_rcpf(d.y);
    f32x2 q = t * 0.5307027145f + (-0.7265760135f); q = q * t + 0.7107068705f; q = q * t + (-0.142248368f); q = q * t + 0.127414796f; q = q * t;
    const f32x2 s = (v * v) * (-0.72134752044f);
    f32x2 e; e.x = __builtin_amdgcn_exp2f(s.x); e.y = __builtin_amdgcn_exp2f(s.y);
    const f32x2 m = v * (q * e), r = v - m;
    f32x2 o; o.x = v.x < 0.f ? m.x : r.x; o.y = v.y < 0.f ? m.y : r.y; return o;
}

template <int ACT  > struct EpiBf16 {
    static constexpr bool PERM = true, AFTER_DRAIN = false; static_assert(ACT == 0 || ACT == 1, "EpiBf16: ACT is 0 (none) or 1 (gelu_pk)");
    bf16_t* O; int ldc; const float* bias; int split_cols; size_t split_stride; float scale0;
    __device__ __forceinline__ void operator()(const f32x4 (&acc)[2][2][4][2], const Unit& u, int wr, int wc, int fr, int fq) const {
        const int row0 = u.pm * BM + wr * 64 + fr; int colt = u.pn * BM; bf16_t* base = O;
        float sc = 1.f; if (split_cols) { const int t = colt / split_cols; base += (size_t)t * split_stride; colt -= t * split_cols; if (t == 0) sc = scale0; }
        const int col0 = colt + wc * 32 + 8 * fq, bcol0 = u.pn * BM + wc * 32 + 8 * fq;
        f32x4 bv[2][2];
#pragma unroll
        for (int bj = 0; bj < 2; ++bj)
#pragma unroll
            for (int n = 0; n < 2; ++n) bv[bj][n] = bias ? *(const f32x4*)(bias + bcol0 + bj * HALF + 4 * n) : (f32x4){0.f, 0.f, 0.f, 0.f};
#pragma unroll
        for (int ai = 0; ai < 2; ++ai)
#pragma unroll
            for (int m = 0; m < 4; ++m) { bf16_t* rowp = base + (size_t)(row0 + ai * HALF + m * 16) * ldc + col0;
#pragma unroll
                for (int bj = 0; bj < 2; ++bj) { f32x4 v0 = acc[ai][bj][m][0] + bv[bj][0], v1 = acc[ai][bj][m][1] + bv[bj][1];
                    if (ACT == 1) { f32x2 a = gelu_pk((f32x2){v0[0], v0[1]}), b = gelu_pk((f32x2){v0[2], v0[3]}), c = gelu_pk((f32x2){v1[0], v1[1]}), d = gelu_pk((f32x2){v1[2], v1[3]});
                        v0 = (f32x4){a.x, a.y, b.x, b.y}; v1 = (f32x4){c.x, c.y, d.x, d.y}; }
                    v0 = v0 * sc; v1 = v1 * sc; u32x4 w; w.x = cvt_pk_bf16(v0[0], v0[1]); w.y = cvt_pk_bf16(v0[2], v0[3]); w.z = cvt_pk_bf16(v1[0], v1[1]); w.w = cvt_pk_bf16(v1[2], v1[3]);
                    *(u32x4*)(rowp + bj * HALF) = w; } }
    }
};
template <class Epi, class Sched, bool ALIGN_EPI = false, bool SP2 = false>
__device__ __forceinline__ void gemm_phase(PG8_LAS unsigned char* lds, const Gemm g, const Sched& S, const Epi& E) {
    const int tid = threadIdx.x, wid = __builtin_amdgcn_readfirstlane(tid >> 6), lane = tid & 63, wr = wid >> 2, wc = wid & 3, fr = lane & 15, fq = lane >> 4;
    const int K = g.K, nt = K / BK;
    unsigned voffA[2], voffB[2];
#pragma unroll
    for (int i = 0; i < 2; ++i) { int R, C; stage_rc(tid * 16 + i * 8192, R, C); const int Rb = Epi::PERM ? ((R & ~31) + perm32(R & 31)) : R;
        voffA[i] = (unsigned)(R * K + C) * 2u; voffB[i] = (unsigned)(Rb * K + C) * 2u; }
    const size_t kstep = (size_t)(BK * 2);
    const size_t hstep = (size_t)HALF * K * 2;
    const size_t tstep = 2 * hstep;
    const unsigned ldsw = (unsigned)wid * 1024u;
    const int aoff = lds_byte(wr * 64 + fr, fq * 8), boff = lds_byte(wc * 32 + fr, fq * 8);
#define PG8_SA(b, h) (((b) * 2 + (h)) * HTB)
#define PG8_SB(b, h) ((4 + (b) * 2 + (h)) * HTB)
#define PG8_STAGE(bufoff, gbase, voff) do { _Pragma("unroll") for (int _i = 0; _i < 2; ++_i) \
        __builtin_amdgcn_global_load_lds((const unsigned*)((const char*)(gbase) + (voff)[_i]), (PG8_LAS unsigned*)(lds + (bufoff) + ldsw + _i * 8192), 16, 0, 0); } while (0)
#define PG8_LDA(dst, b, h) do { _Pragma("unroll") for (int m = 0; m < 4; ++m) _Pragma("unroll") for (int k = 0; k < 2; ++k) dst[m][k] = *(const PG8_LAS bf16x8*)(lds + PG8_SA(b, h) + aoff + m * 2048 + k * 1024); } while (0)
#define PG8_LDB(dst, b, h) do { _Pragma("unroll") for (int n = 0; n < 2; ++n) _Pragma("unroll") for (int k = 0; k < 2; ++k) dst[n][k] = *(const PG8_LAS bf16x8*)(lds + PG8_SB(b, h) + boff + n * 2048 + k * 1024); } while (0)
#define PG8_MMA(ai, bj, At, Bt) do { __builtin_amdgcn_s_setprio(1); _Pragma("unroll") for (int m = 0; m < 4; ++m) _Pragma("unroll") for (int n = 0; n < 2; ++n) _Pragma("unroll") for (int k = 0; k < 2; ++k) \
        acc[ai][bj][m][n] = __builtin_amdgcn_mfma_f32_16x16x32_bf16(Bt[n][k], At[m][k], acc[ai][bj][m][n], 0, 0, 0); __builtin_amdgcn_s_setprio(0); } while (0)
#define PG8_WAIT_V(n) asm volatile("s_waitcnt vmcnt(" #n ")" ::: "memory")
#define PG8_WAIT_L(n) asm volatile("s_waitcnt lgkmcnt(" #n ")" ::: "memory")
#define PG8_BAR __builtin_amdgcn_s_barrier()
#define PG8_SCHED __builtin_amdgcn_sched_barrier(0)
    Unit cur, nxt; int ui = 0;
    if (!S.next(0, cur)) return;
    f32x4 acc[2][2][4][2];
#pragma unroll
    for (int a = 0; a < 2; ++a)
#pragma unroll
        for (int b = 0; b < 2; ++b)
#pragma unroll
            for (int m = 0; m < 4; ++m)
#pragma unroll
                for (int n = 0; n < 2; ++n) acc[a][b][m][n] = (f32x4){0.f, 0.f, 0.f, 0.f};
    bf16x8 At[4][2], B0[2][2], B1[2][2];
    const char* cA = (const char*)g.A + (size_t)cur.pm * tstep; const char* cB = (const char*)g.Bt + (size_t)cur.pn * tstep;
    S.a_ready(cur);
    if constexpr (SP2) {
        PG8_STAGE(PG8_SB(0, 0), cB, voffB); PG8_STAGE(PG8_SB(0, 1), cB + hstep, voffB); PG8_STAGE(PG8_SA(0, 0), cA, voffA); PG8_STAGE(PG8_SA(0, 1), cA + hstep, voffA);
        if (wr == 1) PG8_BAR;
        PG8_WAIT_V(2); PG8_BAR;
        PG8_STAGE(PG8_SB(1, 0), cB + kstep, voffB); PG8_STAGE(PG8_SA(1, 0), cA + kstep, voffA); PG8_STAGE(PG8_SB(1, 1), cB + hstep + kstep, voffB);
        PG8_WAIT_V(6); PG8_BAR;
    } else {
        PG8_STAGE(PG8_SB(0, 0), cB, voffB); PG8_STAGE(PG8_SA(0, 0), cA, voffA); PG8_STAGE(PG8_SB(0, 1), cB + hstep, voffB); PG8_STAGE(PG8_SA(0, 1), cA + hstep, voffA);
        if (wr == 1) PG8_BAR;
        PG8_WAIT_V(4); PG8_BAR;
        PG8_STAGE(PG8_SB(1, 0), cB + kstep, voffB); PG8_STAGE(PG8_SA(1, 0), cA + kstep, voffA); PG8_STAGE(PG8_SB(1, 1), cB + hstep + kstep, voffB);
        PG8_WAIT_V(6); PG8_BAR;
    }
    for (;;) {
        const bool has_next = S.next(ui + 1, nxt);
        const char* nA = has_next ? (const char*)g.A + (size_t)nxt.pm * tstep : cA; const char* nB = has_next ? (const char*)g.Bt + (size_t)nxt.pn * tstep : cB;
        for (int t = 0; t < nt; t += 2) {
            const bool last = (t == nt - 2);
            const char* a1 = cA + (size_t)(t + 1) * kstep;
            const char* a2 = last ? nA : cA + (size_t)(t + 2) * kstep; const char* b2 = last ? nB : cB + (size_t)(t + 2) * kstep;
            const char* a3 = a2 + kstep; const char* b3 = b2 + kstep;
            if (last && has_next) S.a_ready(nxt);
            if constexpr (SP2) {
            PG8_LDB(B0, 0, 0); PG8_LDB(B1, 0, 1); PG8_SCHED; PG8_LDA(At, 0, 0); PG8_STAGE(PG8_SA(1, 1), a1 + hstep, voffA);
            PG8_WAIT_V(8); PG8_WAIT_L(0); PG8_BAR; PG8_MMA(0, 0, At, B0); PG8_MMA(0, 1, At, B1); PG8_BAR; PG8_SCHED;
            PG8_LDA(At, 0, 1); PG8_STAGE(PG8_SB(0, 0), b2, voffB); PG8_STAGE(PG8_SB(0, 1), b2 + hstep, voffB); PG8_STAGE(PG8_SA(0, 0), a2, voffA);
            PG8_WAIT_V(8); PG8_WAIT_L(0); PG8_BAR; PG8_MMA(1, 0, At, B0); PG8_MMA(1, 1, At, B1); PG8_BAR; PG8_SCHED;
            PG8_LDB(B0, 1, 0); PG8_LDB(B1, 1, 1); PG8_SCHED; PG8_LDA(At, 1, 0); PG8_STAGE(PG8_SA(0, 1), a2 + hstep, voffA);
            PG8_WAIT_V(8); PG8_WAIT_L(0); PG8_BAR; PG8_MMA(0, 0, At, B0); PG8_MMA(0, 1, At, B1); PG8_BAR; PG8_SCHED;
            PG8_LDA(At, 1, 1); PG8_STAGE(PG8_SB(1, 0), b3, voffB); PG8_STAGE(PG8_SB(1, 1), b3 + hstep, voffB); PG8_STAGE(PG8_SA(1, 0), a3, voffA);
            PG8_WAIT_V(8); PG8_WAIT_L(0); PG8_BAR; PG8_MMA(1, 0, At, B0); PG8_MMA(1, 1, At, B1); PG8_BAR; PG8_SCHED;
            } else {
            PG8_LDB(B0, 0, 0); PG8_SCHED; PG8_LDA(At, 0, 0); PG8_STAGE(PG8_SA(1, 1), a1 + hstep, voffA);
            PG8_WAIT_L(8); PG8_BAR; PG8_WAIT_L(0); PG8_MMA(0, 0, At, B0); PG8_BAR; PG8_SCHED;
            PG8_LDB(B1, 0, 1); PG8_STAGE(PG8_SB(0, 0), b2, voffB);
            PG8_BAR; PG8_WAIT_L(0); PG8_MMA(0, 1, At, B1); PG8_BAR;
            PG8_LDA(At, 0, 1); PG8_STAGE(PG8_SA(0, 0), a2, voffA);
            PG8_BAR; PG8_WAIT_L(0); PG8_MMA(1, 0, At, B0); PG8_BAR; PG8_SCHED;
            PG8_STAGE(PG8_SB(0, 1), b2 + hstep, voffB);
            PG8_WAIT_V(6); PG8_BAR; PG8_MMA(1, 1, At, B1); PG8_BAR;
            PG8_LDB(B0, 1, 0); PG8_SCHED; PG8_LDA(At, 1, 0); PG8_STAGE(PG8_SA(0, 1), a2 + hstep, voffA);
            PG8_WAIT_L(8); PG8_BAR; PG8_WAIT_L(0); PG8_MMA(0, 0, At, B0); PG8_BAR; PG8_SCHED;
            PG8_LDB(B1, 1, 1); PG8_STAGE(PG8_SB(1, 0), b3, voffB);
            PG8_BAR; PG8_WAIT_L(0); PG8_MMA(0, 1, At, B1); PG8_BAR;
            PG8_LDA(At, 1, 1); PG8_STAGE(PG8_SA(1, 0), a3, voffA);
            PG8_BAR; PG8_WAIT_L(0); PG8_MMA(1, 0, At, B0); PG8_BAR; PG8_SCHED;
            PG8_STAGE(PG8_SB(1, 1), b3 + hstep, voffB);
            PG8_WAIT_V(6); PG8_BAR; PG8_MMA(1, 1, At, B1); PG8_BAR;
            }
        }
        if constexpr (ALIGN_EPI) { if (wr == 0) PG8_BAR; }
        if constexpr (!Epi::AFTER_DRAIN) { E(acc, cur, wr, wc, fr, fq); S.done(cur); }
        if (!has_next) break;
#pragma unroll
        for (int a = 0; a < 2; ++a)
#pragma unroll
            for (int b = 0; b < 2; ++b)
#pragma unroll
                for (int m = 0; m < 4; ++m)
#pragma unroll
                    for (int n = 0; n < 2; ++n) acc[a][b][m][n] = (f32x4){0.f, 0.f, 0.f, 0.f};
        cur = nxt; cA = nA; cB = nB; ++ui;
        if constexpr (ALIGN_EPI) { if (wr == 1) PG8_BAR; }
    }
    PG8_WAIT_V(0);
    if constexpr (!ALIGN_EPI) { if (wr == 0) PG8_BAR; }
    PG8_BAR;
    if constexpr (Epi::AFTER_DRAIN) { E.fused(acc, cur, wr, wc, fr, fq, lds, wid, lane); S.done(cur); }
#undef PG8_SA
#undef PG8_SB
#undef PG8_STAGE
#undef PG8_LDA
#undef PG8_LDB
#undef PG8_MMA
#undef PG8_WAIT_V
#undef PG8_WAIT_L
#undef PG8_BAR
#undef PG8_SCHED
}
}
namespace hy {
typedef unsigned short bf16_t;
typedef unsigned u32x4 __attribute__((ext_vector_type(4)));
typedef unsigned u32x2 __attribute__((ext_vector_type(2)));
typedef float f32x4 __attribute__((ext_vector_type(4)));
constexpr int M = 16384, S = 8192, D = 1024, NL = 4;
constexpr int IN_COLS = 1824, P1W = 2048, P2W = 1536;
constexpr float EPS = 1e-6f, LOG2E = 1.4426950408889634f;
constexpr int MODW = 6 * D;

__device__ __forceinline__ float bf2f(bf16_t v) { return __uint_as_float(((unsigned)v) << 16); }
__device__ __forceinline__ bf16_t f2bf(float f) { unsigned u = __float_as_uint(f); return (bf16_t)((u + 0x7fffu + ((u >> 16) & 1u)) >> 16); }
__device__ __forceinline__ unsigned pk2(float lo, float hi) { return (unsigned)f2bf(lo) | ((unsigned)f2bf(hi) << 16); }
__device__ __forceinline__ float lo16(unsigned w) { return __uint_as_float(w << 16); }
__device__ __forceinline__ float hi16(unsigned w) { return __uint_as_float(w & 0xffff0000u); }
__device__ __forceinline__ float wave_sum(float v) {
#pragma unroll
    for (int o = 1; o < 64; o <<= 1) v += __shfl_xor(v, o);
    return v;
}
__device__ __forceinline__ float gelu_tanh(float x) {
    const float k0 = 0.7978845608028654f, k1 = 0.044715f;
    float t = k0 * (x + k1 * x * x * x);
    float e = __expf(2.f * t);
    float th = 1.f - 2.f / (e + 1.f);
    return 0.5f * x * (1.f + th);
}

constexpr size_t MiB = 1ull << 20;
constexpr size_t WS_CTL = 0;
constexpr size_t WS_MOD = 1 * MiB;
constexpr size_t WS_BIAS = WS_MOD + 256 * 1024;
constexpr size_t WS_ROPE = 2 * MiB;
constexpr size_t WS_SQ = 3 * MiB;
constexpr size_t WS_WIN = 4 * MiB;
constexpr size_t WS_W2 = WS_WIN + 16 * MiB;
constexpr size_t WS_WOUT = WS_W2 + 6 * MiB;
constexpr size_t WS_WQ = WS_WOUT + 8 * MiB;
constexpr size_t WS_WGLU = WS_WQ + 16 * MiB;
constexpr size_t WS_SUBK = WS_WGLU + 1 * MiB;
constexpr size_t WS_PU = 64 * MiB;
constexpr size_t WS_PV = WS_PU + 128 * MiB;
constexpr size_t WS_ACT = 320 * MiB;
constexpr size_t WS_H = WS_ACT;
constexpr size_t WS_P1 = WS_H + 32 * MiB;
constexpr size_t WS_QA = WS_P1 + 64 * MiB;
constexpr size_t WS_KA = WS_QA + 12 * MiB;
constexpr size_t WS_VA = WS_KA + 12 * MiB;
constexpr size_t WS_U = WS_VA + 12 * MiB;
constexpr size_t WS_CQKV = WS_U + 8 * MiB;
constexpr size_t WS_P2 = WS_CQKV + 12 * MiB;
constexpr size_t WS_QM = WS_P2 + 48 * MiB;
constexpr size_t WS_KM = WS_QM + 18 * MiB;
constexpr size_t WS_VM = WS_KM + 18 * MiB;
constexpr size_t WS_YA = WS_VM + 12 * MiB;
constexpr size_t WS_YC = WS_YA + 12 * MiB;
constexpr size_t WS_GS = WS_YC + 12 * MiB;
constexpr size_t WS_GL = WS_GS + 8 * MiB;
constexpr size_t WS_AOUT = WS_GL + 8 * MiB;
constexpr size_t WS_QP = WS_AOUT + 32 * MiB;
constexpr size_t WS_EIDX = WS_QP + 64 * MiB;
constexpr size_t WS_GATE = WS_EIDX + 8 * MiB;
constexpr size_t WS_TOPS = WS_GATE + 8 * MiB;
constexpr size_t WS_TOPI = WS_TOPS + 16 * MiB;
constexpr size_t WS_XST = WS_TOPI + 16 * MiB;
constexpr size_t WS_END = WS_XST + 128 * MiB;

struct In {
    const float *x, *c, *w_in, *w_out, *mix_gain, *norm1_gain, *norm2_gain, *w_ada, *b_ada, *rel_bias, *swa_q_gain, *swa_k_gain,
        *mla_q_lora_gain, *mla_kv_lora_gain, *w_uq, *w_ukv, *mla_q_gain, *mla_k_gain, *s5_a_re, *s5_a_im, *s5_b_re, *s5_b_im, *s5_c_re,
        *s5_c_im, *s5_d, *s5_log_dt, *w_glu, *b_glu, *peer_wq, *peer_subkeys, *peer_u, *peer_v;
};

__global__ void __launch_bounds__(256) k_mod(const float* __restrict__ c, const float* __restrict__ w_ada, const float* __restrict__ b_ada, float* __restrict__ mod) {
    __shared__ float ca[2][D];
    for (int i = threadIdx.x; i < 2 * D; i += 256) { float v = c[i]; ca[i / D][i % D] = v / (1.f + __expf(-v)); }
    __syncthreads();
    const int gid = blockIdx.x * 256 + threadIdx.x;
    const int l = gid / MODW, n = gid % MODW;
    const float* w = w_ada + (size_t)l * D * MODW + n;
    float a0 = 0.f, a1 = 0.f;
#pragma unroll 8
    for (int k = 0; k < D; ++k) { float wv = w[(size_t)k * MODW]; a0 += ca[0][k] * wv; a1 += ca[1][k] * wv; }
    const float bb = b_ada[l * MODW + n];
    mod[(l * 2 + 0) * MODW + n] = a0 + bb;
    mod[(l * 2 + 1) * MODW + n] = a1 + bb;
}

__device__ __forceinline__ int t5_bucket(int dist) {
    if (dist < 16) return dist;
    float df = (float)dist;
    float v = logf(df / 16.f) / 4.852030263919617f * 16.f;
    int large = 16 + (int)v;
    return large < 31 ? large : 31;
}
__global__ void __launch_bounds__(256) k_tables(const float* __restrict__ rel_bias, float* __restrict__ bias, float* __restrict__ rope) {
    const int gid = blockIdx.x * 256 + threadIdx.x;
    if (gid < 3 * 6 * 132) {
        const int br = gid / (6 * 132), h = (gid / 132) % 6, j = gid % 132;
        const int dil = br == 0 ? 1 : (br == 1 ? 4 : 16);
        float v = 0.f;
        if (j <= 128) v = rel_bias[h * 32 + t5_bucket(dil * j)] * LOG2E;
        bias[gid] = v;
    }
    if (gid < S * 16) {
        const int pos = gid / 16, i = gid % 16;
        const float inv = (float)pow(10000.0, -(double)(2 * i) / 32.0);
        const float ang = (float)pos * inv;
        rope[gid] = (float)cos((double)ang);
        rope[S * 16 + gid] = (float)sin((double)ang);
    }
}

struct TC { const float* src; size_t src_lstride; int ld_src; int K_src; bf16_t* dst; size_t dst_lstride; int ld_dst; int k_off; int n_valid; int mode; const float* kscale; int kscale_lstride; };
__global__ void __launch_bounds__(256) k_tconv(TC p) {
    __shared__ float t[64][65];
    const int l = blockIdx.z, n0 = blockIdx.x * 64, k0 = blockIdx.y * 64, tid = threadIdx.x;
    const float* src = p.src + (size_t)l * p.src_lstride;
    bf16_t* dst = p.dst + (size_t)l * p.dst_lstride;
    const int nn = tid & 63, n = n0 + nn;
    int col;
    if (p.mode == 0) col = n < p.n_valid ? n : -1;
    else { const int hh = n >> 7, e = n & 127; col = e < 96 ? hh * 96 + e : -1; }
#pragma unroll
    for (int i = 0; i < 16; ++i) {
        const int kk = i * 4 + (tid >> 6), k = k0 + kk;
        float v = col >= 0 ? src[(size_t)k * p.ld_src + col] : 0.f;
        if (p.kscale) v *= p.kscale[l * p.kscale_lstride + k];
        t[kk][nn] = v;
    }
    __syncthreads();
    const int nl = tid >> 2, kc = (tid & 3) * 16;
    u32x4 o0, o1;
    o0.x = pk2(t[kc + 0][nl], t[kc + 1][nl]); o0.y = pk2(t[kc + 2][nl], t[kc + 3][nl]); o0.z = pk2(t[kc + 4][nl], t[kc + 5][nl]); o0.w = pk2(t[kc + 6][nl], t[kc + 7][nl]);
    o1.x = pk2(t[kc + 8][nl], t[kc + 9][nl]); o1.y = pk2(t[kc + 10][nl], t[kc + 11][nl]); o1.z = pk2(t[kc + 12][nl], t[kc + 13][nl]); o1.w = pk2(t[kc + 14][nl], t[kc + 15][nl]);
    bf16_t* o = dst + (size_t)(n0 + nl) * p.ld_dst + p.k_off + k0 + kc;
    *(u32x4*)o = o0; *(u32x4*)(o + 8) = o1;
}
__global__ void __launch_bounds__(256) k_cvt(const float* __restrict__ src, bf16_t* __restrict__ dst, size_t n8) {
    for (size_t i = (size_t)blockIdx.x * 256 + threadIdx.x; i < n8; i += (size_t)gridDim.x * 256) {
        const f32x4 a = *(const f32x4*)(src + i * 8), b = *(const f32x4*)(src + i * 8 + 4);
        u32x4 o; o.x = pk2(a[0], a[1]); o.y = pk2(a[2], a[3]); o.z = pk2(b[0], b[1]); o.w = pk2(b[2], b[3]);
        *(u32x4*)(dst + i * 8) = o;
    }
}

__global__ void __launch_bounds__(256) k_normmod(const float* __restrict__ x, const float* __restrict__ gain, const float* __restrict__ modl, int sh_off, int sc_off, bf16_t* __restrict__ H) {
    const int lane = threadIdx.x & 63, m = blockIdx.x * 4 + (threadIdx.x >> 6), b = m >> 13;
    const float* xr = x + (size_t)m * D;
    f32x4 v[4]; float ss = 0.f;
#pragma unroll
    for (int j = 0; j < 4; ++j) { v[j] = *(const f32x4*)(xr + j * 256 + lane * 4); ss += v[j][0] * v[j][0] + v[j][1] * v[j][1] + v[j][2] * v[j][2] + v[j][3] * v[j][3]; }
    const float r = rsqrtf(wave_sum(ss) * (1.f / D) + EPS);
    const float* sh = modl + b * MODW + sh_off; const float* sc = modl + b * MODW + sc_off;
#pragma unroll
    for (int j = 0; j < 4; ++j) {
        const int c0 = j * 256 + lane * 4;
        const f32x4 g = *(const f32x4*)(gain + c0), s1 = *(const f32x4*)(sc + c0), s0 = *(const f32x4*)(sh + c0);
        float o[4];
#pragma unroll
        for (int e = 0; e < 4; ++e) o[e] = v[j][e] * r * g[e] * (1.f + s1[e]) + s0[e];
        u32x2 w; w.x = pk2(o[0], o[1]); w.y = pk2(o[2], o[3]);
        *(u32x2*)(H + (size_t)m * D + c0) = w;
    }
}

struct Post1 { const bf16_t* raw; const float* gq; const float* gk; const float* kgain; const float* rope; bf16_t *QA, *KA, *VA, *U, *CQKV, *KM; float* SQ; };
__global__ void __launch_bounds__(256) k_post1(Post1 p) {
    const int lane = threadIdx.x & 63, m = blockIdx.x * 4 + (threadIdx.x >> 6), pos = m & (S - 1);
    const bf16_t* r = p.raw + (size_t)m * P1W;
    const float gq = p.gq[lane], gk = p.gk[lane];
#pragma unroll
    for (int hh = 0; hh < 6; ++hh) {
        float v = bf2f(r[hh * 64 + lane]);
        float rr = rsqrtf(wave_sum(v * v) * (1.f / 64.f) + EPS);
        p.QA[(size_t)m * 384 + hh * 64 + lane] = f2bf(v * rr * gq * (0.125f * LOG2E));
        v = bf2f(r[384 + hh * 64 + lane]);
        rr = rsqrtf(wave_sum(v * v) * (1.f / 64.f) + EPS);
        p.KA[(size_t)m * 384 + hh * 64 + lane] = f2bf(v * rr * gk);
        p.VA[(size_t)m * 384 + hh * 64 + lane] = r[768 + hh * 64 + lane];
    }
    float ss = 0.f;
#pragma unroll
    for (int j = 0; j < 4; ++j) {
        p.U[(size_t)m * 256 + j * 64 + lane] = r[1152 + j * 64 + lane];
        const bf16_t w = r[1408 + j * 64 + lane]; const float v = bf2f(w); ss += v * v;
        p.CQKV[(size_t)m * 384 + j * 64 + lane] = w;
    }
    const float sq = rsqrtf(wave_sum(ss) * (1.f / 256.f) + EPS);
    ss = 0.f;
#pragma unroll
    for (int j = 0; j < 2; ++j) {
        const bf16_t w = r[1664 + j * 64 + lane]; const float v = bf2f(w); ss += v * v;
        p.CQKV[(size_t)m * 384 + 256 + j * 64 + lane] = w;
    }
    const float skv = rsqrtf(wave_sum(ss) * (1.f / 128.f) + EPS);
    if (lane == 0) { p.SQ[m] = sq; p.SQ[M + m] = skv; }
    {
        const int l31 = lane & 31;
        float v = lane < 32 ? bf2f(r[1792 + l31]) : 0.f;
        const float rr = rsqrtf(wave_sum(v * v) * (1.f / 32.f) + EPS);
        const float n = v * rr * p.kgain[64 + l31];
        const float pr = __shfl_xor(n, 16);
        const int i = lane & 15;
        const float cs = p.rope[pos * 16 + i], sn = p.rope[S * 16 + pos * 16 + i];
        const float o = (l31 < 16) ? (n * cs - pr * sn) : (pr * sn + n * cs);
        if (lane < 32) {
            const bf16_t ob = f2bf(o);
#pragma unroll
            for (int hh = 0; hh < 6; ++hh) p.KM[(size_t)m * 576 + hh * 96 + 64 + l31] = ob;
        }
    }
}

struct Post2 { const bf16_t* raw; const float* SQ; const float* qgain; const float* kgain; const float* rope; bf16_t *QM, *KM, *VM; };
__global__ void __launch_bounds__(256) k_post2(Post2 p) {
    const int lane = threadIdx.x & 63, m = blockIdx.x * 4 + (threadIdx.x >> 6), pos = m & (S - 1);
    const bf16_t* r = p.raw + (size_t)m * P2W;
    const float sq = p.SQ[m], skv = p.SQ[M + m];
    const float SCQ = 0.10206207261596575f * LOG2E;
    const int l31 = lane & 31, i = lane & 15;
    const float cs = p.rope[pos * 16 + i], sn = p.rope[S * 16 + pos * 16 + i];
    const float gqn = p.qgain[lane], gqr = p.qgain[64 + l31], gkn = p.kgain[lane];
#pragma unroll
    for (int hh = 0; hh < 6; ++hh) {
        float v = sq * bf2f(r[hh * 128 + lane]);
        float rr = rsqrtf(wave_sum(v * v) * (1.f / 64.f) + EPS);
        p.QM[(size_t)m * 576 + hh * 96 + lane] = f2bf(v * rr * gqn * SCQ);
        v = lane < 32 ? sq * bf2f(r[hh * 128 + 64 + l31]) : 0.f;
        rr = rsqrtf(wave_sum(v * v) * (1.f / 32.f) + EPS);
        const float n = v * rr * gqr;
        const float pr = __shfl_xor(n, 16);
        const float o = (l31 < 16) ? (n * cs - pr * sn) : (pr * sn + n * cs);
        if (lane < 32) p.QM[(size_t)m * 576 + hh * 96 + 64 + l31] = f2bf(o * SCQ);
        v = skv * bf2f(r[768 + hh * 128 + lane]);
        rr = rsqrtf(wave_sum(v * v) * (1.f / 64.f) + EPS);
        p.KM[(size_t)m * 576 + hh * 96 + lane] = f2bf(v * rr * gkn);
        p.VM[(size_t)m * 384 + hh * 64 + lane] = f2bf(skv * bf2f(r[768 + hh * 128 + 64 + lane]));
    }
}
__global__ void __launch_bounds__(256) k_mla_naive(const bf16_t* __restrict__ Q, const bf16_t* __restrict__ K, const bf16_t* __restrict__ V, bf16_t* __restrict__ O) {
    const int bh = blockIdx.x / 32, qb = blockIdx.x % 32, b = bh / 6, h = bh % 6;
    const int qpos = qb * 256 + threadIdx.x;
    const size_t m = (size_t)b * S + qpos;
    float q[96], o[64];
    {
        const unsigned* qp = (const unsigned*)(Q + m * 576 + h * 96);
#pragma unroll
        for (int i = 0; i < 48; ++i) { const unsigned w = qp[i]; q[2 * i] = lo16(w); q[2 * i + 1] = hi16(w); }
    }
#pragma unroll
    for (int i = 0; i < 64; ++i) o[i] = 0.f;
    float mx = -INFINITY, l = 0.f;
    const int jend = qb * 256 + 256;
    for (int j = 0; j < jend; ++j) {
        const unsigned* kp = (const unsigned*)(K + ((size_t)b * S + j) * 576 + h * 96);
        float s = 0.f;
#pragma unroll
        for (int i = 0; i < 48; ++i) { const unsigned w = kp[i]; s += q[2 * i] * lo16(w) + q[2 * i + 1] * hi16(w); }
        if (j <= qpos) {
            const float mn = fmaxf(mx, s), corr = exp2f(mx - mn), pexp = exp2f(s - mn);
            l = l * corr + pexp; mx = mn;
            const unsigned* vp = (const unsigned*)(V + ((size_t)b * S + j) * 384 + h * 64);
#pragma unroll
            for (int i = 0; i < 32; ++i) { const unsigned w = vp[i]; o[2 * i] = o[2 * i] * corr + pexp * lo16(w); o[2 * i + 1] = o[2 * i + 1] * corr + pexp * hi16(w); }
        }
    }
    const float il = 1.f / l;
    unsigned* op = (unsigned*)(O + m * 384 + h * 64);
#pragma unroll
    for (int i = 0; i < 32; ++i) op[i] = pk2(o[2 * i] * il, o[2 * i + 1] * il);
}

__global__ void __launch_bounds__(256) k_swa_naive(const bf16_t* __restrict__ Q, const bf16_t* __restrict__ K, const bf16_t* __restrict__ V, const float* __restrict__ bias, bf16_t* __restrict__ O) {
    const int bh = blockIdx.x / 32, qb = blockIdx.x % 32, b = bh / 6, h = bh % 6;
    const int pos = qb * 256 + threadIdx.x;
    const size_t m = (size_t)b * S + pos;
    float q[64], o[64];
    {
        const unsigned* qp = (const unsigned*)(Q + m * 384 + h * 64);
#pragma unroll
        for (int i = 0; i < 32; ++i) { const unsigned w = qp[i]; q[2 * i] = lo16(w); q[2 * i + 1] = hi16(w); }
    }
#pragma unroll
    for (int i = 0; i < 64; ++i) o[i] = 0.f;
    float mx = -INFINITY, l = 0.f;
    for (int br = 0; br < 3; ++br) {
        const int dil = br == 0 ? 1 : (br == 1 ? 4 : 16);
        const float* bt = bias + (br * 6 + h) * 132;
        for (int j = 0; j <= 128; ++j) {
            const int kpos = pos - j * dil;
            if (kpos < 0) break;
            const size_t km = (size_t)b * S + kpos;
            const unsigned* kp = (const unsigned*)(K + km * 384 + h * 64);
            float s = bt[j];
#pragma unroll
            for (int i = 0; i < 32; ++i) { const unsigned w = kp[i]; s += q[2 * i] * lo16(w) + q[2 * i + 1] * hi16(w); }
            const float mn = fmaxf(mx, s), corr = exp2f(mx - mn), pexp = exp2f(s - mn);
            l = l * corr + pexp; mx = mn;
            const unsigned* vp = (const unsigned*)(V + km * 384 + h * 64);
#pragma unroll
            for (int i = 0; i < 32; ++i) { const unsigned w = vp[i]; o[2 * i] = o[2 * i] * corr + pexp * lo16(w); o[2 * i + 1] = o[2 * i + 1] * corr + pexp * hi16(w); }
        }
    }
    const float il = 1.f / l;
    unsigned* op = (unsigned*)(O + m * 384 + h * 64);
#pragma unroll
    for (int i = 0; i < 32; ++i) op[i] = pk2(o[2 * i] * il, o[2 * i + 1] * il);
}

struct S5P { const float *a_re, *a_im, *b_re, *b_im, *c_re, *c_im, *d, *log_dt; };
__global__ void __launch_bounds__(64) k_s5_scan(S5P s, const bf16_t* __restrict__ U, float* __restrict__ XST) {
    const int b = blockIdx.x / 16, g = blockIdx.x % 16, p = threadIdx.x;
    const float dt = expf(s.log_dt[g]);
    const float are = s.a_re[g * 64 + p], aim = s.a_im[g * 64 + p];
    const float mag = expf(are * dt);
    const float lr = mag * cosf(aim * dt), li = mag * sinf(aim * dt);
    const float den = are * are + aim * aim, nr = lr - 1.f, ni = li;
    const float cr = (nr * are + ni * aim) / den, ci = (ni * are - nr * aim) / den;
    float bbr[16], bbi[16];
#pragma unroll
    for (int c = 0; c < 16; ++c) {
        const float br_ = s.b_re[(g * 64 + p) * 16 + c], bi_ = s.b_im[(g * 64 + p) * 16 + c];
        bbr[c] = cr * br_ - ci * bi_; bbi[c] = cr * bi_ + ci * br_;
    }
    float xr = 0.f, xi = 0.f;
    for (int t = 0; t < S; ++t) {
        const size_t m = (size_t)b * S + t;
        const unsigned* up = (const unsigned*)(U + m * 256 + g * 16);
        float ur = 0.f, ui = 0.f;
#pragma unroll
        for (int c2 = 0; c2 < 8; ++c2) { const unsigned w = up[c2]; const float u0 = lo16(w), u1 = hi16(w);
            ur += bbr[2 * c2] * u0 + bbr[2 * c2 + 1] * u1; ui += bbi[2 * c2] * u0 + bbi[2 * c2 + 1] * u1; }
        const float nxr = lr * xr - li * xi + ur, nxi = lr * xi + li * xr + ui;
        xr = nxr; xi = nxi;
        float2 st; st.x = xr; st.y = xi;
        *(float2*)(XST + ((m * 16 + g) * 64 + p) * 2) = st;
    }
}
__global__ void __launch_bounds__(256) k_s5_out(S5P s, const bf16_t* __restrict__ U, const float* __restrict__ XST, bf16_t* __restrict__ GS) {
    const size_t gid = (size_t)blockIdx.x * 256 + threadIdx.x;
    const size_t m = gid >> 8; const int ch = (int)(gid & 255), g = ch >> 4, c = ch & 15;
    const float* xs = XST + (m * 16 + g) * 128;
    const float* crp = s.c_re + (g * 16 + c) * 64; const float* cip = s.c_im + (g * 16 + c) * 64;
    float y = 0.f;
#pragma unroll 8
    for (int p = 0; p < 64; ++p) y += crp[p] * xs[2 * p] - cip[p] * xs[2 * p + 1];
    y += s.d[ch] * bf2f(U[m * 256 + ch]);
    GS[m * 256 + ch] = f2bf(gelu_tanh(y));
}

__global__ void __launch_bounds__(256) k_merge(const bf16_t* __restrict__ YA, const bf16_t* __restrict__ GS, const bf16_t* __restrict__ GL, const float* __restrict__ b_glu, const bf16_t* __restrict__ YC, bf16_t* __restrict__ AOUT) {
    const int lane = threadIdx.x & 63; const size_t m = (size_t)blockIdx.x * 4 + (threadIdx.x >> 6);
    float v[6]; float ss = 0.f;
#pragma unroll
    for (int j = 0; j < 6; ++j) { v[j] = bf2f(YA[m * 384 + j * 64 + lane]); ss += v[j] * v[j]; }
    float r = rsqrtf(wave_sum(ss) * (1.f / 384.f) + EPS);
#pragma unroll
    for (int j = 0; j < 6; ++j) AOUT[m * D + j * 64 + lane] = f2bf(v[j] * r);
    ss = 0.f;
#pragma unroll
    for (int j = 0; j < 4; ++j) { const float g = bf2f(GS[m * 256 + j * 64 + lane]); const float z = bf2f(GL[m * 256 + j * 64 + lane]) + b_glu[j * 64 + lane];
        v[j] = g / (1.f + __expf(-z)); ss += v[j] * v[j]; }
    r = rsqrtf(wave_sum(ss) * (1.f / 256.f) + EPS);
#pragma unroll
    for (int j = 0; j < 4; ++j) AOUT[m * D + 384 + j * 64 + lane] = f2bf(v[j] * r);
    ss = 0.f;
#pragma unroll
    for (int j = 0; j < 6; ++j) { v[j] = bf2f(YC[m * 384 + j * 64 + lane]); ss += v[j] * v[j]; }
    r = rsqrtf(wave_sum(ss) * (1.f / 384.f) + EPS);
#pragma unroll
    for (int j = 0; j < 6; ++j) AOUT[m * D + 640 + j * 64 + lane] = f2bf(v[j] * r);
}

__global__ void __launch_bounds__(64) k_peer_scores(const bf16_t* __restrict__ QP, const bf16_t* __restrict__ SUBK, float* __restrict__ TOPS, int* __restrict__ TOPI) {
    __shared__ float sc[64][129];
    const int tid = threadIdx.x; const size_t m = (size_t)blockIdx.x * 4 + (tid >> 4); const int hj = tid & 15;
    const u32x4* qp = (const u32x4*)(QP + m * 2048 + hj * 128);
    const bf16_t* sk = SUBK + (size_t)hj * 128 * 128;
    for (int key = 0; key < 128; ++key) {
        const u32x4* kp = (const u32x4*)(sk + key * 128);
        float s = 0.f;
#pragma unroll 4
        for (int d8 = 0; d8 < 16; ++d8) {
            const u32x4 a = qp[d8], bq = kp[d8];
            s += lo16(a.x) * lo16(bq.x) + hi16(a.x) * hi16(bq.x) + lo16(a.y) * lo16(bq.y) + hi16(a.y) * hi16(bq.y)
               + lo16(a.z) * lo16(bq.z) + hi16(a.z) * hi16(bq.z) + lo16(a.w) * lo16(bq.w) + hi16(a.w) * hi16(bq.w);
        }
        sc[tid][key] = s;
    }
    for (int r = 0; r < 16; ++r) {
        float best = -INFINITY; int bi = 0;
        for (int key = 0; key < 128; ++key) { const float v = sc[tid][key]; if (v > best) { best = v; bi = key; } }
        sc[tid][bi] = -INFINITY;
        TOPS[(m * 16 + hj) * 16 + r] = best; TOPI[(m * 16 + hj) * 16 + r] = bi;
    }
}
__global__ void __launch_bounds__(64) k_peer_combine(const float* __restrict__ TOPS, const int* __restrict__ TOPI, int* __restrict__ EIDX, float* __restrict__ GATE) {
    __shared__ float cand[64][257];
    __shared__ float bs[64][17];
    const int tid = threadIdx.x; const size_t mh = (size_t)blockIdx.x * 64 + tid;
    const float* s1 = TOPS + (mh * 2 + 0) * 16; const float* s2 = TOPS + (mh * 2 + 1) * 16;
    const int* i1 = TOPI + (mh * 2 + 0) * 16; const int* i2 = TOPI + (mh * 2 + 1) * 16;
    for (int a = 0; a < 16; ++a) for (int b2 = 0; b2 < 16; ++b2) cand[tid][a * 16 + b2] = s1[a] + s2[b2];
    float mxv = -INFINITY;
    for (int r = 0; r < 16; ++r) {
        float best = -INFINITY; int bi = 0;
        for (int c = 0; c < 256; ++c) { const float v = cand[tid][c]; if (v > best) { best = v; bi = c; } }
        cand[tid][bi] = -INFINITY;
        bs[tid][r] = best; if (r == 0) mxv = best;
        EIDX[mh * 16 + r] = i1[bi >> 4] * 128 + i2[bi & 15];
    }
    float sum = 0.f;
    for (int r = 0; r < 16; ++r) { const float e = __expf(bs[tid][r] - mxv); bs[tid][r] = e; sum += e; }
    const float inv = 1.f / sum;
    for (int r = 0; r < 16; ++r) GATE[mh * 16 + r] = bs[tid][r] * inv;
}
__global__ void __launch_bounds__(256) k_peer_gather(const bf16_t* __restrict__ H, const int* __restrict__ EIDX, const float* __restrict__ GATE, const bf16_t* __restrict__ PU, const bf16_t* __restrict__ PV,
                                                     const float* __restrict__ g2, const float* xin, float* xout) {
    const int lane = threadIdx.x & 63; const size_t m = (size_t)blockIdx.x * 4 + (threadIdx.x >> 6); const int b = (int)(m >> 13);
    float hx[16], acc[16];
    {
        const u32x4 a = *(const u32x4*)(H + m * D + lane * 8), c = *(const u32x4*)(H + m * D + 512 + lane * 8);
        hx[0] = lo16(a.x); hx[1] = hi16(a.x); hx[2] = lo16(a.y); hx[3] = hi16(a.y); hx[4] = lo16(a.z); hx[5] = hi16(a.z); hx[6] = lo16(a.w); hx[7] = hi16(a.w);
        hx[8] = lo16(c.x); hx[9] = hi16(c.x); hx[10] = lo16(c.y); hx[11] = hi16(c.y); hx[12] = lo16(c.z); hx[13] = hi16(c.z); hx[14] = lo16(c.w); hx[15] = hi16(c.w);
    }
#pragma unroll
    for (int i = 0; i < 16; ++i) acc[i] = 0.f;
    for (int e = 0; e < 128; ++e) {
        const int idx = EIDX[m * 128 + e]; const float gt = GATE[m * 128 + e];
        const bf16_t* ur = PU + (size_t)idx * D; const bf16_t* vr = PV + (size_t)idx * D;
        const u32x4 a = *(const u32x4*)(ur + lane * 8), c = *(const u32x4*)(ur + 512 + lane * 8);
        const u32x4 va = *(const u32x4*)(vr + lane * 8), vc = *(const u32x4*)(vr + 512 + lane * 8);
        float s = hx[0] * lo16(a.x) + hx[1] * hi16(a.x) + hx[2] * lo16(a.y) + hx[3] * hi16(a.y) + hx[4] * lo16(a.z) + hx[5] * hi16(a.z) + hx[6] * lo16(a.w) + hx[7] * hi16(a.w)
                + hx[8] * lo16(c.x) + hx[9] * hi16(c.x) + hx[10] * lo16(c.y) + hx[11] * hi16(c.y) + hx[12] * lo16(c.z) + hx[13] * hi16(c.z) + hx[14] * lo16(c.w) + hx[15] * hi16(c.w);
        s = wave_sum(s);
        const float cf = gt * gelu_tanh(s);
        acc[0] += cf * lo16(va.x); acc[1] += cf * hi16(va.x); acc[2] += cf * lo16(va.y); acc[3] += cf * hi16(va.y); acc[4] += cf * lo16(va.z); acc[5] += cf * hi16(va.z); acc[6] += cf * lo16(va.w); acc[7] += cf * hi16(va.w);
        acc[8] += cf * lo16(vc.x); acc[9] += cf * hi16(vc.x); acc[10] += cf * lo16(vc.y); acc[11] += cf * hi16(vc.y); acc[12] += cf * lo16(vc.z); acc[13] += cf * hi16(vc.z); acc[14] += cf * lo16(vc.w); acc[15] += cf * hi16(vc.w);
    }
    const float* g = g2 + b * MODW;
#pragma unroll
    for (int hlf = 0; hlf < 2; ++hlf)
#pragma unroll
        for (int q4 = 0; q4 < 2; ++q4) {
            const int c0 = hlf * 512 + lane * 8 + q4 * 4;
            const f32x4 xi = *(const f32x4*)(xin + m * D + c0), gg = *(const f32x4*)(g + c0);
            f32x4 o;
#pragma unroll
            for (int e = 0; e < 4; ++e) o[e] = xi[e] + gg[e] * acc[hlf * 8 + q4 * 4 + e];
            *(f32x4*)(xout + m * D + c0) = o;
        }
}
}
namespace hy {
struct EpiResid {
    static constexpr bool PERM = false, AFTER_DRAIN = false;
    const float* xin; float* xout; const float* gate;
    __device__ __forceinline__ void operator()(const pg8::f32x4 (&acc)[2][2][4][2], const pg8::Unit& u, int wr, int wc, int fr, int fq) const {
        const int row0 = u.pm * 256 + wr * 64 + fr, b = (u.pm * 256) >> 13;
        const int col0 = u.pn * 256 + wc * 32 + 4 * fq;
        const float* g = gate + b * MODW;
#pragma unroll
        for (int bj = 0; bj < 2; ++bj)
#pragma unroll
            for (int n = 0; n < 2; ++n) {
                const int col = col0 + bj * 128 + n * 16;
                const pg8::f32x4 gv = *(const pg8::f32x4*)(g + col);
#pragma unroll
                for (int ai = 0; ai < 2; ++ai)
#pragma unroll
                    for (int m = 0; m < 4; ++m) {
                        const size_t off = (size_t)(row0 + ai * 128 + m * 16) * D + col;
                        const pg8::f32x4 xi = *(const pg8::f32x4*)(xin + off);
                        *(pg8::f32x4*)(xout + off) = xi + gv * acc[ai][bj][m][n];
                    }
            }
    }
};
template <class Epi>
__global__ void __launch_bounds__(512, 2) k_gemm(pg8::Gemm g, Epi e) {
    extern __shared__ __attribute__((aligned(16))) unsigned char lds[];
    pg8::StaticOrder So; So.init(g.M, g.N, (int)gridDim.x, (int)blockIdx.x);
    pg8::gemm_phase<Epi, pg8::StaticOrder, true, true>((PG8_LAS unsigned char*)lds, g, So, e);
}
constexpr int GEMM_LDS = 131072;
template <class Epi> static void launch_gemm(const bf16_t* A, const bf16_t* Bt, int Mm, int Nn, int Kk, const Epi& e, hipStream_t st) {
    pg8::Gemm g; memset(&g, 0, sizeof(g)); g.A = A; g.Bt = Bt; g.M = Mm; g.N = Nn; g.K = Kk;
    hipLaunchKernelGGL(k_gemm<Epi>, dim3(256), dim3(512), GEMM_LDS, st, g, e);
}
static void launch_gemm_bf16(const bf16_t* A, const bf16_t* Bt, int Mm, int Nn, int Kk, bf16_t* O, hipStream_t st) {
    pg8::EpiBf16<0> e; memset(&e, 0, sizeof(e)); e.O = O; e.ldc = Nn; e.bias = nullptr; e.split_cols = 0; e.split_stride = 0; e.scale0 = 1.f;
    launch_gemm(A, Bt, Mm, Nn, Kk, e, st);
}
}

extern "C" void kernel_launch(void* const* d_in, const int* in_sizes, int n_in, void* d_out, int out_size, void* d_ws, size_t ws_size, hipStream_t stream) {
    using namespace hy;
    static int inited = 0;
    if (!inited) {
        if (n_in != 32 || out_size != M * D || ws_size < WS_END) { fprintf(stderr, "kernel_launch: unexpected problem (n_in %d out %d ws %zu)\n", n_in, out_size, ws_size); inited = -1; return; }
        (void)hipFuncSetAttribute((const void*)k_gemm<pg8::EpiBf16<0>>, hipFuncAttributeMaxDynamicSharedMemorySize, GEMM_LDS);
        (void)hipFuncSetAttribute((const void*)k_gemm<EpiResid>, hipFuncAttributeMaxDynamicSharedMemorySize, GEMM_LDS);
        inited = 1;
    }
    if (inited < 0) return;
    In in; { const float** p = (const float**)&in; for (int i = 0; i < 32; ++i) p[i] = (const float*)d_in[i]; }
    unsigned char* ws = (unsigned char*)d_ws; float* out = (float*)d_out;
    float* MOD = (float*)(ws + WS_MOD); float* BIAS = (float*)(ws + WS_BIAS); float* ROPE = (float*)(ws + WS_ROPE); float* SQ = (float*)(ws + WS_SQ);
    bf16_t *WIN = (bf16_t*)(ws + WS_WIN), *W2 = (bf16_t*)(ws + WS_W2), *WOUT = (bf16_t*)(ws + WS_WOUT), *WQ = (bf16_t*)(ws + WS_WQ), *WGLU = (bf16_t*)(ws + WS_WGLU), *SUBK = (bf16_t*)(ws + WS_SUBK);
    bf16_t *PU = (bf16_t*)(ws + WS_PU), *PV = (bf16_t*)(ws + WS_PV);
    bf16_t *H = (bf16_t*)(ws + WS_H), *P1 = (bf16_t*)(ws + WS_P1), *QA = (bf16_t*)(ws + WS_QA), *KA = (bf16_t*)(ws + WS_KA), *VA = (bf16_t*)(ws + WS_VA), *U = (bf16_t*)(ws + WS_U),
           *CQKV = (bf16_t*)(ws + WS_CQKV), *P2 = (bf16_t*)(ws + WS_P2), *QM = (bf16_t*)(ws + WS_QM), *KM = (bf16_t*)(ws + WS_KM), *VM = (bf16_t*)(ws + WS_VM), *YA = (bf16_t*)(ws + WS_YA),
           *YC = (bf16_t*)(ws + WS_YC), *GS = (bf16_t*)(ws + WS_GS), *GL = (bf16_t*)(ws + WS_GL), *AOUT = (bf16_t*)(ws + WS_AOUT), *QP = (bf16_t*)(ws + WS_QP);
    int* EIDX = (int*)(ws + WS_EIDX); float* GATE = (float*)(ws + WS_GATE); float* TOPS = (float*)(ws + WS_TOPS); int* TOPI = (int*)(ws + WS_TOPI); float* XST = (float*)(ws + WS_XST);

    hipLaunchKernelGGL(k_mod, dim3(NL * MODW / 256), dim3(256), 0, stream, in.c, in.w_ada, in.b_ada, MOD);
    hipLaunchKernelGGL(k_tables, dim3(S * 16 / 256), dim3(256), 0, stream, in.rel_bias, BIAS, ROPE);
    (void)hipMemsetAsync(W2, 0, (size_t)NL * 1536 * 384 * 2, stream);
    {
        TC t;
        memset(&t, 0, sizeof(t)); t.src = in.w_in; t.src_lstride = (size_t)D * IN_COLS; t.ld_src = IN_COLS; t.K_src = D; t.dst = WIN; t.dst_lstride = (size_t)P1W * D; t.ld_dst = D; t.k_off = 0; t.n_valid = IN_COLS; t.mode = 0;
        hipLaunchKernelGGL(k_tconv, dim3(P1W / 64, D / 64, NL), dim3(256), 0, stream, t);
        memset(&t, 0, sizeof(t)); t.src = in.w_uq; t.src_lstride = 256 * 576; t.ld_src = 576; t.K_src = 256; t.dst = W2; t.dst_lstride = (size_t)P2W * 384; t.ld_dst = 384; t.k_off = 0; t.n_valid = 768; t.mode = 1; t.kscale = in.mla_q_lora_gain; t.kscale_lstride = 256;
        hipLaunchKernelGGL(k_tconv, dim3(768 / 64, 256 / 64, NL), dim3(256), 0, stream, t);
        memset(&t, 0, sizeof(t)); t.src = in.w_ukv; t.src_lstride = 128 * 768; t.ld_src = 768; t.K_src = 128; t.dst = W2 + 768 * 384; t.dst_lstride = (size_t)P2W * 384; t.ld_dst = 384; t.k_off = 256; t.n_valid = 768; t.mode = 0; t.kscale = in.mla_kv_lora_gain; t.kscale_lstride = 128;
        hipLaunchKernelGGL(k_tconv, dim3(768 / 64, 128 / 64, NL), dim3(256), 0, stream, t);
        memset(&t, 0, sizeof(t)); t.src = in.w_out; t.src_lstride = (size_t)D * D; t.ld_src = D; t.K_src = D; t.dst = WOUT; t.dst_lstride = (size_t)D * D; t.ld_dst = D; t.k_off = 0; t.n_valid = D; t.mode = 0; t.kscale = in.mix_gain; t.kscale_lstride = D;
        hipLaunchKernelGGL(k_tconv, dim3(D / 64, D / 64, NL), dim3(256), 0, stream, t);
        memset(&t, 0, sizeof(t)); t.src = in.peer_wq; t.src_lstride = (size_t)D * 2048; t.ld_src = 2048; t.K_src = D; t.dst = WQ; t.dst_lstride = (size_t)2048 * D; t.ld_dst = D; t.k_off = 0; t.n_valid = 2048; t.mode = 0;
        hipLaunchKernelGGL(k_tconv, dim3(2048 / 64, D / 64, NL), dim3(256), 0, stream, t);
        memset(&t, 0, sizeof(t)); t.src = in.w_glu; t.src_lstride = 256 * 256; t.ld_src = 256; t.K_src = 256; t.dst = WGLU; t.dst_lstride = 256 * 256; t.ld_dst = 256; t.k_off = 0; t.n_valid = 256; t.mode = 0;
        hipLaunchKernelGGL(k_tconv, dim3(256 / 64, 256 / 64, NL), dim3(256), 0, stream, t);
    }
    hipLaunchKernelGGL(k_cvt, dim3(512), dim3(256), 0, stream, in.peer_subkeys, SUBK, (size_t)NL * 16 * 128 * 128 / 8);
    hipLaunchKernelGGL(k_cvt, dim3(4096), dim3(256), 0, stream, in.peer_u, PU, (size_t)NL * 16384 * 1024 / 8);
    hipLaunchKernelGGL(k_cvt, dim3(4096), dim3(256), 0, stream, in.peer_v, PV, (size_t)NL * 16384 * 1024 / 8);

    for (int l = 0; l < NL; ++l) {
        const float* modl = MOD + (size_t)l * 2 * MODW;
        const float* xcur = l == 0 ? in.x : out;
        hipLaunchKernelGGL(k_normmod, dim3(M / 4), dim3(256), 0, stream, xcur, in.norm1_gain + l * D, modl, 0, D, H);
        launch_gemm_bf16(H, WIN + (size_t)l * P1W * D, M, P1W, D, P1, stream);
        { Post1 p; memset(&p, 0, sizeof(p)); p.raw = P1; p.gq = in.swa_q_gain + l * 64; p.gk = in.swa_k_gain + l * 64; p.kgain = in.mla_k_gain + l * 96; p.rope = ROPE;
          p.QA = QA; p.KA = KA; p.VA = VA; p.U = U; p.CQKV = CQKV; p.KM = KM; p.SQ = SQ;
          hipLaunchKernelGGL(k_post1, dim3(M / 4), dim3(256), 0, stream, p); }
        launch_gemm_bf16(CQKV, W2 + (size_t)l * P2W * 384, M, P2W, 384, P2, stream);
        { Post2 p; memset(&p, 0, sizeof(p)); p.raw = P2; p.SQ = SQ; p.qgain = in.mla_q_gain + l * 96; p.kgain = in.mla_k_gain + l * 96; p.rope = ROPE; p.QM = QM; p.KM = KM; p.VM = VM;
          hipLaunchKernelGGL(k_post2, dim3(M / 4), dim3(256), 0, stream, p); }
        hipLaunchKernelGGL(k_mla_naive, dim3(2 * 6 * 32), dim3(256), 0, stream, QM, KM, VM, YC);
        hipLaunchKernelGGL(k_swa_naive, dim3(2 * 6 * 32), dim3(256), 0, stream, QA, KA, VA, BIAS, YA);
        S5P sp; memset(&sp, 0, sizeof(sp)); sp.a_re = in.s5_a_re + l * 1024; sp.a_im = in.s5_a_im + l * 1024; sp.b_re = in.s5_b_re + l * 16384; sp.b_im = in.s5_b_im + l * 16384;
        sp.c_re = in.s5_c_re + l * 16384; sp.c_im = in.s5_c_im + l * 16384; sp.d = in.s5_d + l * 256; sp.log_dt = in.s5_log_dt + l * 16;
        hipLaunchKernelGGL(k_s5_scan, dim3(32), dim3(64), 0, stream, sp, U, XST);
        hipLaunchKernelGGL(k_s5_out, dim3(M), dim3(256), 0, stream, sp, U, XST, GS);
        launch_gemm_bf16(GS, WGLU + (size_t)l * 65536, M, 256, 256, GL, stream);
        hipLaunchKernelGGL(k_merge, dim3(M / 4), dim3(256), 0, stream, YA, GS, GL, in.b_glu + l * 256, YC, AOUT);
        { EpiResid e; memset(&e, 0, sizeof(e)); e.xin = xcur; e.xout = out; e.gate = modl + 2 * D;
          launch_gemm(AOUT, WOUT + (size_t)l * D * D, M, D, D, e, stream); }
        hipLaunchKernelGGL(k_normmod, dim3(M / 4), dim3(256), 0, stream, out, in.norm2_gain + l * D, modl, 3 * D, 4 * D, H);
        launch_gemm_bf16(H, WQ + (size_t)l * 2048 * D, M, 2048, D, QP, stream);
        hipLaunchKernelGGL(k_peer_scores, dim3(M / 4), dim3(64), 0, stream, QP, SUBK + (size_t)l * 16 * 128 * 128, TOPS, TOPI);
        hipLaunchKernelGGL(k_peer_combine, dim3(M * 8 / 64), dim3(64), 0, stream, TOPS, TOPI, EIDX, GATE);
        hipLaunchKernelGGL(k_peer_gather, dim3(M / 4), dim3(256), 0, stream, H, EIDX, GATE, PU + (size_t)l * 16384 * 1024, PV + (size_t)l * 16384 * 1024, modl + 5 * D, (const float*)out, out);
    }
}
```

```cpp
#include <hip/hip_runtime.h>
#include <cstdint>
#include <cstdio>
#include <cstring>
#include <hip/hip_cooperative_groups.h>
#ifndef HY_PROBE
#define HY_PROBE 0
#endif
#define LAS __attribute__((address_space(3)))
#define XB_TMO      128
#define XB_XCNT(j)  (256  + 64 * (j))
#define XB_XSUB(j)  (1280 + 64 * (j))
#define XB_XGEN(j)  (2304 + 64 * (j))
#define XB_TOP      3328
#define XB_TOPGEN   3392
#define XCD_BAR_WORDS 3456
#define XB_SPIN_CAP (1u << 18)

__device__ __forceinline__ unsigned xb_ld(unsigned* p)              { return __hip_atomic_load(p, __ATOMIC_RELAXED, __HIP_MEMORY_SCOPE_AGENT); }
__device__ __forceinline__ unsigned xb_add(unsigned* p, unsigned v) { return __hip_atomic_fetch_add(p, v, __ATOMIC_RELAXED, __HIP_MEMORY_SCOPE_AGENT); }
__device__ __forceinline__ unsigned xb_xcc_id() { return (unsigned)__builtin_amdgcn_s_getreg((3 << 11) | 20) & 0xFu; }
#define XB_SPIN(cond, bar) do { unsigned _sp = 0; while (cond) { __builtin_amdgcn_s_sleep(1); \
    if ((++_sp & 255u) == 0u) { if (xb_ld(&(bar)[XB_TMO])) break; if (_sp > XB_SPIN_CAP) { atomicAdd(&(bar)[XB_TMO], 1u); break; } } } } while (0)

struct XcdBarrier {
    unsigned* bar; unsigned x;
    volatile LAS unsigned* st;
};

__device__ __forceinline__ XcdBarrier xcd_barrier_post(unsigned* bar, volatile LAS unsigned* st, int tid) {
    XcdBarrier b; b.bar = bar; b.x = xb_xcc_id(); b.st = st;
    if (tid == 0) (void)xb_add(&bar[XB_XCNT(b.x)], 1u);
    return b;
}
__device__ __forceinline__ void xcd_barrier_complete(unsigned* bar, unsigned x, unsigned& nloc, unsigned& nx) {
    const unsigned G = gridDim.x * gridDim.y * gridDim.z;
    unsigned sum, cnt, mine, sp = 0u;
    for (;;) {
        sum = 0u; cnt = 0u; mine = 0u;
#pragma unroll
        for (unsigned j = 0; j < 16; ++j) { const unsigned c = xb_ld(&bar[XB_XCNT(j)]); sum += c; cnt += (c > 0u) ? 1u : 0u; mine = (j == x) ? c : mine; }
        if (sum == G) break;
        __builtin_amdgcn_s_sleep(1);
        if ((++sp & 255u) == 0u) { if (xb_ld(&bar[XB_TMO])) break; if (sp > XB_SPIN_CAP) { atomicAdd(&bar[XB_TMO], 1u); break; } }
    }
    nloc = mine > 0u ? mine : 1u; nx = cnt > 0u ? cnt : 1u;
}

__device__ __forceinline__ void xcd_barrier(const XcdBarrier& b, int tid) {
    asm volatile("s_waitcnt vmcnt(0)" ::: "memory");
    __syncthreads();
    if (tid == 0) {
        unsigned* bar = b.bar;
        __builtin_amdgcn_s_waitcnt(0);
        unsigned nloc = b.st[0], nx = b.st[1];
        if (nloc == 0u) { xcd_barrier_complete(bar, b.x, nloc, nx); b.st[0] = nloc; b.st[1] = nx; }
        const unsigned old = xb_add(&bar[XB_XSUB(b.x)], 1u);
        const unsigned gen = old / nloc;
        if (old + 1u == (gen + 1u) * nloc) {
            __builtin_amdgcn_fence(__ATOMIC_RELEASE, "agent");
            asm volatile("s_waitcnt vmcnt(0)" ::: "memory");
            const unsigned og = xb_add(&bar[XB_TOP], 1u);
            const unsigned tg = og / nx;
            if (og + 1u == (tg + 1u) * nx) xb_add(&bar[XB_TOPGEN], 1u);
            else XB_SPIN(xb_ld(&bar[XB_TOPGEN]) == tg, bar);
            __builtin_amdgcn_fence(__ATOMIC_ACQUIRE, "agent");
            xb_add(&bar[XB_XGEN(b.x)], 1u);
            asm volatile("s_waitcnt vmcnt(0)" ::: "memory");
        } else {
            XB_SPIN(xb_ld(&bar[XB_XGEN(b.x)]) == gen, bar);
            __builtin_amdgcn_fence(__ATOMIC_ACQUIRE, "agent");
            asm volatile("s_waitcnt vmcnt(0)" ::: "memory");
        }
    }
    __syncthreads();
}
namespace pg8 {
#define PG8_LAS __attribute__((address_space(3)))
typedef unsigned short bf16_t;
typedef short bf16x8 __attribute__((ext_vector_type(8)));
typedef float f32x4 __attribute__((ext_vector_type(4)));
typedef unsigned u32x4 __attribute__((ext_vector_type(4)));
constexpr int BM = 256, BK = 64, HALF = 128, HTB = HALF * BK * 2  , STAGE_BYTES = 8 * HTB, NXCD = 8, WGM = 8;

__host__ __device__ __forceinline__ int lds_byte(int r, int c) { const int st = (r >> 4) * 2 + (c >> 5), rr = r & 15, cc = c & 31, ob = rr * 64 + cc * 2; return st * 1024 + (ob ^ (((ob >> 9) & 1) << 5)); }
__host__ __device__ __forceinline__ void stage_rc(int b, int& R, int& C) { const int st = b / 1024, sb = b % 1024, swz = sb ^ (((sb >> 9) & 1) << 5); R = (st >> 1) * 16 + swz / 64; C = (st & 1) * 32 + (swz % 64) / 2; }
__host__ __device__ __forceinline__ int perm32(int rho) { const int n = rho >> 4, i = rho & 15; return 8 * (i >> 2) + 4 * n + (i & 3); }

struct Unit { int pm, pn; };
struct Gemm { const bf16_t* A; const bf16_t* Bt; int M, N, K; };

struct StaticOrder {
    int nM, nN, nwg, G, c;
    __host__ __device__ void init(int M, int N, int G_, int c_) { nM = M / BM; nN = N / BM; nwg = nM * nN; G = G_; c = c_; }
    __host__ __device__ bool next(int i, Unit& u) const {
        const long L = (long)i * G + c; if (L >= nwg) return false;
        int wgid = (int)L; { const int q = nwg / NXCD, r = nwg % NXCD, xcd = wgid % NXCD, off = wgid / NXCD; wgid = (xcd < r ? xcd * (q + 1) : r * (q + 1) + (xcd - r) * q) + off; }
        const int nig = WGM * nN, gid = wgid / nig, fm = gid * WGM, gsz = (nM - fm) < WGM ? (nM - fm) : WGM;
        u.pm = fm + ((wgid % nig) % gsz); u.pn = (wgid % nig) / gsz; return true;
    }
    __device__ __forceinline__ void a_ready(const Unit&) const {}
    __device__ __forceinline__ void done(const Unit&) const {}
};

__device__ __forceinline__ unsigned cvt_pk_bf16(float lo, float hi) { unsigned r; asm volatile("v_cvt_pk_bf16_f32 %0, %1, %2" : "=v"(r) : "v"(lo), "v"(hi)); return r; }
typedef float f32x2 __attribute__((ext_vector_type(2)));
__device__ __forceinline__ f32x2 gelu_pk(f32x2 v) {
    const f32x2 av = __builtin_elementwise_abs(v), d = av * 0.2316418882f + 1.0f;
    f32x2 t; t.x = __builtin_amdgcn_rcpf(d.x); t.y = __builtin_amdgcn_rcpf(d.y);
    f32x2 q = t * 0.5307027145f + (-0.7265760135f); q = q * t + 0.7107068705f; q = q * t + (-0.142248368f); q = q * t + 0.127414796f; q = q * t;
    const f32x2 s = (v * v) * (-0.72134752044f);
    f32x2 e; e.x = __builtin_amdgcn_exp2f(s.x); e.y = __builtin_amdgcn_exp2f(s.y);
    const f32x2 m = v * (q * e), r = v - m;
    f32x2 o; o.x = v.x < 0.f ? m.x : r.x; o.y = v.y < 0.f ? m.y : r.y; return o;
}

template <int ACT  > struct EpiBf16 {
    static constexpr bool PERM = true, AFTER_DRAIN = false; static_assert(ACT == 0 || ACT == 1, "EpiBf16: ACT is 0 (none) or 1 (gelu_pk)");
    bf16_t* O; int ldc; const float* bias; int split_cols; size_t split_stride; float scale0;
    __device__ __forceinline__ void operator()(const f32x4 (&acc)[2][2][4][2], const Unit& u, int wr, int wc, int fr, int fq) const {
        const int row0 = u.pm * BM + wr * 64 + fr; int colt = u.pn * BM; bf16_t* base = O;
        float sc = 1.f; if (split_cols) { const int t = colt / split_cols; base += (size_t)t * split_stride; colt -= t * split_cols; if (t == 0) sc = scale0; }
        const int col0 = colt + wc * 32 + 8 * fq, bcol0 = u.pn * BM + wc * 32 + 8 * fq;
        f32x4 bv[2][2];
#pragma unroll
        for (int bj = 0; bj < 2; ++bj)
#pragma unroll
            for (int n = 0; n < 2; ++n) bv[bj][n] = bias ? *(const f32x4*)(bias + bcol0 + bj * HALF + 4 * n) : (f32x4){0.f, 0.f, 0.f, 0.f};
#pragma unroll
        for (int ai = 0; ai < 2; ++ai)
#pragma unroll
            for (int m = 0; m < 4; ++m) { bf16_t* rowp = base + (size_t)(row0 + ai * HALF + m * 16) * ldc + col0;
#pragma unroll
                for (int bj = 0; bj < 2; ++bj) { f32x4 v0 = acc[ai][bj][m][0] + bv[bj][0], v1 = acc[ai][bj][m][1] + bv[bj][1];
                    if (ACT == 1) { f32x2 a = gelu_pk((f32x2){v0[0], v0[1]}), b = gelu_pk((f32x2){v0[2], v0[3]}), c = gelu_pk((f32x2){v1[0], v1[1]}), d = gelu_pk((f32x2){v1[2], v1[3]});
                        v0 = (f32x4){a.x, a.y, b.x, b.y}; v1 = (f32x4){c.x, c.y, d.x, d.y}; }
                    v0 = v0 * sc; v1 = v1 * sc; u32x4 w; w.x = cvt_pk_bf16(v0[0], v0[1]); w.y = cvt_pk_bf16(v0[2], v0[3]); w.z = cvt_pk_bf16(v1[0], v1[1]); w.w = cvt_pk_bf16(v1[2], v1[3]);
                    *(u32x4*)(rowp + bj * HALF) = w; } }
    }
};
template <class Epi, class Sched, bool ALIGN_EPI = false, bool SP2 = false>
__device__ __forceinline__ void gemm_phase(PG8_LAS unsigned char* lds, const Gemm g, const Sched& S, const Epi& E, int tid_in) {
    int tid_o = tid_in; asm volatile("" : "+v"(tid_o));
    const int tid = tid_o, wid = __builtin_amdgcn_readfirstlane(tid >> 6), lane = tid & 63, wr = wid >> 2, wc = wid & 3, fr = lane & 15, fq = lane >> 4;
    const int K = g.K, nt = K / BK;
    unsigned voffA[2], voffB[2];
#pragma unroll
    for (int i = 0; i < 2; ++i) { int R, C; stage_rc(tid * 16 + i * 8192, R, C); const int Rb = Epi::PERM ? ((R & ~31) + perm32(R & 31)) : R;
        voffA[i] = (unsigned)(R * K + C) * 2u; voffB[i] = (unsigned)(Rb * K + C) * 2u; }
    const size_t kstep = (size_t)(BK * 2);
    const size_t hstep = (size_t)HALF * K * 2;
    const size_t tstep = 2 * hstep;
    const unsigned ldsw = (unsigned)wid * 1024u;
    const int aoff = lds_byte(wr * 64 + fr, fq * 8), boff = lds_byte(wc * 32 + fr, fq * 8);
#define PG8_SA(b, h) (((b) * 2 + (h)) * HTB)
#define PG8_SB(b, h) ((4 + (b) * 2 + (h)) * HTB)
#define PG8_STAGE(bufoff, gbase, voff) do { _Pragma("unroll") for (int _i = 0; _i < 2; ++_i) \
        __builtin_amdgcn_global_load_lds((const unsigned*)((const char*)(gbase) + (voff)[_i]), (PG8_LAS unsigned*)(lds + (bufoff) + ldsw + _i * 8192), 16, 0, 0); } while (0)
#define PG8_LDA(dst, b, h) do { _Pragma("unroll") for (int m = 0; m < 4; ++m) _Pragma("unroll") for (int k = 0; k < 2; ++k) dst[m][k] = *(const PG8_LAS bf16x8*)(lds + PG8_SA(b, h) + aoff + m * 2048 + k * 1024); } while (0)
#define PG8_LDB(dst, b, h) do { _Pragma("unroll") for (int n = 0; n < 2; ++n) _Pragma("unroll") for (int k = 0; k < 2; ++k) dst[n][k] = *(const PG8_LAS bf16x8*)(lds + PG8_SB(b, h) + boff + n * 2048 + k * 1024); } while (0)
#define PG8_MMA(ai, bj, At, Bt) do { __builtin_amdgcn_s_setprio(1); _Pragma("unroll") for (int m = 0; m < 4; ++m) _Pragma("unroll") for (int n = 0; n < 2; ++n) _Pragma("unroll") for (int k = 0; k < 2; ++k) \
        acc[ai][bj][m][n] = __builtin_amdgcn_mfma_f32_16x16x32_bf16(Bt[n][k], At[m][k], acc[ai][bj][m][n], 0, 0, 0); __builtin_amdgcn_s_setprio(0); } while (0)
#define PG8_WAIT_V(n) asm volatile("s_waitcnt vmcnt(" #n ")" ::: "memory")
#define PG8_WAIT_L(n) asm volatile("s_waitcnt lgkmcnt(" #n ")" ::: "memory")
#define PG8_BAR __builtin_amdgcn_s_barrier()
#define PG8_SCHED __builtin_amdgcn_sched_barrier(0)
    Unit cur, nxt; int ui = 0;
    if (!S.next(0, cur)) return;
    f32x4 acc[2][2][4][2];
#pragma unroll
    for (int a = 0; a < 2; ++a)
#pragma unroll
        for (int b = 0; b < 2; ++b)
#pragma unroll
            for (int m = 0; m < 4; ++m)
#pragma unroll
                for (int n = 0; n < 2; ++n) acc[a][b][m][n] = (f32x4){0.f, 0.f, 0.f, 0.f};
    bf16x8 At[4][2], B0[2][2], B1[2][2];
    const char* cA = (const char*)g.A + (size_t)cur.pm * tstep; const char* cB = (const char*)g.Bt + (size_t)cur.pn * tstep;
    S.a_ready(cur);
    if constexpr (SP2) {
        PG8_STAGE(PG8_SB(0, 0), cB, voffB); PG8_STAGE(PG8_SB(0, 1), cB + hstep, voffB); PG8_STAGE(PG8_SA(0, 0), cA, voffA); PG8_STAGE(PG8_SA(0, 1), cA + hstep, voffA);
        if (wr == 1) PG8_BAR;
        PG8_WAIT_V(2); PG8_BAR;
        PG8_STAGE(PG8_SB(1, 0), cB + kstep, voffB); PG8_STAGE(PG8_SA(1, 0), cA + kstep, voffA); PG8_STAGE(PG8_SB(1, 1), cB + hstep + kstep, voffB);
        PG8_WAIT_V(6); PG8_BAR;
    } else {
        PG8_STAGE(PG8_SB(0, 0), cB, voffB); PG8_STAGE(PG8_SA(0, 0), cA, voffA); PG8_STAGE(PG8_SB(0, 1), cB + hstep, voffB); PG8_STAGE(PG8_SA(0, 1), cA + hstep, voffA);
        if (wr == 1) PG8_BAR;
        PG8_WAIT_V(4); PG8_BAR;
        PG8_STAGE(PG8_SB(1, 0), cB + kstep, voffB); PG8_STAGE(PG8_SA(1, 0), cA + kstep, voffA); PG8_STAGE(PG8_SB(1, 1), cB + hstep + kstep, voffB);
        PG8_WAIT_V(6); PG8_BAR;
    }
    for (;;) {
        const bool has_next = S.next(ui + 1, nxt);
        const char* nA = has_next ? (const char*)g.A + (size_t)nxt.pm * tstep : cA; const char* nB = has_next ? (const char*)g.Bt + (size_t)nxt.pn * tstep : cB;
        for (int t = 0; t < nt; t += 2) {
            const bool last = (t == nt - 2);
            const char* a1 = cA + (size_t)(t + 1) * kstep;
            const char* a2 = last ? nA : cA + (size_t)(t + 2) * kstep; const char* b2 = last ? nB : cB + (size_t)(t + 2) * kstep;
            const char* a3 = a2 + kstep; const char* b3 = b2 + kstep;
            if (last && has_next) S.a_ready(nxt);
            if constexpr (SP2) {
            PG8_LDB(B0, 0, 0); PG8_LDB(B1, 0, 1); PG8_SCHED; PG8_LDA(At, 0, 0); PG8_STAGE(PG8_SA(1, 1), a1 + hstep, voffA);
            PG8_WAIT_V(8); PG8_WAIT_L(0); PG8_BAR; PG8_MMA(0, 0, At, B0); PG8_MMA(0, 1, At, B1); PG8_BAR; PG8_SCHED;
            PG8_LDA(At, 0, 1); PG8_STAGE(PG8_SB(0, 0), b2, voffB); PG8_STAGE(PG8_SB(0, 1), b2 + hstep, voffB); PG8_STAGE(PG8_SA(0, 0), a2, voffA);
            PG8_WAIT_V(8); PG8_WAIT_L(0); PG8_BAR; PG8_MMA(1, 0, At, B0); PG8_MMA(1, 1, At, B1); PG8_BAR; PG8_SCHED;
            PG8_LDB(B0, 1, 0); PG8_LDB(B1, 1, 1); PG8_SCHED; PG8_LDA(At, 1, 0); PG8_STAGE(PG8_SA(0, 1), a2 + hstep, voffA);
            PG8_WAIT_V(8); PG8_WAIT_L(0); PG8_BAR; PG8_MMA(0, 0, At, B0); PG8_MMA(0, 1, At, B1); PG8_BAR; PG8_SCHED;
            PG8_LDA(At, 1, 1); PG8_STAGE(PG8_SB(1, 0), b3, voffB); PG8_STAGE(PG8_SB(1, 1), b3 + hstep, voffB); PG8_STAGE(PG8_SA(1, 0), a3, voffA);
            PG8_WAIT_V(8); PG8_WAIT_L(0); PG8_BAR; PG8_MMA(1, 0, At, B0); PG8_MMA(1, 1, At, B1); PG8_BAR; PG8_SCHED;
            } else {
            PG8_LDB(B0, 0, 0); PG8_SCHED; PG8_LDA(At, 0, 0); PG8_STAGE(PG8_SA(1, 1), a1 + hstep, voffA);
            PG8_WAIT_L(8); PG8_BAR; PG8_WAIT_L(0); PG8_MMA(0, 0, At, B0); PG8_BAR; PG8_SCHED;
            PG8_LDB(B1, 0, 1); PG8_STAGE(PG8_SB(0, 0), b2, voffB);
            PG8_BAR; PG8_WAIT_L(0); PG8_MMA(0, 1, At, B1); PG8_BAR;
            PG8_LDA(At, 0, 1); PG8_STAGE(PG8_SA(0, 0), a2, voffA);
            PG8_BAR; PG8_WAIT_L(0); PG8_MMA(1, 0, At, B0); PG8_BAR; PG8_SCHED;
            PG8_STAGE(PG8_SB(0, 1), b2 + hstep, voffB);
            PG8_WAIT_V(6); PG8_BAR; PG8_MMA(1, 1, At, B1); PG8_BAR;
            PG8_LDB(B0, 1, 0); PG8_SCHED; PG8_LDA(At, 1, 0); PG8_STAGE(PG8_SA(0, 1), a2 + hstep, voffA);
            PG8_WAIT_L(8); PG8_BAR; PG8_WAIT_L(0); PG8_MMA(0, 0, At, B0); PG8_BAR; PG8_SCHED;
            PG8_LDB(B1, 1, 1); PG8_STAGE(PG8_SB(1, 0), b3, voffB);
            PG8_BAR; PG8_WAIT_L(0); PG8_MMA(0, 1, At, B1); PG8_BAR;
            PG8_LDA(At, 1, 1); PG8_STAGE(PG8_SA(1, 0), a3, voffA);
            PG8_BAR; PG8_WAIT_L(0); PG8_MMA(1, 0, At, B0); PG8_BAR; PG8_SCHED;
            PG8_STAGE(PG8_SB(1, 1), b3 + hstep, voffB);
            PG8_WAIT_V(6); PG8_BAR; PG8_MMA(1, 1, At, B1); PG8_BAR;
            }
        }
        if constexpr (ALIGN_EPI) { if (wr == 0) PG8_BAR; }
        if constexpr (!Epi::AFTER_DRAIN) { E(acc, cur, wr, wc, fr, fq); S.done(cur); }
        if (!has_next) break;
#pragma unroll
        for (int a = 0; a < 2; ++a)
#pragma unroll
            for (int b = 0; b < 2; ++b)
#pragma unroll
                for (int m = 0; m < 4; ++m)
#pragma unroll
                    for (int n = 0; n < 2; ++n) acc[a][b][m][n] = (f32x4){0.f, 0.f, 0.f, 0.f};
        cur = nxt; cA = nA; cB = nB; ++ui;
        if constexpr (ALIGN_EPI) { if (wr == 1) PG8_BAR; }
    }
    PG8_WAIT_V(0);
    if constexpr (!ALIGN_EPI) { if (wr == 0) PG8_BAR; }
    PG8_BAR;
    if constexpr (Epi::AFTER_DRAIN) { E.fused(acc, cur, wr, wc, fr, fq, lds, wid, lane); S.done(cur); }
#undef PG8_SA
#undef PG8_SB
#undef PG8_STAGE
#undef PG8_LDA
#undef PG8_LDB
#undef PG8_MMA
#undef PG8_WAIT_V
#undef PG8_WAIT_L
#undef PG8_BAR
#undef PG8_SCHED
}
}
namespace hy {
namespace cg = cooperative_groups;
typedef unsigned short bf16_t;
typedef unsigned u32x4 __attribute__((ext_vector_type(4)));
typedef unsigned u32x2 __attribute__((ext_vector_type(2)));
typedef float f32x4 __attribute__((ext_vector_type(4)));
constexpr int M = 16384, S = 8192, D = 1024, NL = 4;
constexpr int IN_COLS = 1824, P1W = 2048, P2W = 1536;
constexpr float EPS = 1e-6f, LOG2E = 1.4426950408889634f;
constexpr int MODW = 6 * D;
constexpr int NT = 512;
constexpr int LDS_BYTES = 147456;

__device__ __forceinline__ float bf2f(bf16_t v) { return __uint_as_float(((unsigned)v) << 16); }
__device__ __forceinline__ bf16_t f2bf(float f) { unsigned u = __float_as_uint(f); return (bf16_t)((u + 0x7fffu + ((u >> 16) & 1u)) >> 16); }
__device__ __forceinline__ unsigned pk2(float lo, float hi) { return (unsigned)f2bf(lo) | ((unsigned)f2bf(hi) << 16); }
__device__ __forceinline__ float lo16(unsigned w) { return __uint_as_float(w << 16); }
__device__ __forceinline__ float hi16(unsigned w) { return __uint_as_float(w & 0xffff0000u); }
__device__ __forceinline__ float wave_sum(float v) {
#pragma unroll
    for (int o = 1; o < 64; o <<= 1) v += __shfl_xor(v, o);
    return v;
}
__device__ __forceinline__ float gelu_tanh(float x) {
    const float k0 = 0.7978845608028654f, k1 = 0.044715f;
    float t = k0 * (x + k1 * x * x * x);
    float e = __expf(2.f * t);
    float th = 1.f - 2.f / (e + 1.f);
    return 0.5f * x * (1.f + th);
}

constexpr size_t MiB = 1ull << 20;
constexpr size_t WS_CTL = 0;
constexpr size_t WS_MOD = 1 * MiB;
constexpr size_t WS_BIAS = WS_MOD + 256 * 1024;
constexpr size_t WS_ROPE = 2 * MiB;
constexpr size_t WS_SQ = 3 * MiB;
constexpr size_t WS_WIN = 4 * MiB;
constexpr size_t WS_W2 = WS_WIN + 16 * MiB;
constexpr size_t WS_WOUT = WS_W2 + 6 * MiB;
constexpr size_t WS_WQ = WS_WOUT + 8 * MiB;
constexpr size_t WS_WGLU = WS_WQ + 16 * MiB;
constexpr size_t WS_SUBK = WS_WGLU + 1 * MiB;
constexpr size_t WS_PU = 64 * MiB;
constexpr size_t WS_PV = WS_PU + 64 * MiB;
constexpr size_t WS_PSU = WS_PV + 64 * MiB;
constexpr size_t WS_ACT = 320 * MiB;
constexpr size_t WS_H = WS_ACT;
constexpr size_t WS_P1 = WS_H + 32 * MiB;
constexpr size_t WS_QA = WS_P1 + 64 * MiB;
constexpr size_t WS_KA = WS_QA + 12 * MiB;
constexpr size_t WS_VA = WS_KA + 12 * MiB;
constexpr size_t WS_U = WS_VA + 12 * MiB;
constexpr size_t WS_CQKV = WS_U + 8 * MiB;
constexpr size_t WS_P2 = WS_CQKV + 12 * MiB;
constexpr size_t WS_QM = WS_P2 + 48 * MiB;
constexpr size_t WS_KM = WS_QM + 18 * MiB;
constexpr size_t WS_VM = WS_KM + 18 * MiB;
constexpr size_t WS_YA = WS_VM + 12 * MiB;
constexpr size_t WS_YC = WS_YA + 12 * MiB;
constexpr size_t WS_GS = WS_YC + 12 * MiB;
constexpr size_t WS_GL = WS_GS + 8 * MiB;
constexpr size_t WS_AOUT = WS_GL + 8 * MiB;
constexpr size_t WS_QP = WS_AOUT + 32 * MiB;
constexpr size_t WS_EIDX = WS_QP + 64 * MiB;
constexpr size_t WS_GATE = WS_EIDX + 8 * MiB;
constexpr size_t WS_TOPS = WS_GATE + 8 * MiB;
constexpr size_t WS_XB = WS_TOPS;
constexpr size_t WS_TOPI = WS_TOPS + 16 * MiB;
constexpr size_t WS_XST = WS_TOPI + 16 * MiB;
constexpr size_t WS_YAB = WS_XST + 128 * MiB;
constexpr size_t WS_MLB = WS_YAB + 36 * MiB;
constexpr size_t WS_LP = WS_MLB + 4 * MiB;
constexpr size_t WS_KMT = WS_LP + 4 * MiB;
constexpr size_t WS_WE = WS_KMT + 2 * MiB;
constexpr size_t WS_WC = WS_WE + 16 * MiB;
constexpr size_t WS_E = WS_WC + 16 * MiB;
constexpr size_t WS_SSQ = WS_E + 2 * MiB;
constexpr size_t WS_SSX = WS_SSQ + 1 * MiB;
constexpr size_t WS_CV = WS_SSX + 1 * MiB;
constexpr size_t WS_BB = WS_CV + 1 * MiB;
constexpr size_t WS_END = WS_BB + 1 * MiB;

struct In {
    const float *x, *c, *w_in, *w_out, *mix_gain, *norm1_gain, *norm2_gain, *w_ada, *b_ada, *rel_bias, *swa_q_gain, *swa_k_gain,
        *mla_q_lora_gain, *mla_kv_lora_gain, *w_uq, *w_ukv, *mla_q_gain, *mla_k_gain, *s5_a_re, *s5_a_im, *s5_b_re, *s5_b_im, *s5_c_re,
        *s5_c_im, *s5_d, *s5_log_dt, *w_glu, *b_glu, *peer_wq, *peer_subkeys, *peer_u, *peer_v;
};
struct Params { In in; float* out; unsigned char* ws; };

struct Ctx { int tid, lane, wave, bid, nblk; unsigned char* lds; };

__device__ __forceinline__ void gemv2_job(const Ctx& C, const float* a0, const float* a1, bool silu, const float* W, int ldw, int n0, const float* bias, float* out0, float* out1) {
    float* av = (float*)C.lds;
    float* red = av + 2 * D;
    for (int i = C.tid; i < D; i += NT) { float v0 = a0[i], v1 = a1[i]; if (silu) { v0 = v0 / (1.f + __expf(-v0)); v1 = v1 / (1.f + __expf(-v1)); } av[i] = v0; av[D + i] = v1; }
    __syncthreads();
    const int nq = C.tid & 7, ks = C.tid >> 3;
    const float* w = W + (size_t)(ks * 16) * ldw + n0 + nq * 4;
    f32x4 wv[16];
#pragma unroll
    for (int k = 0; k < 16; ++k) wv[k] = *(const f32x4*)(w + (size_t)k * ldw);
    f32x4 s0 = {0.f, 0.f, 0.f, 0.f}, s1 = {0.f, 0.f, 0.f, 0.f};
#pragma unroll
    for (int k = 0; k < 16; ++k) { s0 += av[ks * 16 + k] * wv[k]; s1 += av[D + ks * 16 + k] * wv[k]; }
#pragma unroll
    for (int j = 0; j < 4; ++j) { red[(ks * 32 + nq * 4 + j) * 2] = s0[j]; red[(ks * 32 + nq * 4 + j) * 2 + 1] = s1[j]; }
    __syncthreads();
    if (C.tid < 64) {
        const int b = C.tid >> 5, nn = C.tid & 31; float t = 0.f;
#pragma unroll 16
        for (int q = 0; q < 64; ++q) t += red[(q * 32 + nn) * 2 + b];
        if (bias) t += bias[n0 + nn];
        (b ? out1 : out0)[n0 + nn] = t;
    }
    __syncthreads();
}
__device__ __forceinline__ void ph_mod(const Ctx& C, const float* c, const float* w_ada, const float* b_ada, float* mod) {
    for (int job = C.bid; job < NL * (MODW / 32); job += C.nblk) {
        const int l = job / (MODW / 32), n0 = (job % (MODW / 32)) * 32;
        gemv2_job(C, c, c + D, true, w_ada + (size_t)l * D * MODW, MODW, n0, b_ada + l * MODW, mod + (size_t)(l * 2) * MODW, mod + (size_t)(l * 2 + 1) * MODW);
    }
}
__device__ __forceinline__ void ph_cvec(const Ctx& C, const float* wq, const float* mod, float* cv) {
    for (int job = C.bid; job < NL * 64; job += C.nblk) {
        const int l = job >> 6, n0 = (job & 63) * 32;
        gemv2_job(C, mod + (size_t)(l * 2) * MODW + 3 * D, mod + (size_t)(l * 2 + 1) * MODW + 3 * D, false, wq + (size_t)l * D * 2048, 2048, n0, nullptr, cv + (l * 2) * 2048, cv + (l * 2 + 1) * 2048);
    }
}
__device__ __forceinline__ int t5_bucket(int dist) {
    if (dist < 16) return dist;
    float df = (float)dist;
    float v = logf(df / 16.f) / 4.852030263919617f * 16.f;
    int large = 16 + (int)v;
    return large < 31 ? large : 31;
}
__device__ __forceinline__ void ph_bounds(const Ctx& C, const In& in, float* bnd) {
    if (C.bid == 0 && C.tid < NL) {
        const int l = C.tid;
        float sq = 0.f, sk = 0.f, aq = 0.f, ak = 0.f, bm = 0.f;
        for (int d = 0; d < 96; ++d) { const float gq = in.mla_q_gain[l * 96 + d], gk = in.mla_k_gain[l * 96 + d]; sq += gq * gq; sk += gk * gk; }
        for (int d = 0; d < 64; ++d) { const float gq = in.swa_q_gain[l * 64 + d], gk = in.swa_k_gain[l * 64 + d]; aq += gq * gq; ak += gk * gk; }
        for (int i = 0; i < 6 * 32; ++i) bm = fmaxf(bm, fabsf(in.rel_bias[i]));
        bnd[l * 2 + 0] = 0.10206207261596575f * LOG2E * sqrtf(sq) * sqrtf(sk) * 1.01f;
        bnd[l * 2 + 1] = (0.125f * sqrtf(aq) * sqrtf(ak) * 1.01f + bm) * LOG2E;
    }
}
__device__ __forceinline__ void ph_tables(const Ctx& C, const float* rel_bias, float* bias, float* rope) {
    for (int gid = C.bid * NT + C.tid; gid < S * 16; gid += C.nblk * NT) {
        if (gid < 3 * 6 * 132) {
            const int br = gid / (6 * 132), h = (gid / 132) % 6, j = gid % 132;
            const int dil = br == 0 ? 1 : (br == 1 ? 4 : 16);
            float v = 0.f;
            if (j <= 128) v = rel_bias[h * 32 + t5_bucket(dil * j)] * LOG2E;
            bias[gid] = v;
        }
        const int pos = gid / 16, i = gid % 16;
        const float inv = (float)pow(10000.0, -(double)(2 * i) / 32.0);
        const float ang = (float)pos * inv;
        rope[gid] = (float)cos((double)ang);
        rope[S * 16 + gid] = (float)sin((double)ang);
    }
}

struct TC { const float* src; size_t src_lstride; int ld_src; int K_src; bf16_t* dst; size_t dst_lstride; int ld_dst; int k_off; int n_rows; int n_valid; int mode; const float* kscale; int kscale_lstride; };
__device__ __forceinline__ TC get_tc(int which, const Params& P) {
    TC t; t.kscale = nullptr; t.kscale_lstride = 0; t.k_off = 0; t.mode = 0;
    unsigned char* ws = P.ws;
    switch (which) {
    case 0: t.src = P.in.w_in; t.src_lstride = (size_t)D * IN_COLS; t.ld_src = IN_COLS; t.K_src = D; t.dst = (bf16_t*)(ws + WS_WIN); t.dst_lstride = (size_t)P1W * D; t.ld_dst = D; t.n_rows = P1W; t.n_valid = IN_COLS; t.mode = 2; break;
    case 1: t.src = P.in.w_uq; t.src_lstride = 256 * 576; t.ld_src = 576; t.K_src = 256; t.dst = (bf16_t*)(ws + WS_W2); t.dst_lstride = (size_t)P2W * 384; t.ld_dst = 384; t.n_rows = 768; t.n_valid = 768; t.mode = 1; t.kscale = P.in.mla_q_lora_gain; t.kscale_lstride = 256; break;
    case 2: t.src = P.in.w_ukv; t.src_lstride = 128 * 768; t.ld_src = 768; t.K_src = 128; t.dst = (bf16_t*)(ws + WS_W2); t.dst_lstride = (size_t)P2W * 384; t.ld_dst = 384; t.k_off = 256; t.n_rows = 768; t.n_valid = 768; t.mode = 3; t.kscale = P.in.mla_kv_lora_gain; t.kscale_lstride = 128; break;
    case 3: t.src = P.in.w_out; t.src_lstride = (size_t)D * D; t.ld_src = D; t.K_src = D; t.dst = (bf16_t*)(ws + WS_WOUT); t.dst_lstride = (size_t)D * D; t.ld_dst = D; t.n_rows = D; t.n_valid = D; t.kscale = P.in.mix_gain; t.kscale_lstride = D; break;
    case 4: t.src = P.in.peer_wq; t.src_lstride = (size_t)D * 2048; t.ld_src = 2048; t.K_src = D; t.dst = (bf16_t*)(ws + WS_WQ); t.dst_lstride = (size_t)2048 * D; t.ld_dst = D; t.n_rows = 2048; t.n_valid = 2048; break;
    default: t.src = P.in.w_glu; t.src_lstride = 256 * 256; t.ld_src = 256; t.K_src = 256; t.dst = (bf16_t*)(ws + WS_WGLU); t.dst_lstride = 256 * 256; t.ld_dst = 256; t.n_rows = 256; t.n_valid = 256; break;
    }
    return t;
}
__device__ __forceinline__ void ph_tconv(const Ctx& C, const Params& P) {
    const int stid = C.tid & 255, sub = C.tid >> 8;
    constexpr int TQ = 4;
    float* tl0 = (float*)C.lds + sub * (TQ * 64 * 65);
    constexpr int C0 = 32 * 16, C1 = 12 * 4, C2 = 12 * 2, C3 = 16 * 16, C4 = 32 * 16, C5 = 4 * 4;
    constexpr int total = (C0 + C1 + C2 + C3 + C4 + C5) * NL;
    for (int j0 = C.bid * 2 * TQ; j0 < total; j0 += C.nblk * 2 * TQ) {
        bf16_t* oaddr[TQ]; bool val[TQ];
#pragma unroll
        for (int q = 0; q < TQ; ++q) {
            float* tl = tl0 + q * (64 * 65);
            const int job = j0 + sub * TQ + q; const bool valid = job < total; val[q] = valid;
            int which = 0, r = valid ? job : 0, per = C0;
            if (r >= C0 * NL) { r -= C0 * NL; which = 1; per = C1;
                if (r >= C1 * NL) { r -= C1 * NL; which = 2; per = C2;
                    if (r >= C2 * NL) { r -= C2 * NL; which = 3; per = C3;
                        if (r >= C3 * NL) { r -= C3 * NL; which = 4; per = C4;
                            if (r >= C4 * NL) { r -= C4 * NL; which = 5; per = C5; } } } } }
            const TC p = get_tc(which, P);
            const int l = r / per, rr = r % per, ntn = p.n_rows / 64, k0 = (rr / ntn) * 64;
            int n0 = (rr % ntn) * 64;
            if (which == 1 || which == 2) { const int rt = rr % ntn; n0 = (rt >> 1) * 256 + (rt & 1) * 128 + (which == 2 ? 64 : 0); }
            const float* src = p.src + (size_t)l * p.src_lstride;
            const int nq = stid & 15, n = n0 + nq * 4;
            int col;
            if (p.mode == 0) col = n < p.n_valid ? n : -1;
            else if (p.mode == 1) { const int hh = n >> 8, wc = (n >> 5) & 3, d = 32 * ((n >> 7) & 1) + (n & 31); col = wc == 0 ? hh * 96 + d : (d < 32 ? hh * 96 + 64 + d : -1); }
            else if (p.mode == 3) { const int hh = n >> 8, wc = (n >> 5) & 3, d = 32 * ((n >> 7) & 1) + (n & 31); col = hh * 128 + (wc - 2) * 64 + d; }
            else {
                const int t = n >> 8, bj = (n >> 7) & 1, wc = (n >> 5) & 3, d = 32 * bj + (n & 31), uu = 4 * t + wc;
                if (uu < 18) col = 64 * uu + d;
                else if (uu < 20) col = 1664 + 64 * (uu - 18) + d;
                else if (uu < 24) col = 1408 + 64 * (uu - 20) + d;
                else if (uu < 28) col = 1152 + 64 * (uu - 24) + d;
                else if (uu == 28 && d < 32) col = 1792 + d;
                else col = -1;
            }
            oaddr[q] = p.dst + (size_t)l * p.dst_lstride + (size_t)(n0 + (stid >> 2)) * p.ld_dst + p.k_off + k0 + (stid & 3) * 16;
            if (valid) {
#pragma unroll
                for (int i = 0; i < 4; ++i) {
                    const int kk = i * 16 + (stid >> 4), k = k0 + kk;
                    f32x4 v = {0.f, 0.f, 0.f, 0.f};
                    if (col >= 0) v = *(const f32x4*)(src + (size_t)k * p.ld_src + col);
                    if (p.kscale) v *= p.kscale[l * p.kscale_lstride + k];
                    tl[kk * 65 + nq * 4] = v[0]; tl[kk * 65 + nq * 4 + 1] = v[1]; tl[kk * 65 + nq * 4 + 2] = v[2]; tl[kk * 65 + nq * 4 + 3] = v[3];
                }
            }
        }
        __syncthreads();
#pragma unroll
        for (int q = 0; q < TQ; ++q) {
            if (val[q]) {
                const float* tl = tl0 + q * (64 * 65);
                const int nl = stid >> 2, kc = (stid & 3) * 16;
                u32x4 o0, o1;
                o0.x = pk2(tl[(kc + 0) * 65 + nl], tl[(kc + 1) * 65 + nl]); o0.y = pk2(tl[(kc + 2) * 65 + nl], tl[(kc + 3) * 65 + nl]); o0.z = pk2(tl[(kc + 4) * 65 + nl], tl[(kc + 5) * 65 + nl]); o0.w = pk2(tl[(kc + 6) * 65 + nl], tl[(kc + 7) * 65 + nl]);
                o1.x = pk2(tl[(kc + 8) * 65 + nl], tl[(kc + 9) * 65 + nl]); o1.y = pk2(tl[(kc + 10) * 65 + nl], tl[(kc + 11) * 65 + nl]); o1.z = pk2(tl[(kc + 12) * 65 + nl], tl[(kc + 13) * 65 + nl]); o1.w = pk2(tl[(kc + 14) * 65 + nl], tl[(kc + 15) * 65 + nl]);
                *(u32x4*)oaddr[q] = o0; *(u32x4*)(oaddr[q] + 8) = o1;
            }
        }
        __syncthreads();
    }
}
__device__ __forceinline__ void ph_w2zero(const Ctx& C, bf16_t* W2) {
    const u32x4 z = {0u, 0u, 0u, 0u};
    for (int i = C.bid * NT + C.tid; i < NL * P2W * 32; i += C.nblk * NT) {
        const int ch = i & 31, row = (i >> 5) % P2W, l = (i >> 5) / P2W;
        const bool qrow = ((row >> 6) & 1) == 0;
        if (qrow) { if (ch < 16) *(u32x4*)(W2 + ((size_t)l * P2W + row) * 384 + 256 + ch * 8) = z; }
        else *(u32x4*)(W2 + ((size_t)l * P2W + row) * 384 + ch * 8) = z;
    }
}
__device__ __forceinline__ void ph_cvt(const Ctx& C, const float* src, bf16_t* dst, size_t n8) {
    for (size_t i = (size_t)C.bid * NT + C.tid; i < n8; i += (size_t)C.nblk * NT) {
        const f32x4 a = *(const f32x4*)(src + i * 8), b = *(const f32x4*)(src + i * 8 + 4);
        u32x4 o; o.x = pk2(a[0], a[1]); o.y = pk2(a[2], a[3]); o.z = pk2(b[0], b[1]); o.w = pk2(b[2], b[3]);
        *(u32x4*)(dst + i * 8) = o;
    }
}

__device__ __forceinline__ void ph_normmod(const Ctx& C, const float* x, const float* gain, const float* modl, int sh_off, int sc_off, bf16_t* H, float* zero) {
    const int lane = C.lane;
    for (int m = C.bid * 8 + C.wave; m < M; m += C.nblk * 8) {
        const int b = m >> 13;
        const float* xr = x + (size_t)m * D;
        f32x4 v[4]; float ss = 0.f;
#pragma unroll
        for (int j = 0; j < 4; ++j) { v[j] = *(const f32x4*)(xr + j * 256 + lane * 4); ss += v[j][0] * v[j][0] + v[j][1] * v[j][1] + v[j][2] * v[j][2] + v[j][3] * v[j][3]; }
        const float r = rsqrtf(wave_sum(ss) * (1.f / D) + EPS);
        const float* sh = modl + b * MODW + sh_off; const float* sc = modl + b * MODW + sc_off;
#pragma unroll
        for (int j = 0; j < 4; ++j) {
            const int c0 = j * 256 + lane * 4;
            const f32x4 g = *(const f32x4*)(gain + c0), s1 = *(const f32x4*)(sc + c0), s0 = *(const f32x4*)(sh + c0);
            float o[4];
#pragma unroll
            for (int e = 0; e < 4; ++e) o[e] = v[j][e] * r * g[e] * (1.f + s1[e]) + s0[e];
            u32x2 w; w.x = pk2(o[0], o[1]); w.y = pk2(o[2], o[3]);
            *(u32x2*)(H + (size_t)m * D + c0) = w;
        }
    }
}

struct Post1 { const bf16_t* raw; const float* gq; const float* gk; const float* kgain; const float* rope; bf16_t *QA, *KA, *VA, *U, *CQKV, *KM; float* SQ; };
__device__ __forceinline__ void ph_post1(const Ctx& C, const Post1& p) {
    const int lane = C.lane;
    const float gq = p.gq[lane], gk = p.gk[lane];
    for (int m = C.bid * 8 + C.wave; m < M; m += C.nblk * 8) {
        const int pos = m & (S - 1);
        const bf16_t* r = p.raw + (size_t)m * P1W;
#pragma unroll
        for (int hh = 0; hh < 6; ++hh) {
            float v = bf2f(r[hh * 64 + lane]);
            float rr = rsqrtf(wave_sum(v * v) * (1.f / 64.f) + EPS);
            p.QA[(size_t)m * 384 + hh * 64 + lane] = f2bf(v * rr * gq * (0.125f * LOG2E));
            v = bf2f(r[384 + hh * 64 + lane]);
            rr = rsqrtf(wave_sum(v * v) * (1.f / 64.f) + EPS);
            p.KA[(size_t)m * 384 + hh * 64 + lane] = f2bf(v * rr * gk);
            p.VA[(size_t)m * 384 + hh * 64 + lane] = r[768 + hh * 64 + lane];
        }
        float ss = 0.f;
#pragma unroll
        for (int j = 0; j < 4; ++j) {
            p.U[(size_t)m * 256 + j * 64 + lane] = r[1152 + j * 64 + lane];
            const bf16_t w = r[1408 + j * 64 + lane]; const float v = bf2f(w); ss += v * v;
            p.CQKV[(size_t)m * 384 + j * 64 + lane] = w;
        }
        const float sq = rsqrtf(wave_sum(ss) * (1.f / 256.f) + EPS);
        ss = 0.f;
#pragma unroll
        for (int j = 0; j < 2; ++j) {
            const bf16_t w = r[1664 + j * 64 + lane]; const float v = bf2f(w); ss += v * v;
            p.CQKV[(size_t)m * 384 + 256 + j * 64 + lane] = w;
        }
        const float skv = rsqrtf(wave_sum(ss) * (1.f / 128.f) + EPS);
        if (lane == 0) { p.SQ[m] = sq; p.SQ[M + m] = skv; }
        {
            const int l31 = lane & 31;
            float v = lane < 32 ? bf2f(r[1792 + l31]) : 0.f;
            const float rr = rsqrtf(wave_sum(v * v) * (1.f / 32.f) + EPS);
            const float n = v * rr * p.kgain[64 + l31];
            const float pr = __shfl_xor(n, 16);
            const int i = lane & 15;
            const float cs = p.rope[pos * 16 + i], sn = p.rope[S * 16 + pos * 16 + i];
            const float o = (l31 < 16) ? (n * cs - pr * sn) : (pr * sn + n * cs);
            if (lane < 32) {
                const bf16_t ob = f2bf(o);
#pragma unroll
                for (int hh = 0; hh < 6; ++hh) p.KM[(size_t)m * 576 + hh * 96 + 64 + l31] = ob;
            }
        }
    }
}

struct Post2 { const bf16_t* raw; const float* SQ; const float* qgain; const float* kgain; const float* rope; bf16_t *QM, *KM, *VM; };
__device__ __forceinline__ void ph_post2(const Ctx& C, const Post2& p) {
    const int lane = C.lane;
    const float SCQ = 0.10206207261596575f * LOG2E;
    const int l31 = lane & 31, i = lane & 15;
    const float gqn = p.qgain[lane], gqr = p.qgain[64 + l31], gkn = p.kgain[lane];
    for (int m = C.bid * 8 + C.wave; m < M; m += C.nblk * 8) {
        const int pos = m & (S - 1);
        const bf16_t* r = p.raw + (size_t)m * P2W;
        const f32x4 pq = *(const f32x4*)(p.SQ + (size_t)m * 8); const float2 pkv = *(const float2*)(p.SQ + (size_t)m * 8 + 4);
        const float sq = rsqrtf(((pq[0] + pq[1]) + (pq[2] + pq[3])) * (1.f / 256.f) + EPS), skv = rsqrtf((pkv.x + pkv.y) * (1.f / 128.f) + EPS);
        const float cs = p.rope[pos * 16 + i], sn = p.rope[S * 16 + pos * 16 + i];
#pragma unroll
        for (int hh = 0; hh < 6; ++hh) {
            float v = sq * bf2f(r[hh * 128 + lane]);
            float rr = rsqrtf(wave_sum(v * v) * (1.f / 64.f) + EPS);
            p.QM[(size_t)m * 576 + hh * 96 + lane] = f2bf(v * rr * gqn * SCQ);
            v = lane < 32 ? sq * bf2f(r[hh * 128 + 64 + l31]) : 0.f;
            rr = rsqrtf(wave_sum(v * v) * (1.f / 32.f) + EPS);
            const float n = v * rr * gqr;
            const float pr = __shfl_xor(n, 16);
            const float o = (l31 < 16) ? (n * cs - pr * sn) : (pr * sn + n * cs);
            if (lane < 32) p.QM[(size_t)m * 576 + hh * 96 + 64 + l31] = f2bf(o * SCQ);
            v = skv * bf2f(r[768 + hh * 128 + lane]);
            rr = rsqrtf(wave_sum(v * v) * (1.f / 64.f) + EPS);
            p.KM[(size_t)m * 576 + hh * 96 + lane] = f2bf(v * rr * gkn);
            p.VM[(size_t)m * 384 + hh * 64 + lane] = f2bf(skv * bf2f(r[768 + hh * 128 + 64 + lane]));
        }
    }
}
__device__ __forceinline__ void mla_naive_job(int job, int stid, const bf16_t* Q, const bf16_t* K, const bf16_t* V, bf16_t* O) {
    const int bh = job % 12, qb = 31 - job / 12, b = bh / 6, h = bh % 6;
    const int qpos = qb * 256 + stid;
    const size_t m = (size_t)b * S + qpos;
    float q[96], o[64];
    {
        const unsigned* qp = (const unsigned*)(Q + m * 576 + h * 96);
#pragma unroll
        for (int i = 0; i < 48; ++i) { const unsigned w = qp[i]; q[2 * i] = lo16(w); q[2 * i + 1] = hi16(w); }
    }
#pragma unroll
    for (int i = 0; i < 64; ++i) o[i] = 0.f;
    float mx = -INFINITY, l = 0.f;
    const int jend = qb * 256 + 256;
    for (int j = 0; j < jend; ++j) {
        const unsigned* kp = (const unsigned*)(K + ((size_t)b * S + j) * 576 + h * 96);
        float s = 0.f;
#pragma unroll
        for (int i = 0; i < 48; ++i) { const unsigned w = kp[i]; s += q[2 * i] * lo16(w) + q[2 * i + 1] * hi16(w); }
        if (j <= qpos) {
            const float mn = fmaxf(mx, s), corr = exp2f(mx - mn), pexp = exp2f(s - mn);
            l = l * corr + pexp; mx = mn;
            const unsigned* vp = (const unsigned*)(V + ((size_t)b * S + j) * 384 + h * 64);
#pragma unroll
            for (int i = 0; i < 32; ++i) { const unsigned w = vp[i]; o[2 * i] = o[2 * i] * corr + pexp * lo16(w); o[2 * i + 1] = o[2 * i + 1] * corr + pexp * hi16(w); }
        }
    }
    const float il = 1.f / l;
    unsigned* op = (unsigned*)(O + m * 384 + h * 64);
#pragma unroll
    for (int i = 0; i < 32; ++i) op[i] = pk2(o[2 * i] * il, o[2 * i + 1] * il);
}
__device__ __forceinline__ void swa_naive_job(int job, int stid, const bf16_t* Q, const bf16_t* K, const bf16_t* V, const float* bias, bf16_t* O) {
    const int bh = job / 32, qb = job % 32, b = bh / 6, h = bh % 6;
    const int pos = qb * 256 + stid;
    const size_t m = (size_t)b * S + pos;
    float q[64], o[64];
    {
        const unsigned* qp = (const unsigned*)(Q + m * 384 + h * 64);
#pragma unroll
        for (int i = 0; i < 32; ++i) { const unsigned w = qp[i]; q[2 * i] = lo16(w); q[2 * i + 1] = hi16(w); }
    }
#pragma unroll
    for (int i = 0; i < 64; ++i) o[i] = 0.f;
    float mx = -INFINITY, l = 0.f;
    for (int br = 0; br < 3; ++br) {
        const int dil = br == 0 ? 1 : (br == 1 ? 4 : 16);
        const float* bt = bias + (br * 6 + h) * 132;
        for (int j = 0; j <= 128; ++j) {
            const int kpos = pos - j * dil;
            if (kpos < 0) break;
            const size_t km = (size_t)b * S + kpos;
            const unsigned* kp = (const unsigned*)(K + km * 384 + h * 64);
            float s = bt[j];
#pragma unroll
            for (int i = 0; i < 32; ++i) { const unsigned w = kp[i]; s += q[2 * i] * lo16(w) + q[2 * i + 1] * hi16(w); }
            const float mn = fmaxf(mx, s), corr = exp2f(mx - mn), pexp = exp2f(s - mn);
            l = l * corr + pexp; mx = mn;
            const unsigned* vp = (const unsigned*)(V + km * 384 + h * 64);
#pragma unroll
            for (int i = 0; i < 32; ++i) { const unsigned w = vp[i]; o[2 * i] = o[2 * i] * corr + pexp * lo16(w); o[2 * i + 1] = o[2 * i + 1] * corr + pexp * hi16(w); }
        }
    }
    const float il = 1.f / l;
    unsigned* op = (unsigned*)(O + m * 384 + h * 64);
#pragma unroll
    for (int i = 0; i < 32; ++i) op[i] = pk2(o[2 * i] * il, o[2 * i + 1] * il);
}
struct S5P { const float *a_re, *a_im, *b_re, *b_im, *c_re, *c_im, *d, *log_dt; };
__device__ __forceinline__ void s5_scan_job(int job, int p, const S5P& s, const bf16_t* U, float* XST) {
    const int b = job / 16, g = job % 16;
    const float dt = expf(s.log_dt[g]);
    const float are = s.a_re[g * 64 + p], aim = s.a_im[g * 64 + p];
    const float mag = expf(are * dt);
    const float lr = mag * cosf(aim * dt), li = mag * sinf(aim * dt);
    const float den = are * are + aim * aim, nr = lr - 1.f, ni = li;
    const float cr = (nr * are + ni * aim) / den, ci = (ni * are - nr * aim) / den;
    float bbr[16], bbi[16];
#pragma unroll
    for (int c = 0; c < 16; ++c) {
        const float br_ = s.b_re[(g * 64 + p) * 16 + c], bi_ = s.b_im[(g * 64 + p) * 16 + c];
        bbr[c] = cr * br_ - ci * bi_; bbi[c] = cr * bi_ + ci * br_;
    }
    float xr = 0.f, xi = 0.f;
    for (int t = 0; t < S; ++t) {
        const size_t m = (size_t)b * S + t;
        const unsigned* up = (const unsigned*)(U + m * 256 + g * 16);
        float ur = 0.f, ui = 0.f;
#pragma unroll
        for (int c2 = 0; c2 < 8; ++c2) { const unsigned w = up[c2]; const float u0 = lo16(w), u1 = hi16(w);
            ur += bbr[2 * c2] * u0 + bbr[2 * c2 + 1] * u1; ui += bbi[2 * c2] * u0 + bbi[2 * c2 + 1] * u1; }
        const float nxr = lr * xr - li * xi + ur, nxi = lr * xi + li * xr + ui;
        xr = nxr; xi = nxi;
        float2 st; st.x = xr; st.y = xi;
        *(float2*)(XST + ((m * 16 + g) * 64 + p) * 2) = st;
    }
}
struct MixP { const bf16_t *QM, *KM, *VM, *QA, *KA, *VA, *U; const float* bias; bf16_t *YC, *YA; float* XST; S5P s5; };
__device__ __forceinline__ void ph_mixers_naive(const Ctx& C, const MixP& p) {
    const int sub = C.tid >> 8, stid = C.tid & 255;
    for (int job = C.bid * 2 + sub; job < 800; job += C.nblk * 2) {
        if (job < 32) { if (stid < 64) s5_scan_job(job, stid, p.s5, p.U, p.XST); }
        else if (job < 416) mla_naive_job(job - 32, stid, p.QM, p.KM, p.VM, p.YC);
        else swa_naive_job(job - 416, stid, p.QA, p.KA, p.VA, p.bias, p.YA);
    }
}
__device__ __forceinline__ void ph_s5_out(const Ctx& C, const S5P& s, const bf16_t* U, const float* XST, bf16_t* GS) {
    for (size_t gid = (size_t)C.bid * NT + C.tid; gid < (size_t)M * 256; gid += (size_t)C.nblk * NT) {
        const size_t m = gid >> 8; const int ch = (int)(gid & 255), g = ch >> 4, c = ch & 15;
        const float* xs = XST + (m * 16 + g) * 128;
        const float* crp = s.c_re + (g * 16 + c) * 64; const float* cip = s.c_im + (g * 16 + c) * 64;
        float y = 0.f;
#pragma unroll 8
        for (int p = 0; p < 64; ++p) y += crp[p] * xs[2 * p] - cip[p] * xs[2 * p + 1];
        y += s.d[ch] * bf2f(U[m * 256 + ch]);
        GS[m * 256 + ch] = f2bf(gelu_tanh(y));
    }
}
__device__ __forceinline__ void ph_merge(const Ctx& C, const bf16_t* YA, const bf16_t* GS, const bf16_t* GL, const float* b_glu, const bf16_t* YC, bf16_t* AOUT) {
    const int lane = C.lane;
    for (size_t m = (size_t)C.bid * 8 + C.wave; m < M; m += (size_t)C.nblk * 8) {
        float v[6]; float ss = 0.f;
#pragma unroll
        for (int j = 0; j < 6; ++j) { v[j] = bf2f(YA[m * 384 + j * 64 + lane]); ss += v[j] * v[j]; }
        float r = rsqrtf(wave_sum(ss) * (1.f / 384.f) + EPS);
#pragma unroll
        for (int j = 0; j < 6; ++j) AOUT[m * D + j * 64 + lane] = f2bf(v[j] * r);
        ss = 0.f;
#pragma unroll
        for (int j = 0; j < 4; ++j) { const float g = bf2f(GS[m * 256 + j * 64 + lane]); const float z = bf2f(GL[m * 256 + j * 64 + lane]) + b_glu[j * 64 + lane];
            v[j] = g / (1.f + __expf(-z)); ss += v[j] * v[j]; }
        r = rsqrtf(wave_sum(ss) * (1.f / 256.f) + EPS);
#pragma unroll
        for (int j = 0; j < 4; ++j) AOUT[m * D + 384 + j * 64 + lane] = f2bf(v[j] * r);
        ss = 0.f;
#pragma unroll
        for (int j = 0; j < 6; ++j) { v[j] = bf2f(YC[m * 384 + j * 64 + lane]); ss += v[j] * v[j]; }
        r = rsqrtf(wave_sum(ss) * (1.f / 384.f) + EPS);
#pragma unroll
        for (int j = 0; j < 6; ++j) AOUT[m * D + 640 + j * 64 + lane] = f2bf(v[j] * r);
    }
}

__device__ __forceinline__ void ph_peer_scores(const Ctx& C, const bf16_t* QP, const bf16_t* SUBK, float* TOPS, int* TOPI) {
    if (C.wave >= 4) return;
    float* sc = (float*)C.lds + C.wave * (64 * 129);
    const int lane = C.lane;
    for (int wj = C.bid * 4 + C.wave; wj < M / 4; wj += C.nblk * 4) {
        const size_t m = (size_t)wj * 4 + (lane >> 4); const int hj = lane & 15;
        const u32x4* qp = (const u32x4*)(QP + m * 2048 + hj * 128);
        const bf16_t* sk = SUBK + (size_t)hj * 128 * 128;
        for (int key = 0; key < 128; ++key) {
            const u32x4* kp = (const u32x4*)(sk + key * 128);
            float s = 0.f;
#pragma unroll 4
            for (int d8 = 0; d8 < 16; ++d8) {
                const u32x4 a = qp[d8], bq = kp[d8];
                s += lo16(a.x) * lo16(bq.x) + hi16(a.x) * hi16(bq.x) + lo16(a.y) * lo16(bq.y) + hi16(a.y) * hi16(bq.y)
                   + lo16(a.z) * lo16(bq.z) + hi16(a.z) * hi16(bq.z) + lo16(a.w) * lo16(bq.w) + hi16(a.w) * hi16(bq.w);
            }
            sc[lane * 129 + key] = s;
        }
        for (int r = 0; r < 16; ++r) {
            float best = -INFINITY; int bi = 0;
            for (int key = 0; key < 128; ++key) { const float v = sc[lane * 129 + key]; if (v > best) { best = v; bi = key; } }
            sc[lane * 129 + bi] = -INFINITY;
            TOPS[(m * 16 + hj) * 16 + r] = best; TOPI[(m * 16 + hj) * 16 + r] = bi;
        }
    }
}
__device__ __forceinline__ void ph_peer_combine(const Ctx& C, const float* TOPS, const int* TOPI, int* EIDX, float* GATE) {
    if (C.wave >= 2) return;
    float* cand = (float*)C.lds + C.wave * (64 * 257);
    float* bs = (float*)C.lds + 2 * (64 * 257) + C.wave * (64 * 17);
    const int lane = C.lane;
    for (int wj = C.bid * 2 + C.wave; wj < M * 8 / 64; wj += C.nblk * 2) {
        const size_t mh = (size_t)wj * 64 + lane;
        const float* s1 = TOPS + (mh * 2 + 0) * 16; const float* s2 = TOPS + (mh * 2 + 1) * 16;
        const int* i1 = TOPI + (mh * 2 + 0) * 16; const int* i2 = TOPI + (mh * 2 + 1) * 16;
        for (int a = 0; a < 16; ++a) for (int b2 = 0; b2 < 16; ++b2) cand[lane * 257 + a * 16 + b2] = s1[a] + s2[b2];
        float mxv = -INFINITY;
        for (int r = 0; r < 16; ++r) {
            float best = -INFINITY; int bi = 0;
            for (int c = 0; c < 256; ++c) { const float v = cand[lane * 257 + c]; if (v > best) { best = v; bi = c; } }
            cand[lane * 257 + bi] = -INFINITY;
            bs[lane * 17 + r] = best; if (r == 0) mxv = best;
            EIDX[mh * 16 + r] = i1[bi >> 4] * 128 + i2[bi & 15];
        }
        float sum = 0.f;
        for (int r = 0; r < 16; ++r) { const float e = __expf(bs[lane * 17 + r] - mxv); bs[lane * 17 + r] = e; sum += e; }
        const float inv = 1.f / sum;
        for (int r = 0; r < 16; ++r) GATE[mh * 16 + r] = bs[lane * 17 + r] * inv;
    }
}
__device__ __forceinline__ void ph_peer_gather(const Ctx& C, const bf16_t* H, const int* EIDX, const float* GATE, const bf16_t* PU, const bf16_t* PV,
                                               const float* g2, const float* xin, float* xout) {
    const int lane = C.lane;
    for (size_t m = (size_t)C.bid * 8 + C.wave; m < M; m += (size_t)C.nblk * 8) {
        const int b = (int)(m >> 13);
        float hx[16], acc[16];
        {
            const u32x4 a = *(const u32x4*)(H + m * D + lane * 8), c = *(const u32x4*)(H + m * D + 512 + lane * 8);
            hx[0] = lo16(a.x); hx[1] = hi16(a.x); hx[2] = lo16(a.y); hx[3] = hi16(a.y); hx[4] = lo16(a.z); hx[5] = hi16(a.z); hx[6] = lo16(a.w); hx[7] = hi16(a.w);
            hx[8] = lo16(c.x); hx[9] = hi16(c.x); hx[10] = lo16(c.y); hx[11] = hi16(c.y); hx[12] = lo16(c.z); hx[13] = hi16(c.z); hx[14] = lo16(c.w); hx[15] = hi16(c.w);
        }
#pragma unroll
        for (int i = 0; i < 16; ++i) acc[i] = 0.f;
        for (int e = 0; e < 128; ++e) {
            const int idx = EIDX[m * 128 + e]; const float gt = GATE[m * 128 + e];
            const bf16_t* ur = PU + (size_t)idx * D; const bf16_t* vr = PV + (size_t)idx * D;
            const u32x4 a = *(const u32x4*)(ur + lane * 8), c = *(const u32x4*)(ur + 512 + lane * 8);
            const u32x4 va = *(const u32x4*)(vr + lane * 8), vc = *(const u32x4*)(vr + 512 + lane * 8);
            float s = hx[0] * lo16(a.x) + hx[1] * hi16(a.x) + hx[2] * lo16(a.y) + hx[3] * hi16(a.y) + hx[4] * lo16(a.z) + hx[5] * hi16(a.z) + hx[6] * lo16(a.w) + hx[7] * hi16(a.w)
                    + hx[8] * lo16(c.x) + hx[9] * hi16(c.x) + hx[10] * lo16(c.y) + hx[11] * hi16(c.y) + hx[12] * lo16(c.z) + hx[13] * hi16(c.z) + hx[14] * lo16(c.w) + hx[15] * hi16(c.w);
            s = wave_sum(s);
            const float cf = gt * gelu_tanh(s);
            acc[0] += cf * lo16(va.x); acc[1] += cf * hi16(va.x); acc[2] += cf * lo16(va.y); acc[3] += cf * hi16(va.y); acc[4] += cf * lo16(va.z); acc[5] += cf * hi16(va.z); acc[6] += cf * lo16(va.w); acc[7] += cf * hi16(va.w);
            acc[8] += cf * lo16(vc.x); acc[9] += cf * hi16(vc.x); acc[10] += cf * lo16(vc.y); acc[11] += cf * hi16(vc.y); acc[12] += cf * lo16(vc.z); acc[13] += cf * hi16(vc.z); acc[14] += cf * lo16(vc.w); acc[15] += cf * hi16(vc.w);
        }
        const float* g = g2 + b * MODW;
#pragma unroll
        for (int hlf = 0; hlf < 2; ++hlf)
#pragma unroll
            for (int q4 = 0; q4 < 2; ++q4) {
                const int c0 = hlf * 512 + lane * 8 + q4 * 4;
                const f32x4 xi = *(const f32x4*)(xin + m * D + c0), gg = *(const f32x4*)(g + c0);
                f32x4 o;
#pragma unroll
                for (int e = 0; e < 4; ++e) o[e] = xi[e] + gg[e] * acc[hlf * 8 + q4 * 4 + e];
                *(f32x4*)(xout + m * D + c0) = o;
            }
    }
}
}
namespace hy {
typedef short bf16x8 __attribute__((ext_vector_type(8)));
typedef float f32x16 __attribute__((ext_vector_type(16)));
typedef short s16x4 __attribute__((ext_vector_type(4)));
#define HY_LAS __attribute__((address_space(3)))
__device__ __forceinline__ int crow(int r, int hi) { return (r & 3) + 8 * (r >> 2) + 4 * hi; }
__device__ __forceinline__ unsigned cvtpk(float lo, float hi) { unsigned r; asm volatile("v_cvt_pk_bf16_f32 %0, %1, %2" : "=v"(r) : "v"(lo), "v"(hi)); return r; }
__device__ __forceinline__ s16x4 vtr(const HY_LAS unsigned char* p) { return __builtin_bit_cast(s16x4, __builtin_amdgcn_ds_read_tr16_b64_v4i16((HY_LAS s16x4*)p)); }

constexpr int AT_KP96 = 208, AT_KP64 = 144;
constexpr int AT_K0 = 0, AT_K1 = 13312, AT_V0 = 26624, AT_V1 = 34816, AT_BIAS = 43008, AT_END = 43008 + 1536;

struct AttnArgs {
    const bf16_t* Q; const bf16_t* K; const bf16_t* V;
    int qpitch, kpitch, vpitch;
    long q_row0; int q_rstride;
    long k_row0; int k_rstride;
    int q_idx0;
    int t_begin, t_end;
    const float* bias;
    bf16_t* O; int opitch;
    float* ML;  int mlpitch;
    int safe;
};

template <int MODE, int VAR = 0>
__device__ __forceinline__ void attn_unit(const Ctx& C, const AttnArgs& a) {
    constexpr int DQK = MODE == 0 ? 96 : 64, KP = MODE == 0 ? AT_KP96 : AT_KP64, NS = DQK / 16;
    HY_LAS unsigned char* L = (HY_LAS unsigned char*)C.lds;
    const int tid = C.tid, lane = C.lane, wave = C.wave, r32 = lane & 31, hi = lane >> 5;
    constexpr int KCH = DQK / 8;
    const int kr0 = tid / KCH, kc0 = tid % KCH;
    const int kr1 = (tid + 512) / KCH, kc1 = (tid + 512) % KCH;
    const bool k2 = (MODE == 0) && tid < 256;
    const int vr = tid >> 3, vc = tid & 7;
    const unsigned kdst0 = kr0 * KP + kc0 * 16, kdst1 = kr1 * KP + kc1 * 16, vdst = (vc >> 2) * 4096 + vr * 64 + (vc & 3) * 16;
    if (MODE == 1) { if (tid < 384) { const int dl = tid - 64; *(HY_LAS float*)(L + AT_BIAS + tid * 4) = (dl >= 0 && dl <= 128) ? a.bias[dl] : -INFINITY; } }
    const int qi = a.q_idx0 + wave * 32 + r32;
    bf16x8 qr[NS];
    {
        const bf16_t* qp = a.Q + (a.q_row0 + (long)(wave * 32 + r32) * a.q_rstride) * a.qpitch + hi * 8;
#pragma unroll
        for (int s = 0; s < NS; ++s) qr[s] = *(const bf16x8*)(qp + s * 16);
    }
    f32x16 o0, o1;
#pragma unroll
    for (int r = 0; r < 16; ++r) { o0[r] = 0.f; o1[r] = 0.f; }
    float m_ref = 0.f, l_run = 0.f; bool mzero = true;
    int wt_lo, wt_hi;
    {
        const int q_lo = a.q_idx0 + wave * 32, q_hi = q_lo + 31;
        if (MODE == 0) { wt_lo = a.t_begin; wt_hi = q_hi >> 6; }
        else { const int lo = q_lo - 128; wt_lo = lo < 0 ? 0 : (lo >> 6); if (wt_lo < a.t_begin) wt_lo = a.t_begin; wt_hi = q_hi >> 6; }
    }
    u32x4 sk0, sk1, sv;
    auto gload = [&](int t) {
        const long kb = a.k_row0 + (long)(t * 64) * a.k_rstride;
        sk0 = *(const u32x4*)(a.K + (kb + (long)kr0 * a.k_rstride) * a.kpitch + kc0 * 8);
        if (k2) sk1 = *(const u32x4*)(a.K + (kb + (long)kr1 * a.k_rstride) * a.kpitch + kc1 * 8);
        sv = *(const u32x4*)(a.V + (kb + (long)vr * a.k_rstride) * a.vpitch + vc * 8);
    };
    auto lstore = [&](int buf) {
        HY_LAS unsigned char* kb = L + (buf ? AT_K1 : AT_K0); HY_LAS unsigned char* vb = L + (buf ? AT_V1 : AT_V0);
        *(HY_LAS u32x4*)(kb + kdst0) = sk0;
        if (k2) *(HY_LAS u32x4*)(kb + kdst1) = sk1;
        *(HY_LAS u32x4*)(vb + vdst) = sv;
    };
    __syncthreads();
    gload(a.t_begin); lstore(0);
    __syncthreads();
    const unsigned voff = ((lane >> 4) & 1) * 32 + (lane & 3) * 8 + (4 * hi + ((lane & 15) >> 2)) * 64;
    for (int t = a.t_begin; t < a.t_end; ++t) {
        const int buf = (t - a.t_begin) & 1;
        const bool more = t + 1 < a.t_end;
        if (more && VAR != 2) gload(t + 1);
        if (t >= wt_lo && t <= wt_hi) {
            const HY_LAS unsigned char* kb = L + (buf ? AT_K1 : AT_K0); const HY_LAS unsigned char* vb = L + (buf ? AT_V1 : AT_V0);
            f32x16 p0, p1;
#pragma unroll
            for (int r = 0; r < 16; ++r) { p0[r] = 0.f; p1[r] = 0.f; }
#pragma unroll
            for (int s = 0; s < NS; ++s) {
                const bf16x8 a0 = *(const HY_LAS bf16x8*)(kb + r32 * KP + s * 32 + hi * 16);
                const bf16x8 a1 = *(const HY_LAS bf16x8*)(kb + (32 + r32) * KP + s * 32 + hi * 16);
                p0 = __builtin_amdgcn_mfma_f32_32x32x16_bf16(a0, qr[s], p0, 0, 0, 0);
                p1 = __builtin_amdgcn_mfma_f32_32x32x16_bf16(a1, qr[s], p1, 0, 0, 0);
            }
            if (MODE == 0) {
                if (t * 64 + 63 > a.q_idx0 + wave * 32) {
                    const int kbase = t * 64 + 4 * hi;
#pragma unroll
                    for (int r = 0; r < 16; ++r) { const int kj = kbase + (r & 3) + 8 * (r >> 2); if (kj > qi) p0[r] = -INFINITY; if (kj + 32 > qi) p1[r] = -INFINITY; }
                }
            } else {
                const HY_LAS float* bp = (const HY_LAS float*)(L + AT_BIAS) + (64 + qi - t * 64 - 4 * hi - 63);
#pragma unroll
                for (int r = 0; r < 16; ++r) { const int off = (r & 3) + 8 * (r >> 2); p0[r] += bp[63 - off]; p1[r] += bp[63 - 32 - off]; }
            }
            if (!mzero) {
#pragma unroll
                for (int r = 0; r < 16; ++r) { p0[r] -= m_ref; p1[r] -= m_ref; }
            }
            if (!a.safe) {
                float mx = __builtin_fmaxf(p0[0], p1[0]);
#pragma unroll
                for (int r = 1; r < 16; ++r) mx = __builtin_fmaxf(__builtin_fmaxf(mx, p0[r]), p1[r]);
                if (__builtin_expect(__any(mx > 16.f), 0)) {
                    mx = fmaxf(mx, __shfl_xor(mx, 32));
                    const float dl = fmaxf(mx, 0.f), f = __builtin_amdgcn_exp2f(-dl);
                    m_ref += dl; l_run *= f; mzero = false;
#pragma unroll
                    for (int r = 0; r < 16; ++r) { p0[r] -= dl; p1[r] -= dl; o0[r] *= f; o1[r] *= f; }
                }
            }
            float rs0 = 0.f, rs1 = 0.f;
#pragma unroll
            for (int r = 0; r < 16; ++r) { if (VAR != 1) { p0[r] = __builtin_amdgcn_exp2f(p0[r]); p1[r] = __builtin_amdgcn_exp2f(p1[r]); } rs0 += p0[r]; rs1 += p1[r]; }
            l_run += rs0 + rs1;
            u32x4 pw[4];
            pw[0] = (u32x4){cvtpk(p0[0], p0[1]), cvtpk(p0[2], p0[3]), cvtpk(p0[4], p0[5]), cvtpk(p0[6], p0[7])};
            pw[1] = (u32x4){cvtpk(p0[8], p0[9]), cvtpk(p0[10], p0[11]), cvtpk(p0[12], p0[13]), cvtpk(p0[14], p0[15])};
            pw[2] = (u32x4){cvtpk(p1[0], p1[1]), cvtpk(p1[2], p1[3]), cvtpk(p1[4], p1[5]), cvtpk(p1[6], p1[7])};
            pw[3] = (u32x4){cvtpk(p1[8], p1[9]), cvtpk(p1[10], p1[11]), cvtpk(p1[12], p1[13]), cvtpk(p1[14], p1[15])};
#pragma unroll
            for (int s = 0; s < 4; ++s) {
                const s16x4 l0 = vtr(vb + voff + s * 1024), h0 = vtr(vb + voff + s * 1024 + 512);
                const s16x4 l1 = vtr(vb + voff + 4096 + s * 1024), h1 = vtr(vb + voff + 4096 + s * 1024 + 512);
                const bf16x8 vf0 = (bf16x8){l0[0], l0[1], l0[2], l0[3], h0[0], h0[1], h0[2], h0[3]};
                const bf16x8 vf1 = (bf16x8){l1[0], l1[1], l1[2], l1[3], h1[0], h1[1], h1[2], h1[3]};
                const bf16x8 pf = __builtin_bit_cast(bf16x8, pw[s]);
                o0 = __builtin_amdgcn_mfma_f32_32x32x16_bf16(vf0, pf, o0, 0, 0, 0);
                o1 = __builtin_amdgcn_mfma_f32_32x32x16_bf16(vf1, pf, o1, 0, 0, 0);
            }
        }
        if (more && VAR != 2) lstore(buf ^ 1);
        if (VAR != 2) __syncthreads();
    }
    l_run += __shfl_xor(l_run, 32);
    const float il = 1.f / l_run;
    const long orow = a.q_row0 + (long)(wave * 32 + r32) * a.q_rstride;
    bf16_t* op = a.O + orow * a.opitch + 4 * hi;
#pragma unroll
    for (int g = 0; g < 4; ++g) {
        u32x2 w0, w1;
        w0.x = cvtpk(o0[4 * g] * il, o0[4 * g + 1] * il); w0.y = cvtpk(o0[4 * g + 2] * il, o0[4 * g + 3] * il);
        w1.x = cvtpk(o1[4 * g] * il, o1[4 * g + 1] * il); w1.y = cvtpk(o1[4 * g + 2] * il, o1[4 * g + 3] * il);
        *(u32x2*)(op + 8 * g) = w0; *(u32x2*)(op + 32 + 8 * g) = w1;
    }
    if (MODE == 1 && hi == 0) { float2 ml; ml.x = m_ref; ml.y = l_run; *(float2*)(a.ML + orow * a.mlpitch) = ml; }
}
constexpr int M2_KS = 64 * AT_KP96, M2_K = 0, M2_V = 4 * M2_KS, M2_END = M2_V + 4 * 8192;
__device__ __forceinline__ void mla_unit2(const Ctx& C, const AttnArgs& a) {
    constexpr int KP = AT_KP96, NS = 6, KCH = 12;
    HY_LAS unsigned char* L = (HY_LAS unsigned char*)C.lds;
    const int tid = C.tid, lane = C.lane, wave = C.wave, r32 = lane & 31, hi = lane >> 5;
    const int kr0 = tid / KCH, kc0 = tid % KCH, kr1 = (tid + 512) / KCH, kc1 = (tid + 512) % KCH;
    const bool k2 = tid < 256;
    const int vr = tid >> 3, vc = tid & 7;
    const unsigned kdst0 = kr0 * KP + kc0 * 16, kdst1 = kr1 * KP + kc1 * 16, vdst = (vc >> 2) * 4096 + vr * 64 + (vc & 3) * 16;
    const int qi = a.q_idx0 + wave * 32 + r32;
    bf16x8 qr[NS];
    {
        const bf16_t* qp = a.Q + (a.q_row0 + (long)(wave * 32 + r32) * a.q_rstride) * a.qpitch + hi * 8;
#pragma unroll
        for (int s = 0; s < NS; ++s) qr[s] = *(const bf16x8*)(qp + s * 16);
    }
    f32x16 o0, o1;
#pragma unroll
    for (int r = 0; r < 16; ++r) { o0[r] = 0.f; o1[r] = 0.f; }
    float m_ref = 0.f, l_run = 0.f; bool mzero = true;
    const int wt_hi = (a.q_idx0 + wave * 32 + 31) >> 6;
    u32x4 sa0, sa1, sav, sb0, sb1, sbv;
#define HY_M2LOAD(S0, S1, SV, t_) do { const long kb_ = a.k_row0 + (long)((t_) * 64); \
        S0 = *(const u32x4*)(a.K + (kb_ + kr0) * a.kpitch + kc0 * 8); if (k2) S1 = *(const u32x4*)(a.K + (kb_ + kr1) * a.kpitch + kc1 * 8); \
        SV = *(const u32x4*)(a.V + (kb_ + vr) * a.vpitch + vc * 8); } while (0)
#define HY_M2STORE(S0, S1, SV, slot_) do { *(HY_LAS u32x4*)(L + M2_K + (slot_) * M2_KS + kdst0) = S0; if (k2) *(HY_LAS u32x4*)(L + M2_K + (slot_) * M2_KS + kdst1) = S1; \
        *(HY_LAS u32x4*)(L + M2_V + (slot_) * 8192 + vdst) = SV; } while (0)
    const int nstep = a.t_end >> 1;
    __syncthreads();
    HY_M2LOAD(sa0, sa1, sav, 0); HY_M2LOAD(sb0, sb1, sbv, 1);
    HY_M2STORE(sa0, sa1, sav, 0); HY_M2STORE(sb0, sb1, sbv, 1);
    __syncthreads();
    const unsigned voff = ((lane >> 4) & 1) * 32 + (lane & 3) * 8 + (4 * hi + ((lane & 15) >> 2)) * 64;
#pragma unroll 1
    for (int st = 0; st < nstep; ++st) {
        const int buf = st & 1;
        if (st + 1 < nstep) { HY_M2LOAD(sa0, sa1, sav, 2 * st + 2); HY_M2LOAD(sb0, sb1, sbv, 2 * st + 3); }
#pragma unroll
        for (int j = 0; j < 2; ++j) {
            const int t = 2 * st + j;
            if (t <= wt_hi) {
                const int slot = buf * 2 + j;
                const HY_LAS unsigned char* kb = L + M2_K + slot * M2_KS; const HY_LAS unsigned char* vb = L + M2_V + slot * 8192;
                f32x16 p0, p1;
#pragma unroll
                for (int r = 0; r < 16; ++r) { p0[r] = 0.f; p1[r] = 0.f; }
#pragma unroll
                for (int ss = 0; ss < NS; ++ss) {
                    const bf16x8 a0 = *(const HY_LAS bf16x8*)(kb + r32 * KP + ss * 32 + hi * 16);
                    const bf16x8 a1 = *(const HY_LAS bf16x8*)(kb + (32 + r32) * KP + ss * 32 + hi * 16);
                    p0 = __builtin_amdgcn_mfma_f32_32x32x16_bf16(a0, qr[ss], p0, 0, 0, 0);
                    p1 = __builtin_amdgcn_mfma_f32_32x32x16_bf16(a1, qr[ss], p1, 0, 0, 0);
                }
                if (t * 64 + 63 > a.q_idx0 + wave * 32) {
                    const int kbase = t * 64 + 4 * hi;
#pragma unroll
                    for (int r = 0; r < 16; ++r) { const int kj = kbase + (r & 3) + 8 * (r >> 2); if (kj > qi) p0[r] = -INFINITY; if (kj + 32 > qi) p1[r] = -INFINITY; }
                }
                if (!mzero) {
#pragma unroll
                    for (int r = 0; r < 16; ++r) { p0[r] -= m_ref; p1[r] -= m_ref; }
                }
                if (!a.safe) {
                    float mx = __builtin_fmaxf(p0[0], p1[0]);
#pragma unroll
                    for (int r = 1; r < 16; ++r) mx = __builtin_fmaxf(__builtin_fmaxf(mx, p0[r]), p1[r]);
                    if (__builtin_expect(__any(mx > 16.f), 0)) {
                        mx = fmaxf(mx, __shfl_xor(mx, 32));
                        const float dl = fmaxf(mx, 0.f), f = __builtin_amdgcn_exp2f(-dl);
                        m_ref += dl; l_run *= f; mzero = false;
#pragma unroll
                        for (int r = 0; r < 16; ++r) { p0[r] -= dl; p1[r] -= dl; o0[r] *= f; o1[r] *= f; }
                    }
                }
                float rs0 = 0.f, rs1 = 0.f;
#pragma unroll
                for (int r = 0; r < 16; ++r) { p0[r] = __builtin_amdgcn_exp2f(p0[r]); p1[r] = __builtin_amdgcn_exp2f(p1[r]); rs0 += p0[r]; rs1 += p1[r]; }
                l_run += rs0 + rs1;
                u32x4 pw[4];
                pw[0] = (u32x4){cvtpk(p0[0], p0[1]), cvtpk(p0[2], p0[3]), cvtpk(p0[4], p0[5]), cvtpk(p0[6], p0[7])};
                pw[1] = (u32x4){cvtpk(p0[8], p0[9]), cvtpk(p0[10], p0[11]), cvtpk(p0[12], p0[13]), cvtpk(p0[14], p0[15])};
                pw[2] = (u32x4){cvtpk(p1[0], p1[1]), cvtpk(p1[2], p1[3]), cvtpk(p1[4], p1[5]), cvtpk(p1[6], p1[7])};
                pw[3] = (u32x4){cvtpk(p1[8], p1[9]), cvtpk(p1[10], p1[11]), cvtpk(p1[12], p1[13]), cvtpk(p1[14], p1[15])};
#pragma unroll
                for (int ss = 0; ss < 4; ++ss) {
                    const s16x4 l0 = vtr(vb + voff + ss * 1024), h0 = vtr(vb + voff + ss * 1024 + 512);
                    const s16x4 l1 = vtr(vb + voff + 4096 + ss * 1024), h1 = vtr(vb + voff + 4096 + ss * 1024 + 512);
                    const bf16x8 vf0 = (bf16x8){l0[0], l0[1], l0[2], l0[3], h0[0], h0[1], h0[2], h0[3]};
                    const bf16x8 vf1 = (bf16x8){l1[0], l1[1], l1[2], l1[3], h1[0], h1[1], h1[2], h1[3]};
                    const bf16x8 pf = __builtin_bit_cast(bf16x8, pw[ss]);
                    o0 = __builtin_amdgcn_mfma_f32_32x32x16_bf16(vf0, pf, o0, 0, 0, 0);
                    o1 = __builtin_amdgcn_mfma_f32_32x32x16_bf16(vf1, pf, o1, 0, 0, 0);
                }
            }
        }
        if (st + 1 < nstep) { HY_M2STORE(sa0, sa1, sav, (buf ^ 1) * 2); HY_M2STORE(sb0, sb1, sbv, (buf ^ 1) * 2 + 1); }
        __syncthreads();
    }
    l_run += __shfl_xor(l_run, 32);
    const float il = 1.f / l_run;
    const long orow = a.q_row0 + (long)(wave * 32 + r32) * a.q_rstride;
    bf16_t* op = a.O + orow * a.opitch + 4 * hi;
#pragma unroll
    for (int g = 0; g < 4; ++g) {
        u32x2 w0, w1;
        w0.x = cvtpk(o0[4 * g] * il, o0[4 * g + 1] * il); w0.y = cvtpk(o0[4 * g + 2] * il, o0[4 * g + 3] * il);
        w1.x = cvtpk(o1[4 * g] * il, o1[4 * g + 1] * il); w1.y = cvtpk(o1[4 * g + 2] * il, o1[4 * g + 3] * il);
        *(u32x2*)(op + 8 * g) = w0; *(u32x2*)(op + 32 + 8 * g) = w1;
    }
}
constexpr int SP_KS = 64 * AT_KP64, SP_K = 0, SP_V = 4 * SP_KS, SP_BIAS = SP_V + 4 * 8192, SP_END = SP_BIAS + 1536;
__device__ __forceinline__ void swa_unit_pair(const Ctx& C, const AttnArgs& a) {
    constexpr int KP = AT_KP64, NS = 4;
    HY_LAS unsigned char* L = (HY_LAS unsigned char*)C.lds;
    const int tid = C.tid, lane = C.lane, wave = C.wave, r32 = lane & 31, hi = lane >> 5;
    const int kr0 = tid >> 3, kc0 = tid & 7, vr = tid >> 3, vc = tid & 7;
    const unsigned kdst0 = kr0 * KP + kc0 * 16, vdst = (vc >> 2) * 4096 + vr * 64 + (vc & 3) * 16;
    if (tid < 384) { const int dl = tid - 64; *(HY_LAS float*)(L + SP_BIAS + tid * 4) = (dl >= 0 && dl <= 128) ? a.bias[dl] : -INFINITY; }
    const int qi = a.q_idx0 + wave * 32 + r32;
    bf16x8 qr[NS];
    {
        const bf16_t* qp = a.Q + (a.q_row0 + (long)(wave * 32 + r32) * a.q_rstride) * a.qpitch + hi * 8;
#pragma unroll
        for (int s = 0; s < NS; ++s) qr[s] = *(const bf16x8*)(qp + s * 16);
    }
    f32x16 o0, o1;
#pragma unroll
    for (int r = 0; r < 16; ++r) { o0[r] = 0.f; o1[r] = 0.f; }
    float m_ref = 0.f, l_run = 0.f; bool mzero = true;
    const int q_lo = a.q_idx0 + wave * 32, q_hi = q_lo + 31;
    const int wt_lo = q_lo - 128 < 0 ? 0 : ((q_lo - 128) >> 6), wt_hi = q_hi >> 6;
    const int T0 = (a.q_idx0 - 128) >> 6;
    u32x4 skA, svA, skB, svB;
#define HY_SPLOAD(SK, SV, t_) do { if ((t_) >= 0) { const long kb_ = a.k_row0 + (long)((t_) * 64) * a.k_rstride; \
        SK = *(const u32x4*)(a.K + (kb_ + (long)kr0 * a.k_rstride) * a.kpitch + kc0 * 8); SV = *(const u32x4*)(a.V + (kb_ + (long)vr * a.k_rstride) * a.vpitch + vc * 8); } } while (0)
#define HY_SPSTORE(SK, SV, slot_) do { *(HY_LAS u32x4*)(L + SP_K + (slot_) * SP_KS + kdst0) = SK; *(HY_LAS u32x4*)(L + SP_V + (slot_) * 8192 + vdst) = SV; } while (0)
    __syncthreads();
    HY_SPLOAD(skA, svA, T0); HY_SPLOAD(skB, svB, T0 + 3);
    HY_SPSTORE(skA, svA, 0); HY_SPSTORE(skB, svB, 1);
    __syncthreads();
    const unsigned voff = ((lane >> 4) & 1) * 32 + (lane & 3) * 8 + (4 * hi + ((lane & 15) >> 2)) * 64;
#pragma unroll 1
    for (int s = 0; s < 3; ++s) {
        const int buf = s & 1;
        if (s + 1 < 3) { HY_SPLOAD(skA, svA, T0 + s + 1); HY_SPLOAD(skB, svB, T0 + s + 4); }
        const int tA = T0 + s, tB = T0 + s + 3;
        const bool useA = tA >= wt_lo && tA <= wt_hi, useB = tB >= wt_lo && tB <= wt_hi;
        if (useA || useB) {
            const int t = useA ? tA : tB, slot = buf * 2 + (useA ? 0 : 1);
            const HY_LAS unsigned char* kb = L + SP_K + slot * SP_KS; const HY_LAS unsigned char* vb = L + SP_V + slot * 8192;
            f32x16 p0, p1;
            const HY_LAS float* bp = (const HY_LAS float*)(L + SP_BIAS) + (64 + qi - t * 64 - 4 * hi - 63);
#pragma unroll
            for (int r = 0; r < 16; ++r) { const int off = (r & 3) + 8 * (r >> 2); p0[r] = bp[63 - off]; p1[r] = bp[63 - 32 - off]; }
#pragma unroll
            for (int ss = 0; ss < NS; ++ss) {
                const bf16x8 a0 = *(const HY_LAS bf16x8*)(kb + r32 * KP + ss * 32 + hi * 16);
                const bf16x8 a1 = *(const HY_LAS bf16x8*)(kb + (32 + r32) * KP + ss * 32 + hi * 16);
                p0 = __builtin_amdgcn_mfma_f32_32x32x16_bf16(a0, qr[ss], p0, 0, 0, 0);
                p1 = __builtin_amdgcn_mfma_f32_32x32x16_bf16(a1, qr[ss], p1, 0, 0, 0);
            }
            if (!mzero) {
#pragma unroll
                for (int r = 0; r < 16; ++r) { p0[r] -= m_ref; p1[r] -= m_ref; }
            }
            if (!a.safe) {
                float mx = __builtin_fmaxf(p0[0], p1[0]);
#pragma unroll
                for (int r = 1; r < 16; ++r) mx = __builtin_fmaxf(__builtin_fmaxf(mx, p0[r]), p1[r]);
                if (__builtin_expect(__any(mx > 16.f), 0)) {
                    mx = fmaxf(mx, __shfl_xor(mx, 32));
                    const float dl = fmaxf(mx, 0.f), f = __builtin_amdgcn_exp2f(-dl);
                    m_ref += dl; l_run *= f; mzero = false;
#pragma unroll
                    for (int r = 0; r < 16; ++r) { p0[r] -= dl; p1[r] -= dl; o0[r] *= f; o1[r] *= f; }
                }
            }
            float rs0 = 0.f, rs1 = 0.f;
#pragma unroll
            for (int r = 0; r < 16; ++r) { p0[r] = __builtin_amdgcn_exp2f(p0[r]); p1[r] = __builtin_amdgcn_exp2f(p1[r]); rs0 += p0[r]; rs1 += p1[r]; }
            l_run += rs0 + rs1;
            u32x4 pw[4];
            pw[0] = (u32x4){cvtpk(p0[0], p0[1]), cvtpk(p0[2], p0[3]), cvtpk(p0[4], p0[5]), cvtpk(p0[6], p0[7])};
            pw[1] = (u32x4){cvtpk(p0[8], p0[9]), cvtpk(p0[10], p0[11]), cvtpk(p0[12], p0[13]), cvtpk(p0[14], p0[15])};
            pw[2] = (u32x4){cvtpk(p1[0], p1[1]), cvtpk(p1[2], p1[3]), cvtpk(p1[4], p1[5]), cvtpk(p1[6], p1[7])};
            pw[3] = (u32x4){cvtpk(p1[8], p1[9]), cvtpk(p1[10], p1[11]), cvtpk(p1[12], p1[13]), cvtpk(p1[14], p1[15])};
#pragma unroll
            for (int ss = 0; ss < 4; ++ss) {
                const s16x4 l0 = vtr(vb + voff + ss * 1024), h0 = vtr(vb + voff + ss * 1024 + 512);
                const s16x4 l1 = vtr(vb + voff + 4096 + ss * 1024), h1 = vtr(vb + voff + 4096 + ss * 1024 + 512);
                const bf16x8 vf0 = (bf16x8){l0[0], l0[1], l0[2], l0[3], h0[0], h0[1], h0[2], h0[3]};
                const bf16x8 vf1 = (bf16x8){l1[0], l1[1], l1[2], l1[3], h1[0], h1[1], h1[2], h1[3]};
                const bf16x8 pf = __builtin_bit_cast(bf16x8, pw[ss]);
                o0 = __builtin_amdgcn_mfma_f32_32x32x16_bf16(vf0, pf, o0, 0, 0, 0);
                o1 = __builtin_amdgcn_mfma_f32_32x32x16_bf16(vf1, pf, o1, 0, 0, 0);
            }
        }
        if (s + 1 < 3) { HY_SPSTORE(skA, svA, (buf ^ 1) * 2); HY_SPSTORE(skB, svB, (buf ^ 1) * 2 + 1); }
        __syncthreads();
    }
    l_run += __shfl_xor(l_run, 32);
    const float il = 1.f / l_run;
    const long orow = a.q_row0 + (long)(wave * 32 + r32) * a.q_rstride;
    bf16_t* op = a.O + orow * a.opitch + 4 * hi;
#pragma unroll
    for (int g = 0; g < 4; ++g) {
        u32x2 w0, w1;
        w0.x = cvtpk(o0[4 * g] * il, o0[4 * g + 1] * il); w0.y = cvtpk(o0[4 * g + 2] * il, o0[4 * g + 3] * il);
        w1.x = cvtpk(o1[4 * g] * il, o1[4 * g + 1] * il); w1.y = cvtpk(o1[4 * g + 2] * il, o1[4 * g + 3] * il);
        *(u32x2*)(op + 8 * g) = w0; *(u32x2*)(op + 32 + 8 * g) = w1;
    }
    if (hi == 0) { float2 ml; ml.x = m_ref; ml.y = l_run; *(float2*)(a.ML + orow * a.mlpitch) = ml; }
}
}
namespace hy {
constexpr size_t S5_KM_L = 16 * 64 * 256, S5_WE_L = 16 * 128 * 1024, S5_WC_L = 16 * 1024 * 128;
__device__ __forceinline__ void ph_s5_lampow(const Ctx& C, const In& in, float* LP) {
    for (int gid = C.bid * NT + C.tid; gid < NL * 16 * 64 * 65; gid += C.nblk * NT) {
        const int m = gid % 65, lgp = gid / 65, lg = lgp / 64;
        const float dt = expf(in.s5_log_dt[lg]);
        const float are = in.s5_a_re[lgp], aim = in.s5_a_im[lgp];
        const float mag = expf(are * dt * (float)m), ang = aim * dt * (float)m;
        float sn, cs; sincosf(ang, &sn, &cs);
        float2 o; o.x = mag * cs; o.y = mag * sn;
        *(float2*)(LP + (size_t)gid * 2) = o;
    }
}
__device__ __forceinline__ void ph_s5_bbar(const Ctx& C, const In& in, float* BB) {
    for (int gid = C.bid * NT + C.tid; gid < NL * 16 * 64 * 16; gid += C.nblk * NT) {
        const int lgp = gid >> 4, lg = lgp >> 6;
        const float dt = expf(in.s5_log_dt[lg]);
        const float are = in.s5_a_re[lgp], aim = in.s5_a_im[lgp];
        const float mag = expf(are * dt); float sn, cs; sincosf(aim * dt, &sn, &cs);
        const float lr = mag * cs, li = mag * sn;
        const float den = are * are + aim * aim, nr = lr - 1.f, ni = li;
        const float cr = (nr * are + ni * aim) / den, ci = (ni * are - nr * aim) / den;
        const float br = in.s5_b_re[gid], bi = in.s5_b_im[gid];
        float2 o; o.x = cr * br - ci * bi; o.y = cr * bi + ci * br;
        *(float2*)(BB + (size_t)gid * 2) = o;
    }
}
__device__ __forceinline__ void ph_s5_tables(const Ctx& C, const In& in, const float* LP, const float* BB, bf16_t* KM, bf16_t* WE, bf16_t* WC) {
    float* Cs = (float*)C.lds;
    float* Bs = Cs + 2048;
    float* Ls = Bs + 2048;
    const int tid = C.tid;
    for (int job = C.bid; job < NL * 16 * 4; job += C.nblk) {
        const int lg = job >> 2, qt = job & 3;
        __syncthreads();
        if (tid < 256) { const f32x4 r4 = *(const f32x4*)(in.s5_c_re + (size_t)lg * 1024 + tid * 4), i4 = *(const f32x4*)(in.s5_c_im + (size_t)lg * 1024 + tid * 4);
            *(f32x4*)(Cs + tid * 8) = (f32x4){r4[0], i4[0], r4[1], i4[1]}; *(f32x4*)(Cs + tid * 8 + 4) = (f32x4){r4[2], i4[2], r4[3], i4[3]}; }
        *(f32x4*)(Bs + tid * 4) = *(const f32x4*)(BB + (size_t)lg * 2048 + tid * 4);
        for (int i = tid; i < 64 * 65 * 2 / 4; i += NT) *(f32x4*)(Ls + i * 4) = *(const f32x4*)(LP + (size_t)lg * 64 * 65 * 2 + i * 4);
        __syncthreads();
        {
            const int lag = qt * 16 + (tid >> 5), c = (tid >> 1) & 15, jh = tid & 1;
            float a[8];
#pragma unroll
            for (int j = 0; j < 8; ++j) a[j] = 0.f;
#pragma unroll 4
            for (int p = 0; p < 64; ++p) {
                const float2 lm = *(const float2*)(Ls + (p * 65 + lag) * 2), cc = *(const float2*)(Cs + (c * 64 + p) * 2);
                const float xr = cc.x * lm.x - cc.y * lm.y, xi = cc.x * lm.y + cc.y * lm.x;
#pragma unroll
                for (int j = 0; j < 8; j += 2) { const f32x4 b4 = *(const f32x4*)(Bs + (p * 16 + 8 * jh + j) * 2); a[j] += xr * b4[0] - xi * b4[1]; a[j + 1] += xr * b4[2] - xi * b4[3]; }
            }
            *(u32x4*)(KM + ((size_t)lg * 64 + lag) * 256 + c * 16 + 8 * jh) = (u32x4){pk2(a[0], a[1]), pk2(a[2], a[3]), pk2(a[4], a[5]), pk2(a[6], a[7])};
        }
#pragma unroll 1
        for (int it = 0; it < 4; ++it) {
            const int idx = it * NT + tid, i = idx & 63, k = qt * 32 + (idx >> 6), ri = k >> 6, p = k & 63;
            const float2 lm = *(const float2*)(Ls + (p * 65 + 63 - i) * 2);
            unsigned w[8];
#pragma unroll
            for (int cp = 0; cp < 8; ++cp) {
                const f32x4 bb = *(const f32x4*)(Bs + (p * 16 + 2 * cp) * 2);
                const float v0 = ri ? (lm.x * bb[1] + lm.y * bb[0]) : (lm.x * bb[0] - lm.y * bb[1]);
                const float v1 = ri ? (lm.x * bb[3] + lm.y * bb[2]) : (lm.x * bb[2] - lm.y * bb[3]);
                w[cp] = pk2(v0, v1);
            }
            bf16_t* o = WE + (((size_t)lg * 128 + k) * 64 + i) * 16;
            *(u32x4*)o = (u32x4){w[0], w[1], w[2], w[3]}; *(u32x4*)(o + 8) = (u32x4){w[4], w[5], w[6], w[7]};
        }
#pragma unroll 1
        for (int it = 0; it < 8; ++it) {
            const int idx = it * NT + tid, ko = idx & 15, c = (idx >> 4) & 15, j = qt * 16 + (idx >> 8), ri = ko >> 3, p0 = (ko & 7) * 8;
            unsigned w[4];
#pragma unroll
            for (int e = 0; e < 4; ++e) {
                const int p = p0 + 2 * e;
                const float2 lm0 = *(const float2*)(Ls + (p * 65 + j + 1) * 2), lm1 = *(const float2*)(Ls + ((p + 1) * 65 + j + 1) * 2);
                const f32x4 cc = *(const f32x4*)(Cs + (c * 64 + p) * 2);
                const float v0 = ri ? -(cc[0] * lm0.y + cc[1] * lm0.x) : (cc[0] * lm0.x - cc[1] * lm0.y);
                const float v1 = ri ? -(cc[2] * lm1.y + cc[3] * lm1.x) : (cc[2] * lm1.x - cc[3] * lm1.y);
                w[e] = pk2(v0, v1);
            }
            *(u32x4*)(WC + (((size_t)lg * 64 + j) * 16 + c) * 128 + ko * 8) = (u32x4){w[0], w[1], w[2], w[3]};
        }
    }
    __syncthreads();
}
__device__ __forceinline__ void ph_s5_chunk_states(const Ctx& C, const bf16_t* U, const bf16_t* WEl, float* E) {
    const int lane = C.lane, wave = C.wave, r32 = lane & 31, hi = lane >> 5;
    for (int unit = (C.nblk >= 192 ? C.bid - (C.nblk - 64) : C.bid); unit < 64; unit += C.nblk) {
        if (unit < 0) break;
        const int g = unit & 15, nb = unit >> 4, mt = wave & 3, nh = wave >> 2;
        const int n = nb * 64 + nh * 32 + r32;
        const bf16_t* ap = WEl + ((size_t)g * 128 + mt * 32 + r32) * 1024 + hi * 8;
        const bf16_t* bp = U + (size_t)n * 64 * 256 + g * 16 + hi * 8;
        f32x16 acc;
#pragma unroll
        for (int r = 0; r < 16; ++r) acc[r] = 0.f;
#pragma unroll 16
        for (int i = 0; i < 64; ++i) {
            const bf16x8 af = *(const bf16x8*)(ap + i * 16);
            const bf16x8 bf = *(const bf16x8*)(bp + (size_t)i * 256);
            acc = __builtin_amdgcn_mfma_f32_32x32x16_bf16(af, bf, acc, 0, 0, 0);
        }
        float* ep = E + ((size_t)n * 16 + g) * 128 + mt * 32 + 4 * hi;
#pragma unroll
        for (int q4 = 0; q4 < 4; ++q4) *(f32x4*)(ep + 8 * q4) = (f32x4){acc[4 * q4], acc[4 * q4 + 1], acc[4 * q4 + 2], acc[4 * q4 + 3]};
    }
}
constexpr int S5_UP = 2064;
constexpr int S5L_U = 0, S5L_KM = 32 * S5_UP, S5L_X = S5L_KM + 512 + 64 * 512, S5L_XP = 272, S5L_END = S5L_X + 32 * S5L_XP;
struct S5U { const bf16_t* U; const bf16_t* KMl; const bf16_t* WCl; const float* E; const float* LP; const float* dskip; bf16_t* GS; int layer; int var; };
__device__ __forceinline__ void s5_unit(const Ctx& C, const S5U& a, int unit) {
    HY_LAS unsigned char* L = (HY_LAS unsigned char*)C.lds;
    const int tid = C.tid, lane = C.lane, wave = C.wave, r32 = lane & 31, hi = lane >> 5;
    const int g = unit & 15, blk = unit >> 4;
    const int b = blk >> 2, n0 = (blk & 3) * 32, nglob0 = b * 128 + n0;
    __syncthreads();
#pragma unroll
    for (int i = 0; i < 8; ++i) {
        const int c = tid + i * 512, n = c >> 7, tk = (c >> 1) & 63, hf = c & 1;
        const u32x4 v = *(const u32x4*)(a.U + ((size_t)(nglob0 + n) * 64 + tk) * 256 + g * 16 + hf * 8);
        *(HY_LAS u32x4*)(L + S5L_U + n * S5_UP + tk * 32 + hf * 16) = v;
    }
#pragma unroll
    for (int i = 0; i < 4; ++i) {
        const int c = tid + i * 512;
        const u32x4 v = *(const u32x4*)(a.KMl + (size_t)g * 16384 + c * 8);
        *(HY_LAS u32x4*)(L + S5L_KM + 512 + c * 16) = v;
    }
    if (tid < 32) { unsigned zz = 0u; asm volatile("" : "+v"(zz)); *(HY_LAS u32x4*)(L + S5L_KM + tid * 16) = (u32x4){zz, zz, zz, zz}; }
    if (wave == 0 && a.var != 2) {
        const int p = lane, lgp = (a.layer * 16 + g) * 64 + p;
        const float2 lam = *(const float2*)(a.LP + ((size_t)lgp * 65 + 64) * 2);
        float xr = 0.f, xi = 0.f;
        const float* ep = a.E + ((size_t)(b * 128) * 16 + g) * 128 + p;
        for (int nb = 0; nb < n0 + 32; nb += 16) {
            float er[16], ei[16];
#pragma unroll
            for (int j = 0; j < 16; ++j) { er[j] = ep[(size_t)(nb + j) * 2048]; ei[j] = ep[(size_t)(nb + j) * 2048 + 64]; }
#pragma unroll
            for (int j = 0; j < 16; ++j) {
                const int n = nb + j;
                if (n >= n0) {
                    *(HY_LAS bf16_t*)(L + S5L_X + (n - n0) * S5L_XP + p * 2) = f2bf(xr);
                    *(HY_LAS bf16_t*)(L + S5L_X + (n - n0) * S5L_XP + (64 + p) * 2) = f2bf(xi);
                }
                const float nr = lam.x * xr - lam.y * xi + er[j], ni = lam.x * xi + lam.y * xr + ei[j];
                xr = nr; xi = ni;
            }
        }
    }
    __syncthreads();
    const float dsk0 = 0.f; (void)dsk0;
#pragma unroll 1
    for (int q = 0; q < 4; ++q) {
        const int mt = q == 0 ? wave : (q == 1 ? 15 - wave : (q == 2 ? 16 + wave : 31 - wave));
        f32x16 acc;
#pragma unroll
        for (int r = 0; r < 16; ++r) acc[r] = 0.f;
        {
            const bf16_t* wp = a.WCl + ((size_t)g * 1024 + mt * 32 + r32) * 128 + hi * 8;
#pragma unroll
            for (int s = 0; s < 8; ++s) {
                const bf16x8 af = *(const bf16x8*)(wp + s * 16);
                const bf16x8 bf = *(const HY_LAS bf16x8*)(L + S5L_X + r32 * S5L_XP + s * 32 + hi * 16);
                acc = __builtin_amdgcn_mfma_f32_32x32x16_bf16(af, bf, acc, 0, 0, 0);
            }
        }
        const int iend = (a.var == 1) ? 0 : 2 * mt + 2;
#pragma unroll 4
        for (int i = 0; i < iend; ++i) {
            const bf16x8 af = *(const HY_LAS bf16x8*)(L + S5L_KM + 512 + (2 * mt - i) * 512 + r32 * 32 + hi * 16);
            const bf16x8 bf = *(const HY_LAS bf16x8*)(L + S5L_U + r32 * S5_UP + i * 32 + hi * 16);
            acc = __builtin_amdgcn_mfma_f32_32x32x16_bf16(af, bf, acc, 0, 0, 0);
        }
#pragma unroll
        for (int q4 = 0; q4 < 4; ++q4) {
            const int j = 2 * mt + (q4 >> 1), c0 = 8 * (q4 & 1) + 4 * hi;
            const u32x2 uu = *(const HY_LAS u32x2*)(L + S5L_U + r32 * S5_UP + j * 32 + c0 * 2);
            const f32x4 dd = *(const f32x4*)(a.dskip + g * 16 + c0);
            const float y0 = acc[4 * q4] + dd[0] * lo16(uu.x), y1 = acc[4 * q4 + 1] + dd[1] * hi16(uu.x), y2 = acc[4 * q4 + 2] + dd[2] * lo16(uu.y), y3 = acc[4 * q4 + 3] + dd[3] * hi16(uu.y);
            u32x2 w; w.x = pk2(gelu_tanh(y0), gelu_tanh(y1)); w.y = pk2(gelu_tanh(y2), gelu_tanh(y3));
            *(u32x2*)(a.GS + ((size_t)(nglob0 + r32) * 64 + j) * 256 + g * 16 + c0) = w;
        }
    }
}
}
namespace hy {
struct MixQ { const bf16_t *QM, *KM, *VM, *QA, *KA, *VA; const float* bias; bf16_t *YC, *YAB; float* MLB; S5U s5; unsigned* counter; int lo, hi; const float* bnd; int var; };
__device__ __forceinline__ void ph_mixers(const Ctx& C, const MixQ& p) {
    HY_LAS int* slot = (HY_LAS int*)((HY_LAS unsigned char*)C.lds + LDS_BYTES - 64);
    constexpr int N_MLA = 384, N_S5 = 128, N_SWA = 1152, TOTAL = N_S5 + N_MLA + N_SWA;
    int nxt = 0;
    if (C.tid == 0) nxt = (int)atomicAdd(p.counter, 1u);
    for (;;) {
        if (C.tid == 0) *slot = nxt;
        __syncthreads();
        const int it = *slot + p.lo;
        __syncthreads();
        if (it >= (p.hi < TOTAL ? p.hi : TOTAL)) break;
        const bool ahead = it >= N_MLA && it < TOTAL - 256;
        if (ahead && C.tid == 0) nxt = (int)atomicAdd(p.counter, 1u);
        if (it >= N_MLA && it < N_MLA + N_S5) s5_unit(C, p.s5, it - N_MLA);
        else if (it < N_MLA) {
            const int i = it, qb = 31 - i / 12, bh = i % 12, b = bh / 6, h = bh % 6;
            AttnArgs a;
            a.Q = p.QM + h * 96; a.K = p.KM + h * 96; a.V = p.VM + h * 64; a.qpitch = 576; a.kpitch = 576; a.vpitch = 384;
            a.q_row0 = (long)b * S + qb * 256; a.q_rstride = 1; a.k_row0 = (long)b * S; a.k_rstride = 1; a.q_idx0 = qb * 256;
            a.t_begin = 0; a.t_end = (qb + 1) * 4; a.bias = nullptr; a.O = p.YC + h * 64; a.opitch = 384; a.ML = nullptr; a.mlpitch = 0; a.safe = p.bnd[0] < 64.f;
            if (p.var == 0) mla_unit2(C, a);
#if HY_PROBE == 21
            else attn_unit<0, 1>(C, a);
#elif HY_PROBE == 22
            else attn_unit<0, 2>(C, a);
#endif
        } else {
            const int i = it - N_S5 - N_MLA, bh = i / 96, u = i % 96, b = bh / 6, h = bh % 6;
            int br, r, qbk, dil;
            if (u < 32) { br = 0; dil = 1; r = 0; qbk = u; }
            else if (u < 64) { br = 1; dil = 4; r = (u - 32) >> 3; qbk = (u - 32) & 7; }
            else { br = 2; dil = 16; r = (u - 64) >> 1; qbk = (u - 64) & 1; }
            const int m0 = qbk * 256;
            AttnArgs a;
            a.Q = p.QA + h * 64; a.K = p.KA + h * 64; a.V = p.VA + h * 64; a.qpitch = 384; a.kpitch = 384; a.vpitch = 384;
            a.q_row0 = (long)b * S + r + (long)m0 * dil; a.q_rstride = dil; a.k_row0 = (long)b * S + r; a.k_rstride = dil; a.q_idx0 = m0;
            a.t_begin = m0 >= 128 ? (m0 - 128) >> 6 : 0; a.t_end = (m0 + 256) >> 6; a.bias = p.bias + (br * 6 + h) * 132;
            a.O = p.YAB + (size_t)br * M * 384 + h * 64; a.opitch = 384; a.ML = p.MLB + ((size_t)br * M * 6 + h) * 2; a.mlpitch = 12; a.safe = p.bnd[1] < 64.f;
            swa_unit_pair(C, a);
        }
        if (!ahead && C.tid == 0) nxt = (int)atomicAdd(p.counter, 1u);
    }
}
struct MergeIn { u32x4 y0, y1, y2, gs, gl, yc; float2 a0, a1, a2; };
template <bool S5 = true>
__device__ __forceinline__ void merge_load(MergeIn& d, int lane, size_t m, const bf16_t* YAB, const float* MLB, const bf16_t* GS, const bf16_t* GL, const bf16_t* YC) {
    if (lane < 48) {
        const int j = lane >> 3;
        d.y0 = *(const u32x4*)(YAB + ((size_t)0 * M + m) * 384 + lane * 8); d.y1 = *(const u32x4*)(YAB + ((size_t)1 * M + m) * 384 + lane * 8); d.y2 = *(const u32x4*)(YAB + ((size_t)2 * M + m) * 384 + lane * 8);
        d.a0 = *(const float2*)(MLB + ((size_t)0 * M + m) * 12 + j * 2); d.a1 = *(const float2*)(MLB + ((size_t)1 * M + m) * 12 + j * 2); d.a2 = *(const float2*)(MLB + ((size_t)2 * M + m) * 12 + j * 2);
        d.yc = *(const u32x4*)(YC + m * 384 + lane * 8);
    }
    if (S5 && lane >= 32) { d.gs = *(const u32x4*)(GS + m * 256 + (lane - 32) * 8); d.gl = *(const u32x4*)(GL + m * 256 + (lane - 32) * 8); }
}
template <bool S5 = true>
__device__ __forceinline__ void merge_token(const MergeIn& d, int lane, size_t m, const float (&bg)[8], bf16_t* AOUT) {
    float va[8], vs[8], vc[8]; float sa = 0.f, sg = 0.f, sc = 0.f;
    if (lane < 48) {
        const float mm = fmaxf(d.a0.x, fmaxf(d.a1.x, d.a2.x));
        const float w0 = exp2f(d.a0.x - mm) * d.a0.y, w1 = exp2f(d.a1.x - mm) * d.a1.y, w2 = exp2f(d.a2.x - mm) * d.a2.y;
        const float iw = 1.f / (w0 + w1 + w2);
#pragma unroll
        for (int k = 0; k < 4; ++k) {
            va[2 * k] = (w0 * lo16(d.y0[k]) + w1 * lo16(d.y1[k]) + w2 * lo16(d.y2[k])) * iw; va[2 * k + 1] = (w0 * hi16(d.y0[k]) + w1 * hi16(d.y1[k]) + w2 * hi16(d.y2[k])) * iw;
            vc[2 * k] = lo16(d.yc[k]); vc[2 * k + 1] = hi16(d.yc[k]);
            sa += va[2 * k] * va[2 * k] + va[2 * k + 1] * va[2 * k + 1]; sc += vc[2 * k] * vc[2 * k] + vc[2 * k + 1] * vc[2 * k + 1];
        }
    }
    if (S5 && lane >= 32) {
#pragma unroll
        for (int k = 0; k < 4; ++k) {
            const float z0 = lo16(d.gl[k]) + bg[2 * k], z1 = hi16(d.gl[k]) + bg[2 * k + 1];
            vs[2 * k] = lo16(d.gs[k]) / (1.f + __expf(-z0)); vs[2 * k + 1] = hi16(d.gs[k]) / (1.f + __expf(-z1));
            sg += vs[2 * k] * vs[2 * k] + vs[2 * k + 1] * vs[2 * k + 1];
        }
    }
    sa = wave_sum(sa); if (S5) sg = wave_sum(sg); sc = wave_sum(sc);
    const float ra = rsqrtf(sa * (1.f / 384.f) + EPS), rg = rsqrtf(sg * (1.f / 256.f) + EPS), rc = rsqrtf(sc * (1.f / 384.f) + EPS);
    if (lane < 48) {
        u32x4 w;
        w.x = pk2(va[0] * ra, va[1] * ra); w.y = pk2(va[2] * ra, va[3] * ra); w.z = pk2(va[4] * ra, va[5] * ra); w.w = pk2(va[6] * ra, va[7] * ra);
        *(u32x4*)(AOUT + m * D + lane * 8) = w;
        w.x = pk2(vc[0] * rc, vc[1] * rc); w.y = pk2(vc[2] * rc, vc[3] * rc); w.z = pk2(vc[4] * rc, vc[5] * rc); w.w = pk2(vc[6] * rc, vc[7] * rc);
        *(u32x4*)(AOUT + m * D + 640 + lane * 8) = w;
    }
    if (S5 && lane >= 32) {
        u32x4 w;
        w.x = pk2(vs[0] * rg, vs[1] * rg); w.y = pk2(vs[2] * rg, vs[3] * rg); w.z = pk2(vs[4] * rg, vs[5] * rg); w.w = pk2(vs[6] * rg, vs[7] * rg);
        *(u32x4*)(AOUT + m * D + 384 + (lane - 32) * 8) = w;
    }
}
__device__ __forceinline__ void ph_merge2(const Ctx& C, const bf16_t* YAB, const float* MLB, const bf16_t* GS, const bf16_t* GL, const float* b_glu, const bf16_t* YC, bf16_t* AOUT) {
    const int lane = C.lane;
    float bg[8];
    { const int c = lane >= 32 ? (lane - 32) * 8 : 0; const f32x4 b0 = *(const f32x4*)(b_glu + c), b1 = *(const f32x4*)(b_glu + c + 4);
#pragma unroll
      for (int k = 0; k < 4; ++k) { bg[k] = b0[k]; bg[4 + k] = b1[k]; } }
    const size_t stride = (size_t)C.nblk * 8;
    for (size_t m = (size_t)C.bid * 8 + C.wave; m < M; m += 2 * stride) {
        MergeIn d0, d1;
        merge_load(d0, lane, m, YAB, MLB, GS, GL, YC);
        const bool two = m + stride < M;
        if (two) merge_load(d1, lane, m + stride, YAB, MLB, GS, GL, YC);
        merge_token(d0, lane, m, bg, AOUT);
        if (two) merge_token(d1, lane, m + stride, bg, AOUT);
    }
}
constexpr int MG_P = 528, MG_SS = 64 * MG_P;
__device__ __forceinline__ void ph_merge3(const Ctx& C, const bf16_t* YAB, const float* MLB, const bf16_t* GS, const bf16_t* WG, const float* b_glu, const bf16_t* YC, bf16_t* AOUT) {
    HY_LAS unsigned char* L = (HY_LAS unsigned char*)C.lds;
    const int tid = C.tid, lane = C.lane, wave = C.wave, r32 = lane & 31, hi = lane >> 5;
    float bg[8];
#pragma unroll
    for (int k = 0; k < 8; ++k) bg[k] = 0.f;
    for (int u = C.bid; u < M / 64; u += C.nblk) {
        const size_t m0 = (size_t)u * 64;
        __syncthreads();
#pragma unroll
        for (int i = 0; i < 4; ++i) {
            const int c = tid + i * 512, row = c >> 5, cc = c & 31;
            const u32x4 v = *(const u32x4*)(GS + (m0 + row) * 256 + cc * 8);
            *(HY_LAS u32x4*)(L + row * MG_P + cc * 16) = v;
        }
        bf16x8 wf[16];
        { const bf16_t* wp = WG + (size_t)(wave * 32 + r32) * 256 + hi * 8;
#pragma unroll
          for (int s = 0; s < 16; ++s) wf[s] = *(const bf16x8*)(wp + s * 16); }
        MergeIn d0, d1;
        const size_t mw = m0 + wave * 8;
        merge_load<false>(d0, lane, mw, YAB, MLB, GS, GS, YC);
        merge_load<false>(d1, lane, mw + 1, YAB, MLB, GS, GS, YC);
        __syncthreads();
        f32x16 acc0, acc1;
#pragma unroll
        for (int r = 0; r < 16; ++r) { acc0[r] = 0.f; acc1[r] = 0.f; }
#pragma unroll
        for (int s = 0; s < 16; ++s) {
            const bf16x8 b0 = *(const HY_LAS bf16x8*)(L + r32 * MG_P + s * 32 + hi * 16);
            const bf16x8 b1 = *(const HY_LAS bf16x8*)(L + (32 + r32) * MG_P + s * 32 + hi * 16);
            acc0 = __builtin_amdgcn_mfma_f32_32x32x16_bf16(wf[s], b0, acc0, 0, 0, 0);
            acc1 = __builtin_amdgcn_mfma_f32_32x32x16_bf16(wf[s], b1, acc1, 0, 0, 0);
        }
        float ss0 = 0.f, ss1 = 0.f;
#pragma unroll
        for (int q = 0; q < 4; ++q) {
            const int n0 = wave * 32 + 8 * q + 4 * hi;
            const f32x4 bb = *(const f32x4*)(b_glu + n0);
            const u32x2 g0 = *(const HY_LAS u32x2*)(L + r32 * MG_P + n0 * 2), g1 = *(const HY_LAS u32x2*)(L + (32 + r32) * MG_P + n0 * 2);
            const float ga[4] = {lo16(g0.x), hi16(g0.x), lo16(g0.y), hi16(g0.y)}, gb[4] = {lo16(g1.x), hi16(g1.x), lo16(g1.y), hi16(g1.y)};
#pragma unroll
            for (int i = 0; i < 4; ++i) {
                const float va = ga[i] / (1.f + __expf(-(acc0[4 * q + i] + bb[i]))), vb = gb[i] / (1.f + __expf(-(acc1[4 * q + i] + bb[i])));
                acc0[4 * q + i] = va; acc1[4 * q + i] = vb; ss0 += va * va; ss1 += vb * vb;
            }
        }
        ss0 += __shfl_xor(ss0, 32); ss1 += __shfl_xor(ss1, 32);
        if (hi == 0) { *(HY_LAS float*)(L + MG_SS + (wave * 64 + r32) * 4) = ss0; *(HY_LAS float*)(L + MG_SS + (wave * 64 + 32 + r32) * 4) = ss1; }
        __syncthreads();
        float t0 = 0.f, t1 = 0.f;
#pragma unroll
        for (int w = 0; w < 8; ++w) { t0 += *(const HY_LAS float*)(L + MG_SS + (w * 64 + r32) * 4); t1 += *(const HY_LAS float*)(L + MG_SS + (w * 64 + 32 + r32) * 4); }
        const float r0 = rsqrtf(t0 * (1.f / 256.f) + EPS), r1 = rsqrtf(t1 * (1.f / 256.f) + EPS);
#pragma unroll
        for (int q = 0; q < 4; ++q) {
            const int n0 = wave * 32 + 8 * q + 4 * hi;
            u32x2 w0, w1;
            w0.x = pk2(acc0[4 * q] * r0, acc0[4 * q + 1] * r0); w0.y = pk2(acc0[4 * q + 2] * r0, acc0[4 * q + 3] * r0);
            w1.x = pk2(acc1[4 * q] * r1, acc1[4 * q + 1] * r1); w1.y = pk2(acc1[4 * q + 2] * r1, acc1[4 * q + 3] * r1);
            *(u32x2*)(AOUT + (m0 + r32) * D + 384 + n0) = w0; *(u32x2*)(AOUT + (m0 + 32 + r32) * D + 384 + n0) = w1;
        }
        merge_token<false>(d0, lane, mw, bg, AOUT);
        merge_token<false>(d1, lane, mw + 1, bg, AOUT);
#pragma unroll 1
        for (int t = 2; t < 8; t += 2) {
            merge_load<false>(d0, lane, mw + t, YAB, MLB, GS, GS, YC);
            merge_load<false>(d1, lane, mw + t + 1, YAB, MLB, GS, GS, YC);
            merge_token<false>(d0, lane, mw + t, bg, AOUT);
            merge_token<false>(d1, lane, mw + t + 1, bg, AOUT);
        }
    }
}
}
namespace hy {
#define HY_CE(a, b) { const int _mx = max(a, b), _mn = min(a, b); a = _mx; b = _mn; }
__device__ __forceinline__ void sort16_desc(int (&v)[16]) {
    HY_CE(v[0], v[13]); HY_CE(v[1], v[12]); HY_CE(v[2], v[15]); HY_CE(v[3], v[14]); HY_CE(v[4], v[8]); HY_CE(v[5], v[6]); HY_CE(v[7], v[11]); HY_CE(v[9], v[10]);
    HY_CE(v[0], v[5]); HY_CE(v[1], v[7]); HY_CE(v[2], v[9]); HY_CE(v[3], v[4]); HY_CE(v[6], v[13]); HY_CE(v[8], v[14]); HY_CE(v[10], v[15]); HY_CE(v[11], v[12]);
    HY_CE(v[0], v[1]); HY_CE(v[2], v[3]); HY_CE(v[4], v[5]); HY_CE(v[6], v[8]); HY_CE(v[7], v[9]); HY_CE(v[10], v[11]); HY_CE(v[12], v[13]); HY_CE(v[14], v[15]);
    HY_CE(v[0], v[2]); HY_CE(v[1], v[3]); HY_CE(v[4], v[10]); HY_CE(v[5], v[11]); HY_CE(v[6], v[7]); HY_CE(v[8], v[9]); HY_CE(v[12], v[14]); HY_CE(v[13], v[15]);
    HY_CE(v[1], v[2]); HY_CE(v[3], v[12]); HY_CE(v[4], v[6]); HY_CE(v[5], v[7]); HY_CE(v[8], v[10]); HY_CE(v[9], v[11]); HY_CE(v[13], v[14]);
    HY_CE(v[1], v[4]); HY_CE(v[2], v[6]); HY_CE(v[5], v[8]); HY_CE(v[7], v[10]); HY_CE(v[9], v[13]); HY_CE(v[11], v[14]);
    HY_CE(v[2], v[4]); HY_CE(v[3], v[6]); HY_CE(v[9], v[12]); HY_CE(v[11], v[13]);
    HY_CE(v[3], v[5]); HY_CE(v[6], v[8]); HY_CE(v[7], v[9]); HY_CE(v[10], v[12]);
    HY_CE(v[3], v[4]); HY_CE(v[5], v[6]); HY_CE(v[7], v[8]); HY_CE(v[9], v[10]); HY_CE(v[11], v[12]);
    HY_CE(v[6], v[7]); HY_CE(v[8], v[9]);
}
__device__ __forceinline__ void bitonic_merge16_desc(int (&v)[16]) {
#pragma unroll
    for (int j = 8; j > 0; j >>= 1)
#pragma unroll
        for (int i = 0; i < 16; ++i) { if ((i & j) == 0) { HY_CE(v[i], v[i | j]); } }
}
__device__ __forceinline__ void merge_top16(int (&a)[16], const int (&b)[16]) {
#pragma unroll
    for (int i = 0; i < 16; ++i) a[i] = max(a[i], b[15 - i]);
    bitonic_merge16_desc(a);
}
__device__ __forceinline__ int f2ord(float f) { const int b = __float_as_int(f); return b ^ ((b >> 31) & 0x7fffffff); }
__device__ __forceinline__ float ord2f(int s) { return __int_as_float(s ^ ((s >> 31) & 0x7fffffff)); }
__device__ __forceinline__ int xlane32(int v) { return __shfl_xor(v, 32); }

constexpr int PA_SKP = 272;
constexpr int PA_TILE = 128 * PA_SKP;

__device__ __forceinline__ void top16_of_scores(const f32x16 (&acc)[4], int hi, int (&out)[16]) {
    int g[16];
#pragma unroll
    for (int mt = 0; mt < 4; ++mt) {
#pragma unroll
        for (int r = 0; r < 16; ++r) { const int key = 32 * mt + (r & 3) + 8 * (r >> 2) + 4 * hi; g[r] = (f2ord(acc[mt][r]) & ~127) | key; }
        sort16_desc(g);
        if (mt == 0) {
#pragma unroll
            for (int r = 0; r < 16; ++r) out[r] = g[r];
        } else merge_top16(out, g);
    }
    int pb[16];
#pragma unroll
    for (int r = 0; r < 16; ++r) pb[r] = xlane32(out[r]);
    merge_top16(out, pb);
}

__device__ __forceinline__ void ph_peer_topk(const Ctx& C, const bf16_t* QP, const bf16_t* SUBK, int* EIDX, float* GATE) {
    HY_LAS unsigned char* L = (HY_LAS unsigned char*)C.lds;
    const int tid = C.tid, lane = C.lane, wave = C.wave, r32 = lane & 31, hi = lane >> 5;
    int staged = -1;
    for (int unit = C.bid; unit < 64 * 8; unit += C.nblk) {
        const int tt = unit >> 3, h = unit & 7;
        const size_t m = (size_t)tt * 256 + wave * 32 + r32;
        if (h != staged) {
            __syncthreads();
#pragma unroll
            for (int i = 0; i < 8; ++i) {
                const int c = tid + i * 512, j = c >> 11, row = (c >> 4) & 127, ch = c & 15;
                const u32x4 v = *(const u32x4*)(SUBK + ((size_t)(h * 2 + j) * 128 + row) * 128 + ch * 8);
                *(HY_LAS u32x4*)(L + j * PA_TILE + row * PA_SKP + ch * 16) = v;
            }
            __syncthreads();
            staged = h;
        }
        int s1[16], s2[16];
#pragma unroll
        for (int j = 0; j < 2; ++j) {
            f32x16 acc[4];
#pragma unroll
            for (int mt = 0; mt < 4; ++mt)
#pragma unroll
                for (int r = 0; r < 16; ++r) acc[mt][r] = 0.f;
            const bf16_t* qp = QP + m * 2048 + (h * 2 + j) * 128 + hi * 8;
#pragma unroll
            for (int s = 0; s < 8; ++s) {
                const bf16x8 qf = *(const bf16x8*)(qp + s * 16);
#pragma unroll
                for (int mt = 0; mt < 4; ++mt) {
                    const bf16x8 kf = *(const HY_LAS bf16x8*)(L + j * PA_TILE + (mt * 32 + r32) * PA_SKP + s * 32 + hi * 16);
                    acc[mt] = __builtin_amdgcn_mfma_f32_32x32x16_bf16(kf, qf, acc[mt], 0, 0, 0);
                }
            }
            if (j == 0) top16_of_scores(acc, hi, s1); else top16_of_scores(acc, hi, s2);
        }
        float x[16], y[16];
#pragma unroll
        for (int r = 0; r < 16; ++r) { const int xs = hi ? s2[r] : s1[r], ys = hi ? s1[r] : s2[r]; x[r] = ord2f(xs & ~127); y[r] = ord2f(ys & ~127); }
        int ca[16], cb[16];
        {
            int n = 0;
#pragma unroll
            for (int a = 0; a < 16; ++a)
#pragma unroll
                for (int b = a; b < 16; ++b) {
                    if ((a + 1) * (b + 1) <= 16) {
                        const float sum = x[a] + y[b];
                        const int id0 = a * 16 + b, id1 = b * 16 + a;
                        int key = (f2ord(sum) & ~255) | (hi ? id1 : id0);
                        if (a == b && hi) key = (int)0x80000000;
                        if (n < 16) ca[n] = key; else cb[n - 16] = key;
                        ++n;
                    }
                }
#pragma unroll
            for (int i = 27 - 16; i < 16; ++i) cb[i] = (int)0x80000000;
        }
        sort16_desc(ca); sort16_desc(cb); merge_top16(ca, cb);
        {
            int pb[16];
#pragma unroll
            for (int r = 0; r < 16; ++r) pb[r] = xlane32(ca[r]);
            merge_top16(ca, pb);
        }
        unsigned t1[4], t2[4];
#pragma unroll
        for (int q4 = 0; q4 < 4; ++q4) {
            t1[q4] = (unsigned)(s1[4 * q4] & 127) | ((unsigned)(s1[4 * q4 + 1] & 127) << 8) | ((unsigned)(s1[4 * q4 + 2] & 127) << 16) | ((unsigned)(s1[4 * q4 + 3] & 127) << 24);
            t2[q4] = (unsigned)(s2[4 * q4] & 127) | ((unsigned)(s2[4 * q4 + 1] & 127) << 8) | ((unsigned)(s2[4 * q4 + 2] & 127) << 16) | ((unsigned)(s2[4 * q4 + 3] & 127) << 24);
        }
        float e[16]; float sum = 0.f; const float mxv = ord2f(ca[0] & ~255);
#pragma unroll
        for (int r = 0; r < 16; ++r) { e[r] = __expf(ord2f(ca[r] & ~255) - mxv); sum += e[r]; }
        const float inv = 1.f / sum;
        int eo[8]; float go[8];
#pragma unroll
        for (int r = 0; r < 8; ++r) {
            const int cid = (hi ? ca[r + 8] : ca[r]) & 255, a = cid >> 4, b = cid & 15;
            const unsigned la = __builtin_amdgcn_perm(t1[1], t1[0], 0x0c0c0c00u | (a & 7)), ha = __builtin_amdgcn_perm(t1[3], t1[2], 0x0c0c0c00u | (a & 7));
            const unsigned lb = __builtin_amdgcn_perm(t2[1], t2[0], 0x0c0c0c00u | (b & 7)), hb = __builtin_amdgcn_perm(t2[3], t2[2], 0x0c0c0c00u | (b & 7));
            const unsigned i1 = (a & 8) ? ha : la, i2 = (b & 8) ? hb : lb;
            eo[r] = (int)(i1 * 128u + i2);
            go[r] = (hi ? e[r + 8] : e[r]) * inv;
        }
        int* ep = EIDX + m * 128 + h * 16 + hi * 8; float* gp = GATE + m * 128 + h * 16 + hi * 8;
        *(u32x4*)ep = (u32x4){(unsigned)eo[0], (unsigned)eo[1], (unsigned)eo[2], (unsigned)eo[3]}; *(u32x4*)(ep + 4) = (u32x4){(unsigned)eo[4], (unsigned)eo[5], (unsigned)eo[6], (unsigned)eo[7]};
        *(f32x4*)gp = (f32x4){go[0], go[1], go[2], go[3]}; *(f32x4*)(gp + 4) = (f32x4){go[4], go[5], go[6], go[7]};
    }
}
}
namespace hy {
typedef float f32x2 __attribute__((ext_vector_type(2)));
__device__ __forceinline__ void ph_cvt_fp4(const Ctx& C, const float* src, unsigned char* dst, float* scale, int nrows) {
    const int lane = C.lane;
    const int stride = C.nblk * 32;
    int row0 = (C.bid * 8 + C.wave) * 4;
    f32x4 v[4][4], w[4][4];
    if (row0 < nrows) {
#pragma unroll
        for (int rr = 0; rr < 4; ++rr)
#pragma unroll
            for (int j = 0; j < 4; ++j) v[rr][j] = __builtin_nontemporal_load((const f32x4*)(src + (size_t)(row0 + rr) * 1024 + j * 256 + lane * 4));
    }
    for (; row0 < nrows; row0 += stride) {
        const int nxt = row0 + stride;
        if (nxt < nrows) {
#pragma unroll
            for (int rr = 0; rr < 4; ++rr)
#pragma unroll
                for (int j = 0; j < 4; ++j) w[rr][j] = __builtin_nontemporal_load((const f32x4*)(src + (size_t)(nxt + rr) * 1024 + j * 256 + lane * 4));
        }
#pragma unroll
        for (int rr = 0; rr < 4; ++rr) {
            float am = 0.f;
#pragma unroll
            for (int j = 0; j < 4; ++j) am = fmaxf(am, fmaxf(fmaxf(fabsf(v[rr][j][0]), fabsf(v[rr][j][1])), fmaxf(fabsf(v[rr][j][2]), fabsf(v[rr][j][3]))));
#pragma unroll
            for (int o = 1; o < 64; o <<= 1) am = fmaxf(am, __shfl_xor(am, o));
            const float sc = am > 0.f ? am * (1.f / 6.f) : 1.f, inv = am > 0.f ? 6.f / am : 1.f;
            if (lane == 0) scale[row0 + rr] = sc;
#pragma unroll
            for (int j = 0; j < 4; ++j) {
                unsigned q = 0u;
                q = __builtin_amdgcn_cvt_scalef32_pk_fp4_f32(q, v[rr][j][0] * inv, v[rr][j][1] * inv, 1.0f, 0);
                q = __builtin_amdgcn_cvt_scalef32_pk_fp4_f32(q, v[rr][j][2] * inv, v[rr][j][3] * inv, 1.0f, 1);
                *(unsigned short*)(dst + (size_t)(row0 + rr) * 512 + j * 128 + lane * 2) = (unsigned short)q;
            }
        }
#pragma unroll
        for (int rr = 0; rr < 4; ++rr)
#pragma unroll
            for (int j = 0; j < 4; ++j) v[rr][j] = w[rr][j];
    }
}
__device__ __forceinline__ float dot16_fp4(const float (&h)[16], const u32x2 r) {
    float s = 0.f;
#pragma unroll
    for (int w = 0; w < 2; ++w) {
        const f32x2 a = __builtin_amdgcn_cvt_scalef32_pk_f32_fp4(r[w], 1.0f, 0), b = __builtin_amdgcn_cvt_scalef32_pk_f32_fp4(r[w], 1.0f, 1),
                    c = __builtin_amdgcn_cvt_scalef32_pk_f32_fp4(r[w], 1.0f, 2), d = __builtin_amdgcn_cvt_scalef32_pk_f32_fp4(r[w], 1.0f, 3);
        s += h[8 * w] * a[0] + h[8 * w + 1] * a[1] + h[8 * w + 2] * b[0] + h[8 * w + 3] * b[1] + h[8 * w + 4] * c[0] + h[8 * w + 5] * c[1] + h[8 * w + 6] * d[0] + h[8 * w + 7] * d[1];
    }
    return s;
}
__device__ __forceinline__ void axpy16_fp4(f32x2 (&acc2)[8], const float cf, const u32x2 r) {
    const f32x2 c2 = {cf, cf};
#pragma unroll
    for (int w = 0; w < 2; ++w) {
        acc2[4 * w] = __builtin_elementwise_fma(c2, __builtin_amdgcn_cvt_scalef32_pk_f32_fp4(r[w], 1.0f, 0), acc2[4 * w]);
        acc2[4 * w + 1] = __builtin_elementwise_fma(c2, __builtin_amdgcn_cvt_scalef32_pk_f32_fp4(r[w], 1.0f, 1), acc2[4 * w + 1]);
        acc2[4 * w + 2] = __builtin_elementwise_fma(c2, __builtin_amdgcn_cvt_scalef32_pk_f32_fp4(r[w], 1.0f, 2), acc2[4 * w + 2]);
        acc2[4 * w + 3] = __builtin_elementwise_fma(c2, __builtin_amdgcn_cvt_scalef32_pk_f32_fp4(r[w], 1.0f, 3), acc2[4 * w + 3]);
    }
}
__device__ __forceinline__ float dot32_fp4(const f32x2 (&h2)[16], const u32x4 r) {
    f32x2 s2 = {0.f, 0.f};
#pragma unroll
    for (int w = 0; w < 4; ++w) {
        s2 = __builtin_elementwise_fma(h2[4 * w], __builtin_amdgcn_cvt_scalef32_pk_f32_fp4(r[w], 1.0f, 0), s2);
        s2 = __builtin_elementwise_fma(h2[4 * w + 1], __builtin_amdgcn_cvt_scalef32_pk_f32_fp4(r[w], 1.0f, 1), s2);
        s2 = __builtin_elementwise_fma(h2[4 * w + 2], __builtin_amdgcn_cvt_scalef32_pk_f32_fp4(r[w], 1.0f, 2), s2);
        s2 = __builtin_elementwise_fma(h2[4 * w + 3], __builtin_amdgcn_cvt_scalef32_pk_f32_fp4(r[w], 1.0f, 3), s2);
    }
    return s2[0] + s2[1];
}
__device__ __forceinline__ void axpy32_fp4(float (&acc)[32], const float cf, const u32x4 r) {
#pragma unroll
    for (int w = 0; w < 4; ++w) {
        const f32x2 a = __builtin_amdgcn_cvt_scalef32_pk_f32_fp4(r[w], 1.0f, 0), b = __builtin_amdgcn_cvt_scalef32_pk_f32_fp4(r[w], 1.0f, 1),
                    c = __builtin_amdgcn_cvt_scalef32_pk_f32_fp4(r[w], 1.0f, 2), d = __builtin_amdgcn_cvt_scalef32_pk_f32_fp4(r[w], 1.0f, 3);
        acc[8 * w] += cf * a[0]; acc[8 * w + 1] += cf * a[1]; acc[8 * w + 2] += cf * b[0]; acc[8 * w + 3] += cf * b[1];
        acc[8 * w + 4] += cf * c[0]; acc[8 * w + 5] += cf * c[1]; acc[8 * w + 6] += cf * d[0]; acc[8 * w + 7] += cf * d[1];
    }
}
struct GatherP { bf16_t* H; const int* EIDX; const float* GATE; const unsigned char* U8; const float* SU; const unsigned char* V8; const float* SV; const float* g2; const bf16_t* xinb; float* xout; bf16_t* xoutb;
                 const float* SSX; const float* sh2;
                 const float* ngain; const float* nmod; int var; };
__device__ __forceinline__ void ph_peer_gather2(const Ctx& C, const GatherP& P) {
    HY_LAS float* coefL = (HY_LAS float*)((HY_LAS unsigned char*)C.lds) + C.wave * 128;
    const size_t mstep = (size_t)C.nblk * 8;
    size_t m = (size_t)C.bid * 8 + C.wave;
    int nidx0 = 0, nidx1 = 0, pidx0 = 0, pidx1 = 0; float nsu0 = 0.f, nsu1 = 0.f, ngv0 = 0.f, ngv1 = 0.f;
    if (m < M) {
        const int l0 = C.lane;
        nidx0 = P.EIDX[m * 128 + l0]; nidx1 = P.EIDX[m * 128 + 64 + l0];
        nsu0 = P.SU[nidx0]; nsu1 = P.SU[nidx1];
        ngv0 = P.GATE[m * 128 + l0] * P.SV[nidx0]; ngv1 = P.GATE[m * 128 + 64 + l0] * P.SV[nidx1];
        if (m + mstep < M) { pidx0 = P.EIDX[(m + mstep) * 128 + l0]; pidx1 = P.EIDX[(m + mstep) * 128 + 64 + l0]; }
    }
    for (; m < M; m += mstep) {
        unsigned ones_ = ~0u; asm volatile("" : "+s"(ones_));
        const int lane = (int)__builtin_amdgcn_mbcnt_hi(ones_, __builtin_amdgcn_mbcnt_lo(ones_, 0u));
        const int l31 = lane & 31, hh = lane >> 5;
        const int b4 = (lane >> 4) & 1, b3 = (lane >> 3) & 1, b2 = (lane >> 2) & 1, b1 = (lane >> 1) & 1;
        const int ie = 8 * b4 + 4 * b3 + 2 * b2 + b1;
        const int b = (int)(m >> 13);
        const int idx0 = nidx0, idx1 = nidx1; const float su0 = nsu0, su1 = nsu1, gv0 = ngv0, gv1 = ngv1;
        if (m + mstep < M) {
            const size_t mn = m + mstep;
            nidx0 = pidx0; nidx1 = pidx1;
            nsu0 = P.SU[nidx0]; nsu1 = P.SU[nidx1];
            ngv0 = P.GATE[mn * 128 + lane] * P.SV[nidx0]; ngv1 = P.GATE[mn * 128 + 64 + lane] * P.SV[nidx1];
            if (mn + mstep < M) { pidx0 = P.EIDX[(mn + mstep) * 128 + lane]; pidx1 = P.EIDX[(mn + mstep) * 128 + 64 + lane]; }
        }
        {
            f32x2 h[16];
            {
                const bf16_t* hp = P.H + m * D + l31 * 32;
                const f32x4 s0 = *(const f32x4*)(P.SSX + m * 16), s1 = *(const f32x4*)(P.SSX + m * 16 + 4), s2 = *(const f32x4*)(P.SSX + m * 16 + 8), s3 = *(const f32x4*)(P.SSX + m * 16 + 12);
                const float tot = (((s0[0] + s0[1]) + (s0[2] + s0[3])) + ((s1[0] + s1[1]) + (s1[2] + s1[3]))) + (((s2[0] + s2[1]) + (s2[2] + s2[3])) + ((s3[0] + s3[1]) + (s3[2] + s3[3])));
                const float r = rsqrtf(tot * (1.f / D) + EPS);
                const float* sh = P.sh2 + b * MODW + l31 * 32;
#pragma unroll
                for (int q = 0; q < 4; ++q) {
                    const u32x4 a = *(const u32x4*)(hp + q * 8); const f32x4 sa = *(const f32x4*)(sh + q * 8), sb = *(const f32x4*)(sh + q * 8 + 4);
                    h[q * 4] = (f32x2){lo16(a.x) * r + sa[0], hi16(a.x) * r + sa[1]}; h[q * 4 + 1] = (f32x2){lo16(a.y) * r + sa[2], hi16(a.y) * r + sa[3]};
                    h[q * 4 + 2] = (f32x2){lo16(a.z) * r + sb[0], hi16(a.z) * r + sb[1]}; h[q * 4 + 3] = (f32x2){lo16(a.w) * r + sb[2], hi16(a.w) * r + sb[3]};
                }
            }
#pragma unroll 1
            for (int bt = 0; bt < (P.var == 1 ? 0 : 4); ++bt) {
                const int idxv = bt < 2 ? idx0 : idx1;
                u32x4 rows[16];
#pragma unroll
                for (int i = 0; i < 16; ++i) {
                    const int e = __builtin_amdgcn_ds_bpermute(((bt & 1) * 32 + 2 * i + hh) * 4, idxv);
                    rows[i] = *(const u32x4*)(P.U8 + (unsigned)(e * 512 + l31 * 16));
                }
                float p[16];
#pragma unroll
                for (int i = 0; i < 16; ++i) { asm volatile("" : "+v"(rows[i]));
                    p[i] = dot32_fp4(h, rows[i]); }
                float q8[8], q4[4], q2[2];
#pragma unroll
                for (int i = 0; i < 8; ++i) { const float snd = b4 ? p[i] : p[i + 8], kp = b4 ? p[i + 8] : p[i]; q8[i] = kp + __shfl_xor(snd, 16); }
#pragma unroll
                for (int i = 0; i < 4; ++i) { const float snd = b3 ? q8[i] : q8[i + 4], kp = b3 ? q8[i + 4] : q8[i]; q4[i] = kp + __shfl_xor(snd, 8); }
#pragma unroll
                for (int i = 0; i < 2; ++i) { const float snd = b2 ? q4[i] : q4[i + 2], kp = b2 ? q4[i + 2] : q4[i]; q2[i] = kp + __shfl_xor(snd, 4); }
                float tot; { const float snd = b1 ? q2[0] : q2[1], kp = b1 ? q2[1] : q2[0]; tot = kp + __shfl_xor(snd, 2); }
                tot += __shfl_xor(tot, 1);
                const int kk = (bt & 1) * 32 + 2 * ie + hh;
                const float suk = __int_as_float(__builtin_amdgcn_ds_bpermute(kk * 4, __float_as_int(bt < 2 ? su0 : su1)));
                const float gvk = __int_as_float(__builtin_amdgcn_ds_bpermute(kk * 4, __float_as_int(bt < 2 ? gv0 : gv1)));
                const float cf = gvk * gelu_tanh(tot * suk);
                if ((lane & 1) == 0) coefL[bt * 32 + 2 * ie + hh] = cf;
            }
        }
        f32x2 acc2[8];
#pragma unroll
        for (int i = 0; i < 8; ++i) acc2[i] = (f32x2){0.f, 0.f};
#pragma unroll 1
        for (int bt = 0; bt < (P.var == 2 ? 0 : 4); ++bt) {
            const int idxv = bt < 2 ? idx0 : idx1;
            u32x2 rows[32];
#pragma unroll
            for (int i = 0; i < 32; ++i) {
                const int e = __builtin_amdgcn_ds_bpermute(((bt & 1) * 32 + i) * 4, idxv);
                rows[i] = *(const u32x2*)(P.V8 + (unsigned)(e * 512 + lane * 8));
            }
#pragma unroll
            for (int i = 0; i < 32; ++i) { asm volatile("" : "+v"(rows[i])); axpy16_fp4(acc2, coefL[bt * 32 + i], rows[i]); }
        }
        float acc[16];
#pragma unroll
        for (int i = 0; i < 8; ++i) { acc[2 * i] = acc2[i][0]; acc[2 * i + 1] = acc2[i][1]; }
        int le = lane; asm volatile("" : "+v"(le));
        const float* g = P.g2 + b * MODW + le * 16;
        float ss = 0.f;
        {
            const u32x4 xa = *(const u32x4*)(P.xinb + m * D + le * 16), xb = *(const u32x4*)(P.xinb + m * D + le * 16 + 8);
            const float xi[16] = {lo16(xa.x), hi16(xa.x), lo16(xa.y), hi16(xa.y), lo16(xa.z), hi16(xa.z), lo16(xa.w), hi16(xa.w), lo16(xb.x), hi16(xb.x), lo16(xb.y), hi16(xb.y), lo16(xb.z), hi16(xb.z), lo16(xb.w), hi16(xb.w)};
#pragma unroll
            for (int q4i = 0; q4i < 4; ++q4i) {
                const f32x4 gg = *(const f32x4*)(g + q4i * 4);
#pragma unroll
                for (int e = 0; e < 4; ++e) { const float o = xi[q4i * 4 + e] + gg[e] * acc[q4i * 4 + e]; acc[q4i * 4 + e] = o; ss += o * o; }
            }
            if (P.xoutb) {
                *(u32x4*)(P.xoutb + m * D + le * 16) = (u32x4){pk2(acc[0], acc[1]), pk2(acc[2], acc[3]), pk2(acc[4], acc[5]), pk2(acc[6], acc[7])};
                *(u32x4*)(P.xoutb + m * D + le * 16 + 8) = (u32x4){pk2(acc[8], acc[9]), pk2(acc[10], acc[11]), pk2(acc[12], acc[13]), pk2(acc[14], acc[15])};
            } else {
#pragma unroll
                for (int q4i = 0; q4i < 4; ++q4i) *(f32x4*)(P.xout + m * D + le * 16 + q4i * 4) = (f32x4){acc[q4i * 4], acc[q4i * 4 + 1], acc[q4i * 4 + 2], acc[q4i * 4 + 3]};
            }
        }
        if (P.ngain) {
            const float r1 = rsqrtf(wave_sum(ss) * (1.f / D) + EPS);
            const float* gn = P.ngain + le * 16; const float* shn = P.nmod + b * MODW + le * 16; const float* scn = P.nmod + b * MODW + D + le * 16;
            unsigned w[8];
#pragma unroll
            for (int q4i = 0; q4i < 4; ++q4i) {
                const f32x4 g4 = *(const f32x4*)(gn + q4i * 4), s4 = *(const f32x4*)(scn + q4i * 4), h4 = *(const f32x4*)(shn + q4i * 4);
                float o[4];
#pragma unroll
                for (int e = 0; e < 4; ++e) o[e] = acc[q4i * 4 + e] * r1 * g4[e] * (1.f + s4[e]) + h4[e];
                w[q4i * 2] = pk2(o[0], o[1]); w[q4i * 2 + 1] = pk2(o[2], o[3]);
            }
            *(u32x4*)(P.H + m * D + le * 16) = (u32x4){w[0], w[1], w[2], w[3]}; *(u32x4*)(P.H + m * D + le * 16 + 8) = (u32x4){w[4], w[5], w[6], w[7]};
        }
    }
}
__device__ __forceinline__ void ph_peer_gather4(const Ctx& C, const GatherP& P) {
    HY_LAS float* coefL = (HY_LAS float*)((HY_LAS unsigned char*)C.lds) + C.wave * 128;
    const size_t mstep = (size_t)C.nblk * 8;
    size_t m = (size_t)C.bid * 8 + C.wave;
    int nidx0 = 0, nidx1 = 0, pidx0 = 0, pidx1 = 0; float nsu0 = 0.f, nsu1 = 0.f, ngv0 = 0.f, ngv1 = 0.f;
    if (m < M) {
        const int l0 = C.lane;
        nidx0 = P.EIDX[m * 128 + l0]; nidx1 = P.EIDX[m * 128 + 64 + l0];
        nsu0 = P.SU[nidx0]; nsu1 = P.SU[nidx1];
        ngv0 = P.GATE[m * 128 + l0] * P.SV[nidx0]; ngv1 = P.GATE[m * 128 + 64 + l0] * P.SV[nidx1];
        if (m + mstep < M) { pidx0 = P.EIDX[(m + mstep) * 128 + l0]; pidx1 = P.EIDX[(m + mstep) * 128 + 64 + l0]; }
    }
    for (; m < M; m += mstep) {
        unsigned ones_ = ~0u; asm volatile("" : "+s"(ones_));
        const int lane = (int)__builtin_amdgcn_mbcnt_hi(ones_, __builtin_amdgcn_mbcnt_lo(ones_, 0u));
        const int l31 = lane & 31, hh = lane >> 5;
        const int b4 = (lane >> 4) & 1, b3 = (lane >> 3) & 1, b2 = (lane >> 2) & 1, b1 = (lane >> 1) & 1;
        const int ie = 8 * b4 + 4 * b3 + 2 * b2 + b1;
        const int b = (int)(m >> 13);
        const int idx0 = nidx0, idx1 = nidx1; const float su0 = nsu0, su1 = nsu1, gv0 = ngv0, gv1 = ngv1;
        if (m + mstep < M) {
            const size_t mn = m + mstep;
            nidx0 = pidx0; nidx1 = pidx1;
            nsu0 = P.SU[nidx0]; nsu1 = P.SU[nidx1];
            ngv0 = P.GATE[mn * 128 + lane] * P.SV[nidx0]; ngv1 = P.GATE[mn * 128 + 64 + lane] * P.SV[nidx1];
            if (mn + mstep < M) { pidx0 = P.EIDX[(mn + mstep) * 128 + lane]; pidx1 = P.EIDX[(mn + mstep) * 128 + 64 + lane]; }
        }
        {
            f32x2 h[16];
            {
                const bf16_t* hp = P.H + m * D + l31 * 32;
                const f32x4 s0 = *(const f32x4*)(P.SSX + m * 16), s1 = *(const f32x4*)(P.SSX + m * 16 + 4), s2 = *(const f32x4*)(P.SSX + m * 16 + 8), s3 = *(const f32x4*)(P.SSX + m * 16 + 12);
                const float tot = (((s0[0] + s0[1]) + (s0[2] + s0[3])) + ((s1[0] + s1[1]) + (s1[2] + s1[3]))) + (((s2[0] + s2[1]) + (s2[2] + s2[3])) + ((s3[0] + s3[1]) + (s3[2] + s3[3])));
                const float r = rsqrtf(tot * (1.f / D) + EPS);
                const float* sh = P.sh2 + b * MODW + l31 * 32;
#pragma unroll
                for (int q = 0; q < 4; ++q) {
                    const u32x4 a = *(const u32x4*)(hp + q * 8); const f32x4 sa = *(const f32x4*)(sh + q * 8), sb = *(const f32x4*)(sh + q * 8 + 4);
                    h[q * 4] = (f32x2){lo16(a.x) * r + sa[0], hi16(a.x) * r + sa[1]}; h[q * 4 + 1] = (f32x2){lo16(a.y) * r + sa[2], hi16(a.y) * r + sa[3]};
                    h[q * 4 + 2] = (f32x2){lo16(a.z) * r + sb[0], hi16(a.z) * r + sb[1]}; h[q * 4 + 3] = (f32x2){lo16(a.w) * r + sb[2], hi16(a.w) * r + sb[3]};
                }
            }
#pragma unroll 1
            for (int bt = 0; bt < (P.var == 1 ? 0 : 4); ++bt) {
                const int idxv = bt < 2 ? idx0 : idx1;
                u32x4 rows[16];
#pragma unroll
                for (int i = 0; i < 16; ++i) {
                    const int e0 = __builtin_amdgcn_readlane(idxv, (bt & 1) * 32 + 2 * i), e1 = __builtin_amdgcn_readlane(idxv, (bt & 1) * 32 + 2 * i + 1);
                    const int e = hh ? e1 : e0;
                    rows[i] = *(const u32x4*)(P.U8 + (unsigned)(e * 512 + l31 * 16));
                }
                float p[16];
#pragma unroll
                for (int i = 0; i < 16; ++i) { asm volatile("" : "+v"(rows[i]));
                    p[i] = dot32_fp4(h, rows[i]); }
                float q8[8], q4[4], q2[2];
#pragma unroll
                for (int i = 0; i < 8; ++i) { const float snd = b4 ? p[i] : p[i + 8], kp = b4 ? p[i + 8] : p[i]; q8[i] = kp + __shfl_xor(snd, 16); }
#pragma unroll
                for (int i = 0; i < 4; ++i) { const float snd = b3 ? q8[i] : q8[i + 4], kp = b3 ? q8[i + 4] : q8[i]; q4[i] = kp + __shfl_xor(snd, 8); }
#pragma unroll
                for (int i = 0; i < 2; ++i) { const float snd = b2 ? q4[i] : q4[i + 2], kp = b2 ? q4[i + 2] : q4[i]; q2[i] = kp + __shfl_xor(snd, 4); }
                float tot; { const float snd = b1 ? q2[0] : q2[1], kp = b1 ? q2[1] : q2[0]; tot = kp + __shfl_xor(snd, 2); }
                tot += __shfl_xor(tot, 1);
                const int kk = (bt & 1) * 32 + 2 * ie + hh;
                const float suk = __int_as_float(__builtin_amdgcn_ds_bpermute(kk * 4, __float_as_int(bt < 2 ? su0 : su1)));
                const float gvk = __int_as_float(__builtin_amdgcn_ds_bpermute(kk * 4, __float_as_int(bt < 2 ? gv0 : gv1)));
                const float cf = gvk * gelu_tanh(tot * suk);
                if ((lane & 1) == 0) coefL[bt * 32 + 2 * ie + hh] = cf;
            }
        }
        f32x2 acc2[8];
#pragma unroll
        for (int i = 0; i < 8; ++i) acc2[i] = (f32x2){0.f, 0.f};
        const float cfa = coefL[lane], cfb = coefL[64 + lane];
        {
            u32x2 ra[32], rb[32];
#define HY_VLOAD(R, bt_) do { const int idxv_ = (bt_) < 2 ? idx0 : idx1; _Pragma("unroll") for (int i = 0; i < 32; ++i) { const int e = __builtin_amdgcn_readlane(idxv_, ((bt_) & 1) * 32 + i); \
                R[i] = *(const u32x2*)(P.V8 + (unsigned)(e * 512 + lane * 8)); } } while (0)
#define HY_VCOMP(R, bt_) do { const int cfv_ = __float_as_int((bt_) < 2 ? cfa : cfb); _Pragma("unroll") for (int i = 0; i < 32; ++i) { asm volatile("" : "+v"(R[i])); \
                axpy16_fp4(acc2, __int_as_float(__builtin_amdgcn_readlane(cfv_, ((bt_) & 1) * 32 + i)), R[i]); } } while (0)
            HY_VLOAD(ra, 0); HY_VLOAD(rb, 1);
            HY_VCOMP(ra, 0); HY_VLOAD(ra, 2);
            HY_VCOMP(rb, 1); HY_VLOAD(rb, 3);
            HY_VCOMP(ra, 2); HY_VCOMP(rb, 3);
#undef HY_VLOAD
#undef HY_VCOMP
        }
        float acc[16];
#pragma unroll
        for (int i = 0; i < 8; ++i) { acc[2 * i] = acc2[i][0]; acc[2 * i + 1] = acc2[i][1]; }
        int le = lane; asm volatile("" : "+v"(le));
        const float* g = P.g2 + b * MODW + le * 16;
        float ss = 0.f;
        {
            const u32x4 xa = *(const u32x4*)(P.xinb + m * D + le * 16), xb = *(const u32x4*)(P.xinb + m * D + le * 16 + 8);
            const float xi[16] = {lo16(xa.x), hi16(xa.x), lo16(xa.y), hi16(xa.y), lo16(xa.z), hi16(xa.z), lo16(xa.w), hi16(xa.w), lo16(xb.x), hi16(xb.x), lo16(xb.y), hi16(xb.y), lo16(xb.z), hi16(xb.z), lo16(xb.w), hi16(xb.w)};
#pragma unroll
            for (int q4i = 0; q4i < 4; ++q4i) {
                const f32x4 gg = *(const f32x4*)(g + q4i * 4);
#pragma unroll
                for (int e = 0; e < 4; ++e) { const float o = xi[q4i * 4 + e] + gg[e] * acc[q4i * 4 + e]; acc[q4i * 4 + e] = o; ss += o * o; }
            }
            if (P.xoutb) {
                *(u32x4*)(P.xoutb + m * D + le * 16) = (u32x4){pk2(acc[0], acc[1]), pk2(acc[2], acc[3]), pk2(acc[4], acc[5]), pk2(acc[6], acc[7])};
                *(u32x4*)(P.xoutb + m * D + le * 16 + 8) = (u32x4){pk2(acc[8], acc[9]), pk2(acc[10], acc[11]), pk2(acc[12], acc[13]), pk2(acc[14], acc[15])};
            } else {
#pragma unroll
                for (int q4i = 0; q4i < 4; ++q4i) *(f32x4*)(P.xout + m * D + le * 16 + q4i * 4) = (f32x4){acc[q4i * 4], acc[q4i * 4 + 1], acc[q4i * 4 + 2], acc[q4i * 4 + 3]};
            }
        }
        if (P.ngain) {
            const float r1 = rsqrtf(wave_sum(ss) * (1.f / D) + EPS);
            const float* gn = P.ngain + le * 16; const float* shn = P.nmod + b * MODW + le * 16; const float* scn = P.nmod + b * MODW + D + le * 16;
            unsigned w[8];
#pragma unroll
            for (int q4i = 0; q4i < 4; ++q4i) {
                const f32x4 g4 = *(const f32x4*)(gn + q4i * 4), s4 = *(const f32x4*)(scn + q4i * 4), h4 = *(const f32x4*)(shn + q4i * 4);
                float o[4];
#pragma unroll
                for (int e = 0; e < 4; ++e) o[e] = acc[q4i * 4 + e] * r1 * g4[e] * (1.f + s4[e]) + h4[e];
                w[q4i * 2] = pk2(o[0], o[1]); w[q4i * 2 + 1] = pk2(o[2], o[3]);
            }
            *(u32x4*)(P.H + m * D + le * 16) = (u32x4){w[0], w[1], w[2], w[3]}; *(u32x4*)(P.H + m * D + le * 16 + 8) = (u32x4){w[4], w[5], w[6], w[7]};
        }
    }
}
__device__ __forceinline__ void ph_peer_gather3(const Ctx& C, const GatherP& P) {
    HY_LAS float* coefW = (HY_LAS float*)((HY_LAS unsigned char*)C.lds) + C.wave * 2048;
    HY_LAS int* idsW = (HY_LAS int*)(coefW + 1024);
    const size_t mstep = (size_t)C.nblk * 8;
#pragma unroll 1
    for (size_t mbase = (size_t)C.bid * 8 + C.wave; mbase < M; mbase += 8 * mstep) {
    size_t m = mbase;
    int nidx0 = 0, nidx1 = 0, pidx0 = 0, pidx1 = 0; float nsu0 = 0.f, nsu1 = 0.f, ngv0 = 0.f, ngv1 = 0.f;
    {
        const int l0 = C.lane;
        nidx0 = P.EIDX[m * 128 + l0]; nidx1 = P.EIDX[m * 128 + 64 + l0];
        nsu0 = P.SU[nidx0]; nsu1 = P.SU[nidx1];
        ngv0 = P.GATE[m * 128 + l0] * P.SV[nidx0]; ngv1 = P.GATE[m * 128 + 64 + l0] * P.SV[nidx1];
        if (m + mstep < M) { pidx0 = P.EIDX[(m + mstep) * 128 + l0]; pidx1 = P.EIDX[(m + mstep) * 128 + 64 + l0]; }
    }
    int nk = 0;
#pragma unroll 1
    for (int k = 0; k < 8 && m < M; ++k, m += mstep) {
        HY_LAS float* coefL = coefW + k * 128;
        nk = k + 1;
        unsigned ones_ = ~0u; asm volatile("" : "+s"(ones_));
        const int lane = (int)__builtin_amdgcn_mbcnt_hi(ones_, __builtin_amdgcn_mbcnt_lo(ones_, 0u));
        const int l31 = lane & 31, hh = lane >> 5;
        const int b4 = (lane >> 4) & 1, b3 = (lane >> 3) & 1, b2 = (lane >> 2) & 1, b1 = (lane >> 1) & 1;
        const int ie = 8 * b4 + 4 * b3 + 2 * b2 + b1;
        const int b = (int)(m >> 13);
        const int idx0 = nidx0, idx1 = nidx1; const float su0 = nsu0, su1 = nsu1, gv0 = ngv0, gv1 = ngv1;
        if (m + mstep < M) {
            const size_t mn = m + mstep;
            nidx0 = pidx0; nidx1 = pidx1;
            nsu0 = P.SU[nidx0]; nsu1 = P.SU[nidx1];
            ngv0 = P.GATE[mn * 128 + lane] * P.SV[nidx0]; ngv1 = P.GATE[mn * 128 + 64 + lane] * P.SV[nidx1];
            if (mn + mstep < M) { pidx0 = P.EIDX[(mn + mstep) * 128 + lane]; pidx1 = P.EIDX[(mn + mstep) * 128 + 64 + lane]; }
        }
        idsW[k * 128 + lane] = idx0; idsW[k * 128 + 64 + lane] = idx1;
        {
            f32x2 h[16];
            {
                const bf16_t* hp = P.H + m * D + l31 * 32;
                const f32x4 s0 = *(const f32x4*)(P.SSX + m * 16), s1 = *(const f32x4*)(P.SSX + m * 16 + 4), s2 = *(const f32x4*)(P.SSX + m * 16 + 8), s3 = *(const f32x4*)(P.SSX + m * 16 + 12);
                const float tot = (((s0[0] + s0[1]) + (s0[2] + s0[3])) + ((s1[0] + s1[1]) + (s1[2] + s1[3]))) + (((s2[0] + s2[1]) + (s2[2] + s2[3])) + ((s3[0] + s3[1]) + (s3[2] + s3[3])));
                const float r = rsqrtf(tot * (1.f / D) + EPS);
                const float* sh = P.sh2 + b * MODW + l31 * 32;
#pragma unroll
                for (int q = 0; q < 4; ++q) {
                    const u32x4 a = *(const u32x4*)(hp + q * 8); const f32x4 sa = *(const f32x4*)(sh + q * 8), sb = *(const f32x4*)(sh + q * 8 + 4);
                    h[q * 4] = (f32x2){lo16(a.x) * r + sa[0], hi16(a.x) * r + sa[1]}; h[q * 4 + 1] = (f32x2){lo16(a.y) * r + sa[2], hi16(a.y) * r + sa[3]};
                    h[q * 4 + 2] = (f32x2){lo16(a.z) * r + sb[0], hi16(a.z) * r + sb[1]}; h[q * 4 + 3] = (f32x2){lo16(a.w) * r + sb[2], hi16(a.w) * r + sb[3]};
                }
            }
#pragma unroll 1
            for (int bt = 0; bt < (P.var == 1 ? 0 : 4); ++bt) {
                const int idxv = bt < 2 ? idx0 : idx1;
                u32x4 rows[16];
#pragma unroll
                for (int i = 0; i < 16; ++i) {
                    const int e = __builtin_amdgcn_ds_bpermute(((bt & 1) * 32 + 2 * i + hh) * 4, idxv);
                    rows[i] = *(const u32x4*)(P.U8 + (unsigned)(e * 512 + l31 * 16));
                }
                float p[16];
#pragma unroll
                for (int i = 0; i < 16; ++i) { asm volatile("" : "+v"(rows[i]));
                    p[i] = dot32_fp4(h, rows[i]); }
                float q8[8], q4[4], q2[2];
#pragma unroll
                for (int i = 0; i < 8; ++i) { const float snd = b4 ? p[i] : p[i + 8], kp = b4 ? p[i + 8] : p[i]; q8[i] = kp + __shfl_xor(snd, 16); }
#pragma unroll
                for (int i = 0; i < 4; ++i) { const float snd = b3 ? q8[i] : q8[i + 4], kp = b3 ? q8[i + 4] : q8[i]; q4[i] = kp + __shfl_xor(snd, 8); }
#pragma unroll
                for (int i = 0; i < 2; ++i) { const float snd = b2 ? q4[i] : q4[i + 2], kp = b2 ? q4[i + 2] : q4[i]; q2[i] = kp + __shfl_xor(snd, 4); }
                float tot; { const float snd = b1 ? q2[0] : q2[1], kp = b1 ? q2[1] : q2[0]; tot = kp + __shfl_xor(snd, 2); }
                tot += __shfl_xor(tot, 1);
                const int kk = (bt & 1) * 32 + 2 * ie + hh;
                const float suk = __int_as_float(__builtin_amdgcn_ds_bpermute(kk * 4, __float_as_int(bt < 2 ? su0 : su1)));
                const float gvk = __int_as_float(__builtin_amdgcn_ds_bpermute(kk * 4, __float_as_int(bt < 2 ? gv0 : gv1)));
                const float cf = gvk * gelu_tanh(tot * suk);
                if ((lane & 1) == 0) coefL[bt * 32 + 2 * ie + hh] = cf;
            }
        }
    }
    m = mbase;
#pragma unroll 1
    for (int k = 0; k < nk; ++k, m += mstep) {
        HY_LAS float* coefL = coefW + k * 128;
        unsigned ones_ = ~0u; asm volatile("" : "+s"(ones_));
        const int lane = (int)__builtin_amdgcn_mbcnt_hi(ones_, __builtin_amdgcn_mbcnt_lo(ones_, 0u));
        const int b = (int)(m >> 13);
        const int idx0 = idsW[k * 128 + lane], idx1 = idsW[k * 128 + 64 + lane];
        f32x2 acc2[8];
#pragma unroll
        for (int i = 0; i < 8; ++i) acc2[i] = (f32x2){0.f, 0.f};
#pragma unroll 1
        for (int bt = 0; bt < (P.var == 2 ? 0 : 4); ++bt) {
            const int idxv = bt < 2 ? idx0 : idx1;
            u32x2 rows[32];
#pragma unroll
            for (int i = 0; i < 32; ++i) {
                const int e = __builtin_amdgcn_ds_bpermute(((bt & 1) * 32 + i) * 4, idxv);
                rows[i] = *(const u32x2*)(P.V8 + (unsigned)(e * 512 + lane * 8));
            }
#pragma unroll
            for (int i = 0; i < 32; ++i) { asm volatile("" : "+v"(rows[i])); axpy16_fp4(acc2, coefL[bt * 32 + i], rows[i]); }
        }
        float acc[16];
#pragma unroll
        for (int i = 0; i < 8; ++i) { acc[2 * i] = acc2[i][0]; acc[2 * i + 1] = acc2[i][1]; }
        int le = lane; asm volatile("" : "+v"(le));
        const float* g = P.g2 + b * MODW + le * 16;
        float ss = 0.f;
        {
            const u32x4 xa = *(const u32x4*)(P.xinb + m * D + le * 16), xb = *(const u32x4*)(P.xinb + m * D + le * 16 + 8);
            const float xi[16] = {lo16(xa.x), hi16(xa.x), lo16(xa.y), hi16(xa.y), lo16(xa.z), hi16(xa.z), lo16(xa.w), hi16(xa.w), lo16(xb.x), hi16(xb.x), lo16(xb.y), hi16(xb.y), lo16(xb.z), hi16(xb.z), lo16(xb.w), hi16(xb.w)};
#pragma unroll
            for (int q4i = 0; q4i < 4; ++q4i) {
                const f32x4 gg = *(const f32x4*)(g + q4i * 4);
#pragma unroll
                for (int e = 0; e < 4; ++e) { const float o = xi[q4i * 4 + e] + gg[e] * acc[q4i * 4 + e]; acc[q4i * 4 + e] = o; ss += o * o; }
            }
            if (P.xoutb) {
                *(u32x4*)(P.xoutb + m * D + le * 16) = (u32x4){pk2(acc[0], acc[1]), pk2(acc[2], acc[3]), pk2(acc[4], acc[5]), pk2(acc[6], acc[7])};
                *(u32x4*)(P.xoutb + m * D + le * 16 + 8) = (u32x4){pk2(acc[8], acc[9]), pk2(acc[10], acc[11]), pk2(acc[12], acc[13]), pk2(acc[14], acc[15])};
            } else {
#pragma unroll
                for (int q4i = 0; q4i < 4; ++q4i) *(f32x4*)(P.xout + m * D + le * 16 + q4i * 4) = (f32x4){acc[q4i * 4], acc[q4i * 4 + 1], acc[q4i * 4 + 2], acc[q4i * 4 + 3]};
            }
        }
        if (P.ngain) {
            const float r1 = rsqrtf(wave_sum(ss) * (1.f / D) + EPS);
            const float* gn = P.ngain + le * 16; const float* shn = P.nmod + b * MODW + le * 16; const float* scn = P.nmod + b * MODW + D + le * 16;
            unsigned w[8];
#pragma unroll
            for (int q4i = 0; q4i < 4; ++q4i) {
                const f32x4 g4 = *(const f32x4*)(gn + q4i * 4), s4 = *(const f32x4*)(scn + q4i * 4), h4 = *(const f32x4*)(shn + q4i * 4);
                float o[4];
#pragma unroll
                for (int e = 0; e < 4; ++e) o[e] = acc[q4i * 4 + e] * r1 * g4[e] * (1.f + s4[e]) + h4[e];
                w[q4i * 2] = pk2(o[0], o[1]); w[q4i * 2 + 1] = pk2(o[2], o[3]);
            }
            *(u32x4*)(P.H + m * D + le * 16) = (u32x4){w[0], w[1], w[2], w[3]}; *(u32x4*)(P.H + m * D + le * 16 + 8) = (u32x4){w[4], w[5], w[6], w[7]};
        }
    }
    }
}
}
namespace hy {
struct EpiGen {
    static constexpr bool PERM = true, AFTER_DRAIN = false;
    int mode; int ldc; bf16_t* O; const float* xin; const bf16_t* xinb; bf16_t* xoutb; const float* gate; unsigned char* ws; const float *p0, *p1, *p2;
    __device__ __forceinline__ void operator()(const pg8::f32x4 (&acc)[2][2][4][2], const pg8::Unit& u, int wr, int wc, int fr_, int fq_) const {
        int fr = fr_, fq = fq_; asm volatile("" : "+v"(fr), "+v"(fq));
        const int row0 = u.pm * 256 + wr * 64 + fr, col0 = u.pn * 256 + wc * 32 + 8 * fq;
        if (mode == 0) {
#pragma unroll
            for (int ai = 0; ai < 2; ++ai)
#pragma unroll
                for (int m = 0; m < 4; ++m) { bf16_t* rowp = O + (size_t)(row0 + ai * 128 + m * 16) * ldc + col0;
#pragma unroll
                    for (int bj = 0; bj < 2; ++bj) { const pg8::f32x4 v0 = acc[ai][bj][m][0], v1 = acc[ai][bj][m][1];
                        u32x4 w; w.x = pg8::cvt_pk_bf16(v0[0], v0[1]); w.y = pg8::cvt_pk_bf16(v0[2], v0[3]); w.z = pg8::cvt_pk_bf16(v1[0], v1[1]); w.w = pg8::cvt_pk_bf16(v1[2], v1[3]);
                        *(u32x4*)(rowp + bj * 128) = w; } }
        } else if (mode == 2) {
            const int uu = 4 * u.pn + wc;
            if (uu > 28) return;
            bf16_t* dst; int pitch, cb; float osc = 1.f; const float* gn = nullptr;
            if (uu < 6) { dst = (bf16_t*)(ws + WS_QA); pitch = 384; cb = 64 * uu; gn = p0; osc = 0.125f * LOG2E; }
            else if (uu < 12) { dst = (bf16_t*)(ws + WS_KA); pitch = 384; cb = 64 * (uu - 6); gn = p1; }
            else if (uu < 18) { dst = (bf16_t*)(ws + WS_VA); pitch = 384; cb = 64 * (uu - 12); }
            else if (uu < 20) { dst = (bf16_t*)(ws + WS_CQKV); pitch = 384; cb = 256 + 64 * (uu - 18); }
            else if (uu < 24) { dst = (bf16_t*)(ws + WS_CQKV); pitch = 384; cb = 64 * (uu - 20); }
            else if (uu < 28) { dst = (bf16_t*)(ws + WS_U); pitch = 256; cb = 64 * (uu - 24); }
            else { dst = (bf16_t*)(ws + WS_KM); pitch = 576; cb = 64; }
            pg8::f32x4 gv[2][2];
#pragma unroll
            for (int bj = 0; bj < 2; ++bj)
#pragma unroll
                for (int n = 0; n < 2; ++n) gv[bj][n] = gn ? *(const pg8::f32x4*)(gn + 32 * bj + 8 * fq + 4 * n) * osc : (pg8::f32x4){1.f, 1.f, 1.f, 1.f};
            float* ssq = (float*)(ws + WS_SSQ) + (uu < 20 ? 4 + (uu - 18) : (uu - 20));
#pragma unroll
            for (int ai = 0; ai < 2; ++ai)
#pragma unroll
                for (int m = 0; m < 4; ++m) {
                    const int row = row0 + ai * 128 + m * 16;
                    pg8::f32x4 v[2][2];
#pragma unroll
                    for (int bj = 0; bj < 2; ++bj)
#pragma unroll
                        for (int n = 0; n < 2; ++n) v[bj][n] = acc[ai][bj][m][n];
                    if (uu < 12 || (uu >= 18 && uu < 24)) {
                        float ss = 0.f;
#pragma unroll
                        for (int bj = 0; bj < 2; ++bj)
#pragma unroll
                            for (int n = 0; n < 2; ++n) ss += v[bj][n][0] * v[bj][n][0] + v[bj][n][1] * v[bj][n][1] + v[bj][n][2] * v[bj][n][2] + v[bj][n][3] * v[bj][n][3];
                        ss += __shfl_xor(ss, 16); ss += __shfl_xor(ss, 32);
                        if (uu < 12) { const float r = rsqrtf(ss * (1.f / 64.f) + EPS);
#pragma unroll
                            for (int bj = 0; bj < 2; ++bj)
#pragma unroll
                                for (int n = 0; n < 2; ++n) v[bj][n] = v[bj][n] * r * gv[bj][n]; }
                        else if (fq == 0) ssq[(size_t)row * 8] = ss;
                    }
                    if (uu < 28) {
#pragma unroll
                        for (int bj = 0; bj < 2; ++bj) {
                            u32x4 w; w.x = pg8::cvt_pk_bf16(v[bj][0][0], v[bj][0][1]); w.y = pg8::cvt_pk_bf16(v[bj][0][2], v[bj][0][3]); w.z = pg8::cvt_pk_bf16(v[bj][1][0], v[bj][1][1]); w.w = pg8::cvt_pk_bf16(v[bj][1][2], v[bj][1][3]);
                            *(u32x4*)(dst + (size_t)row * pitch + cb + 32 * bj + 8 * fq) = w;
                        }
                    } else {
                        float ss = 0.f;
#pragma unroll
                        for (int n = 0; n < 2; ++n) ss += v[0][n][0] * v[0][n][0] + v[0][n][1] * v[0][n][1] + v[0][n][2] * v[0][n][2] + v[0][n][3] * v[0][n][3];
                        ss += __shfl_xor(ss, 16); ss += __shfl_xor(ss, 32);
                        const float r = rsqrtf(ss * (1.f / 32.f) + EPS);
                        const int pos = row & (S - 1), i0 = 8 * (fq & 1);
                        const float* rp = (const float*)(ws + WS_ROPE) + pos * 16 + i0;
                        float o[8];
#pragma unroll
                        for (int n = 0; n < 2; ++n) {
                            const pg8::f32x4 kg = *(const pg8::f32x4*)(p2 + 64 + 8 * fq + 4 * n);
                            const pg8::f32x4 cs = *(const pg8::f32x4*)(rp + 4 * n), sn = *(const pg8::f32x4*)(rp + S * 16 + 4 * n);
#pragma unroll
                            for (int e = 0; e < 4; ++e) {
                                const float nv = v[0][n][e] * r * kg[e];
                                const float pr = __shfl_xor(nv, 32);
                                o[4 * n + e] = (fq < 2) ? (nv * cs[e] - pr * sn[e]) : (pr * sn[e] + nv * cs[e]);
                            }
                        }
                        u32x4 w; w.x = pg8::cvt_pk_bf16(o[0], o[1]); w.y = pg8::cvt_pk_bf16(o[2], o[3]); w.z = pg8::cvt_pk_bf16(o[4], o[5]); w.w = pg8::cvt_pk_bf16(o[6], o[7]);
#pragma unroll
                        for (int hh = 0; hh < 6; ++hh) *(u32x4*)(dst + (size_t)row * pitch + hh * 96 + cb + 8 * fq) = w;
                    }
                }
        } else if (mode == 3) {
            const int h = u.pn, kind = wc;
            const float SCQ = 0.10206207261596575f * LOG2E;
            const float* gn = kind == 0 ? p0 : (kind == 1 ? p0 + 64 : p1);
            pg8::f32x4 gv[2][2];
#pragma unroll
            for (int bj = 0; bj < 2; ++bj)
#pragma unroll
                for (int n = 0; n < 2; ++n) gv[bj][n] = (kind == 3 || (kind == 1 && bj == 1)) ? (pg8::f32x4){1.f, 1.f, 1.f, 1.f} : *(const pg8::f32x4*)(gn + 32 * bj + 8 * fq + 4 * n);
            bf16_t* dst; int pitch, cb;
            if (kind < 2) { dst = (bf16_t*)(ws + WS_QM); pitch = 576; cb = h * 96 + kind * 64; }
            else if (kind == 2) { dst = (bf16_t*)(ws + WS_KM); pitch = 576; cb = h * 96; }
            else { dst = (bf16_t*)(ws + WS_VM); pitch = 384; cb = h * 64; }
            const float* ssqp = (const float*)(ws + WS_SSQ);
#pragma unroll
            for (int ai = 0; ai < 2; ++ai)
#pragma unroll
                for (int m = 0; m < 4; ++m) {
                    const int row = row0 + ai * 128 + m * 16;
                    const pg8::f32x4 pq = *(const pg8::f32x4*)(ssqp + (size_t)row * 8); const float2 pkv = *(const float2*)(ssqp + (size_t)row * 8 + 4);
                    const float sc = kind < 2 ? rsqrtf(((pq[0] + pq[1]) + (pq[2] + pq[3])) * (1.f / 256.f) + EPS) : rsqrtf((pkv.x + pkv.y) * (1.f / 128.f) + EPS);
                    pg8::f32x4 v[2][2];
#pragma unroll
                    for (int bj = 0; bj < 2; ++bj)
#pragma unroll
                        for (int n = 0; n < 2; ++n) v[bj][n] = acc[ai][bj][m][n] * sc;
                    if (kind != 3) {
                        float ss = 0.f;
#pragma unroll
                        for (int bj = 0; bj < 2; ++bj)
#pragma unroll
                            for (int n = 0; n < 2; ++n) if (kind != 1 || bj == 0) ss += v[bj][n][0] * v[bj][n][0] + v[bj][n][1] * v[bj][n][1] + v[bj][n][2] * v[bj][n][2] + v[bj][n][3] * v[bj][n][3];
                        ss += __shfl_xor(ss, 16); ss += __shfl_xor(ss, 32);
                        const float r = rsqrtf(ss * (kind == 1 ? (1.f / 32.f) : (1.f / 64.f)) + EPS) * (kind < 2 ? SCQ : 1.f);
#pragma unroll
                        for (int bj = 0; bj < 2; ++bj)
#pragma unroll
                            for (int n = 0; n < 2; ++n) v[bj][n] = v[bj][n] * r * gv[bj][n];
                    }
                    if (kind == 1) {
                        const int pos = row & (S - 1), i0 = 8 * (fq & 1);
                        const float* rp = (const float*)(ws + WS_ROPE) + pos * 16 + i0;
                        float o[8];
#pragma unroll
                        for (int n = 0; n < 2; ++n) {
                            const pg8::f32x4 cs = *(const pg8::f32x4*)(rp + 4 * n), sn = *(const pg8::f32x4*)(rp + S * 16 + 4 * n);
#pragma unroll
                            for (int e = 0; e < 4; ++e) { const float nv = v[0][n][e]; const float pr = __shfl_xor(nv, 32); o[4 * n + e] = (fq < 2) ? (nv * cs[e] - pr * sn[e]) : (pr * sn[e] + nv * cs[e]); }
                        }
                        u32x4 w; w.x = pg8::cvt_pk_bf16(o[0], o[1]); w.y = pg8::cvt_pk_bf16(o[2], o[3]); w.z = pg8::cvt_pk_bf16(o[4], o[5]); w.w = pg8::cvt_pk_bf16(o[6], o[7]);
                        *(u32x4*)(dst + (size_t)row * pitch + cb + 8 * fq) = w;
                    } else {
#pragma unroll
                        for (int bj = 0; bj < 2; ++bj) {
                            u32x4 w; w.x = pg8::cvt_pk_bf16(v[bj][0][0], v[bj][0][1]); w.y = pg8::cvt_pk_bf16(v[bj][0][2], v[bj][0][3]); w.z = pg8::cvt_pk_bf16(v[bj][1][0], v[bj][1][1]); w.w = pg8::cvt_pk_bf16(v[bj][1][2], v[bj][1][3]);
                            *(u32x4*)(dst + (size_t)row * pitch + cb + 32 * bj + 8 * fq) = w;
                        }
                    }
                }
        } else if (mode == 4) {
            const float* cv = p0 + ((u.pm * 256) >> 13) * 2048;
            const float* ssx = (const float*)(ws + WS_SSX);
            pg8::f32x4 c0[2], c1[2];
#pragma unroll
            for (int bj = 0; bj < 2; ++bj) { c0[bj] = *(const pg8::f32x4*)(cv + col0 + bj * 128); c1[bj] = *(const pg8::f32x4*)(cv + col0 + bj * 128 + 4); }
#pragma unroll
            for (int ai = 0; ai < 2; ++ai)
#pragma unroll
                for (int m = 0; m < 4; ++m) {
                    const int row = row0 + ai * 128 + m * 16;
                    const pg8::f32x4 s0 = *(const pg8::f32x4*)(ssx + (size_t)row * 16), s1 = *(const pg8::f32x4*)(ssx + (size_t)row * 16 + 4), s2 = *(const pg8::f32x4*)(ssx + (size_t)row * 16 + 8), s3 = *(const pg8::f32x4*)(ssx + (size_t)row * 16 + 12);
                    const float tot = (((s0[0] + s0[1]) + (s0[2] + s0[3])) + ((s1[0] + s1[1]) + (s1[2] + s1[3]))) + (((s2[0] + s2[1]) + (s2[2] + s2[3])) + ((s3[0] + s3[1]) + (s3[2] + s3[3])));
                    const float r = rsqrtf(tot * (1.f / D) + EPS);
                    bf16_t* rowp = O + (size_t)row * ldc + col0;
#pragma unroll
                    for (int bj = 0; bj < 2; ++bj) { const pg8::f32x4 v0 = acc[ai][bj][m][0] * r + c0[bj], v1 = acc[ai][bj][m][1] * r + c1[bj];
                        u32x4 w; w.x = pg8::cvt_pk_bf16(v0[0], v0[1]); w.y = pg8::cvt_pk_bf16(v0[2], v0[3]); w.z = pg8::cvt_pk_bf16(v1[0], v1[1]); w.w = pg8::cvt_pk_bf16(v1[2], v1[3]);
                        *(u32x4*)(rowp + bj * 128) = w; }
                }
        } else {
            const int b = (u.pm * 256) >> 13;
            const float* g = gate + b * MODW; const float* sc2 = p1 + b * MODW;
            float* ssx = (float*)(ws + WS_SSX) + u.pn * 4 + wc;
            bf16_t* A2 = (bf16_t*)(ws + WS_H);
            pg8::f32x4 g0[2], g1[2], w0[2], w1[2];
#pragma unroll
            for (int bj = 0; bj < 2; ++bj) {
                const int col = col0 + bj * 128;
                g0[bj] = *(const pg8::f32x4*)(g + col); g1[bj] = *(const pg8::f32x4*)(g + col + 4);
                w0[bj] = *(const pg8::f32x4*)(p0 + col) * (*(const pg8::f32x4*)(sc2 + col) + 1.f); w1[bj] = *(const pg8::f32x4*)(p0 + col + 4) * (*(const pg8::f32x4*)(sc2 + col + 4) + 1.f);
            }
#pragma unroll
            for (int ai = 0; ai < 2; ++ai)
#pragma unroll
                for (int m = 0; m < 4; ++m) {
                    const int row = row0 + ai * 128 + m * 16; float ss = 0.f;
#pragma unroll
                    for (int bj = 0; bj < 2; ++bj) {
                        const size_t off = (size_t)row * D + col0 + bj * 128;
                        pg8::f32x4 xi0, xi1;
                        if (xin) { xi0 = *(const pg8::f32x4*)(xin + off); xi1 = *(const pg8::f32x4*)(xin + off + 4); }
                        else { const u32x4 xb = *(const u32x4*)(xinb + off); xi0 = (pg8::f32x4){lo16(xb.x), hi16(xb.x), lo16(xb.y), hi16(xb.y)}; xi1 = (pg8::f32x4){lo16(xb.z), hi16(xb.z), lo16(xb.w), hi16(xb.w)}; }
                        const pg8::f32x4 x0 = xi0 + g0[bj] * acc[ai][bj][m][0], x1 = xi1 + g1[bj] * acc[ai][bj][m][1];
                        { u32x4 xw; xw.x = pg8::cvt_pk_bf16(x0[0], x0[1]); xw.y = pg8::cvt_pk_bf16(x0[2], x0[3]); xw.z = pg8::cvt_pk_bf16(x1[0], x1[1]); xw.w = pg8::cvt_pk_bf16(x1[2], x1[3]); *(u32x4*)(xoutb + off) = xw; }
                        ss += (x0[0] * x0[0] + x0[1] * x0[1]) + (x0[2] * x0[2] + x0[3] * x0[3]) + (x1[0] * x1[0] + x1[1] * x1[1]) + (x1[2] * x1[2] + x1[3] * x1[3]);
                        const pg8::f32x4 a0 = x0 * w0[bj], a1 = x1 * w1[bj];
                        u32x4 w; w.x = pg8::cvt_pk_bf16(a0[0], a0[1]); w.y = pg8::cvt_pk_bf16(a0[2], a0[3]); w.z = pg8::cvt_pk_bf16(a1[0], a1[1]); w.w = pg8::cvt_pk_bf16(a1[2], a1[3]);
                        *(u32x4*)(A2 + off) = w;
                    }
                    ss += __shfl_xor(ss, 16); ss += __shfl_xor(ss, 32);
                    if (fq == 0) ssx[(size_t)row * 16] = ss;
                }
        }
    }
};

#ifndef HY_PROBE
#define HY_PROBE 0
#endif
#define HY_PROBE_REPS(s) (((HY_PROBE >= 40 && HY_PROBE < 50 && (s) == 8) || (HY_PROBE >= 100 && (s) == HY_PROBE - 100) || ((HY_PROBE == 2 || HY_PROBE == 7 || HY_PROBE == 8 || HY_PROBE == 9 || HY_PROBE == 20 || HY_PROBE == 21 || HY_PROBE == 22) && (s) == 2) || \
                          (HY_PROBE == 3 && (s) == 8) || (HY_PROBE == 4 && (s) == 7) || (HY_PROBE == 5 && ((s) == 0 || (s) == 1 || (s) == 3 || (s) == 6)) || (HY_PROBE == 6 && (s) == 4)) ? 2 : 1)
#define GSYNC() do { XcdBarrier b_; b_.bar = WSP(unsigned, WS_CTL) + 4096; b_.x = xb_xcc_id(); b_.st = (volatile LAS unsigned*)((HY_LAS unsigned char*)lds + LDS_BYTES - 32); xcd_barrier(b_, HY_TID()); } while (0)
constexpr int NSTEP = 9;

__global__ void __launch_bounds__(NT, 2) k_fwd(Params P) {
    extern __shared__ __attribute__((aligned(16))) unsigned char lds[];
    cg::grid_group grid = cg::this_grid();
    const int wave0 = __builtin_amdgcn_readfirstlane(threadIdx.x >> 6);
#define HY_TID() ({ unsigned o_ = ~0u; asm volatile("" : "+s"(o_)); wave0 * 64 + (int)__builtin_amdgcn_mbcnt_hi(o_, __builtin_amdgcn_mbcnt_lo(o_, 0u)); })
    Ctx C0; C0.tid = HY_TID(); C0.lane = C0.tid & 63; C0.wave = wave0; C0.bid = blockIdx.x; C0.nblk = gridDim.x; C0.lds = lds;
    const In& in = P.in;
    unsigned char* ws = P.ws; float* out = P.out;
    if (C0.tid < 8) ((HY_LAS unsigned*)((HY_LAS unsigned char*)lds + LDS_BYTES - 32))[C0.tid] = 0u;
    __syncthreads();
#define WSP(T, off) ((T*)(ws + (off)))

    for (int prep = 0; prep < (HY_PROBE == 1 ? 2 : 1); ++prep) {
    const Ctx& C = C0;
    if (C.bid == 0) { for (int i = C.tid; i < 8192; i += NT) WSP(unsigned, WS_CTL)[i] = 0u; }
    for (int q = 0; q < (HY_PROBE == 13 ? 2 : 1); ++q)
    ph_mod(C, in.c, in.w_ada, in.b_ada, WSP(float, WS_MOD));
    ph_tables(C, in.rel_bias, WSP(float, WS_BIAS), WSP(float, WS_ROPE));
    ph_bounds(C, in, WSP(float, WS_BIAS) + 4096);
    ph_w2zero(C, WSP(bf16_t, WS_W2));
    for (int q = 0; q < (HY_PROBE == 11 ? 2 : 1); ++q)
    ph_tconv(C, P);
    ph_cvt(C, in.peer_subkeys, WSP(bf16_t, WS_SUBK), (size_t)NL * 16 * 128 * 128 / 8);
    for (int q = 0; q < (HY_PROBE == 12 ? 2 : 1); ++q)
    ph_cvt_fp4(C, in.peer_u, WSP(unsigned char, WS_PU), WSP(float, WS_PSU), NL * 16384);
    ph_s5_lampow(C, in, WSP(float, WS_LP));
    ph_s5_bbar(C, in, WSP(float, WS_BB));
    ph_cvt_fp4(C, in.peer_v, WSP(unsigned char, WS_PV), WSP(float, WS_PSU) + NL * 16384, NL * 16384);
    }
    grid.sync();
    (void)xcd_barrier_post(WSP(unsigned, WS_CTL) + 4096, (volatile LAS unsigned*)((HY_LAS unsigned char*)lds + LDS_BYTES - 32), HY_TID());
    for (int prep = 0; prep < ((HY_PROBE == 1 || HY_PROBE == 10) ? 2 : 1); ++prep)
    { ph_s5_tables(C0, in, WSP(float, WS_LP), WSP(float, WS_BB), WSP(bf16_t, WS_KMT), WSP(bf16_t, WS_WE), WSP(bf16_t, WS_WC));
      ph_cvec(C0, in.peer_wq, WSP(float, WS_MOD), WSP(float, WS_CV));
      ph_normmod(C0, in.x, in.norm1_gain, WSP(float, WS_MOD), 0, D, WSP(bf16_t, WS_H), nullptr); }
    GSYNC();

    for (int step = 0; step < NL * NSTEP; ++step) {
        const int l = step / NSTEP, s = step % NSTEP;
        if (s == 3) continue;
        const int nrep = HY_PROBE_REPS(s);
        for (int rep = 0; rep < nrep; ++rep) {
#define HY_MKCTX() Ctx C; { int t = HY_TID(), bq = blockIdx.x; asm volatile("" : "+v"(t), "+s"(bq)); C.tid = t; C.lane = t & 63; C.wave = __builtin_amdgcn_readfirstlane(t >> 6); C.bid = bq; C.nblk = gridDim.x; C.lds = lds; }
        const float* modl = WSP(float, WS_MOD) + (size_t)l * 2 * MODW;
        const bf16_t* gA = nullptr; const bf16_t* gB = nullptr; int gN = 0, gK = 0; EpiGen ge; ge.mode = 0; ge.ldc = 0; ge.O = nullptr; ge.xin = nullptr; ge.xinb = nullptr; ge.xoutb = nullptr; ge.gate = nullptr; ge.ws = ws; ge.p0 = nullptr; ge.p1 = nullptr; ge.p2 = nullptr;
        switch (s) {
        case 0: gA = WSP(bf16_t, WS_H); gB = WSP(bf16_t, WS_WIN) + (size_t)l * P1W * D; gN = P1W; gK = D; ge.mode = 2; ge.p0 = in.swa_q_gain + l * 64; ge.p1 = in.swa_k_gain + l * 64; ge.p2 = in.mla_k_gain + l * 96; break;
        case 1: gA = WSP(bf16_t, WS_CQKV); gB = WSP(bf16_t, WS_W2) + (size_t)l * P2W * 384; gN = P2W; gK = 384; ge.mode = 3; ge.p0 = in.mla_q_gain + l * 96; ge.p1 = in.mla_k_gain + l * 96; break;
        case 2: { HY_MKCTX(); MixQ mp; mp.QM = WSP(bf16_t, WS_QM); mp.KM = WSP(bf16_t, WS_KM); mp.VM = WSP(bf16_t, WS_VM); mp.QA = WSP(bf16_t, WS_QA); mp.KA = WSP(bf16_t, WS_KA); mp.VA = WSP(bf16_t, WS_VA);
                  mp.bias = WSP(float, WS_BIAS); mp.YC = WSP(bf16_t, WS_YC); mp.YAB = WSP(bf16_t, WS_YAB); mp.MLB = WSP(float, WS_MLB);
                  mp.s5.U = WSP(bf16_t, WS_U); mp.s5.KMl = WSP(bf16_t, WS_KMT) + (size_t)l * S5_KM_L; mp.s5.WCl = WSP(bf16_t, WS_WC) + (size_t)l * S5_WC_L; mp.s5.E = WSP(float, WS_E); mp.s5.LP = WSP(float, WS_LP);
                  mp.s5.dskip = in.s5_d + l * 256; mp.s5.GS = WSP(bf16_t, WS_GS); mp.s5.layer = l; mp.s5.var = 0;
                  mp.counter = WSP(unsigned, WS_CTL) + 64 * (l * 4 + rep);
                  mp.lo = 0; mp.hi = 1 << 30; mp.bnd = WSP(float, WS_BIAS) + 4096 + l * 2;
                  mp.var = 0;
                  if (rep + 1 < nrep && (HY_PROBE == 20 || HY_PROBE == 21 || HY_PROBE == 22)) { mp.lo = 0; mp.hi = 384; mp.YC = WSP(bf16_t, WS_P1); mp.var = HY_PROBE == 20 ? 0 : 1; }
                  if (rep + 1 < nrep) { if (HY_PROBE == 7) { mp.lo = 0; mp.hi = 384; } else if (HY_PROBE == 8) { mp.lo = 512; mp.hi = 1664; } else if (HY_PROBE == 9) { mp.lo = 384; mp.hi = 512; } }
                  ph_mixers(C, mp); } break;
        case 3: gA = WSP(bf16_t, WS_GS); gB = WSP(bf16_t, WS_WGLU) + (size_t)l * 65536; gN = 256; gK = 256; ge.O = WSP(bf16_t, WS_GL); ge.ldc = 256; break;
        case 4: { HY_MKCTX(); ph_merge3(C, WSP(bf16_t, WS_YAB), WSP(float, WS_MLB), WSP(bf16_t, WS_GS), WSP(bf16_t, WS_WGLU) + (size_t)l * 65536, in.b_glu + l * 256, WSP(bf16_t, WS_YC), WSP(bf16_t, WS_AOUT)); } break;
        case 5: gA = WSP(bf16_t, WS_AOUT); gB = WSP(bf16_t, WS_WOUT) + (size_t)l * D * D; gN = D; gK = D; ge.mode = 1; ge.xin = l == 0 ? in.x : nullptr; ge.xinb = WSP(bf16_t, WS_XB); ge.xoutb = WSP(bf16_t, WS_XB); ge.gate = modl + 2 * D; ge.p0 = in.norm2_gain + l * D; ge.p1 = modl + 4 * D; break;
        case 6: gA = WSP(bf16_t, WS_H); gB = WSP(bf16_t, WS_WQ) + (size_t)l * 2048 * D; gN = 2048; gK = D; ge.mode = 4; ge.O = WSP(bf16_t, WS_QP); ge.ldc = 2048; ge.p0 = WSP(float, WS_CV) + (size_t)l * 2 * 2048; break;
        case 7: { HY_MKCTX(); ph_peer_topk(C, WSP(bf16_t, WS_QP), WSP(bf16_t, WS_SUBK) + (size_t)l * 16 * 128 * 128, WSP(int, WS_EIDX), WSP(float, WS_GATE)); } break;
        case 8: { HY_MKCTX(); GatherP gp; gp.H = WSP(bf16_t, WS_H); gp.EIDX = WSP(int, WS_EIDX); gp.GATE = WSP(float, WS_GATE); gp.U8 = WSP(unsigned char, WS_PU) + (size_t)l * 16384 * 512; gp.SU = WSP(float, WS_PSU) + l * 16384;
                  gp.V8 = WSP(unsigned char, WS_PV) + (size_t)l * 16384 * 512; gp.SV = WSP(float, WS_PSU) + (NL + l) * 16384; gp.g2 = modl + 5 * D; gp.xinb = WSP(bf16_t, WS_XB); gp.xout = (rep + 1 < nrep) ? WSP(float, WS_P1) : out; gp.xoutb = (l + 1 < NL) ? ((rep + 1 < nrep) ? WSP(bf16_t, WS_P1) : WSP(bf16_t, WS_XB)) : nullptr;
                  gp.SSX = WSP(float, WS_SSX); gp.sh2 = modl + 3 * D; gp.ngain = (l + 1 < NL && rep + 1 == nrep) ? in.norm1_gain + (l + 1) * D : nullptr; gp.nmod = modl + 2 * MODW;
                  gp.var = (rep + 1 < nrep && HY_PROBE >= 40 && HY_PROBE < 50) ? HY_PROBE - 40 : 0;
#ifdef HY_GSUB
                  { Ctx C3 = C; if ((C.bid & 3) == 3) { C3.bid = 1 << 20; } else { C3.bid = C.bid - (C.bid >> 2); } C3.nblk = 192; ph_peer_gather2(C3, gp); }
#else
                  ph_peer_gather4(C, gp);
#endif
                  } break;
        default: break;
        }
        if (gA) {
            HY_MKCTX();
            pg8::Gemm g; g.A = gA; g.Bt = gB; g.M = M; g.N = gN; g.K = gK;
            pg8::StaticOrder So; So.init(M, gN, C.nblk, C.bid);
            pg8::gemm_phase<EpiGen, pg8::StaticOrder, true, true>((PG8_LAS unsigned char*)C.lds, g, So, ge, C.tid);
        }
        if (s == 1) { HY_MKCTX(); ph_s5_chunk_states(C, WSP(bf16_t, WS_U), WSP(bf16_t, WS_WE) + (size_t)l * S5_WE_L, WSP(float, WS_E)); }
        if (rep + 1 < nrep) GSYNC();
        }
        GSYNC();
    }
}
}

extern "C" void kernel_launch(void* const* d_in, const int* in_sizes, int n_in, void* d_out, int out_size, void* d_ws, size_t ws_size, hipStream_t stream) {
    using namespace hy;
    static int grid_blocks = 0;
    if (grid_blocks == 0) {
        if (n_in != 32 || out_size != M * D || ws_size < WS_END) { fprintf(stderr, "kernel_launch: unexpected problem (n_in %d out %d ws %zu)\n", n_in, out_size, ws_size); grid_blocks = -1; return; }
        (void)hipFuncSetAttribute((const void*)k_fwd, hipFuncAttributeMaxDynamicSharedMemorySize, LDS_BYTES);
        int dev = 0, cus = 0, per_cu = 0;
        (void)hipGetDevice(&dev);
        (void)hipDeviceGetAttribute(&cus, hipDeviceAttributeMultiprocessorCount, dev);
        (void)hipOccupancyMaxActiveBlocksPerMultiprocessor(&per_cu, (const void*)k_fwd, NT, LDS_BYTES);
        if (per_cu < 1) { fprintf(stderr, "kernel_launch: occupancy query says %d blocks/CU\n", per_cu); per_cu = 1; }
        grid_blocks = cus;
        fprintf(stderr, "kernel_launch: cus %d per_cu %d grid %d\n", cus, per_cu, grid_blocks);
    }
    if (grid_blocks < 0) return;
    Params P; memset(&P, 0, sizeof(P));
    { const float** p = (const float**)&P.in; for (int i = 0; i < 32; ++i) p[i] = (const float*)d_in[i]; }
    P.out = (float*)d_out; P.ws = (unsigned char*)d_ws;
    void* args[] = {&P};
    hipError_t e = hipLaunchCooperativeKernel((const void*)k_fwd, dim3(grid_blocks), dim3(NT), args, LDS_BYTES, stream);
    if (e != hipSuccess) fprintf(stderr, "cooperative launch failed: %s (grid %d)\n", hipGetErrorString(e), grid_blocks);
}
```

```cpp
#include <hip/hip_runtime.h>
#include <cstdint>
#include <cstdio>
#include <cstring>
#include <hip/hip_cooperative_groups.h>
#ifndef HY_PROBE
#define HY_PROBE 0
#endif
#define LAS __attribute__((address_space(3)))
#define XB_TMO      128
#define XB_XCNT(j)  (256  + 64 * (j))
#define XB_XSUB(j)  (1280 + 64 * (j))
#define XB_XGEN(j)  (2304 + 64 * (j))
#define XB_TOP      3328
#define XB_TOPGEN   3392
#define XCD_BAR_WORDS 3456
#define XB_SPIN_CAP (1u << 18)

__device__ __forceinline__ unsigned xb_ld(unsigned* p)              { return __hip_atomic_load(p, __ATOMIC_RELAXED, __HIP_MEMORY_SCOPE_AGENT); }
__device__ __forceinline__ unsigned xb_add(unsigned* p, unsigned v) { return __hip_atomic_fetch_add(p, v, __ATOMIC_RELAXED, __HIP_MEMORY_SCOPE_AGENT); }
__device__ __forceinline__ unsigned xb_xcc_id() { return (unsigned)__builtin_amdgcn_s_getreg((3 << 11) | 20) & 0xFu; }
#define XB_SPIN(cond, bar) do { unsigned _sp = 0; while (cond) { __builtin_amdgcn_s_sleep(1); \
    if ((++_sp & 255u) == 0u) { if (xb_ld(&(bar)[XB_TMO])) break; if (_sp > XB_SPIN_CAP) { atomicAdd(&(bar)[XB_TMO], 1u); break; } } } } while (0)

struct XcdBarrier {
    unsigned* bar; unsigned x;
    volatile LAS unsigned* st;
};

__device__ __forceinline__ XcdBarrier xcd_barrier_post(unsigned* bar, volatile LAS unsigned* st, int tid) {
    XcdBarrier b; b.bar = bar; b.x = xb_xcc_id(); b.st = st;
    if (tid == 0) (void)xb_add(&bar[XB_XCNT(b.x)], 1u);
    return b;
}
__device__ __forceinline__ void xcd_barrier_complete(unsigned* bar, unsigned x, unsigned& nloc, unsigned& nx) {
    const unsigned G = gridDim.x * gridDim.y * gridDim.z;
    unsigned sum, cnt, mine, sp = 0u;
    for (;;) {
        sum = 0u; cnt = 0u; mine = 0u;
#pragma unroll
        for (unsigned j = 0; j < 16; ++j) { const unsigned c = xb_ld(&bar[XB_XCNT(j)]); sum += c; cnt += (c > 0u) ? 1u : 0u; mine = (j == x) ? c : mine; }
        if (sum == G) break;
        __builtin_amdgcn_s_sleep(1);
        if ((++sp & 255u) == 0u) { if (xb_ld(&bar[XB_TMO])) break; if (sp > XB_SPIN_CAP) { atomicAdd(&bar[XB_TMO], 1u); break; } }
    }
    nloc = mine > 0u ? mine : 1u; nx = cnt > 0u ? cnt : 1u;
}

__device__ __forceinline__ void xcd_barrier(const XcdBarrier& b, int tid) {
    asm volatile("s_waitcnt vmcnt(0)" ::: "memory");
    __syncthreads();
    if (tid == 0) {
        unsigned* bar = b.bar;
        __builtin_amdgcn_s_waitcnt(0);
        unsigned nloc = b.st[0], nx = b.st[1];
        if (nloc == 0u) { xcd_barrier_complete(bar, b.x, nloc, nx); b.st[0] = nloc; b.st[1] = nx; }
        const unsigned old = xb_add(&bar[XB_XSUB(b.x)], 1u);
        const unsigned gen = old / nloc;
        if (old + 1u == (gen + 1u) * nloc) {
            __builtin_amdgcn_fence(__ATOMIC_RELEASE, "agent");
            asm volatile("s_waitcnt vmcnt(0)" ::: "memory");
            const unsigned og = xb_add(&bar[XB_TOP], 1u);
            const unsigned tg = og / nx;
            if (og + 1u == (tg + 1u) * nx) xb_add(&bar[XB_TOPGEN], 1u);
            else XB_SPIN(xb_ld(&bar[XB_TOPGEN]) == tg, bar);
            __builtin_amdgcn_fence(__ATOMIC_ACQUIRE, "agent");
            xb_add(&bar[XB_XGEN(b.x)], 1u);
            asm volatile("s_waitcnt vmcnt(0)" ::: "memory");
        } else {
            XB_SPIN(xb_ld(&bar[XB_XGEN(b.x)]) == gen, bar);
            __builtin_amdgcn_fence(__ATOMIC_ACQUIRE, "agent");
            asm volatile("s_waitcnt vmcnt(0)" ::: "memory");
        }
    }
    __syncthreads();
}
namespace pg8 {
#define PG8_LAS __attribute__((address_space(3)))
typedef unsigned short bf16_t;
typedef short bf16x8 __attribute__((ext_vector_type(8)));
typedef float f32x4 __attribute__((ext_vector_type(4)));
typedef unsigned u32x4 __attribute__((ext_vector_type(4)));
constexpr int BM = 256, BK = 64, HALF = 128, HTB = HALF * BK * 2  , STAGE_BYTES = 8 * HTB, NXCD = 8, WGM = 8;

__host__ __device__ __forceinline__ int lds_byte(int r, int c) { const int st = (r >> 4) * 2 + (c >> 5), rr = r & 15, cc = c & 31, ob = rr * 64 + cc * 2; return st * 1024 + (ob ^ (((ob >> 9) & 1) << 5)); }
__host__ __device__ __forceinline__ void stage_rc(int b, int& R, int& C) { const int st = b / 1024, sb = b % 1024, swz = sb ^ (((sb >> 9) & 1) << 5); R = (st >> 1) * 16 + swz / 64; C = (st & 1) * 32 + (swz % 64) / 2; }
__host__ __device__ __forceinline__ int perm32(int rho) { const int n = rho >> 4, i = rho & 15; return 8 * (i >> 2) + 4 * n + (i & 3); }

struct Unit { int pm, pn; };
struct Gemm { const bf16_t* A; const bf16_t* Bt; int M, N, K; };

struct StaticOrder {
    int nM, nN, nwg, G, c;
    __host__ __device__ void init(int M, int N, int G_, int c_) { nM = M / BM; nN = N / BM; nwg = nM * nN; G = G_; c = c_; }
    __host__ __device__ bool next(int i, Unit& u) const {
        const long L = (long)i * G + c; if (L >= nwg) return false;
        int wgid = (int)L; { const int q = nwg / NXCD, r = nwg % NXCD, xcd = wgid % NXCD, off = wgid / NXCD; wgid = (xcd < r ? xcd * (q + 1) : r * (q + 1) + (xcd - r) * q) + off; }
        const int nig = WGM * nN, gid = wgid / nig, fm = gid * WGM, gsz = (nM - fm) < WGM ? (nM - fm) : WGM;
        u.pm = fm + ((wgid % nig) % gsz); u.pn = (wgid % nig) / gsz; return true;
    }
    __device__ __forceinline__ void a_ready(const Unit&) const {}
    __device__ __forceinline__ void done(const Unit&) const {}
};

__device__ __forceinline__ unsigned cvt_pk_bf16(float lo, float hi) { unsigned r; asm volatile("v_cvt_pk_bf16_f32 %0, %1, %2" : "=v"(r) : "v"(lo), "v"(hi)); return r; }
typedef float f32x2 __attribute__((ext_vector_type(2)));
__device__ __forceinline__ f32x2 gelu_pk(f32x2 v) {
    const f32x2 av = __builtin_elementwise_abs(v), d = av * 0.2316418882f + 1.0f;
    f32x2 t; t.x = __builtin_amdgcn_rcpf(d.x); t.y = __builtin_amdgcn_rcpf(d.y);
    f32x2 q = t * 0.5307027145f + (-0.7265760135f); q = q * t + 0.7107068705f; q = q * t + (-0.142248368f); q = q * t + 0.127414796f; q = q * t;
    const f32x2 s = (v * v) * (-0.72134752044f);
    f32x2 e; e.x = __builtin_amdgcn_exp2f(s.x); e.y = __builtin_amdgcn_exp2f(s.y);
    const f32x2 m = v * (q * e), r = v - m;
    f32x2 o; o.x = v.x < 0.f ? m.x : r.x; o.y = v.y < 0.f ? m.y : r.y; return o;
}

template <int ACT  > struct EpiBf16 {
    static constexpr bool PERM = true, AFTER_DRAIN = false; static_assert(ACT == 0 || ACT == 1, "EpiBf16: ACT is 0 (none) or 1 (gelu_pk)");
    bf16_t* O; int ldc; const float* bias; int split_cols; size_t split_stride; float scale0;
    __device__ __forceinline__ void operator()(const f32x4 (&acc)[2][2][4][2], const Unit& u, int wr, int wc, int fr, int fq) const {
        const int row0 = u.pm * BM + wr * 64 + fr; int colt = u.pn * BM; bf16_t* base = O;
        float sc = 1.f; if (split_cols) { const int t = colt / split_cols; base += (size_t)t * split_stride; colt -= t * split_cols; if (t == 0) sc = scale0; }
        const int col0 = colt + wc * 32 + 8 * fq, bcol0 = u.pn * BM + wc * 32 + 8 * fq;
        f32x4 bv[2][2];
#pragma unroll
        for (int bj = 0; bj < 2; ++bj)
#pragma unroll
            for (int n = 0; n < 2; ++n) bv[bj][n] = bias ? *(const f32x4*)(bias + bcol0 + bj * HALF + 4 * n) : (f32x4){0.f, 0.f, 0.f, 0.f};
#pragma unroll
        for (int ai = 0; ai < 2; ++ai)
#pragma unroll
            for (int m = 0; m < 4; ++m) { bf16_t* rowp = base + (size_t)(row0 + ai * HALF + m * 16) * ldc + col0;
#pragma unroll
                for (int bj = 0; bj < 2; ++bj) { f32x4 v0 = acc[ai][bj][m][0] + bv[bj][0], v1 = acc[ai][bj][m][1] + bv[bj][1];
                    if (ACT == 1) { f32x2 a = gelu_pk((f32x2){v0[0], v0[1]}), b = gelu_pk((f32x2){v0[2], v0[3]}), c = gelu_pk((f32x2){v1[0], v1[1]}), d = gelu_pk((f32x2){v1[2], v1[3]});
                        v0 = (f32x4){a.x, a.y, b.x, b.y}; v1 = (f32x4){c.x, c.y, d.x, d.y}; }
                    v0 = v0 * sc; v1 = v1 * sc; u32x4 w; w.x = cvt_pk_bf16(v0[0], v0[1]); w.y = cvt_pk_bf16(v0[2], v0[3]); w.z = cvt_pk_bf16(v1[0], v1[1]); w.w = cvt_pk_bf16(v1[2], v1[3]);
                    *(u32x4*)(rowp + bj * HALF) = w; } }
    }
};
template <class Epi, class Sched, bool ALIGN_EPI = false, bool SP2 = false>
__device__ __forceinline__ void gemm_phase(PG8_LAS unsigned char* lds, const Gemm g, const Sched& S, const Epi& E, int tid_in) {
    int tid_o = tid_in; asm volatile("" : "+v"(tid_o));
    const int tid = tid_o, wid = __builtin_amdgcn_readfirstlane(tid >> 6), lane = tid & 63, wr = wid >> 2, wc = wid & 3, fr = lane & 15, fq = lane >> 4;
    const int K = g.K, nt = K / BK;
    unsigned voffA[2], voffB[2];
#pragma unroll
    for (int i = 0; i < 2; ++i) { int R, C; stage_rc(tid * 16 + i * 8192, R, C); const int Rb = Epi::PERM ? ((R & ~31) + perm32(R & 31)) : R;
        voffA[i] = (unsigned)(R * K + C) * 2u; voffB[i] = (unsigned)(Rb * K + C) * 2u; }
    const size_t kstep = (size_t)(BK * 2);
    const size_t hstep = (size_t)HALF * K * 2;
    const size_t tstep = 2 * hstep;
    const unsigned ldsw = (unsigned)wid * 1024u;
    const int aoff = lds_byte(wr * 64 + fr, fq * 8), boff = lds_byte(wc * 32 + fr, fq * 8);
#define PG8_SA(b, h) (((b) * 2 + (h)) * HTB)
#define PG8_SB(b, h) ((4 + (b) * 2 + (h)) * HTB)
#define PG8_STAGE(bufoff, gbase, voff) do { _Pragma("unroll") for (int _i = 0; _i < 2; ++_i) \
        __builtin_amdgcn_global_load_lds((const unsigned*)((const char*)(gbase) + (voff)[_i]), (PG8_LAS unsigned*)(lds + (bufoff) + ldsw + _i * 8192), 16, 0, 0); } while (0)
#define PG8_LDA(dst, b, h) do { _Pragma("unroll") for (int m = 0; m < 4; ++m) _Pragma("unroll") for (int k = 0; k < 2; ++k) dst[m][k] = *(const PG8_LAS bf16x8*)(lds + PG8_SA(b, h) + aoff + m * 2048 + k * 1024); } while (0)
#define PG8_LDB(dst, b, h) do { _Pragma("unroll") for (int n = 0; n < 2; ++n) _Pragma("unroll") for (int k = 0; k < 2; ++k) dst[n][k] = *(const PG8_LAS bf16x8*)(lds + PG8_SB(b, h) + boff + n * 2048 + k * 1024); } while (0)
#define PG8_MMA(ai, bj, At, Bt) do { __builtin_amdgcn_s_setprio(1); _Pragma("unroll") for (int m = 0; m < 4; ++m) _Pragma("unroll") for (int n = 0; n < 2; ++n) _Pragma("unroll") for (int k = 0; k < 2; ++k) \
        acc[ai][bj][m][n] = __builtin_amdgcn_mfma_f32_16x16x32_bf16(Bt[n][k], At[m][k], acc[ai][bj][m][n], 0, 0, 0); __builtin_amdgcn_s_setprio(0); } while (0)
#define PG8_WAIT_V(n) asm volatile("s_waitcnt vmcnt(" #n ")" ::: "memory")
#define PG8_WAIT_L(n) asm volatile("s_waitcnt lgkmcnt(" #n ")" ::: "memory")
#define PG8_BAR __builtin_amdgcn_s_barrier()
#define PG8_SCHED __builtin_amdgcn_sched_barrier(0)
    Unit cur, nxt; int ui = 0;
    if (!S.next(0, cur)) return;
    f32x4 acc[2][2][4][2];
#pragma unroll
    for (int a = 0; a < 2; ++a)
#pragma unroll
        for (int b = 0; b < 2; ++b)
#pragma unroll
            for (int m = 0; m < 4; ++m)
#pragma unroll
                for (int n = 0; n < 2; ++n) acc[a][b][m][n] = (f32x4){0.f, 0.f, 0.f, 0.f};
    bf16x8 At[4][2], B0[2][2], B1[2][2];
    const char* cA = (const char*)g.A + (size_t)cur.pm * tstep; const char* cB = (const char*)g.Bt + (size_t)cur.pn * tstep;
    S.a_ready(cur);
    if constexpr (SP2) {
        PG8_STAGE(PG8_SB(0, 0), cB, voffB); PG8_STAGE(PG8_SB(0, 1), cB + hstep, voffB); PG8_STAGE(PG8_SA(0, 0), cA, voffA); PG8_STAGE(PG8_SA(0, 1), cA + hstep, voffA);
        if (wr == 1) PG8_BAR;
        PG8_WAIT_V(2); PG8_BAR;
        PG8_STAGE(PG8_SB(1, 0), cB + kstep, voffB); PG8_STAGE(PG8_SA(1, 0), cA + kstep, voffA); PG8_STAGE(PG8_SB(1, 1), cB + hstep + kstep, voffB);
        PG8_WAIT_V(6); PG8_BAR;
    } else {
        PG8_STAGE(PG8_SB(0, 0), cB, voffB); PG8_STAGE(PG8_SA(0, 0), cA, voffA); PG8_STAGE(PG8_SB(0, 1), cB + hstep, voffB); PG8_STAGE(PG8_SA(0, 1), cA + hstep, voffA);
        if (wr == 1) PG8_BAR;
        PG8_WAIT_V(4); PG8_BAR;
        PG8_STAGE(PG8_SB(1, 0), cB + kstep, voffB); PG8_STAGE(PG8_SA(1, 0), cA + kstep, voffA); PG8_STAGE(PG8_SB(1, 1), cB + hstep + kstep, voffB);
        PG8_WAIT_V(6); PG8_BAR;
    }
    for (;;) {
        const bool has_next = S.next(ui + 1, nxt);
        const char* nA = has_next ? (const char*)g.A + (size_t)nxt.pm * tstep : cA; const char* nB = has_next ? (const char*)g.Bt + (size_t)nxt.pn * tstep : cB;
        for (int t = 0; t < nt; t += 2) {
            const bool last = (t == nt - 2);
            const char* a1 = cA + (size_t)(t + 1) * kstep;
            const char* a2 = last ? nA : cA + (size_t)(t + 2) * kstep; const char* b2 = last ? nB : cB + (size_t)(t + 2) * kstep;
            const char* a3 = a2 + kstep; const char* b3 = b2 + kstep;
            if (last && has_next) S.a_ready(nxt);
            if constexpr (SP2) {
            PG8_LDB(B0, 0, 0); PG8_LDB(B1, 0, 1); PG8_SCHED; PG8_LDA(At, 0, 0); PG8_STAGE(PG8_SA(1, 1), a1 + hstep, voffA);
            PG8_WAIT_V(8); PG8_WAIT_L(0); PG8_BAR; PG8_MMA(0, 0, At, B0); PG8_MMA(0, 1, At, B1); PG8_BAR; PG8_SCHED;
            PG8_LDA(At, 0, 1); PG8_STAGE(PG8_SB(0, 0), b2, voffB); PG8_STAGE(PG8_SB(0, 1), b2 + hstep, voffB); PG8_STAGE(PG8_SA(0, 0), a2, voffA);
            PG8_WAIT_V(8); PG8_WAIT_L(0); PG8_BAR; PG8_MMA(1, 0, At, B0); PG8_MMA(1, 1, At, B1); PG8_BAR; PG8_SCHED;
            PG8_LDB(B0, 1, 0); PG8_LDB(B1, 1, 1); PG8_SCHED; PG8_LDA(At, 1, 0); PG8_STAGE(PG8_SA(0, 1), a2 + hstep, voffA);
            PG8_WAIT_V(8); PG8_WAIT_L(0); PG8_BAR; PG8_MMA(0, 0, At, B0); PG8_MMA(0, 1, At, B1); PG8_BAR; PG8_SCHED;
            PG8_LDA(At, 1, 1); PG8_STAGE(PG8_SB(1, 0), b3, voffB); PG8_STAGE(PG8_SB(1, 1), b3 + hstep, voffB); PG8_STAGE(PG8_SA(1, 0), a3, voffA);
            PG8_WAIT_V(8); PG8_WAIT_L(0); PG8_BAR; PG8_MMA(1, 0, At, B0); PG8_MMA(1, 1, At, B1); PG8_BAR; PG8_SCHED;
            } else {
            PG8_LDB(B0, 0, 0); PG8_SCHED; PG8_LDA(At, 0, 0); PG8_STAGE(PG8_SA(1, 1), a1 + hstep, voffA);
            PG8_WAIT_L(8); PG8_BAR; PG8_WAIT_L(0); PG8_MMA(0, 0, At, B0); PG8_BAR; PG8_SCHED;
            PG8_LDB(B1, 0, 1); PG8_STAGE(PG8_SB(0, 0), b2, voffB);
            PG8_BAR; PG8_WAIT_L(0); PG8_MMA(0, 1, At, B1); PG8_BAR;
            PG8_LDA(At, 0, 1); PG8_STAGE(PG8_SA(0, 0), a2, voffA);
            PG8_BAR; PG8_WAIT_L(0); PG8_MMA(1, 0, At, B0); PG8_BAR; PG8_SCHED;
            PG8_STAGE(PG8_SB(0, 1), b2 + hstep, voffB);
            PG8_WAIT_V(6); PG8_BAR; PG8_MMA(1, 1, At, B1); PG8_BAR;
            PG8_LDB(B0, 1, 0); PG8_SCHED; PG8_LDA(At, 1, 0); PG8_STAGE(PG8_SA(0, 1), a2 + hstep, voffA);
            PG8_WAIT_L(8); PG8_BAR; PG8_WAIT_L(0); PG8_MMA(0, 0, At, B0); PG8_BAR; PG8_SCHED;
            PG8_LDB(B1, 1, 1); PG8_STAGE(PG8_SB(1, 0), b3, voffB);
            PG8_BAR; PG8_WAIT_L(0); PG8_MMA(0, 1, At, B1); PG8_BAR;
            PG8_LDA(At, 1, 1); PG8_STAGE(PG8_SA(1, 0), a3, voffA);
            PG8_BAR; PG8_WAIT_L(0); PG8_MMA(1, 0, At, B0); PG8_BAR; PG8_SCHED;
            PG8_STAGE(PG8_SB(1, 1), b3 + hstep, voffB);
            PG8_WAIT_V(6); PG8_BAR; PG8_MMA(1, 1, At, B1); PG8_BAR;
            }
        }
        if constexpr (ALIGN_EPI) { if (wr == 0) PG8_BAR; }
        if constexpr (!Epi::AFTER_DRAIN) { E(acc, cur, wr, wc, fr, fq); S.done(cur); }
        if (!has_next) break;
#pragma unroll
        for (int a = 0; a < 2; ++a)
#pragma unroll
            for (int b = 0; b < 2; ++b)
#pragma unroll
                for (int m = 0; m < 4; ++m)
#pragma unroll
                    for (int n = 0; n < 2; ++n) acc[a][b][m][n] = (f32x4){0.f, 0.f, 0.f, 0.f};
        cur = nxt; cA = nA; cB = nB; ++ui;
        if constexpr (ALIGN_EPI) { if (wr == 1) PG8_BAR; }
    }
    PG8_WAIT_V(0);
    if constexpr (!ALIGN_EPI) { if (wr == 0) PG8_BAR; }
    PG8_BAR;
    if constexpr (Epi::AFTER_DRAIN) { E.fused(acc, cur, wr, wc, fr, fq, lds, wid, lane); S.done(cur); }
#undef PG8_SA
#undef PG8_SB
#undef PG8_STAGE
#undef PG8_LDA
#undef PG8_LDB
#undef PG8_MMA
#undef PG8_WAIT_V
#undef PG8_WAIT_L
#undef PG8_BAR
#undef PG8_SCHED
}
}
namespace hy {
namespace cg = cooperative_groups;
typedef unsigned short bf16_t;
typedef unsigned u32x4 __attribute__((ext_vector_type(4)));
typedef unsigned u32x2 __attribute__((ext_vector_type(2)));
typedef float f32x4 __attribute__((ext_vector_type(4)));
constexpr int M = 16384, S = 8192, D = 1024, NL = 4;
constexpr int IN_COLS = 1824, P1W = 2048, P2W = 1536;
constexpr float EPS = 1e-6f, LOG2E = 1.4426950408889634f;
constexpr int MODW = 6 * D;
constexpr int NT = 512;
constexpr int LDS_BYTES = 147456;

__device__ __forceinline__ float bf2f(bf16_t v) { return __uint_as_float(((unsigned)v) << 16); }
__device__ __forceinline__ bf16_t f2bf(float f) { unsigned u = __float_as_uint(f); return (bf16_t)((u + 0x7fffu + ((u >> 16) & 1u)) >> 16); }
__device__ __forceinline__ unsigned pk2(float lo, float hi) { return (unsigned)f2bf(lo) | ((unsigned)f2bf(hi) << 16); }
__device__ __forceinline__ float lo16(unsigned w) { return __uint_as_float(w << 16); }
__device__ __forceinline__ float hi16(unsigned w) { return __uint_as_float(w & 0xffff0000u); }
__device__ __forceinline__ float wave_sum(float v) {
#pragma unroll
    for (int o = 1; o < 64; o <<= 1) v += __shfl_xor(v, o);
    return v;
}
__device__ __forceinline__ float gelu_tanh(float x) {
    const float k0 = 0.7978845608028654f, k1 = 0.044715f;
    float t = k0 * (x + k1 * x * x * x);
    float e = __expf(2.f * t);
    float th = 1.f - 2.f / (e + 1.f);
    return 0.5f * x * (1.f + th);
}

constexpr size_t MiB = 1ull << 20;
constexpr size_t WS_CTL = 0;
constexpr size_t WS_MOD = 1 * MiB;
constexpr size_t WS_BIAS = WS_MOD + 256 * 1024;
constexpr size_t WS_ROPE = 2 * MiB;
constexpr size_t WS_SQ = 3 * MiB;
constexpr size_t WS_WIN = 4 * MiB;
constexpr size_t WS_W2 = WS_WIN + 16 * MiB;
constexpr size_t WS_WOUT = WS_W2 + 6 * MiB;
constexpr size_t WS_WQ = WS_WOUT + 8 * MiB;
constexpr size_t WS_WGLU = WS_WQ + 16 * MiB;
constexpr size_t WS_SUBK = WS_WGLU + 1 * MiB;
constexpr size_t WS_PU = 64 * MiB;
constexpr size_t WS_PV = WS_PU + 64 * MiB;
constexpr size_t WS_PSU = WS_PV + 64 * MiB;
constexpr size_t WS_ACT = 320 * MiB;
constexpr size_t WS_H = WS_ACT;
constexpr size_t WS_P1 = WS_H + 32 * MiB;
constexpr size_t WS_QA = WS_P1 + 64 * MiB;
constexpr size_t WS_KA = WS_QA + 12 * MiB;
constexpr size_t WS_VA = WS_KA + 12 * MiB;
constexpr size_t WS_U = WS_VA + 12 * MiB;
constexpr size_t WS_CQKV = WS_U + 8 * MiB;
constexpr size_t WS_P2 = WS_CQKV + 12 * MiB;
constexpr size_t WS_QM = WS_P2 + 48 * MiB;
constexpr size_t WS_KM = WS_QM + 18 * MiB;
constexpr size_t WS_VM = WS_KM + 18 * MiB;
constexpr size_t WS_YA = WS_VM + 12 * MiB;
constexpr size_t WS_YC = WS_YA + 12 * MiB;
constexpr size_t WS_GS = WS_YC + 12 * MiB;
constexpr size_t WS_GL = WS_GS + 8 * MiB;
constexpr size_t WS_AOUT = WS_GL + 8 * MiB;
constexpr size_t WS_QP = WS_AOUT + 32 * MiB;
constexpr size_t WS_EIDX = WS_QP + 64 * MiB;
constexpr size_t WS_GATE = WS_EIDX + 8 * MiB;
constexpr size_t WS_TOPS = WS_GATE + 8 * MiB;
constexpr size_t WS_XB = WS_TOPS;
constexpr size_t WS_TOPI = WS_TOPS + 16 * MiB;
constexpr size_t WS_XST = WS_TOPI + 16 * MiB;
constexpr size_t WS_YAB = WS_XST + 128 * MiB;
constexpr size_t WS_MLB = WS_YAB + 36 * MiB;
constexpr size_t WS_LP = WS_MLB + 4 * MiB;
constexpr size_t WS_KMT = WS_LP + 4 * MiB;
constexpr size_t WS_WE = WS_KMT + 2 * MiB;
constexpr size_t WS_WC = WS_WE + 16 * MiB;
constexpr size_t WS_E = WS_WC + 16 * MiB;
constexpr size_t WS_SSQ = WS_E + 2 * MiB;
constexpr size_t WS_SSX = WS_SSQ + 1 * MiB;
constexpr size_t WS_CV = WS_SSX + 1 * MiB;
constexpr size_t WS_BB = WS_CV + 1 * MiB;
constexpr size_t WS_END = WS_BB + 1 * MiB;

struct In {
    const float *x, *c, *w_in, *w_out, *mix_gain, *norm1_gain, *norm2_gain, *w_ada, *b_ada, *rel_bias, *swa_q_gain, *swa_k_gain,
        *mla_q_lora_gain, *mla_kv_lora_gain, *w_uq, *w_ukv, *mla_q_gain, *mla_k_gain, *s5_a_re, *s5_a_im, *s5_b_re, *s5_b_im, *s5_c_re,
        *s5_c_im, *s5_d, *s5_log_dt, *w_glu, *b_glu, *peer_wq, *peer_subkeys, *peer_u, *peer_v;
};
struct Params { In in; float* out; unsigned char* ws; };

struct Ctx { int tid, lane, wave, bid, nblk; unsigned char* lds; };

__device__ __forceinline__ void gemv2_job(const Ctx& C, const float* a0, const float* a1, bool silu, const float* W, int ldw, int n0, const float* bias, float* out0, float* out1) {
    float* av = (float*)C.lds;
    float* red = av + 2 * D;
    for (int i = C.tid; i < D; i += NT) { float v0 = a0[i], v1 = a1[i]; if (silu) { v0 = v0 / (1.f + __expf(-v0)); v1 = v1 / (1.f + __expf(-v1)); } av[i] = v0; av[D + i] = v1; }
    __syncthreads();
    const int nq = C.tid & 7, ks = C.tid >> 3;
    const float* w = W + (size_t)(ks * 16) * ldw + n0 + nq * 4;
    f32x4 wv[16];
#pragma unroll
    for (int k = 0; k < 16; ++k) wv[k] = *(const f32x4*)(w + (size_t)k * ldw);
    f32x4 s0 = {0.f, 0.f, 0.f, 0.f}, s1 = {0.f, 0.f, 0.f, 0.f};
#pragma unroll
    for (int k = 0; k < 16; ++k) { s0 += av[ks * 16 + k] * wv[k]; s1 += av[D + ks * 16 + k] * wv[k]; }
#pragma unroll
    for (int j = 0; j < 4; ++j) { red[(ks * 32 + nq * 4 + j) * 2] = s0[j]; red[(ks * 32 + nq * 4 + j) * 2 + 1] = s1[j]; }
    __syncthreads();
    if (C.tid < 64) {
        const int b = C.tid >> 5, nn = C.tid & 31; float t = 0.f;
#pragma unroll 16
        for (int q = 0; q < 64; ++q) t += red[(q * 32 + nn) * 2 + b];
        if (bias) t += bias[n0 + nn];
        (b ? out1 : out0)[n0 + nn] = t;
    }
    __syncthreads();
}
__device__ __forceinline__ void ph_mod(const Ctx& C, const float* c, const float* w_ada, const float* b_ada, float* mod) {
    for (int job = C.bid; job < NL * (MODW / 32); job += C.nblk) {
        const int l = job / (MODW / 32), n0 = (job % (MODW / 32)) * 32;
        gemv2_job(C, c, c + D, true, w_ada + (size_t)l * D * MODW, MODW, n0, b_ada + l * MODW, mod + (size_t)(l * 2) * MODW, mod + (size_t)(l * 2 + 1) * MODW);
    }
}
__device__ __forceinline__ void ph_cvec(const Ctx& C, const float* wq, const float* mod, float* cv) {
    for (int job = C.bid; job < NL * 64; job += C.nblk) {
        const int l = job >> 6, n0 = (job & 63) * 32;
        gemv2_job(C, mod + (size_t)(l * 2) * MODW + 3 * D, mod + (size_t)(l * 2 + 1) * MODW + 3 * D, false, wq + (size_t)l * D * 2048, 2048, n0, nullptr, cv + (l * 2) * 2048, cv + (l * 2 + 1) * 2048);
    }
}
__device__ __forceinline__ int t5_bucket(int dist) {
    if (dist < 16) return dist;
    float df = (float)dist;
    float v = logf(df / 16.f) / 4.852030263919617f * 16.f;
    int large = 16 + (int)v;
    return large < 31 ? large : 31;
}
__device__ __forceinline__ void ph_bounds(const Ctx& C, const In& in, float* bnd) {
    if (C.bid == 0 && C.tid < NL) {
        const int l = C.tid;
        float sq = 0.f, sk = 0.f, aq = 0.f, ak = 0.f, bm = 0.f;
        for (int d = 0; d < 96; ++d) { const float gq = in.mla_q_gain[l * 96 + d], gk = in.mla_k_gain[l * 96 + d]; sq += gq * gq; sk += gk * gk; }
        for (int d = 0; d < 64; ++d) { const float gq = in.swa_q_gain[l * 64 + d], gk = in.swa_k_gain[l * 64 + d]; aq += gq * gq; ak += gk * gk; }
        for (int i = 0; i < 6 * 32; ++i) bm = fmaxf(bm, fabsf(in.rel_bias[i]));
        bnd[l * 2 + 0] = 0.10206207261596575f * LOG2E * sqrtf(sq) * sqrtf(sk) * 1.01f;
        bnd[l * 2 + 1] = (0.125f * sqrtf(aq) * sqrtf(ak) * 1.01f + bm) * LOG2E;
    }
}
__device__ __forceinline__ void ph_tables(const Ctx& C, const float* rel_bias, float* bias, float* rope) {
    for (int gid = C.bid * NT + C.tid; gid < S * 16; gid += C.nblk * NT) {
        if (gid < 3 * 6 * 132) {
            const int br = gid / (6 * 132), h = (gid / 132) % 6, j = gid % 132;
            const int dil = br == 0 ? 1 : (br == 1 ? 4 : 16);
            float v = 0.f;
            if (j <= 128) v = rel_bias[h * 32 + t5_bucket(dil * j)] * LOG2E;
            bias[gid] = v;
        }
        const int pos = gid / 16, i = gid % 16;
        const float inv = (float)pow(10000.0, -(double)(2 * i) / 32.0);
        const float ang = (float)pos * inv;
        rope[gid] = (float)cos((double)ang);
        rope[S * 16 + gid] = (float)sin((double)ang);
    }
}

struct TC { const float* src; size_t src_lstride; int ld_src; int K_src; bf16_t* dst; size_t dst_lstride; int ld_dst; int k_off; int n_rows; int n_valid; int mode; const float* kscale; int kscale_lstride; };
__device__ __forceinline__ TC get_tc(int which, const Params& P) {
    TC t; t.kscale = nullptr; t.kscale_lstride = 0; t.k_off = 0; t.mode = 0;
    unsigned char* ws = P.ws;
    switch (which) {
    case 0: t.src = P.in.w_in; t.src_lstride = (size_t)D * IN_COLS; t.ld_src = IN_COLS; t.K_src = D; t.dst = (bf16_t*)(ws + WS_WIN); t.dst_lstride = (size_t)P1W * D; t.ld_dst = D; t.n_rows = P1W; t.n_valid = IN_COLS; t.mode = 2; break;
    case 1: t.src = P.in.w_uq; t.src_lstride = 256 * 576; t.ld_src = 576; t.K_src = 256; t.dst = (bf16_t*)(ws + WS_W2); t.dst_lstride = (size_t)P2W * 384; t.ld_dst = 384; t.n_rows = 768; t.n_valid = 768; t.mode = 1; t.kscale = P.in.mla_q_lora_gain; t.kscale_lstride = 256; break;
    case 2: t.src = P.in.w_ukv; t.src_lstride = 128 * 768; t.ld_src = 768; t.K_src = 128; t.dst = (bf16_t*)(ws + WS_W2); t.dst_lstride = (size_t)P2W * 384; t.ld_dst = 384; t.k_off = 256; t.n_rows = 768; t.n_valid = 768; t.mode = 3; t.kscale = P.in.mla_kv_lora_gain; t.kscale_lstride = 128; break;
    case 3: t.src = P.in.w_out; t.src_lstride = (size_t)D * D; t.ld_src = D; t.K_src = D; t.dst = (bf16_t*)(ws + WS_WOUT); t.dst_lstride = (size_t)D * D; t.ld_dst = D; t.n_rows = D; t.n_valid = D; t.kscale = P.in.mix_gain; t.kscale_lstride = D; break;
    case 4: t.src = P.in.peer_wq; t.src_lstride = (size_t)D * 2048; t.ld_src = 2048; t.K_src = D; t.dst = (bf16_t*)(ws + WS_WQ); t.dst_lstride = (size_t)2048 * D; t.ld_dst = D; t.n_rows = 2048; t.n_valid = 2048; break;
    default: t.src = P.in.w_glu; t.src_lstride = 256 * 256; t.ld_src = 256; t.K_src = 256; t.dst = (bf16_t*)(ws + WS_WGLU); t.dst_lstride = 256 * 256; t.ld_dst = 256; t.n_rows = 256; t.n_valid = 256; break;
    }
    return t;
}
__device__ __forceinline__ void ph_tconv(const Ctx& C, const Params& P) {
    const int stid = C.tid & 255, sub = C.tid >> 8;
    constexpr int TQ = 4;
    float* tl0 = (float*)C.lds + sub * (TQ * 64 * 65);
    constexpr int C0 = 32 * 16, C1 = 12 * 4, C2 = 12 * 2, C3 = 16 * 16, C4 = 32 * 16, C5 = 4 * 4;
    constexpr int total = (C0 + C1 + C2 + C3 + C4 + C5) * NL;
    for (int j0 = C.bid * 2 * TQ; j0 < total; j0 += C.nblk * 2 * TQ) {
        bf16_t* oaddr[TQ]; bool val[TQ];
#pragma unroll
        for (int q = 0; q < TQ; ++q) {
            float* tl = tl0 + q * (64 * 65);
            const int job = j0 + sub * TQ + q; const bool valid = job < total; val[q] = valid;
            int which = 0, r = valid ? job : 0, per = C0;
            if (r >= C0 * NL) { r -= C0 * NL; which = 1; per = C1;
                if (r >= C1 * NL) { r -= C1 * NL; which = 2; per = C2;
                    if (r >= C2 * NL) { r -= C2 * NL; which = 3; per = C3;
                        if (r >= C3 * NL) { r -= C3 * NL; which = 4; per = C4;
                            if (r >= C4 * NL) { r -= C4 * NL; which = 5; per = C5; } } } } }
            const TC p = get_tc(which, P);
            const int l = r / per, rr = r % per, ntn = p.n_rows / 64, k0 = (rr / ntn) * 64;
            int n0 = (rr % ntn) * 64;
            if (which == 1 || which == 2) { const int rt = rr % ntn; n0 = (rt >> 1) * 256 + (rt & 1) * 128 + (which == 2 ? 64 : 0); }
            const float* src = p.src + (size_t)l * p.src_lstride;
            const int nq = stid & 15, n = n0 + nq * 4;
            int col;
            if (p.mode == 0) col = n < p.n_valid ? n : -1;
            else if (p.mode == 1) { const int hh = n >> 8, wc = (n >> 5) & 3, d = 32 * ((n >> 7) & 1) + (n & 31); col = wc == 0 ? hh * 96 + d : (d < 32 ? hh * 96 + 64 + d : -1); }
            else if (p.mode == 3) { const int hh = n >> 8, wc = (n >> 5) & 3, d = 32 * ((n >> 7) & 1) + (n & 31); col = hh * 128 + (wc - 2) * 64 + d; }
            else {
                const int t = n >> 8, bj = (n >> 7) & 1, wc = (n >> 5) & 3, d = 32 * bj + (n & 31), uu = 4 * t + wc;
                if (uu < 18) col = 64 * uu + d;
                else if (uu < 20) col = 1664 + 64 * (uu - 18) + d;
                else if (uu < 24) col = 1408 + 64 * (uu - 20) + d;
                else if (uu < 28) col = 1152 + 64 * (uu - 24) + d;
                else if (uu == 28 && d < 32) col = 1792 + d;
                else col = -1;
            }
            oaddr[q] = p.dst + (size_t)l * p.dst_lstride + (size_t)(n0 + (stid >> 2)) * p.ld_dst + p.k_off + k0 + (stid & 3) * 16;
            if (valid) {
#pragma unroll
                for (int i = 0; i < 4; ++i) {
                    const int kk = i * 16 + (stid >> 4), k = k0 + kk;
                    f32x4 v = {0.f, 0.f, 0.f, 0.f};
                    if (col >= 0) v = *(const f32x4*)(src + (size_t)k * p.ld_src + col);
                    if (p.kscale) v *= p.kscale[l * p.kscale_lstride + k];
                    tl[kk * 65 + nq * 4] = v[0]; tl[kk * 65 + nq * 4 + 1] = v[1]; tl[kk * 65 + nq * 4 + 2] = v[2]; tl[kk * 65 + nq * 4 + 3] = v[3];
                }
            }
        }
        __syncthreads();
#pragma unroll
        for (int q = 0; q < TQ; ++q) {
            if (val[q]) {
                const float* tl = tl0 + q * (64 * 65);
                const int nl = stid >> 2, kc = (stid & 3) * 16;
                u32x4 o0, o1;
                o0.x = pk2(tl[(kc + 0) * 65 + nl], tl[(kc + 1) * 65 + nl]); o0.y = pk2(tl[(kc + 2) * 65 + nl], tl[(kc + 3) * 65 + nl]); o0.z = pk2(tl[(kc + 4) * 65 + nl], tl[(kc + 5) * 65 + nl]); o0.w = pk2(tl[(kc + 6) * 65 + nl], tl[(kc + 7) * 65 + nl]);
                o1.x = pk2(tl[(kc + 8) * 65 + nl], tl[(kc + 9) * 65 + nl]); o1.y = pk2(tl[(kc + 10) * 65 + nl], tl[(kc + 11) * 65 + nl]); o1.z = pk2(tl[(kc + 12) * 65 + nl], tl[(kc + 13) * 65 + nl]); o1.w = pk2(tl[(kc + 14) * 65 + nl], tl[(kc + 15) * 65 + nl]);
                *(u32x4*)oaddr[q] = o0; *(u32x4*)(oaddr[q] + 8) = o1;
            }
        }
        __syncthreads();
    }
}
__device__ __forceinline__ void ph_w2zero(const Ctx& C, bf16_t* W2) {
    const u32x4 z = {0u, 0u, 0u, 0u};
    for (int i = C.bid * NT + C.tid; i < NL * P2W * 32; i += C.nblk * NT) {
        const int ch = i & 31, row = (i >> 5) % P2W, l = (i >> 5) / P2W;
        const bool qrow = ((row >> 6) & 1) == 0;
        if (qrow) { if (ch < 16) *(u32x4*)(W2 + ((size_t)l * P2W + row) * 384 + 256 + ch * 8) = z; }
        else *(u32x4*)(W2 + ((size_t)l * P2W + row) * 384 + ch * 8) = z;
    }
}
__device__ __forceinline__ void ph_cvt(const Ctx& C, const float* src, bf16_t* dst, size_t n8) {
    for (size_t i = (size_t)C.bid * NT + C.tid; i < n8; i += (size_t)C.nblk * NT) {
        const f32x4 a = *(const f32x4*)(src + i * 8), b = *(const f32x4*)(src + i * 8 + 4);
        u32x4 o; o.x = pk2(a[0], a[1]); o.y = pk2(a[2], a[3]); o.z = pk2(b[0], b[1]); o.w = pk2(b[2], b[3]);
        *(u32x4*)(dst + i * 8) = o;
    }
}

__device__ __forceinline__ void ph_normmod(const Ctx& C, const float* x, const float* gain, const float* modl, int sh_off, int sc_off, bf16_t* H, float* zero) {
    const int lane = C.lane;
    for (int m = C.bid * 8 + C.wave; m < M; m += C.nblk * 8) {
        const int b = m >> 13;
        const float* xr = x + (size_t)m * D;
        f32x4 v[4]; float ss = 0.f;
#pragma unroll
        for (int j = 0; j < 4; ++j) { v[j] = *(const f32x4*)(xr + j * 256 + lane * 4); ss += v[j][0] * v[j][0] + v[j][1] * v[j][1] + v[j][2] * v[j][2] + v[j][3] * v[j][3]; }
        const float r = rsqrtf(wave_sum(ss) * (1.f / D) + EPS);
        const float* sh = modl + b * MODW + sh_off; const float* sc = modl + b * MODW + sc_off;
#pragma unroll
        for (int j = 0; j < 4; ++j) {
            const int c0 = j * 256 + lane * 4;
            const f32x4 g = *(const f32x4*)(gain + c0), s1 = *(const f32x4*)(sc + c0), s0 = *(const f32x4*)(sh + c0);
            float o[4];
#pragma unroll
            for (int e = 0; e < 4; ++e) o[e] = v[j][e] * r * g[e] * (1.f + s1[e]) + s0[e];
            u32x2 w; w.x = pk2(o[0], o[1]); w.y = pk2(o[2], o[3]);
            *(u32x2*)(H + (size_t)m * D + c0) = w;
        }
    }
}

struct Post1 { const bf16_t* raw; const float* gq; const float* gk; const float* kgain; const float* rope; bf16_t *QA, *KA, *VA, *U, *CQKV, *KM; float* SQ; };
__device__ __forceinline__ void ph_post1(const Ctx& C, const Post1& p) {
    const int lane = C.lane;
    const float gq = p.gq[lane], gk = p.gk[lane];
    for (int m = C.bid * 8 + C.wave; m < M; m += C.nblk * 8) {
        const int pos = m & (S - 1);
        const bf16_t* r = p.raw + (size_t)m * P1W;
#pragma unroll
        for (int hh = 0; hh < 6; ++hh) {
            float v = bf2f(r[hh * 64 + lane]);
            float rr = rsqrtf(wave_sum(v * v) * (1.f / 64.f) + EPS);
            p.QA[(size_t)m * 384 + hh * 64 + lane] = f2bf(v * rr * gq * (0.125f * LOG2E));
            v = bf2f(r[384 + hh * 64 + lane]);
            rr = rsqrtf(wave_sum(v * v) * (1.f / 64.f) + EPS);
            p.KA[(size_t)m * 384 + hh * 64 + lane] = f2bf(v * rr * gk);
            p.VA[(size_t)m * 384 + hh * 64 + lane] = r[768 + hh * 64 + lane];
        }
        float ss = 0.f;
#pragma unroll
        for (int j = 0; j < 4; ++j) {
            p.U[(size_t)m * 256 + j * 64 + lane] = r[1152 + j * 64 + lane];
            const bf16_t w = r[1408 + j * 64 + lane]; const float v = bf2f(w); ss += v * v;
            p.CQKV[(size_t)m * 384 + j * 64 + lane] = w;
        }
        const float sq = rsqrtf(wave_sum(ss) * (1.f / 256.f) + EPS);
        ss = 0.f;
#pragma unroll
        for (int j = 0; j < 2; ++j) {
            const bf16_t w = r[1664 + j * 64 + lane]; const float v = bf2f(w); ss += v * v;
            p.CQKV[(size_t)m * 384 + 256 + j * 64 + lane] = w;
        }
        const float skv = rsqrtf(wave_sum(ss) * (1.f / 128.f) + EPS);
        if (lane == 0) { p.SQ[m] = sq; p.SQ[M + m] = skv; }
        {
            const int l31 = lane & 31;
            float v = lane < 32 ? bf2f(r[1792 + l31]) : 0.f;
            const float rr = rsqrtf(wave_sum(v * v) * (1.f / 32.f) + EPS);
            const float n = v * rr * p.kgain[64 + l31];
            const float pr = __shfl_xor(n, 16);
            const int i = lane & 15;
            const float cs = p.rope[pos * 16 + i], sn = p.rope[S * 16 + pos * 16 + i];
            const float o = (l31 < 16) ? (n * cs - pr * sn) : (pr * sn + n * cs);
            if (lane < 32) {
                const bf16_t ob = f2bf(o);
#pragma unroll
                for (int hh = 0; hh < 6; ++hh) p.KM[(size_t)m * 576 + hh * 96 + 64 + l31] = ob;
            }
        }
    }
}

struct Post2 { const bf16_t* raw; const float* SQ; const float* qgain; const float* kgain; const float* rope; bf16_t *QM, *KM, *VM; };
__device__ __forceinline__ void ph_post2(const Ctx& C, const Post2& p) {
    const int lane = C.lane;
    const float SCQ = 0.10206207261596575f * LOG2E;
    const int l31 = lane & 31, i = lane & 15;
    const float gqn = p.qgain[lane], gqr = p.qgain[64 + l31], gkn = p.kgain[lane];
    for (int m = C.bid * 8 + C.wave; m < M; m += C.nblk * 8) {
        const int pos = m & (S - 1);
        const bf16_t* r = p.raw + (size_t)m * P2W;
        const f32x4 pq = *(const f32x4*)(p.SQ + (size_t)m * 8); const float2 pkv = *(const float2*)(p.SQ + (size_t)m * 8 + 4);
        const float sq = rsqrtf(((pq[0] + pq[1]) + (pq[2] + pq[3])) * (1.f / 256.f) + EPS), skv = rsqrtf((pkv.x + pkv.y) * (1.f / 128.f) + EPS);
        const float cs = p.rope[pos * 16 + i], sn = p.rope[S * 16 + pos * 16 + i];
#pragma unroll
        for (int hh = 0; hh < 6; ++hh) {
            float v = sq * bf2f(r[hh * 128 + lane]);
            float rr = rsqrtf(wave_sum(v * v) * (1.f / 64.f) + EPS);
            p.QM[(size_t)m * 576 + hh * 96 + lane] = f2bf(v * rr * gqn * SCQ);
            v = lane < 32 ? sq * bf2f(r[hh * 128 + 64 + l31]) : 0.f;
            rr = rsqrtf(wave_sum(v * v) * (1.f / 32.f) + EPS);
            const float n = v * rr * gqr;
            const float pr = __shfl_xor(n, 16);
            const float o = (l31 < 16) ? (n * cs - pr * sn) : (pr * sn + n * cs);
            if (lane < 32) p.QM[(size_t)m * 576 + hh * 96 + 64 + l31] = f2bf(o * SCQ);
            v = skv * bf2f(r[768 + hh * 128 + lane]);
            rr = rsqrtf(wave_sum(v * v) * (1.f / 64.f) + EPS);
            p.KM[(size_t)m * 576 + hh * 96 + lane] = f2bf(v * rr * gkn);
            p.VM[(size_t)m * 384 + hh * 64 + lane] = f2bf(skv * bf2f(r[768 + hh * 128 + 64 + lane]));
        }
    }
}
__device__ __forceinline__ void mla_naive_job(int job, int stid, const bf16_t* Q, const bf16_t* K, const bf16_t* V, bf16_t* O) {
    const int bh = job % 12, qb = 31 - job / 12, b = bh / 6, h = bh % 6;
    const int qpos = qb * 256 + stid;
    const size_t m = (size_t)b * S + qpos;
    float q[96], o[64];
    {
        const unsigned* qp = (const unsigned*)(Q + m * 576 + h * 96);
#pragma unroll
        for (int i = 0; i < 48; ++i) { const unsigned w = qp[i]; q[2 * i] = lo16(w); q[2 * i + 1] = hi16(w); }
    }
#pragma unroll
    for (int i = 0; i < 64; ++i) o[i] = 0.f;
    float mx = -INFINITY, l = 0.f;
    const int jend = qb * 256 + 256;
    for (int j = 0; j < jend; ++j) {
        const unsigned* kp = (const unsigned*)(K + ((size_t)b * S + j) * 576 + h * 96);
        float s = 0.f;
#pragma unroll
        for (int i = 0; i < 48; ++i) { const unsigned w = kp[i]; s += q[2 * i] * lo16(w) + q[2 * i + 1] * hi16(w); }
        if (j <= qpos) {
            const float mn = fmaxf(mx, s), corr = exp2f(mx - mn), pexp = exp2f(s - mn);
            l = l * corr + pexp; mx = mn;
            const unsigned* vp = (const unsigned*)(V + ((size_t)b * S + j) * 384 + h * 64);
#pragma unroll
            for (int i = 0; i < 32; ++i) { const unsigned w = vp[i]; o[2 * i] = o[2 * i] * corr + pexp * lo16(w); o[2 * i + 1] = o[2 * i + 1] * corr + pexp * hi16(w); }
        }
    }
    const float il = 1.f / l;
    unsigned* op = (unsigned*)(O + m * 384 + h * 64);
#pragma unroll
    for (int i = 0; i < 32; ++i) op[i] = pk2(o[2 * i] * il, o[2 * i + 1] * il);
}
__device__ __forceinline__ void swa_naive_job(int job, int stid, const bf16_t* Q, const bf16_t* K, const bf16_t* V, const float* bias, bf16_t* O) {
    const int bh = job / 32, qb = job % 32, b = bh / 6, h = bh % 6;
    const int pos = qb * 256 + stid;
    const size_t m = (size_t)b * S + pos;
    float q[64], o[64];
    {
        const unsigned* qp = (const unsigned*)(Q + m * 384 + h * 64);
#pragma unroll
        for (int i = 0; i < 32; ++i) { const unsigned w = qp[i]; q[2 * i] = lo16(w); q[2 * i + 1] = hi16(w); }
    }
#pragma unroll
    for (int i = 0; i < 64; ++i) o[i] = 0.f;
    float mx = -INFINITY, l = 0.f;
    for (int br = 0; br < 3; ++br) {
        const int dil = br == 0 ? 1 : (br == 1 ? 4 : 16);
        const float* bt = bias + (br * 6 + h) * 132;
        for (int j = 0; j <= 128; ++j) {
            const int kpos = pos - j * dil;
            if (kpos < 0) break;
            const size_t km = (size_t)b * S + kpos;
            const unsigned* kp = (const unsigned*)(K + km * 384 + h * 64);
            float s = bt[j];
#pragma unroll
            for (int i = 0; i < 32; ++i) { const unsigned w = kp[i]; s += q[2 * i] * lo16(w) + q[2 * i + 1] * hi16(w); }
            const float mn = fmaxf(mx, s), corr = exp2f(mx - mn), pexp = exp2f(s - mn);
            l = l * corr + pexp; mx = mn;
            const unsigned* vp = (const unsigned*)(V + km * 384 + h * 64);
#pragma unroll
            for (int i = 0; i < 32; ++i) { const unsigned w = vp[i]; o[2 * i] = o[2 * i] * corr + pexp * lo16(w); o[2 * i + 1] = o[2 * i + 1] * corr + pexp * hi16(w); }
        }
    }
    const float il = 1.f / l;
    unsigned* op = (unsigned*)(O + m * 384 + h * 64);
#pragma unroll
    for (int i = 0; i < 32; ++i) op[i] = pk2(o[2 * i] * il, o[2 * i + 1] * il);
}
struct S5P { const float *a_re, *a_im, *b_re, *b_im, *c_re, *c_im, *d, *log_dt; };
__device__ __forceinline__ void s5_scan_job(int job, int p, const S5P& s, const bf16_t* U, float* XST) {
    const int b = job / 16, g = job % 16;
    const float dt = expf(s.log_dt[g]);
    const float are = s.a_re[g * 64 + p], aim = s.a_im[g * 64 + p];
    const float mag = expf(are * dt);
    const float lr = mag * cosf(aim * dt), li = mag * sinf(aim * dt);
    const float den = are * are + aim * aim, nr = lr - 1.f, ni = li;
    const float cr = (nr * are + ni * aim) / den, ci = (ni * are - nr * aim) / den;
    float bbr[16], bbi[16];
#pragma unroll
    for (int c = 0; c < 16; ++c) {
        const float br_ = s.b_re[(g * 64 + p) * 16 + c], bi_ = s.b_im[(g * 64 + p) * 16 + c];
        bbr[c] = cr * br_ - ci * bi_; bbi[c] = cr * bi_ + ci * br_;
    }
    float xr = 0.f, xi = 0.f;
    for (int t = 0; t < S; ++t) {
        const size_t m = (size_t)b * S + t;
        const unsigned* up = (const unsigned*)(U + m * 256 + g * 16);
        float ur = 0.f, ui = 0.f;
#pragma unroll
        for (int c2 = 0; c2 < 8; ++c2) { const unsigned w = up[c2]; const float u0 = lo16(w), u1 = hi16(w);
            ur += bbr[2 * c2] * u0 + bbr[2 * c2 + 1] * u1; ui += bbi[2 * c2] * u0 + bbi[2 * c2 + 1] * u1; }
        const float nxr = lr * xr - li * xi + ur, nxi = lr * xi + li * xr + ui;
        xr = nxr; xi = nxi;
        float2 st; st.x = xr; st.y = xi;
        *(float2*)(XST + ((m * 16 + g) * 64 + p) * 2) = st;
    }
}
struct MixP { const bf16_t *QM, *KM, *VM, *QA, *KA, *VA, *U; const float* bias; bf16_t *YC, *YA; float* XST; S5P s5; };
__device__ __forceinline__ void ph_mixers_naive(const Ctx& C, const MixP& p) {
    const int sub = C.tid >> 8, stid = C.tid & 255;
    for (int job = C.bid * 2 + sub; job < 800; job += C.nblk * 2) {
        if (job < 32) { if (stid < 64) s5_scan_job(job, stid, p.s5, p.U, p.XST); }
        else if (job < 416) mla_naive_job(job - 32, stid, p.QM, p.KM, p.VM, p.YC);
        else swa_naive_job(job - 416, stid, p.QA, p.KA, p.VA, p.bias, p.YA);
    }
}
__device__ __forceinline__ void ph_s5_out(const Ctx& C, const S5P& s, const bf16_t* U, const float* XST, bf16_t* GS) {
    for (size_t gid = (size_t)C.bid * NT + C.tid; gid < (size_t)M * 256; gid += (size_t)C.nblk * NT) {
        const size_t m = gid >> 8; const int ch = (int)(gid & 255), g = ch >> 4, c = ch & 15;
        const float* xs = XST + (m * 16 + g) * 128;
        const float* crp = s.c_re + (g * 16 + c) * 64; const float* cip = s.c_im + (g * 16 + c) * 64;
        float y = 0.f;
#pragma unroll 8
        for (int p = 0; p < 64; ++p) y += crp[p] * xs[2 * p] - cip[p] * xs[2 * p + 1];
        y += s.d[ch] * bf2f(U[m * 256 + ch]);
        GS[m * 256 + ch] = f2bf(gelu_tanh(y));
    }
}
__device__ __forceinline__ void ph_merge(const Ctx& C, const bf16_t* YA, const bf16_t* GS, const bf16_t* GL, const float* b_glu, const bf16_t* YC, bf16_t* AOUT) {
    const int lane = C.lane;
    for (size_t m = (size_t)C.bid * 8 + C.wave; m < M; m += (size_t)C.nblk * 8) {
        float v[6]; float ss = 0.f;
#pragma unroll
        for (int j = 0; j < 6; ++j) { v[j] = bf2f(YA[m * 384 + j * 64 + lane]); ss += v[j] * v[j]; }
        float r = rsqrtf(wave_sum(ss) * (1.f / 384.f) + EPS);
#pragma unroll
        for (int j = 0; j < 6; ++j) AOUT[m * D + j * 64 + lane] = f2bf(v[j] * r);
        ss = 0.f;
#pragma unroll
        for (int j = 0; j < 4; ++j) { const float g = bf2f(GS[m * 256 + j * 64 + lane]); const float z = bf2f(GL[m * 256 + j * 64 + lane]) + b_glu[j * 64 + lane];
            v[j] = g / (1.f + __expf(-z)); ss += v[j] * v[j]; }
        r = rsqrtf(wave_sum(ss) * (1.f / 256.f) + EPS);
#pragma unroll
        for (int j = 0; j < 4; ++j) AOUT[m * D + 384 + j * 64 + lane] = f2bf(v[j] * r);
        ss = 0.f;
#pragma unroll
        for (int j = 0; j < 6; ++j) { v[j] = bf2f(YC[m * 384 + j * 64 + lane]); ss += v[j] * v[j]; }
        r = rsqrtf(wave_sum(ss) * (1.f / 384.f) + EPS);
#pragma unroll
        for (int j = 0; j < 6; ++j) AOUT[m * D + 640 + j * 64 + lane] = f2bf(v[j] * r);
    }
}

__device__ __forceinline__ void ph_peer_scores(const Ctx& C, const bf16_t* QP, const bf16_t* SUBK, float* TOPS, int* TOPI) {
    if (C.wave >= 4) return;
    float* sc = (float*)C.lds + C.wave * (64 * 129);
    const int lane = C.lane;
    for (int wj = C.bid * 4 + C.wave; wj < M / 4; wj += C.nblk * 4) {
        const size_t m = (size_t)wj * 4 + (lane >> 4); const int hj = lane & 15;
        const u32x4* qp = (const u32x4*)(QP + m * 2048 + hj * 128);
        const bf16_t* sk = SUBK + (size_t)hj * 128 * 128;
        for (int key = 0; key < 128; ++key) {
            const u32x4* kp = (const u32x4*)(sk + key * 128);
            float s = 0.f;
#pragma unroll 4
            for (int d8 = 0; d8 < 16; ++d8) {
                const u32x4 a = qp[d8], bq = kp[d8];
                s += lo16(a.x) * lo16(bq.x) + hi16(a.x) * hi16(bq.x) + lo16(a.y) * lo16(bq.y) + hi16(a.y) * hi16(bq.y)
                   + lo16(a.z) * lo16(bq.z) + hi16(a.z) * hi16(bq.z) + lo16(a.w) * lo16(bq.w) + hi16(a.w) * hi16(bq.w);
            }
            sc[lane * 129 + key] = s;
        }
        for (int r = 0; r < 16; ++r) {
            float best = -INFINITY; int bi = 0;
            for (int key = 0; key < 128; ++key) { const float v = sc[lane * 129 + key]; if (v > best) { best = v; bi = key; } }
            sc[lane * 129 + bi] = -INFINITY;
            TOPS[(m * 16 + hj) * 16 + r] = best; TOPI[(m * 16 + hj) * 16 + r] = bi;
        }
    }
}
__device__ __forceinline__ void ph_peer_combine(const Ctx& C, const float* TOPS, const int* TOPI, int* EIDX, float* GATE) {
    if (C.wave >= 2) return;
    float* cand = (float*)C.lds + C.wave * (64 * 257);
    float* bs = (float*)C.lds + 2 * (64 * 257) + C.wave * (64 * 17);
    const int lane = C.lane;
    for (int wj = C.bid * 2 + C.wave; wj < M * 8 / 64; wj += C.nblk * 2) {
        const size_t mh = (size_t)wj * 64 + lane;
        const float* s1 = TOPS + (mh * 2 + 0) * 16; const float* s2 = TOPS + (mh * 2 + 1) * 16;
        const int* i1 = TOPI + (mh * 2 + 0) * 16; const int* i2 = TOPI + (mh * 2 + 1) * 16;
        for (int a = 0; a < 16; ++a) for (int b2 = 0; b2 < 16; ++b2) cand[lane * 257 + a * 16 + b2] = s1[a] + s2[b2];
        float mxv = -INFINITY;
        for (int r = 0; r < 16; ++r) {
            float best = -INFINITY; int bi = 0;
            for (int c = 0; c < 256; ++c) { const float v = cand[lane * 257 + c]; if (v > best) { best = v; bi = c; } }
            cand[lane * 257 + bi] = -INFINITY;
            bs[lane * 17 + r] = best; if (r == 0) mxv = best;
            EIDX[mh * 16 + r] = i1[bi >> 4] * 128 + i2[bi & 15];
        }
        float sum = 0.f;
        for (int r = 0; r < 16; ++r) { const float e = __expf(bs[lane * 17 + r] - mxv); bs[lane * 17 + r] = e; sum += e; }
        const float inv = 1.f / sum;
        for (int r = 0; r < 16; ++r) GATE[mh * 16 + r] = bs[lane * 17 + r] * inv;
    }
}
__device__ __forceinline__ void ph_peer_gather(const Ctx& C, const bf16_t* H, const int* EIDX, const float* GATE, const bf16_t* PU, const bf16_t* PV,
                                               const float* g2, const float* xin, float* xout) {
    const int lane = C.lane;
    for (size_t m = (size_t)C.bid * 8 + C.wave; m < M; m += (size_t)C.nblk * 8) {
        const int b = (int)(m >> 13);
        float hx[16], acc[16];
        {
            const u32x4 a = *(const u32x4*)(H + m * D + lane * 8), c = *(const u32x4*)(H + m * D + 512 + lane * 8);
            hx[0] = lo16(a.x); hx[1] = hi16(a.x); hx[2] = lo16(a.y); hx[3] = hi16(a.y); hx[4] = lo16(a.z); hx[5] = hi16(a.z); hx[6] = lo16(a.w); hx[7] = hi16(a.w);
            hx[8] = lo16(c.x); hx[9] = hi16(c.x); hx[10] = lo16(c.y); hx[11] = hi16(c.y); hx[12] = lo16(c.z); hx[13] = hi16(c.z); hx[14] = lo16(c.w); hx[15] = hi16(c.w);
        }
#pragma unroll
        for (int i = 0; i < 16; ++i) acc[i] = 0.f;
        for (int e = 0; e < 128; ++e) {
            const int idx = EIDX[m * 128 + e]; const float gt = GATE[m * 128 + e];
            const bf16_t* ur = PU + (size_t)idx * D; const bf16_t* vr = PV + (size_t)idx * D;
            const u32x4 a = *(const u32x4*)(ur + lane * 8), c = *(const u32x4*)(ur + 512 + lane * 8);
            const u32x4 va = *(const u32x4*)(vr + lane * 8), vc = *(const u32x4*)(vr + 512 + lane * 8);
            float s = hx[0] * lo16(a.x) + hx[1] * hi16(a.x) + hx[2] * lo16(a.y) + hx[3] * hi16(a.y) + hx[4] * lo16(a.z) + hx[5] * hi16(a.z) + hx[6] * lo16(a.w) + hx[7] * hi16(a.w)
                    + hx[8] * lo16(c.x) + hx[9] * hi16(c.x) + hx[10] * lo16(c.y) + hx[11] * hi16(c.y) + hx[12] * lo16(c.z) + hx[13] * hi16(c.z) + hx[14] * lo16(c.w) + hx[15] * hi16(c.w);
            s = wave_sum(s);
            const float cf = gt * gelu_tanh(s);
            acc[0] += cf * lo16(va.x); acc[1] += cf * hi16(va.x); acc[2] += cf * lo16(va.y); acc[3] += cf * hi16(va.y); acc[4] += cf * lo16(va.z); acc[5] += cf * hi16(va.z); acc[6] += cf * lo16(va.w); acc[7] += cf * hi16(va.w);
            acc[8] += cf * lo16(vc.x); acc[9] += cf * hi16(vc.x); acc[10] += cf * lo16(vc.y); acc[11] += cf * hi16(vc.y); acc[12] += cf * lo16(vc.z); acc[13] += cf * hi16(vc.z); acc[14] += cf * lo16(vc.w); acc[15] += cf * hi16(vc.w);
        }
        const float* g = g2 + b * MODW;
#pragma unroll
        for (int hlf = 0; hlf < 2; ++hlf)
#pragma unroll
            for (int q4 = 0; q4 < 2; ++q4) {
                const int c0 = hlf * 512 + lane * 8 + q4 * 4;
                const f32x4 xi = *(const f32x4*)(xin + m * D + c0), gg = *(const f32x4*)(g + c0);
                f32x4 o;
#pragma unroll
                for (int e = 0; e < 4; ++e) o[e] = xi[e] + gg[e] * acc[hlf * 8 + q4 * 4 + e];
                *(f32x4*)(xout + m * D + c0) = o;
            }
    }
}
}
namespace hy {
typedef short bf16x8 __attribute__((ext_vector_type(8)));
typedef float f32x16 __attribute__((ext_vector_type(16)));
typedef short s16x4 __attribute__((ext_vector_type(4)));
#define HY_LAS __attribute__((address_space(3)))
__device__ __forceinline__ int crow(int r, int hi) { return (r & 3) + 8 * (r >> 2) + 4 * hi; }
__device__ __forceinline__ unsigned cvtpk(float lo, float hi) { unsigned r; asm volatile("v_cvt_pk_bf16_f32 %0, %1, %2" : "=v"(r) : "v"(lo), "v"(hi)); return r; }
__device__ __forceinline__ s16x4 vtr(const HY_LAS unsigned char* p) { return __builtin_bit_cast(s16x4, __builtin_amdgcn_ds_read_tr16_b64_v4i16((HY_LAS s16x4*)p)); }

constexpr int AT_KP96 = 208, AT_KP64 = 144;
constexpr int AT_K0 = 0, AT_K1 = 13312, AT_V0 = 26624, AT_V1 = 34816, AT_BIAS = 43008, AT_END = 43008 + 1536;

struct AttnArgs {
    const bf16_t* Q; const bf16_t* K; const bf16_t* V;
    int qpitch, kpitch, vpitch;
    long q_row0; int q_rstride;
    long k_row0; int k_rstride;
    int q_idx0;
    int t_begin, t_end;
    const float* bias;
    bf16_t* O; int opitch;
    float* ML;  int mlpitch;
    int safe;
};

template <int MODE, int VAR = 0>
__device__ __forceinline__ void attn_unit(const Ctx& C, const AttnArgs& a) {
    constexpr int DQK = MODE == 0 ? 96 : 64, KP = MODE == 0 ? AT_KP96 : AT_KP64, NS = DQK / 16;
    HY_LAS unsigned char* L = (HY_LAS unsigned char*)C.lds;
    const int tid = C.tid, lane = C.lane, wave = C.wave, r32 = lane & 31, hi = lane >> 5;
    constexpr int KCH = DQK / 8;
    const int kr0 = tid / KCH, kc0 = tid % KCH;
    const int kr1 = (tid + 512) / KCH, kc1 = (tid + 512) % KCH;
    const bool k2 = (MODE == 0) && tid < 256;
    const int vr = tid >> 3, vc = tid & 7;
    const unsigned kdst0 = kr0 * KP + kc0 * 16, kdst1 = kr1 * KP + kc1 * 16, vdst = (vc >> 2) * 4096 + vr * 64 + (vc & 3) * 16;
    if (MODE == 1) { if (tid < 384) { const int dl = tid - 64; *(HY_LAS float*)(L + AT_BIAS + tid * 4) = (dl >= 0 && dl <= 128) ? a.bias[dl] : -INFINITY; } }
    const int qi = a.q_idx0 + wave * 32 + r32;
    bf16x8 qr[NS];
    {
        const bf16_t* qp = a.Q + (a.q_row0 + (long)(wave * 32 + r32) * a.q_rstride) * a.qpitch + hi * 8;
#pragma unroll
        for (int s = 0; s < NS; ++s) qr[s] = *(const bf16x8*)(qp + s * 16);
    }
    f32x16 o0, o1;
#pragma unroll
    for (int r = 0; r < 16; ++r) { o0[r] = 0.f; o1[r] = 0.f; }
    float m_ref = 0.f, l_run = 0.f; bool mzero = true;
    int wt_lo, wt_hi;
    {
        const int q_lo = a.q_idx0 + wave * 32, q_hi = q_lo + 31;
        if (MODE == 0) { wt_lo = a.t_begin; wt_hi = q_hi >> 6; }
        else { const int lo = q_lo - 128; wt_lo = lo < 0 ? 0 : (lo >> 6); if (wt_lo < a.t_begin) wt_lo = a.t_begin; wt_hi = q_hi >> 6; }
    }
    u32x4 sk0, sk1, sv;
    auto gload = [&](int t) {
        const long kb = a.k_row0 + (long)(t * 64) * a.k_rstride;
        sk0 = *(const u32x4*)(a.K + (kb + (long)kr0 * a.k_rstride) * a.kpitch + kc0 * 8);
        if (k2) sk1 = *(const u32x4*)(a.K + (kb + (long)kr1 * a.k_rstride) * a.kpitch + kc1 * 8);
        sv = *(const u32x4*)(a.V + (kb + (long)vr * a.k_rstride) * a.vpitch + vc * 8);
    };
    auto lstore = [&](int buf) {
        HY_LAS unsigned char* kb = L + (buf ? AT_K1 : AT_K0); HY_LAS unsigned char* vb = L + (buf ? AT_V1 : AT_V0);
        *(HY_LAS u32x4*)(kb + kdst0) = sk0;
        if (k2) *(HY_LAS u32x4*)(kb + kdst1) = sk1;
        *(HY_LAS u32x4*)(vb + vdst) = sv;
    };
    __syncthreads();
    gload(a.t_begin); lstore(0);
    __syncthreads();
    const unsigned voff = ((lane >> 4) & 1) * 32 + (lane & 3) * 8 + (4 * hi + ((lane & 15) >> 2)) * 64;
    for (int t = a.t_begin; t < a.t_end; ++t) {
        const int buf = (t - a.t_begin) & 1;
        const bool more = t + 1 < a.t_end;
        if (more && VAR != 2) gload(t + 1);
        if (t >= wt_lo && t <= wt_hi) {
            const HY_LAS unsigned char* kb = L + (buf ? AT_K1 : AT_K0); const HY_LAS unsigned char* vb = L + (buf ? AT_V1 : AT_V0);
            f32x16 p0, p1;
#pragma unroll
            for (int r = 0; r < 16; ++r) { p0[r] = 0.f; p1[r] = 0.f; }
#pragma unroll
            for (int s = 0; s < NS; ++s) {
                const bf16x8 a0 = *(const HY_LAS bf16x8*)(kb + r32 * KP + s * 32 + hi * 16);
                const bf16x8 a1 = *(const HY_LAS bf16x8*)(kb + (32 + r32) * KP + s * 32 + hi * 16);
                p0 = __builtin_amdgcn_mfma_f32_32x32x16_bf16(a0, qr[s], p0, 0, 0, 0);
                p1 = __builtin_amdgcn_mfma_f32_32x32x16_bf16(a1, qr[s], p1, 0, 0, 0);
            }
            if (MODE == 0) {
                if (t * 64 + 63 > a.q_idx0 + wave * 32) {
                    const int kbase = t * 64 + 4 * hi;
#pragma unroll
                    for (int r = 0; r < 16; ++r) { const int kj = kbase + (r & 3) + 8 * (r >> 2); if (kj > qi) p0[r] = -INFINITY; if (kj + 32 > qi) p1[r] = -INFINITY; }
                }
            } else {
                const HY_LAS float* bp = (const HY_LAS float*)(L + AT_BIAS) + (64 + qi - t * 64 - 4 * hi - 63);
#pragma unroll
                for (int r = 0; r < 16; ++r) { const int off = (r & 3) + 8 * (r >> 2); p0[r] += bp[63 - off]; p1[r] += bp[63 - 32 - off]; }
            }
            if (!mzero) {
#pragma unroll
                for (int r = 0; r < 16; ++r) { p0[r] -= m_ref; p1[r] -= m_ref; }
            }
            if (!a.safe) {
                float mx = __builtin_fmaxf(p0[0], p1[0]);
#pragma unroll
                for (int r = 1; r < 16; ++r) mx = __builtin_fmaxf(__builtin_fmaxf(mx, p0[r]), p1[r]);
                if (__builtin_expect(__any(mx > 16.f), 0)) {
                    mx = fmaxf(mx, __shfl_xor(mx, 32));
                    const float dl = fmaxf(mx, 0.f), f = __builtin_amdgcn_exp2f(-dl);
                    m_ref += dl; l_run *= f; mzero = false;
#pragma unroll
                    for (int r = 0; r < 16; ++r) { p0[r] -= dl; p1[r] -= dl; o0[r] *= f; o1[r] *= f; }
                }
            }
            float rs0 = 0.f, rs1 = 0.f;
#pragma unroll
            for (int r = 0; r < 16; ++r) { if (VAR != 1) { p0[r] = __builtin_amdgcn_exp2f(p0[r]); p1[r] = __builtin_amdgcn_exp2f(p1[r]); } rs0 += p0[r]; rs1 += p1[r]; }
            l_run += rs0 + rs1;
            u32x4 pw[4];
            pw[0] = (u32x4){cvtpk(p0[0], p0[1]), cvtpk(p0[2], p0[3]), cvtpk(p0[4], p0[5]), cvtpk(p0[6], p0[7])};
            pw[1] = (u32x4){cvtpk(p0[8], p0[9]), cvtpk(p0[10], p0[11]), cvtpk(p0[12], p0[13]), cvtpk(p0[14], p0[15])};
            pw[2] = (u32x4){cvtpk(p1[0], p1[1]), cvtpk(p1[2], p1[3]), cvtpk(p1[4], p1[5]), cvtpk(p1[6], p1[7])};
            pw[3] = (u32x4){cvtpk(p1[8], p1[9]), cvtpk(p1[10], p1[11]), cvtpk(p1[12], p1[13]), cvtpk(p1[14], p1[15])};
#pragma unroll
            for (int s = 0; s < 4; ++s) {
                const s16x4 l0 = vtr(vb + voff + s * 1024), h0 = vtr(vb + voff + s * 1024 + 512);
                const s16x4 l1 = vtr(vb + voff + 4096 + s * 1024), h1 = vtr(vb + voff + 4096 + s * 1024 + 512);
                const bf16x8 vf0 = (bf16x8){l0[0], l0[1], l0[2], l0[3], h0[0], h0[1], h0[2], h0[3]};
                const bf16x8 vf1 = (bf16x8){l1[0], l1[1], l1[2], l1[3], h1[0], h1[1], h1[2], h1[3]};
                const bf16x8 pf = __builtin_bit_cast(bf16x8, pw[s]);
                o0 = __builtin_amdgcn_mfma_f32_32x32x16_bf16(vf0, pf, o0, 0, 0, 0);
                o1 = __builtin_amdgcn_mfma_f32_32x32x16_bf16(vf1, pf, o1, 0, 0, 0);
            }
        }
        if (more && VAR != 2) lstore(buf ^ 1);
        if (VAR != 2) __syncthreads();
    }
    l_run += __shfl_xor(l_run, 32);
    const float il = 1.f / l_run;
    const long orow = a.q_row0 + (long)(wave * 32 + r32) * a.q_rstride;
    bf16_t* op = a.O + orow * a.opitch + 4 * hi;
#pragma unroll
    for (int g = 0; g < 4; ++g) {
        u32x2 w0, w1;
        w0.x = cvtpk(o0[4 * g] * il, o0[4 * g + 1] * il); w0.y = cvtpk(o0[4 * g + 2] * il, o0[4 * g + 3] * il);
        w1.x = cvtpk(o1[4 * g] * il, o1[4 * g + 1] * il); w1.y = cvtpk(o1[4 * g + 2] * il, o1[4 * g + 3] * il);
        *(u32x2*)(op + 8 * g) = w0; *(u32x2*)(op + 32 + 8 * g) = w1;
    }
    if (MODE == 1 && hi == 0) { float2 ml; ml.x = m_ref; ml.y = l_run; *(float2*)(a.ML + orow * a.mlpitch) = ml; }
}
constexpr int M2_KS = 64 * AT_KP96, M2_K = 0, M2_V = 4 * M2_KS, M2_END = M2_V + 4 * 8192;
__device__ __forceinline__ void mla_unit2(const Ctx& C, const AttnArgs& a) {
    constexpr int KP = AT_KP96, NS = 6, KCH = 12;
    HY_LAS unsigned char* L = (HY_LAS unsigned char*)C.lds;
    const int tid = C.tid, lane = C.lane, wave = C.wave, r32 = lane & 31, hi = lane >> 5;
    const int kr0 = tid / KCH, kc0 = tid % KCH, kr1 = (tid + 512) / KCH, kc1 = (tid + 512) % KCH;
    const bool k2 = tid < 256;
    const int vr = tid >> 3, vc = tid & 7;
    const unsigned kdst0 = kr0 * KP + kc0 * 16, kdst1 = kr1 * KP + kc1 * 16, vdst = (vc >> 2) * 4096 + vr * 64 + (vc & 3) * 16;
    const int qi = a.q_idx0 + wave * 32 + r32;
    bf16x8 qr[NS];
    {
        const bf16_t* qp = a.Q + (a.q_row0 + (long)(wave * 32 + r32) * a.q_rstride) * a.qpitch + hi * 8;
#pragma unroll
        for (int s = 0; s < NS; ++s) qr[s] = *(const bf16x8*)(qp + s * 16);
    }
    f32x16 o0, o1;
#pragma unroll
    for (int r = 0; r < 16; ++r) { o0[r] = 0.f; o1[r] = 0.f; }
    float m_ref = 0.f, l_run = 0.f; bool mzero = true;
    const int wt_hi = (a.q_idx0 + wave * 32 + 31) >> 6;
    u32x4 sa0, sa1, sav, sb0, sb1, sbv;
#define HY_M2LOAD(S0, S1, SV, t_) do { const long kb_ = a.k_row0 + (long)((t_) * 64); \
        S0 = *(const u32x4*)(a.K + (kb_ + kr0) * a.kpitch + kc0 * 8); if (k2) S1 = *(const u32x4*)(a.K + (kb_ + kr1) * a.kpitch + kc1 * 8); \
        SV = *(const u32x4*)(a.V + (kb_ + vr) * a.vpitch + vc * 8); } while (0)
#define HY_M2STORE(S0, S1, SV, slot_) do { *(HY_LAS u32x4*)(L + M2_K + (slot_) * M2_KS + kdst0) = S0; if (k2) *(HY_LAS u32x4*)(L + M2_K + (slot_) * M2_KS + kdst1) = S1; \
        *(HY_LAS u32x4*)(L + M2_V + (slot_) * 8192 + vdst) = SV; } while (0)
    const int nstep = a.t_end >> 1;
    __syncthreads();
    HY_M2LOAD(sa0, sa1, sav, 0); HY_M2LOAD(sb0, sb1, sbv, 1);
    HY_M2STORE(sa0, sa1, sav, 0); HY_M2STORE(sb0, sb1, sbv, 1);
    __syncthreads();
    const unsigned voff = ((lane >> 4) & 1) * 32 + (lane & 3) * 8 + (4 * hi + ((lane & 15) >> 2)) * 64;
#pragma unroll 1
    for (int st = 0; st < nstep; ++st) {
        const int buf = st & 1;
        if (st + 1 < nstep) { HY_M2LOAD(sa0, sa1, sav, 2 * st + 2); HY_M2LOAD(sb0, sb1, sbv, 2 * st + 3); }
#pragma unroll
        for (int j = 0; j < 2; ++j) {
            const int t = 2 * st + j;
            if (t <= wt_hi) {
                const int slot = buf * 2 + j;
                const HY_LAS unsigned char* kb = L + M2_K + slot * M2_KS; const HY_LAS unsigned char* vb = L + M2_V + slot * 8192;
                f32x16 p0, p1;
#pragma unroll
                for (int r = 0; r < 16; ++r) { p0[r] = 0.f; p1[r] = 0.f; }
#pragma unroll
                for (int ss = 0; ss < NS; ++ss) {
                    const bf16x8 a0 = *(const HY_LAS bf16x8*)(kb + r32 * KP + ss * 32 + hi * 16);
                    const bf16x8 a1 = *(const HY_LAS bf16x8*)(kb + (32 + r32) * KP + ss * 32 + hi * 16);
                    p0 = __builtin_amdgcn_mfma_f32_32x32x16_bf16(a0, qr[ss], p0, 0, 0, 0);
                    p1 = __builtin_amdgcn_mfma_f32_32x32x16_bf16(a1, qr[ss], p1, 0, 0, 0);
                }
                if (t * 64 + 63 > a.q_idx0 + wave * 32) {
                    const int kbase = t * 64 + 4 * hi;
#pragma unroll
                    for (int r = 0; r < 16; ++r) { const int kj = kbase + (r & 3) + 8 * (r >> 2); if (kj > qi) p0[r] = -INFINITY; if (kj + 32 > qi) p1[r] = -INFINITY; }
                }
                if (!mzero) {
#pragma unroll
                    for (int r = 0; r < 16; ++r) { p0[r] -= m_ref; p1[r] -= m_ref; }
                }
                if (!a.safe) {
                    float mx = __builtin_fmaxf(p0[0], p1[0]);
#pragma unroll
                    for (int r = 1; r < 16; ++r) mx = __builtin_fmaxf(__builtin_fmaxf(mx, p0[r]), p1[r]);
                    if (__builtin_expect(__any(mx > 16.f), 0)) {
                        mx = fmaxf(mx, __shfl_xor(mx, 32));
                        const float dl = fmaxf(mx, 0.f), f = __builtin_amdgcn_exp2f(-dl);
                        m_ref += dl; l_run *= f; mzero = false;
#pragma unroll
                        for (int r = 0; r < 16; ++r) { p0[r] -= dl; p1[r] -= dl; o0[r] *= f; o1[r] *= f; }
                    }
                }
                float rs0 = 0.f, rs1 = 0.f;
#pragma unroll
                for (int r = 0; r < 16; ++r) { p0[r] = __builtin_amdgcn_exp2f(p0[r]); p1[r] = __builtin_amdgcn_exp2f(p1[r]); rs0 += p0[r]; rs1 += p1[r]; }
                l_run += rs0 + rs1;
                u32x4 pw[4];
                pw[0] = (u32x4){cvtpk(p0[0], p0[1]), cvtpk(p0[2], p0[3]), cvtpk(p0[4], p0[5]), cvtpk(p0[6], p0[7])};
                pw[1] = (u32x4){cvtpk(p0[8], p0[9]), cvtpk(p0[10], p0[11]), cvtpk(p0[12], p0[13]), cvtpk(p0[14], p0[15])};
                pw[2] = (u32x4){cvtpk(p1[0], p1[1]), cvtpk(p1[2], p1[3]), cvtpk(p1[4], p1[5]), cvtpk(p1[6], p1[7])};
                pw[3] = (u32x4){cvtpk(p1[8], p1[9]), cvtpk(p1[10], p1[11]), cvtpk(p1[12], p1[13]), cvtpk(p1[14], p1[15])};
#pragma unroll
                for (int ss = 0; ss < 4; ++ss) {
                    const s16x4 l0 = vtr(vb + voff + ss * 1024), h0 = vtr(vb + voff + ss * 1024 + 512);
                    const s16x4 l1 = vtr(vb + voff + 4096 + ss * 1024), h1 = vtr(vb + voff + 4096 + ss * 1024 + 512);
                    const bf16x8 vf0 = (bf16x8){l0[0], l0[1], l0[2], l0[3], h0[0], h0[1], h0[2], h0[3]};
                    const bf16x8 vf1 = (bf16x8){l1[0], l1[1], l1[2], l1[3], h1[0], h1[1], h1[2], h1[3]};
                    const bf16x8 pf = __builtin_bit_cast(bf16x8, pw[ss]);
                    o0 = __builtin_amdgcn_mfma_f32_32x32x16_bf16(vf0, pf, o0, 0, 0, 0);
                    o1 = __builtin_amdgcn_mfma_f32_32x32x16_bf16(vf1, pf, o1, 0, 0, 0);
                }
            }
        }
        if (st + 1 < nstep) { HY_M2STORE(sa0, sa1, sav, (buf ^ 1) * 2); HY_M2STORE(sb0, sb1, sbv, (buf ^ 1) * 2 + 1); }
        __syncthreads();
    }
    l_run += __shfl_xor(l_run, 32);
    const float il = 1.f / l_run;
    const long orow = a.q_row0 + (long)(wave * 32 + r32) * a.q_rstride;
    bf16_t* op = a.O + orow * a.opitch + 4 * hi;
#pragma unroll
    for (int g = 0; g < 4; ++g) {
        u32x2 w0, w1;
        w0.x = cvtpk(o0[4 * g] * il, o0[4 * g + 1] * il); w0.y = cvtpk(o0[4 * g + 2] * il, o0[4 * g + 3] * il);
        w1.x = cvtpk(o1[4 * g] * il, o1[4 * g + 1] * il); w1.y = cvtpk(o1[4 * g + 2] * il, o1[4 * g + 3] * il);
        *(u32x2*)(op + 8 * g) = w0; *(u32x2*)(op + 32 + 8 * g) = w1;
    }
}
constexpr int SP_KS = 64 * AT_KP64, SP_K = 0, SP_V = 4 * SP_KS, SP_BIAS = SP_V + 4 * 8192, SP_END = SP_BIAS + 1536;
__device__ __forceinline__ void swa_unit_pair(const Ctx& C, const AttnArgs& a) {
    constexpr int KP = AT_KP64, NS = 4;
    HY_LAS unsigned char* L = (HY_LAS unsigned char*)C.lds;
    const int tid = C.tid, lane = C.lane, wave = C.wave, r32 = lane & 31, hi = lane >> 5;
    const int kr0 = tid >> 3, kc0 = tid & 7, vr = tid >> 3, vc = tid & 7;
    const unsigned kdst0 = kr0 * KP + kc0 * 16, vdst = (vc >> 2) * 4096 + vr * 64 + (vc & 3) * 16;
    if (tid < 384) { const int dl = tid - 64; *(HY_LAS float*)(L + SP_BIAS + tid * 4) = (dl >= 0 && dl <= 128) ? a.bias[dl] : -INFINITY; }
    const int qi = a.q_idx0 + wave * 32 + r32;
    bf16x8 qr[NS];
    {
        const bf16_t* qp = a.Q + (a.q_row0 + (long)(wave * 32 + r32) * a.q_rstride) * a.qpitch + hi * 8;
#pragma unroll
        for (int s = 0; s < NS; ++s) qr[s] = *(const bf16x8*)(qp + s * 16);
    }
    f32x16 o0, o1;
#pragma unroll
    for (int r = 0; r < 16; ++r) { o0[r] = 0.f; o1[r] = 0.f; }
    float m_ref = 0.f, l_run = 0.f; bool mzero = true;
    const int q_lo = a.q_idx0 + wave * 32, q_hi = q_lo + 31;
    const int wt_lo = q_lo - 128 < 0 ? 0 : ((q_lo - 128) >> 6), wt_hi = q_hi >> 6;
    const int T0 = (a.q_idx0 - 128) >> 6;
    u32x4 skA, svA, skB, svB;
#define HY_SPLOAD(SK, SV, t_) do { if ((t_) >= 0) { const long kb_ = a.k_row0 + (long)((t_) * 64) * a.k_rstride; \
        SK = *(const u32x4*)(a.K + (kb_ + (long)kr0 * a.k_rstride) * a.kpitch + kc0 * 8); SV = *(const u32x4*)(a.V + (kb_ + (long)vr * a.k_rstride) * a.vpitch + vc * 8); } } while (0)
#define HY_SPSTORE(SK, SV, slot_) do { *(HY_LAS u32x4*)(L + SP_K + (slot_) * SP_KS + kdst0) = SK; *(HY_LAS u32x4*)(L + SP_V + (slot_) * 8192 + vdst) = SV; } while (0)
    __syncthreads();
    HY_SPLOAD(skA, svA, T0); HY_SPLOAD(skB, svB, T0 + 3);
    HY_SPSTORE(skA, svA, 0); HY_SPSTORE(skB, svB, 1);
    __syncthreads();
    const unsigned voff = ((lane >> 4) & 1) * 32 + (lane & 3) * 8 + (4 * hi + ((lane & 15) >> 2)) * 64;
#pragma unroll 1
    for (int s = 0; s < 3; ++s) {
        const int buf = s & 1;
        if (s + 1 < 3) { HY_SPLOAD(skA, svA, T0 + s + 1); HY_SPLOAD(skB, svB, T0 + s + 4); }
        const int tA = T0 + s, tB = T0 + s + 3;
        const bool useA = tA >= wt_lo && tA <= wt_hi, useB = tB >= wt_lo && tB <= wt_hi;
        if (useA || useB) {
            const int t = useA ? tA : tB, slot = buf * 2 + (useA ? 0 : 1);
            const HY_LAS unsigned char* kb = L + SP_K + slot * SP_KS; const HY_LAS unsigned char* vb = L + SP_V + slot * 8192;
            f32x16 p0, p1;
            const HY_LAS float* bp = (const HY_LAS float*)(L + SP_BIAS) + (64 + qi - t * 64 - 4 * hi - 63);
#pragma unroll
            for (int r = 0; r < 16; ++r) { const int off = (r & 3) + 8 * (r >> 2); p0[r] = bp[63 - off]; p1[r] = bp[63 - 32 - off]; }
#pragma unroll
            for (int ss = 0; ss < NS; ++ss) {
                const bf16x8 a0 = *(const HY_LAS bf16x8*)(kb + r32 * KP + ss * 32 + hi * 16);
                const bf16x8 a1 = *(const HY_LAS bf16x8*)(kb + (32 + r32) * KP + ss * 32 + hi * 16);
                p0 = __builtin_amdgcn_mfma_f32_32x32x16_bf16(a0, qr[ss], p0, 0, 0, 0);
                p1 = __builtin_amdgcn_mfma_f32_32x32x16_bf16(a1, qr[ss], p1, 0, 0, 0);
            }
            if (!mzero) {
#pragma unroll
                for (int r = 0; r < 16; ++r) { p0[r] -= m_ref; p1[r] -= m_ref; }
            }
            if (!a.safe) {
                float mx = __builtin_fmaxf(p0[0], p1[0]);
#pragma unroll
                for (int r = 1; r < 16; ++r) mx = __builtin_fmaxf(__builtin_fmaxf(mx, p0[r]), p1[r]);
                if (__builtin_expect(__any(mx > 16.f), 0)) {
                    mx = fmaxf(mx, __shfl_xor(mx, 32));
                    const float dl = fmaxf(mx, 0.f), f = __builtin_amdgcn_exp2f(-dl);
                    m_ref += dl; l_run *= f; mzero = false;
#pragma unroll
                    for (int r = 0; r < 16; ++r) { p0[r] -= dl; p1[r] -= dl; o0[r] *= f; o1[r] *= f; }
                }
            }
            float rs0 = 0.f, rs1 = 0.f;
#pragma unroll
            for (int r = 0; r < 16; ++r) { p0[r] = __builtin_amdgcn_exp2f(p0[r]); p1[r] = __builtin_amdgcn_exp2f(p1[r]); rs0 += p0[r]; rs1 += p1[r]; }
            l_run += rs0 + rs1;
            u32x4 pw[4];
            pw[0] = (u32x4){cvtpk(p0[0], p0[1]), cvtpk(p0[2], p0[3]), cvtpk(p0[4], p0[5]), cvtpk(p0[6], p0[7])};
            pw[1] = (u32x4){cvtpk(p0[8], p0[9]), cvtpk(p0[10], p0[11]), cvtpk(p0[12], p0[13]), cvtpk(p0[14], p0[15])};
            pw[2] = (u32x4){cvtpk(p1[0], p1[1]), cvtpk(p1[2], p1[3]), cvtpk(p1[4], p1[5]), cvtpk(p1[6], p1[7])};
            pw[3] = (u32x4){cvtpk(p1[8], p1[9]), cvtpk(p1[10], p1[11]), cvtpk(p1[12], p1[13]), cvtpk(p1[14], p1[15])};
#pragma unroll
            for (int ss = 0; ss < 4; ++ss) {
                const s16x4 l0 = vtr(vb + voff + ss * 1024), h0 = vtr(vb + voff + ss * 1024 + 512);
                const s16x4 l1 = vtr(vb + voff + 4096 + ss * 1024), h1 = vtr(vb + voff + 4096 + ss * 1024 + 512);
                const bf16x8 vf0 = (bf16x8){l0[0], l0[1], l0[2], l0[3], h0[0], h0[1], h0[2], h0[3]};
                const bf16x8 vf1 = (bf16x8){l1[0], l1[1], l1[2], l1[3], h1[0], h1[1], h1[2], h1[3]};
                const bf16x8 pf = __builtin_bit_cast(bf16x8, pw[ss]);
                o0 = __builtin_amdgcn_mfma_f32_32x32x16_bf16(vf0, pf, o0, 0, 0, 0);
                o1 = __builtin_amdgcn_mfma_f32_32x32x16_bf16(vf1, pf, o1, 0, 0, 0);
            }
        }
        if (s + 1 < 3) { HY_SPSTORE(skA, svA, (buf ^ 1) * 2); HY_SPSTORE(skB, svB, (buf ^ 1) * 2 + 1); }
        __syncthreads();
    }
    l_run += __shfl_xor(l_run, 32);
    const float il = 1.f / l_run;
    const long orow = a.q_row0 + (long)(wave * 32 + r32) * a.q_rstride;
    bf16_t* op = a.O + orow * a.opitch + 4 * hi;
#pragma unroll
    for (int g = 0; g < 4; ++g) {
        u32x2 w0, w1;
        w0.x = cvtpk(o0[4 * g] * il, o0[4 * g + 1] * il); w0.y = cvtpk(o0[4 * g + 2] * il, o0[4 * g + 3] * il);
        w1.x = cvtpk(o1[4 * g] * il, o1[4 * g + 1] * il); w1.y = cvtpk(o1[4 * g + 2] * il, o1[4 * g + 3] * il);
        *(u32x2*)(op + 8 * g) = w0; *(u32x2*)(op + 32 + 8 * g) = w1;
    }
    if (hi == 0) { float2 ml; ml.x = m_ref; ml.y = l_run; *(float2*)(a.ML + orow * a.mlpitch) = ml; }
}
}
namespace hy {
constexpr size_t S5_KM_L = 16 * 64 * 256, S5_WE_L = 16 * 128 * 1024, S5_WC_L = 16 * 1024 * 128;
__device__ __forceinline__ void ph_s5_lampow(const Ctx& C, const In& in, float* LP) {
    for (int gid = C.bid * NT + C.tid; gid < NL * 16 * 64 * 65; gid += C.nblk * NT) {
        const int m = gid % 65, lgp = gid / 65, lg = lgp / 64;
        const float dt = expf(in.s5_log_dt[lg]);
        const float are = in.s5_a_re[lgp], aim = in.s5_a_im[lgp];
        const float mag = expf(are * dt * (float)m), ang = aim * dt * (float)m;
        float sn, cs; sincosf(ang, &sn, &cs);
        float2 o; o.x = mag * cs; o.y = mag * sn;
        *(float2*)(LP + (size_t)gid * 2) = o;
    }
}
__device__ __forceinline__ void ph_s5_bbar(const Ctx& C, const In& in, float* BB) {
    for (int gid = C.bid * NT + C.tid; gid < NL * 16 * 64 * 16; gid += C.nblk * NT) {
        const int lgp = gid >> 4, lg = lgp >> 6;
        const float dt = expf(in.s5_log_dt[lg]);
        const float are = in.s5_a_re[lgp], aim = in.s5_a_im[lgp];
        const float mag = expf(are * dt); float sn, cs; sincosf(aim * dt, &sn, &cs);
        const float lr = mag * cs, li = mag * sn;
        const float den = are * are + aim * aim, nr = lr - 1.f, ni = li;
        const float cr = (nr * are + ni * aim) / den, ci = (ni * are - nr * aim) / den;
        const float br = in.s5_b_re[gid], bi = in.s5_b_im[gid];
        float2 o; o.x = cr * br - ci * bi; o.y = cr * bi + ci * br;
        *(float2*)(BB + (size_t)gid * 2) = o;
    }
}
__device__ __forceinline__ void ph_s5_tables(const Ctx& C, const In& in, const float* LP, const float* BB, bf16_t* KM, bf16_t* WE, bf16_t* WC) {
    float* Cs = (float*)C.lds;
    float* Bs = Cs + 2048;
    float* Ls = Bs + 2048;
    const int tid = C.tid;
    for (int job = C.bid; job < NL * 16 * 4; job += C.nblk) {
        const int lg = job >> 2, qt = job & 3;
        __syncthreads();
        if (tid < 256) { const f32x4 r4 = *(const f32x4*)(in.s5_c_re + (size_t)lg * 1024 + tid * 4), i4 = *(const f32x4*)(in.s5_c_im + (size_t)lg * 1024 + tid * 4);
            *(f32x4*)(Cs + tid * 8) = (f32x4){r4[0], i4[0], r4[1], i4[1]}; *(f32x4*)(Cs + tid * 8 + 4) = (f32x4){r4[2], i4[2], r4[3], i4[3]}; }
        *(f32x4*)(Bs + tid * 4) = *(const f32x4*)(BB + (size_t)lg * 2048 + tid * 4);
        for (int i = tid; i < 64 * 65 * 2 / 4; i += NT) *(f32x4*)(Ls + i * 4) = *(const f32x4*)(LP + (size_t)lg * 64 * 65 * 2 + i * 4);
        __syncthreads();
        {
            const int lag = qt * 16 + (tid >> 5), c = (tid >> 1) & 15, jh = tid & 1;
            float a[8];
#pragma unroll
            for (int j = 0; j < 8; ++j) a[j] = 0.f;
#pragma unroll 4
            for (int p = 0; p < 64; ++p) {
                const float2 lm = *(const float2*)(Ls + (p * 65 + lag) * 2), cc = *(const float2*)(Cs + (c * 64 + p) * 2);
                const float xr = cc.x * lm.x - cc.y * lm.y, xi = cc.x * lm.y + cc.y * lm.x;
#pragma unroll
                for (int j = 0; j < 8; j += 2) { const f32x4 b4 = *(const f32x4*)(Bs + (p * 16 + 8 * jh + j) * 2); a[j] += xr * b4[0] - xi * b4[1]; a[j + 1] += xr * b4[2] - xi * b4[3]; }
            }
            *(u32x4*)(KM + ((size_t)lg * 64 + lag) * 256 + c * 16 + 8 * jh) = (u32x4){pk2(a[0], a[1]), pk2(a[2], a[3]), pk2(a[4], a[5]), pk2(a[6], a[7])};
        }
#pragma unroll 1
        for (int it = 0; it < 4; ++it) {
            const int idx = it * NT + tid, i = idx & 63, k = qt * 32 + (idx >> 6), ri = k >> 6, p = k & 63;
            const float2 lm = *(const float2*)(Ls + (p * 65 + 63 - i) * 2);
            unsigned w[8];
#pragma unroll
            for (int cp = 0; cp < 8; ++cp) {
                const f32x4 bb = *(const f32x4*)(Bs + (p * 16 + 2 * cp) * 2);
                const float v0 = ri ? (lm.x * bb[1] + lm.y * bb[0]) : (lm.x * bb[0] - lm.y * bb[1]);
                const float v1 = ri ? (lm.x * bb[3] + lm.y * bb[2]) : (lm.x * bb[2] - lm.y * bb[3]);
                w[cp] = pk2(v0, v1);
            }
            bf16_t* o = WE + (((size_t)lg * 128 + k) * 64 + i) * 16;
            *(u32x4*)o = (u32x4){w[0], w[1], w[2], w[3]}; *(u32x4*)(o + 8) = (u32x4){w[4], w[5], w[6], w[7]};
        }
#pragma unroll 1
        for (int it = 0; it < 8; ++it) {
            const int idx = it * NT + tid, ko = idx & 15, c = (idx >> 4) & 15, j = qt * 16 + (idx >> 8), ri = ko >> 3, p0 = (ko & 7) * 8;
            unsigned w[4];
#pragma unroll
            for (int e = 0; e < 4; ++e) {
                const int p = p0 + 2 * e;
                const float2 lm0 = *(const float2*)(Ls + (p * 65 + j + 1) * 2), lm1 = *(const float2*)(Ls + ((p + 1) * 65 + j + 1) * 2);
                const f32x4 cc = *(const f32x4*)(Cs + (c * 64 + p) * 2);
                const float v0 = ri ? -(cc[0] * lm0.y + cc[1] * lm0.x) : (cc[0] * lm0.x - cc[1] * lm0.y);
                const float v1 = ri ? -(cc[2] * lm1.y + cc[3] * lm1.x) : (cc[2] * lm1.x - cc[3] * lm1.y);
                w[e] = pk2(v0, v1);
            }
            *(u32x4*)(WC + (((size_t)lg * 64 + j) * 16 + c) * 128 + ko * 8) = (u32x4){w[0], w[1], w[2], w[3]};
        }
    }
    __syncthreads();
}
__device__ __forceinline__ void ph_s5_chunk_states(const Ctx& C, const bf16_t* U, const bf16_t* WEl, float* E) {
    const int lane = C.lane, wave = C.wave, r32 = lane & 31, hi = lane >> 5;
    for (int unit = (C.nblk >= 192 ? C.bid - (C.nblk - 64) : C.bid); unit < 64; unit += C.nblk) {
        if (unit < 0) break;
        const int g = unit & 15, nb = unit >> 4, mt = wave & 3, nh = wave >> 2;
        const int n = nb * 64 + nh * 32 + r32;
        const bf16_t* ap = WEl + ((size_t)g * 128 + mt * 32 + r32) * 1024 + hi * 8;
        const bf16_t* bp = U + (size_t)n * 64 * 256 + g * 16 + hi * 8;
        f32x16 acc;
#pragma unroll
        for (int r = 0; r < 16; ++r) acc[r] = 0.f;
#pragma unroll 16
        for (int i = 0; i < 64; ++i) {
            const bf16x8 af = *(const bf16x8*)(ap + i * 16);
            const bf16x8 bf = *(const bf16x8*)(bp + (size_t)i * 256);
            acc = __builtin_amdgcn_mfma_f32_32x32x16_bf16(af, bf, acc, 0, 0, 0);
        }
        float* ep = E + ((size_t)n * 16 + g) * 128 + mt * 32 + 4 * hi;
#pragma unroll
        for (int q4 = 0; q4 < 4; ++q4) *(f32x4*)(ep + 8 * q4) = (f32x4){acc[4 * q4], acc[4 * q4 + 1], acc[4 * q4 + 2], acc[4 * q4 + 3]};
    }
}
constexpr int S5_UP = 2064;
constexpr int S5L_U = 0, S5L_KM = 32 * S5_UP, S5L_X = S5L_KM + 512 + 64 * 512, S5L_XP = 272, S5L_END = S5L_X + 32 * S5L_XP;
struct S5U { const bf16_t* U; const bf16_t* KMl; const bf16_t* WCl; const float* E; const float* LP; const float* dskip; bf16_t* GS; int layer; int var; };
__device__ __forceinline__ void s5_unit(const Ctx& C, const S5U& a, int unit) {
    HY_LAS unsigned char* L = (HY_LAS unsigned char*)C.lds;
    const int tid = C.tid, lane = C.lane, wave = C.wave, r32 = lane & 31, hi = lane >> 5;
    const int g = unit & 15, blk = unit >> 4;
    const int b = blk >> 2, n0 = (blk & 3) * 32, nglob0 = b * 128 + n0;
    __syncthreads();
#pragma unroll
    for (int i = 0; i < 8; ++i) {
        const int c = tid + i * 512, n = c >> 7, tk = (c >> 1) & 63, hf = c & 1;
        const u32x4 v = *(const u32x4*)(a.U + ((size_t)(nglob0 + n) * 64 + tk) * 256 + g * 16 + hf * 8);
        *(HY_LAS u32x4*)(L + S5L_U + n * S5_UP + tk * 32 + hf * 16) = v;
    }
#pragma unroll
    for (int i = 0; i < 4; ++i) {
        const int c = tid + i * 512;
        const u32x4 v = *(const u32x4*)(a.KMl + (size_t)g * 16384 + c * 8);
        *(HY_LAS u32x4*)(L + S5L_KM + 512 + c * 16) = v;
    }
    if (tid < 32) { unsigned zz = 0u; asm volatile("" : "+v"(zz)); *(HY_LAS u32x4*)(L + S5L_KM + tid * 16) = (u32x4){zz, zz, zz, zz}; }
    if (wave == 0 && a.var != 2) {
        const int p = lane, lgp = (a.layer * 16 + g) * 64 + p;
        const float2 lam = *(const float2*)(a.LP + ((size_t)lgp * 65 + 64) * 2);
        float xr = 0.f, xi = 0.f;
        const float* ep = a.E + ((size_t)(b * 128) * 16 + g) * 128 + p;
        for (int nb = 0; nb < n0 + 32; nb += 16) {
            float er[16], ei[16];
#pragma unroll
            for (int j = 0; j < 16; ++j) { er[j] = ep[(size_t)(nb + j) * 2048]; ei[j] = ep[(size_t)(nb + j) * 2048 + 64]; }
#pragma unroll
            for (int j = 0; j < 16; ++j) {
                const int n = nb + j;
                if (n >= n0) {
                    *(HY_LAS bf16_t*)(L + S5L_X + (n - n0) * S5L_XP + p * 2) = f2bf(xr);
                    *(HY_LAS bf16_t*)(L + S5L_X + (n - n0) * S5L_XP + (64 + p) * 2) = f2bf(xi);
                }
                const float nr = lam.x * xr - lam.y * xi + er[j], ni = lam.x * xi + lam.y * xr + ei[j];
                xr = nr; xi = ni;
            }
        }
    }
    __syncthreads();
    const float dsk0 = 0.f; (void)dsk0;
#pragma unroll 1
    for (int q = 0; q < 4; ++q) {
        const int mt = q == 0 ? wave : (q == 1 ? 15 - wave : (q == 2 ? 16 + wave : 31 - wave));
        f32x16 acc;
#pragma unroll
        for (int r = 0; r < 16; ++r) acc[r] = 0.f;
        {
            const bf16_t* wp = a.WCl + ((size_t)g * 1024 + mt * 32 + r32) * 128 + hi * 8;
#pragma unroll
            for (int s = 0; s < 8; ++s) {
                const bf16x8 af = *(const bf16x8*)(wp + s * 16);
                const bf16x8 bf = *(const HY_LAS bf16x8*)(L + S5L_X + r32 * S5L_XP + s * 32 + hi * 16);
                acc = __builtin_amdgcn_mfma_f32_32x32x16_bf16(af, bf, acc, 0, 0, 0);
            }
        }
        const int iend = (a.var == 1) ? 0 : 2 * mt + 2;
#pragma unroll 4
        for (int i = 0; i < iend; ++i) {
            const bf16x8 af = *(const HY_LAS bf16x8*)(L + S5L_KM + 512 + (2 * mt - i) * 512 + r32 * 32 + hi * 16);
            const bf16x8 bf = *(const HY_LAS bf16x8*)(L + S5L_U + r32 * S5_UP + i * 32 + hi * 16);
            acc = __builtin_amdgcn_mfma_f32_32x32x16_bf16(af, bf, acc, 0, 0, 0);
        }
#pragma unroll
        for (int q4 = 0; q4 < 4; ++q4) {
            const int j = 2 * mt + (q4 >> 1), c0 = 8 * (q4 & 1) + 4 * hi;
            const u32x2 uu = *(const HY_LAS u32x2*)(L + S5L_U + r32 * S5_UP + j * 32 + c0 * 2);
            const f32x4 dd = *(const f32x4*)(a.dskip + g * 16 + c0);
            const float y0 = acc[4 * q4] + dd[0] * lo16(uu.x), y1 = acc[4 * q4 + 1] + dd[1] * hi16(uu.x), y2 = acc[4 * q4 + 2] + dd[2] * lo16(uu.y), y3 = acc[4 * q4 + 3] + dd[3] * hi16(uu.y);
            u32x2 w; w.x = pk2(gelu_tanh(y0), gelu_tanh(y1)); w.y = pk2(gelu_tanh(y2), gelu_tanh(y3));
            *(u32x2*)(a.GS + ((size_t)(nglob0 + r32) * 64 + j) * 256 + g * 16 + c0) = w;
        }
    }
}
}
namespace hy {
struct MixQ { const bf16_t *QM, *KM, *VM, *QA, *KA, *VA; const float* bias; bf16_t *YC, *YAB; float* MLB; S5U s5; unsigned* counter; int lo, hi; const float* bnd; int var; };
__device__ __forceinline__ void ph_mixers(const Ctx& C, const MixQ& p) {
    HY_LAS int* slot = (HY_LAS int*)((HY_LAS unsigned char*)C.lds + LDS_BYTES - 64);
    constexpr int N_MLA = 384, N_S5 = 128, N_SWA = 1152, TOTAL = N_S5 + N_MLA + N_SWA;
    int nxt = 0;
    if (C.tid == 0) nxt = (int)atomicAdd(p.counter, 1u);
    for (;;) {
        if (C.tid == 0) *slot = nxt;
        __syncthreads();
        const int it = *slot + p.lo;
        __syncthreads();
        if (it >= (p.hi < TOTAL ? p.hi : TOTAL)) break;
        const bool ahead = it >= N_MLA && it < TOTAL - 256;
        if (ahead && C.tid == 0) nxt = (int)atomicAdd(p.counter, 1u);
        if (it >= N_MLA && it < N_MLA + N_S5) s5_unit(C, p.s5, it - N_MLA);
        else if (it < N_MLA) {
            const int i = it, qb = 31 - i / 12, bh = i % 12, b = bh / 6, h = bh % 6;
            AttnArgs a;
            a.Q = p.QM + h * 96; a.K = p.KM + h * 96; a.V = p.VM + h * 64; a.qpitch = 576; a.kpitch = 576; a.vpitch = 384;
            a.q_row0 = (long)b * S + qb * 256; a.q_rstride = 1; a.k_row0 = (long)b * S; a.k_rstride = 1; a.q_idx0 = qb * 256;
            a.t_begin = 0; a.t_end = (qb + 1) * 4; a.bias = nullptr; a.O = p.YC + h * 64; a.opitch = 384; a.ML = nullptr; a.mlpitch = 0; a.safe = p.bnd[0] < 64.f;
            if (p.var == 0) mla_unit2(C, a);
#if HY_PROBE == 21
            else attn_unit<0, 1>(C, a);
#elif HY_PROBE == 22
            else attn_unit<0, 2>(C, a);
#endif
        } else {
            const int i = it - N_S5 - N_MLA, bh = i / 96, u = i % 96, b = bh / 6, h = bh % 6;
            int br, r, qbk, dil;
            if (u < 32) { br = 0; dil = 1; r = 0; qbk = u; }
            else if (u < 64) { br = 1; dil = 4; r = (u - 32) >> 3; qbk = (u - 32) & 7; }
            else { br = 2; dil = 16; r = (u - 64) >> 1; qbk = (u - 64) & 1; }
            const int m0 = qbk * 256;
            AttnArgs a;
            a.Q = p.QA + h * 64; a.K = p.KA + h * 64; a.V = p.VA + h * 64; a.qpitch = 384; a.kpitch = 384; a.vpitch = 384;
            a.q_row0 = (long)b * S + r + (long)m0 * dil; a.q_rstride = dil; a.k_row0 = (long)b * S + r; a.k_rstride = dil; a.q_idx0 = m0;
            a.t_begin = m0 >= 128 ? (m0 - 128) >> 6 : 0; a.t_end = (m0 + 256) >> 6; a.bias = p.bias + (br * 6 + h) * 132;
            a.O = p.YAB + (size_t)br * M * 384 + h * 64; a.opitch = 384; a.ML = p.MLB + ((size_t)br * M * 6 + h) * 2; a.mlpitch = 12; a.safe = p.bnd[1] < 64.f;
            swa_unit_pair(C, a);
        }
        if (!ahead && C.tid == 0) nxt = (int)atomicAdd(p.counter, 1u);
    }
}
struct MergeIn { u32x4 y0, y1, y2, gs, gl, yc; float2 a0, a1, a2; };
template <bool S5 = true>
__device__ __forceinline__ void merge_load(MergeIn& d, int lane, size_t m, const bf16_t* YAB, const float* MLB, const bf16_t* GS, const bf16_t* GL, const bf16_t* YC) {
    if (lane < 48) {
        const int j = lane >> 3;
        d.y0 = *(const u32x4*)(YAB + ((size_t)0 * M + m) * 384 + lane * 8); d.y1 = *(const u32x4*)(YAB + ((size_t)1 * M + m) * 384 + lane * 8); d.y2 = *(const u32x4*)(YAB + ((size_t)2 * M + m) * 384 + lane * 8);
        d.a0 = *(const float2*)(MLB + ((size_t)0 * M + m) * 12 + j * 2); d.a1 = *(const float2*)(MLB + ((size_t)1 * M + m) * 12 + j * 2); d.a2 = *(const float2*)(MLB + ((size_t)2 * M + m) * 12 + j * 2);
        d.yc = *(const u32x4*)(YC + m * 384 + lane * 8);
    }
    if (S5 && lane >= 32) { d.gs = *(const u32x4*)(GS + m * 256 + (lane - 32) * 8); d.gl = *(const u32x4*)(GL + m * 256 + (lane - 32) * 8); }
}
template <bool S5 = true>
__device__ __forceinline__ void merge_token(const MergeIn& d, int lane, size_t m, const float (&bg)[8], bf16_t* AOUT) {
    float va[8], vs[8], vc[8]; float sa = 0.f, sg = 0.f, sc = 0.f;
    if (lane < 48) {
        const float mm = fmaxf(d.a0.x, fmaxf(d.a1.x, d.a2.x));
        const float w0 = exp2f(d.a0.x - mm) * d.a0.y, w1 = exp2f(d.a1.x - mm) * d.a1.y, w2 = exp2f(d.a2.x - mm) * d.a2.y;
        const float iw = 1.f / (w0 + w1 + w2);
#pragma unroll
        for (int k = 0; k < 4; ++k) {
            va[2 * k] = (w0 * lo16(d.y0[k]) + w1 * lo16(d.y1[k]) + w2 * lo16(d.y2[k])) * iw; va[2 * k + 1] = (w0 * hi16(d.y0[k]) + w1 * hi16(d.y1[k]) + w2 * hi16(d.y2[k])) * iw;
            vc[2 * k] = lo16(d.yc[k]); vc[2 * k + 1] = hi16(d.yc[k]);
            sa += va[2 * k] * va[2 * k] + va[2 * k + 1] * va[2 * k + 1]; sc += vc[2 * k] * vc[2 * k] + vc[2 * k + 1] * vc[2 * k + 1];
        }
    }
    if (S5 && lane >= 32) {
#pragma unroll
        for (int k = 0; k < 4; ++k) {
            const float z0 = lo16(d.gl[k]) + bg[2 * k], z1 = hi16(d.gl[k]) + bg[2 * k + 1];
            vs[2 * k] = lo16(d.gs[k]) / (1.f + __expf(-z0)); vs[2 * k + 1] = hi16(d.gs[k]) / (1.f + __expf(-z1));
            sg += vs[2 * k] * vs[2 * k] + vs[2 * k + 1] * vs[2 * k + 1];
        }
    }
    sa = wave_sum(sa); if (S5) sg = wave_sum(sg); sc = wave_sum(sc);
    const float ra = rsqrtf(sa * (1.f / 384.f) + EPS), rg = rsqrtf(sg * (1.f / 256.f) + EPS), rc = rsqrtf(sc * (1.f / 384.f) + EPS);
    if (lane < 48) {
        u32x4 w;
        w.x = pk2(va[0] * ra, va[1] * ra); w.y = pk2(va[2] * ra, va[3] * ra); w.z = pk2(va[4] * ra, va[5] * ra); w.w = pk2(va[6] * ra, va[7] * ra);
        *(u32x4*)(AOUT + m * D + lane * 8) = w;
        w.x = pk2(vc[0] * rc, vc[1] * rc); w.y = pk2(vc[2] * rc, vc[3] * rc); w.z = pk2(vc[4] * rc, vc[5] * rc); w.w = pk2(vc[6] * rc, vc[7] * rc);
        *(u32x4*)(AOUT + m * D + 640 + lane * 8) = w;
    }
    if (S5 && lane >= 32) {
        u32x4 w;
        w.x = pk2(vs[0] * rg, vs[1] * rg); w.y = pk2(vs[2] * rg, vs[3] * rg); w.z = pk2(vs[4] * rg, vs[5] * rg); w.w = pk2(vs[6] * rg, vs[7] * rg);
        *(u32x4*)(AOUT + m * D + 384 + (lane - 32) * 8) = w;
    }
}
__device__ __forceinline__ void ph_merge2(const Ctx& C, const bf16_t* YAB, const float* MLB, const bf16_t* GS, const bf16_t* GL, const float* b_glu, const bf16_t* YC, bf16_t* AOUT) {
    const int lane = C.lane;
    float bg[8];
    { const int c = lane >= 32 ? (lane - 32) * 8 : 0; const f32x4 b0 = *(const f32x4*)(b_glu + c), b1 = *(const f32x4*)(b_glu + c + 4);
#pragma unroll
      for (int k = 0; k < 4; ++k) { bg[k] = b0[k]; bg[4 + k] = b1[k]; } }
    const size_t stride = (size_t)C.nblk * 8;
    for (size_t m = (size_t)C.bid * 8 + C.wave; m < M; m += 2 * stride) {
        MergeIn d0, d1;
        merge_load(d0, lane, m, YAB, MLB, GS, GL, YC);
        const bool two = m + stride < M;
        if (two) merge_load(d1, lane, m + stride, YAB, MLB, GS, GL, YC);
        merge_token(d0, lane, m, bg, AOUT);
        if (two) merge_token(d1, lane, m + stride, bg, AOUT);
    }
}
constexpr int MG_P = 528, MG_SS = 64 * MG_P;
__device__ __forceinline__ void ph_merge3(const Ctx& C, const bf16_t* YAB, const float* MLB, const bf16_t* GS, const bf16_t* WG, const float* b_glu, const bf16_t* YC, bf16_t* AOUT) {
    HY_LAS unsigned char* L = (HY_LAS unsigned char*)C.lds;
    const int tid = C.tid, lane = C.lane, wave = C.wave, r32 = lane & 31, hi = lane >> 5;
    float bg[8];
#pragma unroll
    for (int k = 0; k < 8; ++k) bg[k] = 0.f;
    for (int u = C.bid; u < M / 64; u += C.nblk) {
        const size_t m0 = (size_t)u * 64;
        __syncthreads();
#pragma unroll
        for (int i = 0; i < 4; ++i) {
            const int c = tid + i * 512, row = c >> 5, cc = c & 31;
            const u32x4 v = *(const u32x4*)(GS + (m0 + row) * 256 + cc * 8);
            *(HY_LAS u32x4*)(L + row * MG_P + cc * 16) = v;
        }
        bf16x8 wf[16];
        { const bf16_t* wp = WG + (size_t)(wave * 32 + r32) * 256 + hi * 8;
#pragma unroll
          for (int s = 0; s < 16; ++s) wf[s] = *(const bf16x8*)(wp + s * 16); }
        MergeIn d0, d1;
        const size_t mw = m0 + wave * 8;
        merge_load<false>(d0, lane, mw, YAB, MLB, GS, GS, YC);
        merge_load<false>(d1, lane, mw + 1, YAB, MLB, GS, GS, YC);
        __syncthreads();
        f32x16 acc0, acc1;
#pragma unroll
        for (int r = 0; r < 16; ++r) { acc0[r] = 0.f; acc1[r] = 0.f; }
#pragma unroll
        for (int s = 0; s < 16; ++s) {
            const bf16x8 b0 = *(const HY_LAS bf16x8*)(L + r32 * MG_P + s * 32 + hi * 16);
            const bf16x8 b1 = *(const HY_LAS bf16x8*)(L + (32 + r32) * MG_P + s * 32 + hi * 16);
            acc0 = __builtin_amdgcn_mfma_f32_32x32x16_bf16(wf[s], b0, acc0, 0, 0, 0);
            acc1 = __builtin_amdgcn_mfma_f32_32x32x16_bf16(wf[s], b1, acc1, 0, 0, 0);
        }
        float ss0 = 0.f, ss1 = 0.f;
#pragma unroll
        for (int q = 0; q < 4; ++q) {
            const int n0 = wave * 32 + 8 * q + 4 * hi;
            const f32x4 bb = *(const f32x4*)(b_glu + n0);
            const u32x2 g0 = *(const HY_LAS u32x2*)(L + r32 * MG_P + n0 * 2), g1 = *(const HY_LAS u32x2*)(L + (32 + r32) * MG_P + n0 * 2);
            const float ga[4] = {lo16(g0.x), hi16(g0.x), lo16(g0.y), hi16(g0.y)}, gb[4] = {lo16(g1.x), hi16(g1.x), lo16(g1.y), hi16(g1.y)};
#pragma unroll
            for (int i = 0; i < 4; ++i) {
                const float va = ga[i] / (1.f + __expf(-(acc0[4 * q + i] + bb[i]))), vb = gb[i] / (1.f + __expf(-(acc1[4 * q + i] + bb[i])));
                acc0[4 * q + i] = va; acc1[4 * q + i] = vb; ss0 += va * va; ss1 += vb * vb;
            }
        }
        ss0 += __shfl_xor(ss0, 32); ss1 += __shfl_xor(ss1, 32);
        if (hi == 0) { *(HY_LAS float*)(L + MG_SS + (wave * 64 + r32) * 4) = ss0; *(HY_LAS float*)(L + MG_SS + (wave * 64 + 32 + r32) * 4) = ss1; }
        __syncthreads();
        float t0 = 0.f, t1 = 0.f;
#pragma unroll
        for (int w = 0; w < 8; ++w) { t0 += *(const HY_LAS float*)(L + MG_SS + (w * 64 + r32) * 4); t1 += *(const HY_LAS float*)(L + MG_SS + (w * 64 + 32 + r32) * 4); }
        const float r0 = rsqrtf(t0 * (1.f / 256.f) + EPS), r1 = rsqrtf(t1 * (1.f / 256.f) + EPS);
#pragma unroll
        for (int q = 0; q < 4; ++q) {
            const int n0 = wave * 32 + 8 * q + 4 * hi;
            u32x2 w0, w1;
            w0.x = pk2(acc0[4 * q] * r0, acc0[4 * q + 1] * r0); w0.y = pk2(acc0[4 * q + 2] * r0, acc0[4 * q + 3] * r0);
            w1.x = pk2(acc1[4 * q] * r1, acc1[4 * q + 1] * r1); w1.y = pk2(acc1[4 * q + 2] * r1, acc1[4 * q + 3] * r1);
            *(u32x2*)(AOUT + (m0 + r32) * D + 384 + n0) = w0; *(u32x2*)(AOUT + (m0 + 32 + r32) * D + 384 + n0) = w1;
        }
        merge_token<false>(d0, lane, mw, bg, AOUT);
        merge_token<false>(d1, lane, mw + 1, bg, AOUT);
#pragma unroll 1
        for (int t = 2; t < 8; t += 2) {
            merge_load<false>(d0, lane, mw + t, YAB, MLB, GS, GS, YC);
            merge_load<false>(d1, lane, mw + t + 1, YAB, MLB, GS, GS, YC);
            merge_token<false>(d0, lane, mw + t, bg, AOUT);
            merge_token<false>(d1, lane, mw + t + 1, bg, AOUT);
        }
    }
}
}
namespace hy {
#define HY_CE(a, b) { const int _mx = max(a, b), _mn = min(a, b); a = _mx; b = _mn; }
__device__ __forceinline__ void sort16_desc(int (&v)[16]) {
    HY_CE(v[0], v[13]); HY_CE(v[1], v[12]); HY_CE(v[2], v[15]); HY_CE(v[3], v[14]); HY_CE(v[4], v[8]); HY_CE(v[5], v[6]); HY_CE(v[7], v[11]); HY_CE(v[9], v[10]);
    HY_CE(v[0], v[5]); HY_CE(v[1], v[7]); HY_CE(v[2], v[9]); HY_CE(v[3], v[4]); HY_CE(v[6], v[13]); HY_CE(v[8], v[14]); HY_CE(v[10], v[15]); HY_CE(v[11], v[12]);
    HY_CE(v[0], v[1]); HY_CE(v[2], v[3]); HY_CE(v[4], v[5]); HY_CE(v[6], v[8]); HY_CE(v[7], v[9]); HY_CE(v[10], v[11]); HY_CE(v[12], v[13]); HY_CE(v[14], v[15]);
    HY_CE(v[0], v[2]); HY_CE(v[1], v[3]); HY_CE(v[4], v[10]); HY_CE(v[5], v[11]); HY_CE(v[6], v[7]); HY_CE(v[8], v[9]); HY_CE(v[12], v[14]); HY_CE(v[13], v[15]);
    HY_CE(v[1], v[2]); HY_CE(v[3], v[12]); HY_CE(v[4], v[6]); HY_CE(v[5], v[7]); HY_CE(v[8], v[10]); HY_CE(v[9], v[11]); HY_CE(v[13], v[14]);
    HY_CE(v[1], v[4]); HY_CE(v[2], v[6]); HY_CE(v[5], v[8]); HY_CE(v[7], v[10]); HY_CE(v[9], v[13]); HY_CE(v[11], v[14]);
    HY_CE(v[2], v[4]); HY_CE(v[3], v[6]); HY_CE(v[9], v[12]); HY_CE(v[11], v[13]);
    HY_CE(v[3], v[5]); HY_CE(v[6], v[8]); HY_CE(v[7], v[9]); HY_CE(v[10], v[12]);
    HY_CE(v[3], v[4]); HY_CE(v[5], v[6]); HY_CE(v[7], v[8]); HY_CE(v[9], v[10]); HY_CE(v[11], v[12]);
    HY_CE(v[6], v[7]); HY_CE(v[8], v[9]);
}
__device__ __forceinline__ void bitonic_merge16_desc(int (&v)[16]) {
#pragma unroll
    for (int j = 8; j > 0; j >>= 1)
#pragma unroll
        for (int i = 0; i < 16; ++i) { if ((i & j) == 0) { HY_CE(v[i], v[i | j]); } }
}
__device__ __forceinline__ void merge_top16(int (&a)[16], const int (&b)[16]) {
#pragma unroll
    for (int i = 0; i < 16; ++i) a[i] = max(a[i], b[15 - i]);
    bitonic_merge16_desc(a);
}
__device__ __forceinline__ int f2ord(float f) { const int b = __float_as_int(f); return b ^ ((b >> 31) & 0x7fffffff); }
__device__ __forceinline__ float ord2f(int s) { return __int_as_float(s ^ ((s >> 31) & 0x7fffffff)); }
__device__ __forceinline__ int xlane32(int v) { return __shfl_xor(v, 32); }

constexpr int PA_SKP = 272;
constexpr int PA_TILE = 128 * PA_SKP;

__device__ __forceinline__ void top16_of_scores(const f32x16 (&acc)[4], int hi, int (&out)[16]) {
    int g[16];
#pragma unroll
    for (int mt = 0; mt < 4; ++mt) {
#pragma unroll
        for (int r = 0; r < 16; ++r) { const int key = 32 * mt + (r & 3) + 8 * (r >> 2) + 4 * hi; g[r] = (f2ord(acc[mt][r]) & ~127) | key; }
        sort16_desc(g);
        if (mt == 0) {
#pragma unroll
            for (int r = 0; r < 16; ++r) out[r] = g[r];
        } else merge_top16(out, g);
    }
    int pb[16];
#pragma unroll
    for (int r = 0; r < 16; ++r) pb[r] = xlane32(out[r]);
    merge_top16(out, pb);
}

__device__ __forceinline__ void ph_peer_topk(const Ctx& C, const bf16_t* QP, const bf16_t* SUBK, int* EIDX, float* GATE) {
    HY_LAS unsigned char* L = (HY_LAS unsigned char*)C.lds;
    const int tid = C.tid, lane = C.lane, wave = C.wave, r32 = lane & 31, hi = lane >> 5;
    int staged = -1;
    for (int unit = C.bid; unit < 64 * 8; unit += C.nblk) {
        const int tt = unit >> 3, h = unit & 7;
        const size_t m = (size_t)tt * 256 + wave * 32 + r32;
        if (h != staged) {
            __syncthreads();
#pragma unroll
            for (int i = 0; i < 8; ++i) {
                const int c = tid + i * 512, j = c >> 11, row = (c >> 4) & 127, ch = c & 15;
                const u32x4 v = *(const u32x4*)(SUBK + ((size_t)(h * 2 + j) * 128 + row) * 128 + ch * 8);
                *(HY_LAS u32x4*)(L + j * PA_TILE + row * PA_SKP + ch * 16) = v;
            }
            __syncthreads();
            staged = h;
        }
        int s1[16], s2[16];
#pragma unroll
        for (int j = 0; j < 2; ++j) {
            f32x16 acc[4];
#pragma unroll
            for (int mt = 0; mt < 4; ++mt)
#pragma unroll
                for (int r = 0; r < 16; ++r) acc[mt][r] = 0.f;
            const bf16_t* qp = QP + m * 2048 + (h * 2 + j) * 128 + hi * 8;
#pragma unroll
            for (int s = 0; s < 8; ++s) {
                const bf16x8 qf = *(const bf16x8*)(qp + s * 16);
#pragma unroll
                for (int mt = 0; mt < 4; ++mt) {
                    const bf16x8 kf = *(const HY_LAS bf16x8*)(L + j * PA_TILE + (mt * 32 + r32) * PA_SKP + s * 32 + hi * 16);
                    acc[mt] = __builtin_amdgcn_mfma_f32_32x32x16_bf16(kf, qf, acc[mt], 0, 0, 0);
                }
            }
            if (j == 0) top16_of_scores(acc, hi, s1); else top16_of_scores(acc, hi, s2);
        }
        float x[16], y[16];
#pragma unroll
        for (int r = 0; r < 16; ++r) { const int xs = hi ? s2[r] : s1[r], ys = hi ? s1[r] : s2[r]; x[r] = ord2f(xs & ~127); y[r] = ord2f(ys & ~127); }
        int ca[16], cb[16];
        {
            int n = 0;
#pragma unroll
            for (int a = 0; a < 16; ++a)
#pragma unroll
                for (int b = a; b < 16; ++b) {
                    if ((a + 1) * (b + 1) <= 16) {
                        const float sum = x[a] + y[b];
                        const int id0 = a * 16 + b, id1 = b * 16 + a;
                        int key = (f2ord(sum) & ~255) | (hi ? id1 : id0);
                        if (a == b && hi) key = (int)0x80000000;
                        if (n < 16) ca[n] = key; else cb[n - 16] = key;
                        ++n;
                    }
                }
#pragma unroll
            for (int i = 27 - 16; i < 16; ++i) cb[i] = (int)0x80000000;
        }
        sort16_desc(ca); sort16_desc(cb); merge_top16(ca, cb);
        {
            int pb[16];
#pragma unroll
            for (int r = 0; r < 16; ++r) pb[r] = xlane32(ca[r]);
            merge_top16(ca, pb);
        }
        unsigned t1[4], t2[4];
#pragma unroll
        for (int q4 = 0; q4 < 4; ++q4) {
            t1[q4] = (unsigned)(s1[4 * q4] & 127) | ((unsigned)(s1[4 * q4 + 1] & 127) << 8) | ((unsigned)(s1[4 * q4 + 2] & 127) << 16) | ((unsigned)(s1[4 * q4 + 3] & 127) << 24);
            t2[q4] = (unsigned)(s2[4 * q4] & 127) | ((unsigned)(s2[4 * q4 + 1] & 127) << 8) | ((unsigned)(s2[4 * q4 + 2] & 127) << 16) | ((unsigned)(s2[4 * q4 + 3] & 127) << 24);
        }
        float e[16]; float sum = 0.f; const float mxv = ord2f(ca[0] & ~255);
#pragma unroll
        for (int r = 0; r < 16; ++r) { e[r] = __expf(ord2f(ca[r] & ~255) - mxv); sum += e[r]; }
        const float inv = 1.f / sum;
        int eo[8]; float go[8];
#pragma unroll
        for (int r = 0; r < 8; ++r) {
            const int cid = (hi ? ca[r + 8] : ca[r]) & 255, a = cid >> 4, b = cid & 15;
            const unsigned la = __builtin_amdgcn_perm(t1[1], t1[0], 0x0c0c0c00u | (a & 7)), ha = __builtin_amdgcn_perm(t1[3], t1[2], 0x0c0c0c00u | (a & 7));
            const unsigned lb = __builtin_amdgcn_perm(t2[1], t2[0], 0x0c0c0c00u | (b & 7)), hb = __builtin_amdgcn_perm(t2[3], t2[2], 0x0c0c0c00u | (b & 7));
            const unsigned i1 = (a & 8) ? ha : la, i2 = (b & 8) ? hb : lb;
            eo[r] = (int)(i1 * 128u + i2);
            go[r] = (hi ? e[r + 8] : e[r]) * inv;
        }
        int* ep = EIDX + m * 128 + h * 16 + hi * 8; float* gp = GATE + m * 128 + h * 16 + hi * 8;
        *(u32x4*)ep = (u32x4){(unsigned)eo[0], (unsigned)eo[1], (unsigned)eo[2], (unsigned)eo[3]}; *(u32x4*)(ep + 4) = (u32x4){(unsigned)eo[4], (unsigned)eo[5], (unsigned)eo[6], (unsigned)eo[7]};
        *(f32x4*)gp = (f32x4){go[0], go[1], go[2], go[3]}; *(f32x4*)(gp + 4) = (f32x4){go[4], go[5], go[6], go[7]};
    }
}
}
namespace hy {
typedef float f32x2 __attribute__((ext_vector_type(2)));
__device__ __forceinline__ void ph_cvt_fp4(const Ctx& C, const float* src, unsigned char* dst, float* scale, int nrows) {
    const int lane = C.lane;
    const int stride = C.nblk * 32;
    int row0 = (C.bid * 8 + C.wave) * 4;
    f32x4 v[4][4], w[4][4];
    if (row0 < nrows) {
#pragma unroll
        for (int rr = 0; rr < 4; ++rr)
#pragma unroll
            for (int j = 0; j < 4; ++j) v[rr][j] = __builtin_nontemporal_load((const f32x4*)(src + (size_t)(row0 + rr) * 1024 + j * 256 + lane * 4));
    }
    for (; row0 < nrows; row0 += stride) {
        const int nxt = row0 + stride;
        if (nxt < nrows) {
#pragma unroll
            for (int rr = 0; rr < 4; ++rr)
#pragma unroll
                for (int j = 0; j < 4; ++j) w[rr][j] = __builtin_nontemporal_load((const f32x4*)(src + (size_t)(nxt + rr) * 1024 + j * 256 + lane * 4));
        }
#pragma unroll
        for (int rr = 0; rr < 4; ++rr) {
            float am = 0.f;
#pragma unroll
            for (int j = 0; j < 4; ++j) am = fmaxf(am, fmaxf(fmaxf(fabsf(v[rr][j][0]), fabsf(v[rr][j][1])), fmaxf(fabsf(v[rr][j][2]), fabsf(v[rr][j][3]))));
#pragma unroll
            for (int o = 1; o < 64; o <<= 1) am = fmaxf(am, __shfl_xor(am, o));
            const float sc = am > 0.f ? am * (1.f / 6.f) : 1.f, inv = am > 0.f ? 6.f / am : 1.f;
            if (lane == 0) scale[row0 + rr] = sc;
#pragma unroll
            for (int j = 0; j < 4; ++j) {
                unsigned q = 0u;
                q = __builtin_amdgcn_cvt_scalef32_pk_fp4_f32(q, v[rr][j][0] * inv, v[rr][j][1] * inv, 1.0f, 0);
                q = __builtin_amdgcn_cvt_scalef32_pk_fp4_f32(q, v[rr][j][2] * inv, v[rr][j][3] * inv, 1.0f, 1);
                *(unsigned short*)(dst + (size_t)(row0 + rr) * 512 + j * 128 + lane * 2) = (unsigned short)q;
            }
        }
#pragma unroll
        for (int rr = 0; rr < 4; ++rr)
#pragma unroll
            for (int j = 0; j < 4; ++j) v[rr][j] = w[rr][j];
    }
}
__device__ __forceinline__ float dot16_fp4(const float (&h)[16], const u32x2 r) {
    float s = 0.f;
#pragma unroll
    for (int w = 0; w < 2; ++w) {
        const f32x2 a = __builtin_amdgcn_cvt_scalef32_pk_f32_fp4(r[w], 1.0f, 0), b = __builtin_amdgcn_cvt_scalef32_pk_f32_fp4(r[w], 1.0f, 1),
                    c = __builtin_amdgcn_cvt_scalef32_pk_f32_fp4(r[w], 1.0f, 2), d = __builtin_amdgcn_cvt_scalef32_pk_f32_fp4(r[w], 1.0f, 3);
        s += h[8 * w] * a[0] + h[8 * w + 1] * a[1] + h[8 * w + 2] * b[0] + h[8 * w + 3] * b[1] + h[8 * w + 4] * c[0] + h[8 * w + 5] * c[1] + h[8 * w + 6] * d[0] + h[8 * w + 7] * d[1];
    }
    return s;
}
__device__ __forceinline__ void axpy16_fp4(f32x2 (&acc2)[8], const float cf, const u32x2 r) {
    const f32x2 c2 = {cf, cf};
#pragma unroll
    for (int w = 0; w < 2; ++w) {
        acc2[4 * w] = __builtin_elementwise_fma(c2, __builtin_amdgcn_cvt_scalef32_pk_f32_fp4(r[w], 1.0f, 0), acc2[4 * w]);
        acc2[4 * w + 1] = __builtin_elementwise_fma(c2, __builtin_amdgcn_cvt_scalef32_pk_f32_fp4(r[w], 1.0f, 1), acc2[4 * w + 1]);
        acc2[4 * w + 2] = __builtin_elementwise_fma(c2, __builtin_amdgcn_cvt_scalef32_pk_f32_fp4(r[w], 1.0f, 2), acc2[4 * w + 2]);
        acc2[4 * w + 3] = __builtin_elementwise_fma(c2, __builtin_amdgcn_cvt_scalef32_pk_f32_fp4(r[w], 1.0f, 3), acc2[4 * w + 3]);
    }
}
__device__ __forceinline__ float dot32_fp4(const f32x2 (&h2)[16], const u32x4 r) {
    f32x2 s2 = {0.f, 0.f};
#pragma unroll
    for (int w = 0; w < 4; ++w) {
        s2 = __builtin_elementwise_fma(h2[4 * w], __builtin_amdgcn_cvt_scalef32_pk_f32_fp4(r[w], 1.0f, 0), s2);
        s2 = __builtin_elementwise_fma(h2[4 * w + 1], __builtin_amdgcn_cvt_scalef32_pk_f32_fp4(r[w], 1.0f, 1), s2);
        s2 = __builtin_elementwise_fma(h2[4 * w + 2], __builtin_amdgcn_cvt_scalef32_pk_f32_fp4(r[w], 1.0f, 2), s2);
        s2 = __builtin_elementwise_fma(h2[4 * w + 3], __builtin_amdgcn_cvt_scalef32_pk_f32_fp4(r[w], 1.0f, 3), s2);
    }
    return s2[0] + s2[1];
}
__device__ __forceinline__ void axpy32_fp4(float (&acc)[32], const float cf, const u32x4 r) {
#pragma unroll
    for (int w = 0; w < 4; ++w) {
        const f32x2 a = __builtin_amdgcn_cvt_scalef32_pk_f32_fp4(r[w], 1.0f, 0), b = __builtin_amdgcn_cvt_scalef32_pk_f32_fp4(r[w], 1.0f, 1),
                    c = __builtin_amdgcn_cvt_scalef32_pk_f32_fp4(r[w], 1.0f, 2), d = __builtin_amdgcn_cvt_scalef32_pk_f32_fp4(r[w], 1.0f, 3);
        acc[8 * w] += cf * a[0]; acc[8 * w + 1] += cf * a[1]; acc[8 * w + 2] += cf * b[0]; acc[8 * w + 3] += cf * b[1];
        acc[8 * w + 4] += cf * c[0]; acc[8 * w + 5] += cf * c[1]; acc[8 * w + 6] += cf * d[0]; acc[8 * w + 7] += cf * d[1];
    }
}
struct GatherP { bf16_t* H; const int* EIDX; const float* GATE; const unsigned char* U8; const float* SU; const unsigned char* V8; const float* SV; const float* g2; const bf16_t* xinb; float* xout; bf16_t* xoutb;
                 const float* SSX; const float* sh2;
                 const float* ngain; const float* nmod; int var; };
__device__ __forceinline__ void ph_peer_gather2(const Ctx& C, const GatherP& P) {
    HY_LAS float* coefL = (HY_LAS float*)((HY_LAS unsigned char*)C.lds) + C.wave * 128;
    const size_t mstep = (size_t)C.nblk * 8;
    size_t m = (size_t)C.bid * 8 + C.wave;
    int nidx0 = 0, nidx1 = 0, pidx0 = 0, pidx1 = 0; float nsu0 = 0.f, nsu1 = 0.f, ngv0 = 0.f, ngv1 = 0.f;
    if (m < M) {
        const int l0 = C.lane;
        nidx0 = P.EIDX[m * 128 + l0]; nidx1 = P.EIDX[m * 128 + 64 + l0];
        nsu0 = P.SU[nidx0]; nsu1 = P.SU[nidx1];
        ngv0 = P.GATE[m * 128 + l0] * P.SV[nidx0]; ngv1 = P.GATE[m * 128 + 64 + l0] * P.SV[nidx1];
        if (m + mstep < M) { pidx0 = P.EIDX[(m + mstep) * 128 + l0]; pidx1 = P.EIDX[(m + mstep) * 128 + 64 + l0]; }
    }
    for (; m < M; m += mstep) {
        unsigned ones_ = ~0u; asm volatile("" : "+s"(ones_));
        const int lane = (int)__builtin_amdgcn_mbcnt_hi(ones_, __builtin_amdgcn_mbcnt_lo(ones_, 0u));
        const int l31 = lane & 31, hh = lane >> 5;
        const int b4 = (lane >> 4) & 1, b3 = (lane >> 3) & 1, b2 = (lane >> 2) & 1, b1 = (lane >> 1) & 1;
        const int ie = 8 * b4 + 4 * b3 + 2 * b2 + b1;
        const int b = (int)(m >> 13);
        const int idx0 = nidx0, idx1 = nidx1; const float su0 = nsu0, su1 = nsu1, gv0 = ngv0, gv1 = ngv1;
        if (m + mstep < M) {
            const size_t mn = m + mstep;
            nidx0 = pidx0; nidx1 = pidx1;
            nsu0 = P.SU[nidx0]; nsu1 = P.SU[nidx1];
            ngv0 = P.GATE[mn * 128 + lane] * P.SV[nidx0]; ngv1 = P.GATE[mn * 128 + 64 + lane] * P.SV[nidx1];
            if (mn + mstep < M) { pidx0 = P.EIDX[(mn + mstep) * 128 + lane]; pidx1 = P.EIDX[(mn + mstep) * 128 + 64 + lane]; }
        }
        {
            f32x2 h[16];
            {
                const bf16_t* hp = P.H + m * D + l31 * 32;
                const f32x4 s0 = *(const f32x4*)(P.SSX + m * 16), s1 = *(const f32x4*)(P.SSX + m * 16 + 4), s2 = *(const f32x4*)(P.SSX + m * 16 + 8), s3 = *(const f32x4*)(P.SSX + m * 16 + 12);
                const float tot = (((s0[0] + s0[1]) + (s0[2] + s0[3])) + ((s1[0] + s1[1]) + (s1[2] + s1[3]))) + (((s2[0] + s2[1]) + (s2[2] + s2[3])) + ((s3[0] + s3[1]) + (s3[2] + s3[3])));
                const float r = rsqrtf(tot * (1.f / D) + EPS);
                const float* sh = P.sh2 + b * MODW + l31 * 32;
#pragma unroll
                for (int q = 0; q < 4; ++q) {
                    const u32x4 a = *(const u32x4*)(hp + q * 8); const f32x4 sa = *(const f32x4*)(sh + q * 8), sb = *(const f32x4*)(sh + q * 8 + 4);
                    h[q * 4] = (f32x2){lo16(a.x) * r + sa[0], hi16(a.x) * r + sa[1]}; h[q * 4 + 1] = (f32x2){lo16(a.y) * r + sa[2], hi16(a.y) * r + sa[3]};
                    h[q * 4 + 2] = (f32x2){lo16(a.z) * r + sb[0], hi16(a.z) * r + sb[1]}; h[q * 4 + 3] = (f32x2){lo16(a.w) * r + sb[2], hi16(a.w) * r + sb[3]};
                }
            }
#pragma unroll 1
            for (int bt = 0; bt < (P.var == 1 ? 0 : 4); ++bt) {
                const int idxv = bt < 2 ? idx0 : idx1;
                u32x4 rows[16];
#pragma unroll
                for (int i = 0; i < 16; ++i) {
                    const int e = __builtin_amdgcn_ds_bpermute(((bt & 1) * 32 + 2 * i + hh) * 4, idxv);
                    rows[i] = *(const u32x4*)(P.U8 + (unsigned)(e * 512 + l31 * 16));
                }
                float p[16];
#pragma unroll
                for (int i = 0; i < 16; ++i) { asm volatile("" : "+v"(rows[i]));
                    p[i] = dot32_fp4(h, rows[i]); }
                float q8[8], q4[4], q2[2];
#pragma unroll
                for (int i = 0; i < 8; ++i) { const float snd = b4 ? p[i] : p[i + 8], kp = b4 ? p[i + 8] : p[i]; q8[i] = kp + __shfl_xor(snd, 16); }
#pragma unroll
                for (int i = 0; i < 4; ++i) { const float snd = b3 ? q8[i] : q8[i + 4], kp = b3 ? q8[i + 4] : q8[i]; q4[i] = kp + __shfl_xor(snd, 8); }
#pragma unroll
                for (int i = 0; i < 2; ++i) { const float snd = b2 ? q4[i] : q4[i + 2], kp = b2 ? q4[i + 2] : q4[i]; q2[i] = kp + __shfl_xor(snd, 4); }
                float tot; { const float snd = b1 ? q2[0] : q2[1], kp = b1 ? q2[1] : q2[0]; tot = kp + __shfl_xor(snd, 2); }
                tot += __shfl_xor(tot, 1);
                const int kk = (bt & 1) * 32 + 2 * ie + hh;
                const float suk = __int_as_float(__builtin_amdgcn_ds_bpermute(kk * 4, __float_as_int(bt < 2 ? su0 : su1)));
                const float gvk = __int_as_float(__builtin_amdgcn_ds_bpermute(kk * 4, __float_as_int(bt < 2 ? gv0 : gv1)));
                const float cf = gvk * gelu_tanh(tot * suk);
                if ((lane & 1) == 0) coefL[bt * 32 + 2 * ie + hh] = cf;
            }
        }
        f32x2 acc2[8];
#pragma unroll
        for (int i = 0; i < 8; ++i) acc2[i] = (f32x2){0.f, 0.f};
#pragma unroll 1
        for (int bt = 0; bt < (P.var == 2 ? 0 : 4); ++bt) {
            const int idxv = bt < 2 ? idx0 : idx1;
            u32x2 rows[32];
#pragma unroll
            for (int i = 0; i < 32; ++i) {
                const int e = __builtin_amdgcn_ds_bpermute(((bt & 1) * 32 + i) * 4, idxv);
                rows[i] = *(const u32x2*)(P.V8 + (unsigned)(e * 512 + lane * 8));
            }
#pragma unroll
            for (int i = 0; i < 32; ++i) { asm volatile("" : "+v"(rows[i])); axpy16_fp4(acc2, coefL[bt * 32 + i], rows[i]); }
        }
        float acc[16];
#pragma unroll
        for (int i = 0; i < 8; ++i) { acc[2 * i] = acc2[i][0]; acc[2 * i + 1] = acc2[i][1]; }
        int le = lane; asm volatile("" : "+v"(le));
        const float* g = P.g2 + b * MODW + le * 16;
        float ss = 0.f;
        {
            const u32x4 xa = *(const u32x4*)(P.xinb + m * D + le * 16), xb = *(const u32x4*)(P.xinb + m * D + le * 16 + 8);
            const float xi[16] = {lo16(xa.x), hi16(xa.x), lo16(xa.y), hi16(xa.y), lo16(xa.z), hi16(xa.z), lo16(xa.w), hi16(xa.w), lo16(xb.x), hi16(xb.x), lo16(xb.y), hi16(xb.y), lo16(xb.z), hi16(xb.z), lo16(xb.w), hi16(xb.w)};
#pragma unroll
            for (int q4i = 0; q4i < 4; ++q4i) {
                const f32x4 gg = *(const f32x4*)(g + q4i * 4);
#pragma unroll
                for (int e = 0; e < 4; ++e) { const float o = xi[q4i * 4 + e] + gg[e] * acc[q4i * 4 + e]; acc[q4i * 4 + e] = o; ss += o * o; }
            }
            if (P.xoutb) {
                *(u32x4*)(P.xoutb + m * D + le * 16) = (u32x4){pk2(acc[0], acc[1]), pk2(acc[2], acc[3]), pk2(acc[4], acc[5]), pk2(acc[6], acc[7])};
                *(u32x4*)(P.xoutb + m * D + le * 16 + 8) = (u32x4){pk2(acc[8], acc[9]), pk2(acc[10], acc[11]), pk2(acc[12], acc[13]), pk2(acc[14], acc[15])};
            } else {
#pragma unroll
                for (int q4i = 0; q4i < 4; ++q4i) *(f32x4*)(P.xout + m * D + le * 16 + q4i * 4) = (f32x4){acc[q4i * 4], acc[q4i * 4 + 1], acc[q4i * 4 + 2], acc[q4i * 4 + 3]};
            }
        }
        if (P.ngain) {
            const float r1 = rsqrtf(wave_sum(ss) * (1.f / D) + EPS);
            const float* gn = P.ngain + le * 16; const float* shn = P.nmod + b * MODW + le * 16; const float* scn = P.nmod + b * MODW + D + le * 16;
            unsigned w[8];
#pragma unroll
            for (int q4i = 0; q4i < 4; ++q4i) {
                const f32x4 g4 = *(const f32x4*)(gn + q4i * 4), s4 = *(const f32x4*)(scn + q4i * 4), h4 = *(const f32x4*)(shn + q4i * 4);
                float o[4];
#pragma unroll
                for (int e = 0; e < 4; ++e) o[e] = acc[q4i * 4 + e] * r1 * g4[e] * (1.f + s4[e]) + h4[e];
                w[q4i * 2] = pk2(o[0], o[1]); w[q4i * 2 + 1] = pk2(o[2], o[3]);
            }
            *(u32x4*)(P.H + m * D + le * 16) = (u32x4){w[0], w[1], w[2], w[3]}; *(u32x4*)(P.H + m * D + le * 16 + 8) = (u32x4){w[4], w[5], w[6], w[7]};
        }
    }
}
__device__ __forceinline__ void ph_peer_gather4(const Ctx& C, const GatherP& P) {
    HY_LAS float* coefL = (HY_LAS float*)((HY_LAS unsigned char*)C.lds) + C.wave * 128;
    const size_t mstep = (size_t)C.nblk * 8;
    size_t m = (size_t)C.bid * 8 + C.wave;
    int nidx0 = 0, nidx1 = 0, pidx0 = 0, pidx1 = 0; float nsu0 = 0.f, nsu1 = 0.f, ngv0 = 0.f, ngv1 = 0.f;
    if (m < M) {
        const int l0 = C.lane;
        nidx0 = P.EIDX[m * 128 + l0]; nidx1 = P.EIDX[m * 128 + 64 + l0];
        nsu0 = P.SU[nidx0]; nsu1 = P.SU[nidx1];
        ngv0 = P.GATE[m * 128 + l0] * P.SV[nidx0]; ngv1 = P.GATE[m * 128 + 64 + l0] * P.SV[nidx1];
        if (m + mstep < M) { pidx0 = P.EIDX[(m + mstep) * 128 + l0]; pidx1 = P.EIDX[(m + mstep) * 128 + 64 + l0]; }
    }
    u32x4 hpre[4]; f32x4 spre[4];
    if (m < M) {
        const bf16_t* hp0 = P.H + m * D + (C.lane & 31) * 32;
#pragma unroll
        for (int q = 0; q < 4; ++q) { hpre[q] = *(const u32x4*)(hp0 + q * 8); spre[q] = *(const f32x4*)(P.SSX + m * 16 + q * 4); }
    }
    for (; m < M; m += mstep) {
        unsigned ones_ = ~0u; asm volatile("" : "+s"(ones_));
        const int lane = (int)__builtin_amdgcn_mbcnt_hi(ones_, __builtin_amdgcn_mbcnt_lo(ones_, 0u));
        const int l31 = lane & 31, hh = lane >> 5;
        const int b4 = (lane >> 4) & 1, b3 = (lane >> 3) & 1, b2 = (lane >> 2) & 1, b1 = (lane >> 1) & 1;
        const int ie = 8 * b4 + 4 * b3 + 2 * b2 + b1;
        const int b = (int)(m >> 13);
        const int idx0 = nidx0, idx1 = nidx1; const float su0 = nsu0, su1 = nsu1, gv0 = ngv0, gv1 = ngv1;
        if (m + mstep < M) {
            const size_t mn = m + mstep;
            nidx0 = pidx0; nidx1 = pidx1;
            nsu0 = P.SU[nidx0]; nsu1 = P.SU[nidx1];
            ngv0 = P.GATE[mn * 128 + lane] * P.SV[nidx0]; ngv1 = P.GATE[mn * 128 + 64 + lane] * P.SV[nidx1];
            if (mn + mstep < M) { pidx0 = P.EIDX[(mn + mstep) * 128 + lane]; pidx1 = P.EIDX[(mn + mstep) * 128 + 64 + lane]; }
        }
        {
            f32x2 h[16];
            {
                const f32x4 s0 = spre[0], s1 = spre[1], s2 = spre[2], s3 = spre[3];
                const float tot = (((s0[0] + s0[1]) + (s0[2] + s0[3])) + ((s1[0] + s1[1]) + (s1[2] + s1[3]))) + (((s2[0] + s2[1]) + (s2[2] + s2[3])) + ((s3[0] + s3[1]) + (s3[2] + s3[3])));
                const float r = rsqrtf(tot * (1.f / D) + EPS);
                const float* sh = P.sh2 + b * MODW + l31 * 32;
#pragma unroll
                for (int q = 0; q < 4; ++q) {
                    const u32x4 a = hpre[q]; const f32x4 sa = *(const f32x4*)(sh + q * 8), sb = *(const f32x4*)(sh + q * 8 + 4);
                    h[q * 4] = (f32x2){lo16(a.x) * r + sa[0], hi16(a.x) * r + sa[1]}; h[q * 4 + 1] = (f32x2){lo16(a.y) * r + sa[2], hi16(a.y) * r + sa[3]};
                    h[q * 4 + 2] = (f32x2){lo16(a.z) * r + sb[0], hi16(a.z) * r + sb[1]}; h[q * 4 + 3] = (f32x2){lo16(a.w) * r + sb[2], hi16(a.w) * r + sb[3]};
                }
            }
#pragma unroll 1
            for (int bt = 0; bt < (P.var == 1 ? 0 : 4); ++bt) {
                const int idxv = bt < 2 ? idx0 : idx1;
                u32x4 rows[16];
#pragma unroll
                for (int i = 0; i < 16; ++i) {
                    const int e0 = __builtin_amdgcn_readlane(idxv, (bt & 1) * 32 + 2 * i), e1 = __builtin_amdgcn_readlane(idxv, (bt & 1) * 32 + 2 * i + 1);
                    const int e = hh ? e1 : e0;
                    rows[i] = *(const u32x4*)(P.U8 + (unsigned)(e * 512 + l31 * 16));
                }
                float p[16];
#pragma unroll
                for (int i = 0; i < 16; ++i) { asm volatile("" : "+v"(rows[i]));
                    p[i] = dot32_fp4(h, rows[i]); }
                float q8[8], q4[4], q2[2];
#pragma unroll
                for (int i = 0; i < 8; ++i) { const float snd = b4 ? p[i] : p[i + 8], kp = b4 ? p[i + 8] : p[i]; q8[i] = kp + __shfl_xor(snd, 16); }
#pragma unroll
                for (int i = 0; i < 4; ++i) { const float snd = b3 ? q8[i] : q8[i + 4], kp = b3 ? q8[i + 4] : q8[i]; q4[i] = kp + __shfl_xor(snd, 8); }
#pragma unroll
                for (int i = 0; i < 2; ++i) { const float snd = b2 ? q4[i] : q4[i + 2], kp = b2 ? q4[i + 2] : q4[i]; q2[i] = kp + __shfl_xor(snd, 4); }
                float tot; { const float snd = b1 ? q2[0] : q2[1], kp = b1 ? q2[1] : q2[0]; tot = kp + __shfl_xor(snd, 2); }
                tot += __shfl_xor(tot, 1);
                const int kk = (bt & 1) * 32 + 2 * ie + hh;
                const float suk = __int_as_float(__builtin_amdgcn_ds_bpermute(kk * 4, __float_as_int(bt < 2 ? su0 : su1)));
                const float gvk = __int_as_float(__builtin_amdgcn_ds_bpermute(kk * 4, __float_as_int(bt < 2 ? gv0 : gv1)));
                const float cf = gvk * gelu_tanh(tot * suk);
                if ((lane & 1) == 0) coefL[bt * 32 + 2 * ie + hh] = cf;
            }
        }
        f32x2 acc2[8];
#pragma unroll
        for (int i = 0; i < 8; ++i) acc2[i] = (f32x2){0.f, 0.f};
        int le = lane; asm volatile("" : "+v"(le));
        const u32x4 xa = *(const u32x4*)(P.xinb + m * D + le * 16), xb = *(const u32x4*)(P.xinb + m * D + le * 16 + 8);
        if (m + mstep < M) {
            const bf16_t* hpn = P.H + (m + mstep) * D + l31 * 32;
#pragma unroll
            for (int q = 0; q < 4; ++q) { hpre[q] = *(const u32x4*)(hpn + q * 8); spre[q] = *(const f32x4*)(P.SSX + (m + mstep) * 16 + q * 4); }
        }
        const float cfa = coefL[lane], cfb = coefL[64 + lane];
        {
            u32x2 ra[32], rb[32];
#define HY_VLOAD(R, bt_) do { const int idxv_ = (bt_) < 2 ? idx0 : idx1; _Pragma("unroll") for (int i = 0; i < 32; ++i) { const int e = __builtin_amdgcn_readlane(idxv_, ((bt_) & 1) * 32 + i); \
                R[i] = *(const u32x2*)(P.V8 + (unsigned)(e * 512 + lane * 8)); } } while (0)
#define HY_VCOMP(R, bt_) do { const int cfv_ = __float_as_int((bt_) < 2 ? cfa : cfb); _Pragma("unroll") for (int i = 0; i < 32; ++i) { asm volatile("" : "+v"(R[i])); \
                axpy16_fp4(acc2, __int_as_float(__builtin_amdgcn_readlane(cfv_, ((bt_) & 1) * 32 + i)), R[i]); } } while (0)
            HY_VLOAD(ra, 0); HY_VLOAD(rb, 1);
            HY_VCOMP(ra, 0); HY_VLOAD(ra, 2);
            HY_VCOMP(rb, 1); HY_VLOAD(rb, 3);
            HY_VCOMP(ra, 2); HY_VCOMP(rb, 3);
#undef HY_VLOAD
#undef HY_VCOMP
        }
        float acc[16];
#pragma unroll
        for (int i = 0; i < 8; ++i) { acc[2 * i] = acc2[i][0]; acc[2 * i + 1] = acc2[i][1]; }
        const float* g = P.g2 + b * MODW + le * 16;
        float ss = 0.f;
        {
            const float xi[16] = {lo16(xa.x), hi16(xa.x), lo16(xa.y), hi16(xa.y), lo16(xa.z), hi16(xa.z), lo16(xa.w), hi16(xa.w), lo16(xb.x), hi16(xb.x), lo16(xb.y), hi16(xb.y), lo16(xb.z), hi16(xb.z), lo16(xb.w), hi16(xb.w)};
#pragma unroll
            for (int q4i = 0; q4i < 4; ++q4i) {
                const f32x4 gg = *(const f32x4*)(g + q4i * 4);
#pragma unroll
                for (int e = 0; e < 4; ++e) { const float o = xi[q4i * 4 + e] + gg[e] * acc[q4i * 4 + e]; acc[q4i * 4 + e] = o; ss += o * o; }
            }
            if (P.xoutb) {
                *(u32x4*)(P.xoutb + m * D + le * 16) = (u32x4){pk2(acc[0], acc[1]), pk2(acc[2], acc[3]), pk2(acc[4], acc[5]), pk2(acc[6], acc[7])};
                *(u32x4*)(P.xoutb + m * D + le * 16 + 8) = (u32x4){pk2(acc[8], acc[9]), pk2(acc[10], acc[11]), pk2(acc[12], acc[13]), pk2(acc[14], acc[15])};
            } else {
#pragma unroll
                for (int q4i = 0; q4i < 4; ++q4i) *(f32x4*)(P.xout + m * D + le * 16 + q4i * 4) = (f32x4){acc[q4i * 4], acc[q4i * 4 + 1], acc[q4i * 4 + 2], acc[q4i * 4 + 3]};
            }
        }
        if (P.ngain) {
            const float r1 = rsqrtf(wave_sum(ss) * (1.f / D) + EPS);
            const float* gn = P.ngain + le * 16; const float* shn = P.nmod + b * MODW + le * 16; const float* scn = P.nmod + b * MODW + D + le * 16;
            unsigned w[8];
#pragma unroll
            for (int q4i = 0; q4i < 4; ++q4i) {
                const f32x4 g4 = *(const f32x4*)(gn + q4i * 4), s4 = *(const f32x4*)(scn + q4i * 4), h4 = *(const f32x4*)(shn + q4i * 4);
                float o[4];
#pragma unroll
                for (int e = 0; e < 4; ++e) o[e] = acc[q4i * 4 + e] * r1 * g4[e] * (1.f + s4[e]) + h4[e];
                w[q4i * 2] = pk2(o[0], o[1]); w[q4i * 2 + 1] = pk2(o[2], o[3]);
            }
            *(u32x4*)(P.H + m * D + le * 16) = (u32x4){w[0], w[1], w[2], w[3]}; *(u32x4*)(P.H + m * D + le * 16 + 8) = (u32x4){w[4], w[5], w[6], w[7]};
        }
    }
}
__device__ __forceinline__ void ph_peer_gather3(const Ctx& C, const GatherP& P) {
    HY_LAS float* coefW = (HY_LAS float*)((HY_LAS unsigned char*)C.lds) + C.wave * 2048;
    HY_LAS int* idsW = (HY_LAS int*)(coefW + 1024);
    const size_t mstep = (size_t)C.nblk * 8;
#pragma unroll 1
    for (size_t mbase = (size_t)C.bid * 8 + C.wave; mbase < M; mbase += 8 * mstep) {
    size_t m = mbase;
    int nidx0 = 0, nidx1 = 0, pidx0 = 0, pidx1 = 0; float nsu0 = 0.f, nsu1 = 0.f, ngv0 = 0.f, ngv1 = 0.f;
    {
        const int l0 = C.lane;
        nidx0 = P.EIDX[m * 128 + l0]; nidx1 = P.EIDX[m * 128 + 64 + l0];
        nsu0 = P.SU[nidx0]; nsu1 = P.SU[nidx1];
        ngv0 = P.GATE[m * 128 + l0] * P.SV[nidx0]; ngv1 = P.GATE[m * 128 + 64 + l0] * P.SV[nidx1];
        if (m + mstep < M) { pidx0 = P.EIDX[(m + mstep) * 128 + l0]; pidx1 = P.EIDX[(m + mstep) * 128 + 64 + l0]; }
    }
    int nk = 0;
#pragma unroll 1
    for (int k = 0; k < 8 && m < M; ++k, m += mstep) {
        HY_LAS float* coefL = coefW + k * 128;
        nk = k + 1;
        unsigned ones_ = ~0u; asm volatile("" : "+s"(ones_));
        const int lane = (int)__builtin_amdgcn_mbcnt_hi(ones_, __builtin_amdgcn_mbcnt_lo(ones_, 0u));
        const int l31 = lane & 31, hh = lane >> 5;
        const int b4 = (lane >> 4) & 1, b3 = (lane >> 3) & 1, b2 = (lane >> 2) & 1, b1 = (lane >> 1) & 1;
        const int ie = 8 * b4 + 4 * b3 + 2 * b2 + b1;
        const int b = (int)(m >> 13);
        const int idx0 = nidx0, idx1 = nidx1; const float su0 = nsu0, su1 = nsu1, gv0 = ngv0, gv1 = ngv1;
        if (m + mstep < M) {
            const size_t mn = m + mstep;
            nidx0 = pidx0; nidx1 = pidx1;
            nsu0 = P.SU[nidx0]; nsu1 = P.SU[nidx1];
            ngv0 = P.GATE[mn * 128 + lane] * P.SV[nidx0]; ngv1 = P.GATE[mn * 128 + 64 + lane] * P.SV[nidx1];
            if (mn + mstep < M) { pidx0 = P.EIDX[(mn + mstep) * 128 + lane]; pidx1 = P.EIDX[(mn + mstep) * 128 + 64 + lane]; }
        }
        idsW[k * 128 + lane] = idx0; idsW[k * 128 + 64 + lane] = idx1;
        {
            f32x2 h[16];
            {
                const bf16_t* hp = P.H + m * D + l31 * 32;
                const f32x4 s0 = *(const f32x4*)(P.SSX + m * 16), s1 = *(const f32x4*)(P.SSX + m * 16 + 4), s2 = *(const f32x4*)(P.SSX + m * 16 + 8), s3 = *(const f32x4*)(P.SSX + m * 16 + 12);
                const float tot = (((s0[0] + s0[1]) + (s0[2] + s0[3])) + ((s1[0] + s1[1]) + (s1[2] + s1[3]))) + (((s2[0] + s2[1]) + (s2[2] + s2[3])) + ((s3[0] + s3[1]) + (s3[2] + s3[3])));
                const float r = rsqrtf(tot * (1.f / D) + EPS);
                const float* sh = P.sh2 + b * MODW + l31 * 32;
#pragma unroll
                for (int q = 0; q < 4; ++q) {
                    const u32x4 a = *(const u32x4*)(hp + q * 8); const f32x4 sa = *(const f32x4*)(sh + q * 8), sb = *(const f32x4*)(sh + q * 8 + 4);
                    h[q * 4] = (f32x2){lo16(a.x) * r + sa[0], hi16(a.x) * r + sa[1]}; h[q * 4 + 1] = (f32x2){lo16(a.y) * r + sa[2], hi16(a.y) * r + sa[3]};
                    h[q * 4 + 2] = (f32x2){lo16(a.z) * r + sb[0], hi16(a.z) * r + sb[1]}; h[q * 4 + 3] = (f32x2){lo16(a.w) * r + sb[2], hi16(a.w) * r + sb[3]};
                }
            }
#pragma unroll 1
            for (int bt = 0; bt < (P.var == 1 ? 0 : 4); ++bt) {
                const int idxv = bt < 2 ? idx0 : idx1;
                u32x4 rows[16];
#pragma unroll
                for (int i = 0; i < 16; ++i) {
                    const int e = __builtin_amdgcn_ds_bpermute(((bt & 1) * 32 + 2 * i + hh) * 4, idxv);
                    rows[i] = *(const u32x4*)(P.U8 + (unsigned)(e * 512 + l31 * 16));
                }
                float p[16];
#pragma unroll
                for (int i = 0; i < 16; ++i) { asm volatile("" : "+v"(rows[i]));
                    p[i] = dot32_fp4(h, rows[i]); }
                float q8[8], q4[4], q2[2];
#pragma unroll
                for (int i = 0; i < 8; ++i) { const float snd = b4 ? p[i] : p[i + 8], kp = b4 ? p[i + 8] : p[i]; q8[i] = kp + __shfl_xor(snd, 16); }
#pragma unroll
                for (int i = 0; i < 4; ++i) { const float snd = b3 ? q8[i] : q8[i + 4], kp = b3 ? q8[i + 4] : q8[i]; q4[i] = kp + __shfl_xor(snd, 8); }
#pragma unroll
                for (int i = 0; i < 2; ++i) { const float snd = b2 ? q4[i] : q4[i + 2], kp = b2 ? q4[i + 2] : q4[i]; q2[i] = kp + __shfl_xor(snd, 4); }
                float tot; { const float snd = b1 ? q2[0] : q2[1], kp = b1 ? q2[1] : q2[0]; tot = kp + __shfl_xor(snd, 2); }
                tot += __shfl_xor(tot, 1);
                const int kk = (bt & 1) * 32 + 2 * ie + hh;
                const float suk = __int_as_float(__builtin_amdgcn_ds_bpermute(kk * 4, __float_as_int(bt < 2 ? su0 : su1)));
                const float gvk = __int_as_float(__builtin_amdgcn_ds_bpermute(kk * 4, __float_as_int(bt < 2 ? gv0 : gv1)));
                const float cf = gvk * gelu_tanh(tot * suk);
                if ((lane & 1) == 0) coefL[bt * 32 + 2 * ie + hh] = cf;
            }
        }
    }
    m = mbase;
#pragma unroll 1
    for (int k = 0; k < nk; ++k, m += mstep) {
        HY_LAS float* coefL = coefW + k * 128;
        unsigned ones_ = ~0u; asm volatile("" : "+s"(ones_));
        const int lane = (int)__builtin_amdgcn_mbcnt_hi(ones_, __builtin_amdgcn_mbcnt_lo(ones_, 0u));
        const int b = (int)(m >> 13);
        const int idx0 = idsW[k * 128 + lane], idx1 = idsW[k * 128 + 64 + lane];
        f32x2 acc2[8];
#pragma unroll
        for (int i = 0; i < 8; ++i) acc2[i] = (f32x2){0.f, 0.f};
#pragma unroll 1
        for (int bt = 0; bt < (P.var == 2 ? 0 : 4); ++bt) {
            const int idxv = bt < 2 ? idx0 : idx1;
            u32x2 rows[32];
#pragma unroll
            for (int i = 0; i < 32; ++i) {
                const int e = __builtin_amdgcn_ds_bpermute(((bt & 1) * 32 + i) * 4, idxv);
                rows[i] = *(const u32x2*)(P.V8 + (unsigned)(e * 512 + lane * 8));
            }
#pragma unroll
            for (int i = 0; i < 32; ++i) { asm volatile("" : "+v"(rows[i])); axpy16_fp4(acc2, coefL[bt * 32 + i], rows[i]); }
        }
        float acc[16];
#pragma unroll
        for (int i = 0; i < 8; ++i) { acc[2 * i] = acc2[i][0]; acc[2 * i + 1] = acc2[i][1]; }
        int le = lane; asm volatile("" : "+v"(le));
        const float* g = P.g2 + b * MODW + le * 16;
        float ss = 0.f;
        {
            const u32x4 xa = *(const u32x4*)(P.xinb + m * D + le * 16), xb = *(const u32x4*)(P.xinb + m * D + le * 16 + 8);
            const float xi[16] = {lo16(xa.x), hi16(xa.x), lo16(xa.y), hi16(xa.y), lo16(xa.z), hi16(xa.z), lo16(xa.w), hi16(xa.w), lo16(xb.x), hi16(xb.x), lo16(xb.y), hi16(xb.y), lo16(xb.z), hi16(xb.z), lo16(xb.w), hi16(xb.w)};
#pragma unroll
            for (int q4i = 0; q4i < 4; ++q4i) {
                const f32x4 gg = *(const f32x4*)(g + q4i * 4);
#pragma unroll
                for (int e = 0; e < 4; ++e) { const float o = xi[q4i * 4 + e] + gg[e] * acc[q4i * 4 + e]; acc[q4i * 4 + e] = o; ss += o * o; }
            }
            if (P.xoutb) {
                *(u32x4*)(P.xoutb + m * D + le * 16) = (u32x4){pk2(acc[0], acc[1]), pk2(acc[2], acc[3]), pk2(acc[4], acc[5]), pk2(acc[6], acc[7])};
                *(u32x4*)(P.xoutb + m * D + le * 16 + 8) = (u32x4){pk2(acc[8], acc[9]), pk2(acc[10], acc[11]), pk2(acc[12], acc[13]), pk2(acc[14], acc[15])};
            } else {
#pragma unroll
                for (int q4i = 0; q4i < 4; ++q4i) *(f32x4*)(P.xout + m * D + le * 16 + q4i * 4) = (f32x4){acc[q4i * 4], acc[q4i * 4 + 1], acc[q4i * 4 + 2], acc[q4i * 4 + 3]};
            }
        }
        if (P.ngain) {
            const float r1 = rsqrtf(wave_sum(ss) * (1.f / D) + EPS);
            const float* gn = P.ngain + le * 16; const float* shn = P.nmod + b * MODW + le * 16; const float* scn = P.nmod + b * MODW + D + le * 16;
            unsigned w[8];
#pragma unroll
            for (int q4i = 0; q4i < 4; ++q4i) {
                const f32x4 g4 = *(const f32x4*)(gn + q4i * 4), s4 = *(const f32x4*)(scn + q4i * 4), h4 = *(const f32x4*)(shn + q4i * 4);
                float o[4];
#pragma unroll
                for (int e = 0; e < 4; ++e) o[e] = acc[q4i * 4 + e] * r1 * g4[e] * (1.f + s4[e]) + h4[e];
                w[q4i * 2] = pk2(o[0], o[1]); w[q4i * 2 + 1] = pk2(o[2], o[3]);
            }
            *(u32x4*)(P.H + m * D + le * 16) = (u32x4){w[0], w[1], w[2], w[3]}; *(u32x4*)(P.H + m * D + le * 16 + 8) = (u32x4){w[4], w[5], w[6], w[7]};
        }
    }
    }
}
}
namespace hy {
struct EpiGen {
    static constexpr bool PERM = true, AFTER_DRAIN = false;
    int mode; int ldc; bf16_t* O; const float* xin; const bf16_t* xinb; bf16_t* xoutb; const float* gate; unsigned char* ws; const float *p0, *p1, *p2;
    __device__ __forceinline__ void operator()(const pg8::f32x4 (&acc)[2][2][4][2], const pg8::Unit& u, int wr, int wc, int fr_, int fq_) const {
        int fr = fr_, fq = fq_; asm volatile("" : "+v"(fr), "+v"(fq));
        const int row0 = u.pm * 256 + wr * 64 + fr, col0 = u.pn * 256 + wc * 32 + 8 * fq;
        if (mode == 0) {
#pragma unroll
            for (int ai = 0; ai < 2; ++ai)
#pragma unroll
                for (int m = 0; m < 4; ++m) { bf16_t* rowp = O + (size_t)(row0 + ai * 128 + m * 16) * ldc + col0;
#pragma unroll
                    for (int bj = 0; bj < 2; ++bj) { const pg8::f32x4 v0 = acc[ai][bj][m][0], v1 = acc[ai][bj][m][1];
                        u32x4 w; w.x = pg8::cvt_pk_bf16(v0[0], v0[1]); w.y = pg8::cvt_pk_bf16(v0[2], v0[3]); w.z = pg8::cvt_pk_bf16(v1[0], v1[1]); w.w = pg8::cvt_pk_bf16(v1[2], v1[3]);
                        *(u32x4*)(rowp + bj * 128) = w; } }
        } else if (mode == 2) {
            const int uu = 4 * u.pn + wc;
            if (uu > 28) return;
            bf16_t* dst; int pitch, cb; float osc = 1.f; const float* gn = nullptr;
            if (uu < 6) { dst = (bf16_t*)(ws + WS_QA); pitch = 384; cb = 64 * uu; gn = p0; osc = 0.125f * LOG2E; }
            else if (uu < 12) { dst = (bf16_t*)(ws + WS_KA); pitch = 384; cb = 64 * (uu - 6); gn = p1; }
            else if (uu < 18) { dst = (bf16_t*)(ws + WS_VA); pitch = 384; cb = 64 * (uu - 12); }
            else if (uu < 20) { dst = (bf16_t*)(ws + WS_CQKV); pitch = 384; cb = 256 + 64 * (uu - 18); }
            else if (uu < 24) { dst = (bf16_t*)(ws + WS_CQKV); pitch = 384; cb = 64 * (uu - 20); }
            else if (uu < 28) { dst = (bf16_t*)(ws + WS_U); pitch = 256; cb = 64 * (uu - 24); }
            else { dst = (bf16_t*)(ws + WS_KM); pitch = 576; cb = 64; }
            pg8::f32x4 gv[2][2];
#pragma unroll
            for (int bj = 0; bj < 2; ++bj)
#pragma unroll
                for (int n = 0; n < 2; ++n) gv[bj][n] = gn ? *(const pg8::f32x4*)(gn + 32 * bj + 8 * fq + 4 * n) * osc : (pg8::f32x4){1.f, 1.f, 1.f, 1.f};
            float* ssq = (float*)(ws + WS_SSQ) + (uu < 20 ? 4 + (uu - 18) : (uu - 20));
#pragma unroll
            for (int ai = 0; ai < 2; ++ai)
#pragma unroll
                for (int m = 0; m < 4; ++m) {
                    const int row = row0 + ai * 128 + m * 16;
                    pg8::f32x4 v[2][2];
#pragma unroll
                    for (int bj = 0; bj < 2; ++bj)
#pragma unroll
                        for (int n = 0; n < 2; ++n) v[bj][n] = acc[ai][bj][m][n];
                    if (uu < 12 || (uu >= 18 && uu < 24)) {
                        float ss = 0.f;
#pragma unroll
                        for (int bj = 0; bj < 2; ++bj)
#pragma unroll
                            for (int n = 0; n < 2; ++n) ss += v[bj][n][0] * v[bj][n][0] + v[bj][n][1] * v[bj][n][1] + v[bj][n][2] * v[bj][n][2] + v[bj][n][3] * v[bj][n][3];
                        ss += __shfl_xor(ss, 16); ss += __shfl_xor(ss, 32);
                        if (uu < 12) { const float r = rsqrtf(ss * (1.f / 64.f) + EPS);
#pragma unroll
                            for (int bj = 0; bj < 2; ++bj)
#pragma unroll
                                for (int n = 0; n < 2; ++n) v[bj][n] = v[bj][n] * r * gv[bj][n]; }
                        else if (fq == 0) ssq[(size_t)row * 8] = ss;
                    }
                    if (uu < 28) {
#pragma unroll
                        for (int bj = 0; bj < 2; ++bj) {
                            u32x4 w; w.x = pg8::cvt_pk_bf16(v[bj][0][0], v[bj][0][1]); w.y = pg8::cvt_pk_bf16(v[bj][0][2], v[bj][0][3]); w.z = pg8::cvt_pk_bf16(v[bj][1][0], v[bj][1][1]); w.w = pg8::cvt_pk_bf16(v[bj][1][2], v[bj][1][3]);
                            *(u32x4*)(dst + (size_t)row * pitch + cb + 32 * bj + 8 * fq) = w;
                        }
                    } else {
                        float ss = 0.f;
#pragma unroll
                        for (int n = 0; n < 2; ++n) ss += v[0][n][0] * v[0][n][0] + v[0][n][1] * v[0][n][1] + v[0][n][2] * v[0][n][2] + v[0][n][3] * v[0][n][3];
                        ss += __shfl_xor(ss, 16); ss += __shfl_xor(ss, 32);
                        const float r = rsqrtf(ss * (1.f / 32.f) + EPS);
                        const int pos = row & (S - 1), i0 = 8 * (fq & 1);
                        const float* rp = (const float*)(ws + WS_ROPE) + pos * 16 + i0;
                        float o[8];
#pragma unroll
                        for (int n = 0; n < 2; ++n) {
                            const pg8::f32x4 kg = *(const pg8::f32x4*)(p2 + 64 + 8 * fq + 4 * n);
                            const pg8::f32x4 cs = *(const pg8::f32x4*)(rp + 4 * n), sn = *(const pg8::f32x4*)(rp + S * 16 + 4 * n);
#pragma unroll
                            for (int e = 0; e < 4; ++e) {
                                const float nv = v[0][n][e] * r * kg[e];
                                const float pr = __shfl_xor(nv, 32);
                                o[4 * n + e] = (fq < 2) ? (nv * cs[e] - pr * sn[e]) : (pr * sn[e] + nv * cs[e]);
                            }
                        }
                        u32x4 w; w.x = pg8::cvt_pk_bf16(o[0], o[1]); w.y = pg8::cvt_pk_bf16(o[2], o[3]); w.z = pg8::cvt_pk_bf16(o[4], o[5]); w.w = pg8::cvt_pk_bf16(o[6], o[7]);
#pragma unroll
                        for (int hh = 0; hh < 6; ++hh) *(u32x4*)(dst + (size_t)row * pitch + hh * 96 + cb + 8 * fq) = w;
                    }
                }
        } else if (mode == 3) {
            const int h = u.pn, kind = wc;
            const float SCQ = 0.10206207261596575f * LOG2E;
            const float* gn = kind == 0 ? p0 : (kind == 1 ? p0 + 64 : p1);
            pg8::f32x4 gv[2][2];
#pragma unroll
            for (int bj = 0; bj < 2; ++bj)
#pragma unroll
                for (int n = 0; n < 2; ++n) gv[bj][n] = (kind == 3 || (kind == 1 && bj == 1)) ? (pg8::f32x4){1.f, 1.f, 1.f, 1.f} : *(const pg8::f32x4*)(gn + 32 * bj + 8 * fq + 4 * n);
            bf16_t* dst; int pitch, cb;
            if (kind < 2) { dst = (bf16_t*)(ws + WS_QM); pitch = 576; cb = h * 96 + kind * 64; }
            else if (kind == 2) { dst = (bf16_t*)(ws + WS_KM); pitch = 576; cb = h * 96; }
            else { dst = (bf16_t*)(ws + WS_VM); pitch = 384; cb = h * 64; }
            const float* ssqp = (const float*)(ws + WS_SSQ);
#pragma unroll
            for (int ai = 0; ai < 2; ++ai)
#pragma unroll
                for (int m = 0; m < 4; ++m) {
                    const int row = row0 + ai * 128 + m * 16;
                    const pg8::f32x4 pq = *(const pg8::f32x4*)(ssqp + (size_t)row * 8); const float2 pkv = *(const float2*)(ssqp + (size_t)row * 8 + 4);
                    const float sc = kind < 2 ? rsqrtf(((pq[0] + pq[1]) + (pq[2] + pq[3])) * (1.f / 256.f) + EPS) : rsqrtf((pkv.x + pkv.y) * (1.f / 128.f) + EPS);
                    pg8::f32x4 v[2][2];
#pragma unroll
                    for (int bj = 0; bj < 2; ++bj)
#pragma unroll
                        for (int n = 0; n < 2; ++n) v[bj][n] = acc[ai][bj][m][n] * sc;
                    if (kind != 3) {
                        float ss = 0.f;
#pragma unroll
                        for (int bj = 0; bj < 2; ++bj)
#pragma unroll
                            for (int n = 0; n < 2; ++n) if (kind != 1 || bj == 0) ss += v[bj][n][0] * v[bj][n][0] + v[bj][n][1] * v[bj][n][1] + v[bj][n][2] * v[bj][n][2] + v[bj][n][3] * v[bj][n][3];
                        ss += __shfl_xor(ss, 16); ss += __shfl_xor(ss, 32);
                        const float r = rsqrtf(ss * (kind == 1 ? (1.f / 32.f) : (1.f / 64.f)) + EPS) * (kind < 2 ? SCQ : 1.f);
#pragma unroll
                        for (int bj = 0; bj < 2; ++bj)
#pragma unroll
                            for (int n = 0; n < 2; ++n) v[bj][n] = v[bj][n] * r * gv[bj][n];
                    }
                    if (kind == 1) {
                        const int pos = row & (S - 1), i0 = 8 * (fq & 1);
                        const float* rp = (const float*)(ws + WS_ROPE) + pos * 16 + i0;
                        float o[8];
#pragma unroll
                        for (int n = 0; n < 2; ++n) {
                            const pg8::f32x4 cs = *(const pg8::f32x4*)(rp + 4 * n), sn = *(const pg8::f32x4*)(rp + S * 16 + 4 * n);
#pragma unroll
                            for (int e = 0; e < 4; ++e) { const float nv = v[0][n][e]; const float pr = __shfl_xor(nv, 32); o[4 * n + e] = (fq < 2) ? (nv * cs[e] - pr * sn[e]) : (pr * sn[e] + nv * cs[e]); }
                        }
                        u32x4 w; w.x = pg8::cvt_pk_bf16(o[0], o[1]); w.y = pg8::cvt_pk_bf16(o[2], o[3]); w.z = pg8::cvt_pk_bf16(o[4], o[5]); w.w = pg8::cvt_pk_bf16(o[6], o[7]);
                        *(u32x4*)(dst + (size_t)row * pitch + cb + 8 * fq) = w;
                    } else {
#pragma unroll
                        for (int bj = 0; bj < 2; ++bj) {
                            u32x4 w; w.x = pg8::cvt_pk_bf16(v[bj][0][0], v[bj][0][1]); w.y = pg8::cvt_pk_bf16(v[bj][0][2], v[bj][0][3]); w.z = pg8::cvt_pk_bf16(v[bj][1][0], v[bj][1][1]); w.w = pg8::cvt_pk_bf16(v[bj][1][2], v[bj][1][3]);
                            *(u32x4*)(dst + (size_t)row * pitch + cb + 32 * bj + 8 * fq) = w;
                        }
                    }
                }
        } else if (mode == 4) {
            const float* cv = p0 + ((u.pm * 256) >> 13) * 2048;
            const float* ssx = (const float*)(ws + WS_SSX);
            pg8::f32x4 c0[2], c1[2];
#pragma unroll
            for (int bj = 0; bj < 2; ++bj) { c0[bj] = *(const pg8::f32x4*)(cv + col0 + bj * 128); c1[bj] = *(const pg8::f32x4*)(cv + col0 + bj * 128 + 4); }
#pragma unroll
            for (int ai = 0; ai < 2; ++ai)
#pragma unroll
                for (int m = 0; m < 4; ++m) {
                    const int row = row0 + ai * 128 + m * 16;
                    const pg8::f32x4 s0 = *(const pg8::f32x4*)(ssx + (size_t)row * 16), s1 = *(const pg8::f32x4*)(ssx + (size_t)row * 16 + 4), s2 = *(const pg8::f32x4*)(ssx + (size_t)row * 16 + 8), s3 = *(const pg8::f32x4*)(ssx + (size_t)row * 16 + 12);
                    const float tot = (((s0[0] + s0[1]) + (s0[2] + s0[3])) + ((s1[0] + s1[1]) + (s1[2] + s1[3]))) + (((s2[0] + s2[1]) + (s2[2] + s2[3])) + ((s3[0] + s3[1]) + (s3[2] + s3[3])));
                    const float r = rsqrtf(tot * (1.f / D) + EPS);
                    bf16_t* rowp = O + (size_t)row * ldc + col0;
#pragma unroll
                    for (int bj = 0; bj < 2; ++bj) { const pg8::f32x4 v0 = acc[ai][bj][m][0] * r + c0[bj], v1 = acc[ai][bj][m][1] * r + c1[bj];
                        u32x4 w; w.x = pg8::cvt_pk_bf16(v0[0], v0[1]); w.y = pg8::cvt_pk_bf16(v0[2], v0[3]); w.z = pg8::cvt_pk_bf16(v1[0], v1[1]); w.w = pg8::cvt_pk_bf16(v1[2], v1[3]);
                        *(u32x4*)(rowp + bj * 128) = w; }
                }
        } else {
            const int b = (u.pm * 256) >> 13;
            const float* g = gate + b * MODW; const float* sc2 = p1 + b * MODW;
            float* ssx = (float*)(ws + WS_SSX) + u.pn * 4 + wc;
            bf16_t* A2 = (bf16_t*)(ws + WS_H);
            pg8::f32x4 g0[2], g1[2], w0[2], w1[2];
#pragma unroll
            for (int bj = 0; bj < 2; ++bj) {
                const int col = col0 + bj * 128;
                g0[bj] = *(const pg8::f32x4*)(g + col); g1[bj] = *(const pg8::f32x4*)(g + col + 4);
                w0[bj] = *(const pg8::f32x4*)(p0 + col) * (*(const pg8::f32x4*)(sc2 + col) + 1.f); w1[bj] = *(const pg8::f32x4*)(p0 + col + 4) * (*(const pg8::f32x4*)(sc2 + col + 4) + 1.f);
            }
#pragma unroll
            for (int ai = 0; ai < 2; ++ai)
#pragma unroll
                for (int m = 0; m < 4; ++m) {
                    const int row = row0 + ai * 128 + m * 16; float ss = 0.f;
#pragma unroll
                    for (int bj = 0; bj < 2; ++bj) {
                        const size_t off = (size_t)row * D + col0 + bj * 128;
                        pg8::f32x4 xi0, xi1;
                        if (xin) { xi0 = *(const pg8::f32x4*)(xin + off); xi1 = *(const pg8::f32x4*)(xin + off + 4); }
                        else { const u32x4 xb = *(const u32x4*)(xinb + off); xi0 = (pg8::f32x4){lo16(xb.x), hi16(xb.x), lo16(xb.y), hi16(xb.y)}; xi1 = (pg8::f32x4){lo16(xb.z), hi16(xb.z), lo16(xb.w), hi16(xb.w)}; }
                        const pg8::f32x4 x0 = xi0 + g0[bj] * acc[ai][bj][m][0], x1 = xi1 + g1[bj] * acc[ai][bj][m][1];
                        { u32x4 xw; xw.x = pg8::cvt_pk_bf16(x0[0], x0[1]); xw.y = pg8::cvt_pk_bf16(x0[2], x0[3]); xw.z = pg8::cvt_pk_bf16(x1[0], x1[1]); xw.w = pg8::cvt_pk_bf16(x1[2], x1[3]); *(u32x4*)(xoutb + off) = xw; }
                        ss += (x0[0] * x0[0] + x0[1] * x0[1]) + (x0[2] * x0[2] + x0[3] * x0[3]) + (x1[0] * x1[0] + x1[1] * x1[1]) + (x1[2] * x1[2] + x1[3] * x1[3]);
                        const pg8::f32x4 a0 = x0 * w0[bj], a1 = x1 * w1[bj];
                        u32x4 w; w.x = pg8::cvt_pk_bf16(a0[0], a0[1]); w.y = pg8::cvt_pk_bf16(a0[2], a0[3]); w.z = pg8::cvt_pk_bf16(a1[0], a1[1]); w.w = pg8::cvt_pk_bf16(a1[2], a1[3]);
                        *(u32x4*)(A2 + off) = w;
                    }
                    ss += __shfl_xor(ss, 16); ss += __shfl_xor(ss, 32);
                    if (fq == 0) ssx[(size_t)row * 16] = ss;
                }
        }
    }
};

#ifndef HY_PROBE
#define HY_PROBE 0
#endif
#define HY_PROBE_REPS(s) (((HY_PROBE >= 40 && HY_PROBE < 50 && (s) == 8) || (HY_PROBE >= 100 && (s) == HY_PROBE - 100) || ((HY_PROBE == 2 || HY_PROBE == 7 || HY_PROBE == 8 || HY_PROBE == 9 || HY_PROBE == 20 || HY_PROBE == 21 || HY_PROBE == 22) && (s) == 2) || \
                          (HY_PROBE == 3 && (s) == 8) || (HY_PROBE == 4 && (s) == 7) || (HY_PROBE == 5 && ((s) == 0 || (s) == 1 || (s) == 3 || (s) == 6)) || (HY_PROBE == 6 && (s) == 4)) ? 2 : 1)
#define GSYNC() do { XcdBarrier b_; b_.bar = WSP(unsigned, WS_CTL) + 4096; b_.x = xb_xcc_id(); b_.st = (volatile LAS unsigned*)((HY_LAS unsigned char*)lds + LDS_BYTES - 32); xcd_barrier(b_, HY_TID()); } while (0)
constexpr int NSTEP = 9;

__global__ void __launch_bounds__(NT, 2) k_fwd(Params P) {
    extern __shared__ __attribute__((aligned(16))) unsigned char lds[];
    cg::grid_group grid = cg::this_grid();
    const int wave0 = __builtin_amdgcn_readfirstlane(threadIdx.x >> 6);
#define HY_TID() ({ unsigned o_ = ~0u; asm volatile("" : "+s"(o_)); wave0 * 64 + (int)__builtin_amdgcn_mbcnt_hi(o_, __builtin_amdgcn_mbcnt_lo(o_, 0u)); })
    Ctx C0; C0.tid = HY_TID(); C0.lane = C0.tid & 63; C0.wave = wave0; C0.bid = blockIdx.x; C0.nblk = gridDim.x; C0.lds = lds;
    const In& in = P.in;
    unsigned char* ws = P.ws; float* out = P.out;
    if (C0.tid < 8) ((HY_LAS unsigned*)((HY_LAS unsigned char*)lds + LDS_BYTES - 32))[C0.tid] = 0u;
    __syncthreads();
#define WSP(T, off) ((T*)(ws + (off)))

    for (int prep = 0; prep < (HY_PROBE == 1 ? 2 : 1); ++prep) {
    const Ctx& C = C0;
    if (C.bid == 0) { for (int i = C.tid; i < 8192; i += NT) WSP(unsigned, WS_CTL)[i] = 0u; }
    for (int q = 0; q < (HY_PROBE == 13 ? 2 : 1); ++q)
    ph_mod(C, in.c, in.w_ada, in.b_ada, WSP(float, WS_MOD));
    ph_tables(C, in.rel_bias, WSP(float, WS_BIAS), WSP(float, WS_ROPE));
    ph_bounds(C, in, WSP(float, WS_BIAS) + 4096);
    ph_w2zero(C, WSP(bf16_t, WS_W2));
    for (int q = 0; q < (HY_PROBE == 11 ? 2 : 1); ++q)
    ph_tconv(C, P);
    ph_cvt(C, in.peer_subkeys, WSP(bf16_t, WS_SUBK), (size_t)NL * 16 * 128 * 128 / 8);
    for (int q = 0; q < (HY_PROBE == 12 ? 2 : 1); ++q)
    ph_cvt_fp4(C, in.peer_u, WSP(unsigned char, WS_PU), WSP(float, WS_PSU), NL * 16384);
    ph_s5_lampow(C, in, WSP(float, WS_LP));
    ph_s5_bbar(C, in, WSP(float, WS_BB));
    ph_cvt_fp4(C, in.peer_v, WSP(unsigned char, WS_PV), WSP(float, WS_PSU) + NL * 16384, NL * 16384);
    }
    grid.sync();
    (void)xcd_barrier_post(WSP(unsigned, WS_CTL) + 4096, (volatile LAS unsigned*)((HY_LAS unsigned char*)lds + LDS_BYTES - 32), HY_TID());
    for (int prep = 0; prep < ((HY_PROBE == 1 || HY_PROBE == 10) ? 2 : 1); ++prep)
    { ph_s5_tables(C0, in, WSP(float, WS_LP), WSP(float, WS_BB), WSP(bf16_t, WS_KMT), WSP(bf16_t, WS_WE), WSP(bf16_t, WS_WC));
      ph_cvec(C0, in.peer_wq, WSP(float, WS_MOD), WSP(float, WS_CV));
      ph_normmod(C0, in.x, in.norm1_gain, WSP(float, WS_MOD), 0, D, WSP(bf16_t, WS_H), nullptr); }
    GSYNC();

    for (int step = 0; step < NL * NSTEP; ++step) {
        const int l = step / NSTEP, s = step % NSTEP;
        if (s == 3) continue;
        const int nrep = HY_PROBE_REPS(s);
        for (int rep = 0; rep < nrep; ++rep) {
#define HY_MKCTX() Ctx C; { int t = HY_TID(), bq = blockIdx.x; asm volatile("" : "+v"(t), "+s"(bq)); C.tid = t; C.lane = t & 63; C.wave = __builtin_amdgcn_readfirstlane(t >> 6); C.bid = bq; C.nblk = gridDim.x; C.lds = lds; }
        const float* modl = WSP(float, WS_MOD) + (size_t)l * 2 * MODW;
        const bf16_t* gA = nullptr; const bf16_t* gB = nullptr; int gN = 0, gK = 0; EpiGen ge; ge.mode = 0; ge.ldc = 0; ge.O = nullptr; ge.xin = nullptr; ge.xinb = nullptr; ge.xoutb = nullptr; ge.gate = nullptr; ge.ws = ws; ge.p0 = nullptr; ge.p1 = nullptr; ge.p2 = nullptr;
        switch (s) {
        case 0: gA = WSP(bf16_t, WS_H); gB = WSP(bf16_t, WS_WIN) + (size_t)l * P1W * D; gN = P1W; gK = D; ge.mode = 2; ge.p0 = in.swa_q_gain + l * 64; ge.p1 = in.swa_k_gain + l * 64; ge.p2 = in.mla_k_gain + l * 96; break;
        case 1: gA = WSP(bf16_t, WS_CQKV); gB = WSP(bf16_t, WS_W2) + (size_t)l * P2W * 384; gN = P2W; gK = 384; ge.mode = 3; ge.p0 = in.mla_q_gain + l * 96; ge.p1 = in.mla_k_gain + l * 96; break;
        case 2: { HY_MKCTX(); MixQ mp; mp.QM = WSP(bf16_t, WS_QM); mp.KM = WSP(bf16_t, WS_KM); mp.VM = WSP(bf16_t, WS_VM); mp.QA = WSP(bf16_t, WS_QA); mp.KA = WSP(bf16_t, WS_KA); mp.VA = WSP(bf16_t, WS_VA);
                  mp.bias = WSP(float, WS_BIAS); mp.YC = WSP(bf16_t, WS_YC); mp.YAB = WSP(bf16_t, WS_YAB); mp.MLB = WSP(float, WS_MLB);
                  mp.s5.U = WSP(bf16_t, WS_U); mp.s5.KMl = WSP(bf16_t, WS_KMT) + (size_t)l * S5_KM_L; mp.s5.WCl = WSP(bf16_t, WS_WC) + (size_t)l * S5_WC_L; mp.s5.E = WSP(float, WS_E); mp.s5.LP = WSP(float, WS_LP);
                  mp.s5.dskip = in.s5_d + l * 256; mp.s5.GS = WSP(bf16_t, WS_GS); mp.s5.layer = l; mp.s5.var = 0;
                  mp.counter = WSP(unsigned, WS_CTL) + 64 * (l * 4 + rep);
                  mp.lo = 0; mp.hi = 1 << 30; mp.bnd = WSP(float, WS_BIAS) + 4096 + l * 2;
                  mp.var = 0;
                  if (rep + 1 < nrep && (HY_PROBE == 20 || HY_PROBE == 21 || HY_PROBE == 22)) { mp.lo = 0; mp.hi = 384; mp.YC = WSP(bf16_t, WS_P1); mp.var = HY_PROBE == 20 ? 0 : 1; }
                  if (rep + 1 < nrep) { if (HY_PROBE == 7) { mp.lo = 0; mp.hi = 384; } else if (HY_PROBE == 8) { mp.lo = 512; mp.hi = 1664; } else if (HY_PROBE == 9) { mp.lo = 384; mp.hi = 512; } }
                  ph_mixers(C, mp); } break;
        case 3: gA = WSP(bf16_t, WS_GS); gB = WSP(bf16_t, WS_WGLU) + (size_t)l * 65536; gN = 256; gK = 256; ge.O = WSP(bf16_t, WS_GL); ge.ldc = 256; break;
        case 4: { HY_MKCTX(); ph_merge3(C, WSP(bf16_t, WS_YAB), WSP(float, WS_MLB), WSP(bf16_t, WS_GS), WSP(bf16_t, WS_WGLU) + (size_t)l * 65536, in.b_glu + l * 256, WSP(bf16_t, WS_YC), WSP(bf16_t, WS_AOUT)); } break;
        case 5: gA = WSP(bf16_t, WS_AOUT); gB = WSP(bf16_t, WS_WOUT) + (size_t)l * D * D; gN = D; gK = D; ge.mode = 1; ge.xin = l == 0 ? in.x : nullptr; ge.xinb = WSP(bf16_t, WS_XB); ge.xoutb = WSP(bf16_t, WS_XB); ge.gate = modl + 2 * D; ge.p0 = in.norm2_gain + l * D; ge.p1 = modl + 4 * D; break;
        case 6: gA = WSP(bf16_t, WS_H); gB = WSP(bf16_t, WS_WQ) + (size_t)l * 2048 * D; gN = 2048; gK = D; ge.mode = 4; ge.O = WSP(bf16_t, WS_QP); ge.ldc = 2048; ge.p0 = WSP(float, WS_CV) + (size_t)l * 2 * 2048; break;
        case 7: { HY_MKCTX(); ph_peer_topk(C, WSP(bf16_t, WS_QP), WSP(bf16_t, WS_SUBK) + (size_t)l * 16 * 128 * 128, WSP(int, WS_EIDX), WSP(float, WS_GATE)); } break;
        case 8: { HY_MKCTX(); GatherP gp; gp.H = WSP(bf16_t, WS_H); gp.EIDX = WSP(int, WS_EIDX); gp.GATE = WSP(float, WS_GATE); gp.U8 = WSP(unsigned char, WS_PU) + (size_t)l * 16384 * 512; gp.SU = WSP(float, WS_PSU) + l * 16384;
                  gp.V8 = WSP(unsigned char, WS_PV) + (size_t)l * 16384 * 512; gp.SV = WSP(float, WS_PSU) + (NL + l) * 16384; gp.g2 = modl + 5 * D; gp.xinb = WSP(bf16_t, WS_XB); gp.xout = (rep + 1 < nrep) ? WSP(float, WS_P1) : out; gp.xoutb = (l + 1 < NL) ? ((rep + 1 < nrep) ? WSP(bf16_t, WS_P1) : WSP(bf16_t, WS_XB)) : nullptr;
                  gp.SSX = WSP(float, WS_SSX); gp.sh2 = modl + 3 * D; gp.ngain = (l + 1 < NL && rep + 1 == nrep) ? in.norm1_gain + (l + 1) * D : nullptr; gp.nmod = modl + 2 * MODW;
                  gp.var = (rep + 1 < nrep && HY_PROBE >= 40 && HY_PROBE < 50) ? HY_PROBE - 40 : 0;
#ifdef HY_GSUB
                  { Ctx C3 = C; if ((C.bid & 3) == 3) { C3.bid = 1 << 20; } else { C3.bid = C.bid - (C.bid >> 2); } C3.nblk = 192; ph_peer_gather2(C3, gp); }
#else
                  ph_peer_gather4(C, gp);
#endif
                  } break;
        default: break;
        }
        if (gA) {
            HY_MKCTX();
            pg8::Gemm g; g.A = gA; g.Bt = gB; g.M = M; g.N = gN; g.K = gK;
            pg8::StaticOrder So; So.init(M, gN, C.nblk, C.bid);
            pg8::gemm_phase<EpiGen, pg8::StaticOrder, true, true>((PG8_LAS unsigned char*)C.lds, g, So, ge, C.tid);
        }
        if (s == 1) { HY_MKCTX(); ph_s5_chunk_states(C, WSP(bf16_t, WS_U), WSP(bf16_t, WS_WE) + (size_t)l * S5_WE_L, WSP(float, WS_E)); }
        if (rep + 1 < nrep) GSYNC();
        }
        GSYNC();
    }
}
}

extern "C" void kernel_launch(void* const* d_in, const int* in_sizes, int n_in, void* d_out, int out_size, void* d_ws, size_t ws_size, hipStream_t stream) {
    using namespace hy;
    static int grid_blocks = 0;
    if (grid_blocks == 0) {
        if (n_in != 32 || out_size != M * D || ws_size < WS_END) { fprintf(stderr, "kernel_launch: unexpected problem (n_in %d out %d ws %zu)\n", n_in, out_size, ws_size); grid_blocks = -1; return; }
        (void)hipFuncSetAttribute((const void*)k_fwd, hipFuncAttributeMaxDynamicSharedMemorySize, LDS_BYTES);
        int dev = 0, cus = 0, per_cu = 0;
        (void)hipGetDevice(&dev);
        (void)hipDeviceGetAttribute(&cus, hipDeviceAttributeMultiprocessorCount, dev);
        (void)hipOccupancyMaxActiveBlocksPerMultiprocessor(&per_cu, (const void*)k_fwd, NT, LDS_BYTES);
        if (per_cu < 1) { fprintf(stderr, "kernel_launch: occupancy query says %d blocks/CU\n", per_cu); per_cu = 1; }
        grid_blocks = cus;
        fprintf(stderr, "kernel_launch: cus %d per_cu %d grid %d\n", cus, per_cu, grid_blocks);
    }
    if (grid_blocks < 0) return;
    Params P; memset(&P, 0, sizeof(P));
    { const float** p = (const float**)&P.in; for (int i = 0; i < 32; ++i) p[i] = (const float*)d_in[i]; }
    P.out = (float*)d_out; P.ws = (unsigned char*)d_ws;
    void* args[] = {&P};
    hipError_t e = hipLaunchCooperativeKernel((const void*)k_fwd, dim3(grid_blocks), dim3(NT), args, LDS_BYTES, stream);
    if (e != hipSuccess) fprintf(stderr, "cooperative launch failed: %s (grid %d)\n", hipGetErrorString(e), grid_blocks);
}
```

```cpp
#include <hip/hip_runtime.h>
#include <cstdint>
#include <cstdio>
#include <cstring>
#include <hip/hip_cooperative_groups.h>
#ifndef HY_PROBE
#define HY_PROBE 0
#endif
#define LAS __attribute__((address_space(3)))
#define XB_TMO      128
#define XB_XCNT(j)  (256  + 64 * (j))
#define XB_XSUB(j)  (1280 + 64 * (j))
#define XB_XGEN(j)  (2304 + 64 * (j))
#define XB_TOP      3328
#define XB_TOPGEN   3392
#define XCD_BAR_WORDS 3456
#define XB_SPIN_CAP (1u << 18)

__device__ __forceinline__ unsigned xb_ld(unsigned* p)              { return __hip_atomic_load(p, __ATOMIC_RELAXED, __HIP_MEMORY_SCOPE_AGENT); }
__device__ __forceinline__ unsigned xb_add(unsigned* p, unsigned v) { return __hip_atomic_fetch_add(p, v, __ATOMIC_RELAXED, __HIP_MEMORY_SCOPE_AGENT); }
__device__ __forceinline__ unsigned xb_xcc_id() { return (unsigned)__builtin_amdgcn_s_getreg((3 << 11) | 20) & 0xFu; }
#define XB_SPIN(cond, bar) do { unsigned _sp = 0; while (cond) { __builtin_amdgcn_s_sleep(1); \
    if ((++_sp & 255u) == 0u) { if (xb_ld(&(bar)[XB_TMO])) break; if (_sp > XB_SPIN_CAP) { atomicAdd(&(bar)[XB_TMO], 1u); break; } } } } while (0)

struct XcdBarrier {
    unsigned* bar; unsigned x;
    volatile LAS unsigned* st;
};

__device__ __forceinline__ XcdBarrier xcd_barrier_post(unsigned* bar, volatile LAS unsigned* st, int tid) {
    XcdBarrier b; b.bar = bar; b.x = xb_xcc_id(); b.st = st;
    if (tid == 0) (void)xb_add(&bar[XB_XCNT(b.x)], 1u);
    return b;
}
__device__ __forceinline__ void xcd_barrier_complete(unsigned* bar, unsigned x, unsigned& nloc, unsigned& nx) {
    const unsigned G = gridDim.x * gridDim.y * gridDim.z;
    unsigned sum, cnt, mine, sp = 0u;
    for (;;) {
        sum = 0u; cnt = 0u; mine = 0u;
#pragma unroll
        for (unsigned j = 0; j < 16; ++j) { const unsigned c = xb_ld(&bar[XB_XCNT(j)]); sum += c; cnt += (c > 0u) ? 1u : 0u; mine = (j == x) ? c : mine; }
        if (sum == G) break;
        __builtin_amdgcn_s_sleep(1);
        if ((++sp & 255u) == 0u) { if (xb_ld(&bar[XB_TMO])) break; if (sp > XB_SPIN_CAP) { atomicAdd(&bar[XB_TMO], 1u); break; } }
    }
    nloc = mine > 0u ? mine : 1u; nx = cnt > 0u ? cnt : 1u;
}

__device__ __forceinline__ void xcd_barrier(const XcdBarrier& b, int tid) {
    asm volatile("s_waitcnt vmcnt(0)" ::: "memory");
    __syncthreads();
    if (tid == 0) {
        unsigned* bar = b.bar;
        __builtin_amdgcn_s_waitcnt(0);
        unsigned nloc = b.st[0], nx = b.st[1];
        if (nloc == 0u) { xcd_barrier_complete(bar, b.x, nloc, nx); b.st[0] = nloc; b.st[1] = nx; }
        const unsigned old = xb_add(&bar[XB_XSUB(b.x)], 1u);
        const unsigned gen = old / nloc;
        if (old + 1u == (gen + 1u) * nloc) {
            __builtin_amdgcn_fence(__ATOMIC_RELEASE, "agent");
            asm volatile("s_waitcnt vmcnt(0)" ::: "memory");
            const unsigned og = xb_add(&bar[XB_TOP], 1u);
            const unsigned tg = og / nx;
            if (og + 1u == (tg + 1u) * nx) xb_add(&bar[XB_TOPGEN], 1u);
            else XB_SPIN(xb_ld(&bar[XB_TOPGEN]) == tg, bar);
            __builtin_amdgcn_fence(__ATOMIC_ACQUIRE, "agent");
            xb_add(&bar[XB_XGEN(b.x)], 1u);
            asm volatile("s_waitcnt vmcnt(0)" ::: "memory");
        } else {
            XB_SPIN(xb_ld(&bar[XB_XGEN(b.x)]) == gen, bar);
            __builtin_amdgcn_fence(__ATOMIC_ACQUIRE, "agent");
            asm volatile("s_waitcnt vmcnt(0)" ::: "memory");
        }
    }
    __syncthreads();
}
namespace pg8 {
#define PG8_LAS __attribute__((address_space(3)))
typedef unsigned short bf16_t;
typedef short bf16x8 __attribute__((ext_vector_type(8)));
typedef float f32x4 __attribute__((ext_vector_type(4)));
typedef unsigned u32x4 __attribute__((ext_vector_type(4)));
constexpr int BM = 256, BK = 64, HALF = 128, HTB = HALF * BK * 2  , STAGE_BYTES = 8 * HTB, NXCD = 8, WGM = 8;

__host__ __device__ __forceinline__ int lds_byte(int r, int c) { const int st = (r >> 4) * 2 + (c >> 5), rr = r & 15, cc = c & 31, ob = rr * 64 + cc * 2; return st * 1024 + (ob ^ (((ob >> 9) & 1) << 5)); }
__host__ __device__ __forceinline__ void stage_rc(int b, int& R, int& C) { const int st = b / 1024, sb = b % 1024, swz = sb ^ (((sb >> 9) & 1) << 5); R = (st >> 1) * 16 + swz / 64; C = (st & 1) * 32 + (swz % 64) / 2; }
__host__ __device__ __forceinline__ int perm32(int rho) { const int n = rho >> 4, i = rho & 15; return 8 * (i >> 2) + 4 * n + (i & 3); }

struct Unit { int pm, pn; };
struct Gemm { const bf16_t* A; const bf16_t* Bt; int M, N, K; };

struct StaticOrder {
    int nM, nN, nwg, G, c;
    __host__ __device__ void init(int M, int N, int G_, int c_) { nM = M / BM; nN = N / BM; nwg = nM * nN; G = G_; c = c_; }
    __host__ __device__ bool next(int i, Unit& u) const {
        const long L = (long)i * G + c; if (L >= nwg) return false;
        int wgid = (int)L; { const int q = nwg / NXCD, r = nwg % NXCD, xcd = wgid % NXCD, off = wgid / NXCD; wgid = (xcd < r ? xcd * (q + 1) : r * (q + 1) + (xcd - r) * q) + off; }
        const int nig = WGM * nN, gid = wgid / nig, fm = gid * WGM, gsz = (nM - fm) < WGM ? (nM - fm) : WGM;
        u.pm = fm + ((wgid % nig) % gsz); u.pn = (wgid % nig) / gsz; return true;
    }
    __device__ __forceinline__ void a_ready(const Unit&) const {}
    __device__ __forceinline__ void done(const Unit&) const {}
};

__device__ __forceinline__ unsigned cvt_pk_bf16(float lo, float hi) { unsigned r; asm volatile("v_cvt_pk_bf16_f32 %0, %1, %2" : "=v"(r) : "v"(lo), "v"(hi)); return r; }
typedef float f32x2 __attribute__((ext_vector_type(2)));
__device__ __forceinline__ f32x2 gelu_pk(f32x2 v) {
    const f32x2 av = __builtin_elementwise_abs(v), d = av * 0.2316418882f + 1.0f;
    f32x2 t; t.x = __builtin_amdgcn_rcpf(d.x); t.y = __builtin_amdgcn_rcpf(d.y);
    f32x2 q = t * 0.5307027145f + (-0.7265760135f); q = q * t + 0.7107068705f; q = q * t + (-0.142248368f); q = q * t + 0.127414796f; q = q * t;
    const f32x2 s = (v * v) * (-0.72134752044f);
    f32x2 e; e.x = __builtin_amdgcn_exp2f(s.x); e.y = __builtin_amdgcn_exp2f(s.y);
    const f32x2 m = v * (q * e), r = v - m;
    f32x2 o; o.x = v.x < 0.f ? m.x : r.x; o.y = v.y < 0.f ? m.y : r.y; return o;
}

template <int ACT  > struct EpiBf16 {
    static constexpr bool PERM = true, AFTER_DRAIN = false; static_assert(ACT == 0 || ACT == 1, "EpiBf16: ACT is 0 (none) or 1 (gelu_pk)");
    bf16_t* O; int ldc; const float* bias; int split_cols; size_t split_stride; float scale0;
    __device__ __forceinline__ void operator()(const f32x4 (&acc)[2][2][4][2], const Unit& u, int wr, int wc, int fr, int fq) const {
        const int row0 = u.pm * BM + wr * 64 + fr; int colt = u.pn * BM; bf16_t* base = O;
        float sc = 1.f; if (split_cols) { const int t = colt / split_cols; base += (size_t)t * split_stride; colt -= t * split_cols; if (t == 0) sc = scale0; }
        const int col0 = colt + wc * 32 + 8 * fq, bcol0 = u.pn * BM + wc * 32 + 8 * fq;
        f32x4 bv[2][2];
#pragma unroll
        for (int bj = 0; bj < 2; ++bj)
#pragma unroll
            for (int n = 0; n < 2; ++n) bv[bj][n] = bias ? *(const f32x4*)(bias + bcol0 + bj * HALF + 4 * n) : (f32x4){0.f, 0.f, 0.f, 0.f};
#pragma unroll
        for (int ai = 0; ai < 2; ++ai)
#pragma unroll
            for (int m = 0; m < 4; ++m) { bf16_t* rowp = base + (size_t)(row0 + ai * HALF + m * 16) * ldc + col0;
#pragma unroll
                for (int bj = 0; bj < 2; ++bj) { f32x4 v0 = acc[ai][bj][m][0] + bv[bj][0], v1 = acc[ai][bj][m][1] + bv[bj][1];
                    if (ACT == 1) { f32x2 a = gelu_pk((f32x2){v0[0], v0[1]}), b = gelu_pk((f32x2){v0[2], v0[3]}), c = gelu_pk((f32x2){v1[0], v1[1]}), d = gelu_pk((f32x2){v1[2], v1[3]});
                        v0 = (f32x4){a.x, a.y, b.x, b.y}; v1 = (f32x4){c.x, c.y, d.x, d.y}; }
                    v0 = v0 * sc; v1 = v1 * sc; u32x4 w; w.x = cvt_pk_bf16(v0[0], v0[1]); w.y = cvt_pk_bf16(v0[2], v0[3]); w.z = cvt_pk_bf16(v1[0], v1[1]); w.w = cvt_pk_bf16(v1[2], v1[3]);
                    *(u32x4*)(rowp + bj * HALF) = w; } }
    }
};
template <class Epi, class Sched, bool ALIGN_EPI = false, bool SP2 = false>
__device__ __forceinline__ void gemm_phase(PG8_LAS unsigned char* lds, const Gemm g, const Sched& S, const Epi& E, int tid_in) {
    int tid_o = tid_in; asm volatile("" : "+v"(tid_o));
    const int tid = tid_o, wid = __builtin_amdgcn_readfirstlane(tid >> 6), lane = tid & 63, wr = wid >> 2, wc = wid & 3, fr = lane & 15, fq = lane >> 4;
    const int K = g.K, nt = K / BK;
    unsigned voffA[2], voffB[2];
#pragma unroll
    for (int i = 0; i < 2; ++i) { int R, C; stage_rc(tid * 16 + i * 8192, R, C); const int Rb = Epi::PERM ? ((R & ~31) + perm32(R & 31)) : R;
        voffA[i] = (unsigned)(R * K + C) * 2u; voffB[i] = (unsigned)(Rb * K + C) * 2u; }
    const size_t kstep = (size_t)(BK * 2);
    const size_t hstep = (size_t)HALF * K * 2;
    const size_t tstep = 2 * hstep;
    const unsigned ldsw = (unsigned)wid * 1024u;
    const int aoff = lds_byte(wr * 64 + fr, fq * 8), boff = lds_byte(wc * 32 + fr, fq * 8);
#define PG8_SA(b, h) (((b) * 2 + (h)) * HTB)
#define PG8_SB(b, h) ((4 + (b) * 2 + (h)) * HTB)
#define PG8_STAGE(bufoff, gbase, voff) do { _Pragma("unroll") for (int _i = 0; _i < 2; ++_i) \
        __builtin_amdgcn_global_load_lds((const unsigned*)((const char*)(gbase) + (voff)[_i]), (PG8_LAS unsigned*)(lds + (bufoff) + ldsw + _i * 8192), 16, 0, 0); } while (0)
#define PG8_LDA(dst, b, h) do { _Pragma("unroll") for (int m = 0; m < 4; ++m) _Pragma("unroll") for (int k = 0; k < 2; ++k) dst[m][k] = *(const PG8_LAS bf16x8*)(lds + PG8_SA(b, h) + aoff + m * 2048 + k * 1024); } while (0)
#define PG8_LDB(dst, b, h) do { _Pragma("unroll") for (int n = 0; n < 2; ++n) _Pragma("unroll") for (int k = 0; k < 2; ++k) dst[n][k] = *(const PG8_LAS bf16x8*)(lds + PG8_SB(b, h) + boff + n * 2048 + k * 1024); } while (0)
#define PG8_MMA(ai, bj, At, Bt) do { __builtin_amdgcn_s_setprio(1); _Pragma("unroll") for (int m = 0; m < 4; ++m) _Pragma("unroll") for (int n = 0; n < 2; ++n) _Pragma("unroll") for (int k = 0; k < 2; ++k) \
        acc[ai][bj][m][n] = __builtin_amdgcn_mfma_f32_16x16x32_bf16(Bt[n][k], At[m][k], acc[ai][bj][m][n], 0, 0, 0); __builtin_amdgcn_s_setprio(0); } while (0)
#define PG8_WAIT_V(n) asm volatile("s_waitcnt vmcnt(" #n ")" ::: "memory")
#define PG8_WAIT_L(n) asm volatile("s_waitcnt lgkmcnt(" #n ")" ::: "memory")
#define PG8_BAR __builtin_amdgcn_s_barrier()
#define PG8_SCHED __builtin_amdgcn_sched_barrier(0)
    Unit cur, nxt; int ui = 0;
    if (!S.next(0, cur)) return;
    f32x4 acc[2][2][4][2];
#pragma unroll
    for (int a = 0; a < 2; ++a)
#pragma unroll
        for (int b = 0; b < 2; ++b)
#pragma unroll
            for (int m = 0; m < 4; ++m)
#pragma unroll
                for (int n = 0; n < 2; ++n) acc[a][b][m][n] = (f32x4){0.f, 0.f, 0.f, 0.f};
    bf16x8 At[4][2], B0[2][2], B1[2][2];
    const char* cA = (const char*)g.A + (size_t)cur.pm * tstep; const char* cB = (const char*)g.Bt + (size_t)cur.pn * tstep;
    S.a_ready(cur);
    if constexpr (SP2) {
        PG8_STAGE(PG8_SB(0, 0), cB, voffB); PG8_STAGE(PG8_SB(0, 1), cB + hstep, voffB); PG8_STAGE(PG8_SA(0, 0), cA, voffA); PG8_STAGE(PG8_SA(0, 1), cA + hstep, voffA);
        if (wr == 1) PG8_BAR;
        PG8_WAIT_V(2); PG8_BAR;
        PG8_STAGE(PG8_SB(1, 0), cB + kstep, voffB); PG8_STAGE(PG8_SA(1, 0), cA + kstep, voffA); PG8_STAGE(PG8_SB(1, 1), cB + hstep + kstep, voffB);
        PG8_WAIT_V(6); PG8_BAR;
    } else {
        PG8_STAGE(PG8_SB(0, 0), cB, voffB); PG8_STAGE(PG8_SA(0, 0), cA, voffA); PG8_STAGE(PG8_SB(0, 1), cB + hstep, voffB); PG8_STAGE(PG8_SA(0, 1), cA + hstep, voffA);
        if (wr == 1) PG8_BAR;
        PG8_WAIT_V(4); PG8_BAR;
        PG8_STAGE(PG8_SB(1, 0), cB + kstep, voffB); PG8_STAGE(PG8_SA(1, 0), cA + kstep, voffA); PG8_STAGE(PG8_SB(1, 1), cB + hstep + kstep, voffB);
        PG8_WAIT_V(6); PG8_BAR;
    }
    for (;;) {
        const bool has_next = S.next(ui + 1, nxt);
        const char* nA = has_next ? (const char*)g.A + (size_t)nxt.pm * tstep : cA; const char* nB = has_next ? (const char*)g.Bt + (size_t)nxt.pn * tstep : cB;
        for (int t = 0; t < nt; t += 2) {
            const bool last = (t == nt - 2);
            const char* a1 = cA + (size_t)(t + 1) * kstep;
            const char* a2 = last ? nA : cA + (size_t)(t + 2) * kstep; const char* b2 = last ? nB : cB + (size_t)(t + 2) * kstep;
            const char* a3 = a2 + kstep; const char* b3 = b2 + kstep;
            if (last && has_next) S.a_ready(nxt);
            if constexpr (SP2) {
            PG8_LDB(B0, 0, 0); PG8_LDB(B1, 0, 1); PG8_SCHED; PG8_LDA(At, 0, 0); PG8_STAGE(PG8_SA(1, 1), a1 + hstep, voffA);
            PG8_WAIT_V(8); PG8_WAIT_L(0); PG8_BAR; PG8_MMA(0, 0, At, B0); PG8_MMA(0, 1, At, B1); PG8_BAR; PG8_SCHED;
            PG8_LDA(At, 0, 1); PG8_STAGE(PG8_SB(0, 0), b2, voffB); PG8_STAGE(PG8_SB(0, 1), b2 + hstep, voffB); PG8_STAGE(PG8_SA(0, 0), a2, voffA);
            PG8_WAIT_V(8); PG8_WAIT_L(0); PG8_BAR; PG8_MMA(1, 0, At, B0); PG8_MMA(1, 1, At, B1); PG8_BAR; PG8_SCHED;
            PG8_LDB(B0, 1, 0); PG8_LDB(B1, 1, 1); PG8_SCHED; PG8_LDA(At, 1, 0); PG8_STAGE(PG8_SA(0, 1), a2 + hstep, voffA);
            PG8_WAIT_V(8); PG8_WAIT_L(0); PG8_BAR; PG8_MMA(0, 0, At, B0); PG8_MMA(0, 1, At, B1); PG8_BAR; PG8_SCHED;
            PG8_LDA(At, 1, 1); PG8_STAGE(PG8_SB(1, 0), b3, voffB); PG8_STAGE(PG8_SB(1, 1), b3 + hstep, voffB); PG8_STAGE(PG8_SA(1, 0), a3, voffA);
            PG8_WAIT_V(8); PG8_WAIT_L(0); PG8_BAR; PG8_MMA(1, 0, At, B0); PG8_MMA(1, 1, At, B1); PG8_BAR; PG8_SCHED;
            } else {
            PG8_LDB(B0, 0, 0); PG8_SCHED; PG8_LDA(At, 0, 0); PG8_STAGE(PG8_SA(1, 1), a1 + hstep, voffA);
            PG8_WAIT_L(8); PG8_BAR; PG8_WAIT_L(0); PG8_MMA(0, 0, At, B0); PG8_BAR; PG8_SCHED;
            PG8_LDB(B1, 0, 1); PG8_STAGE(PG8_SB(0, 0), b2, voffB);
            PG8_BAR; PG8_WAIT_L(0); PG8_MMA(0, 1, At, B1); PG8_BAR;
            PG8_LDA(At, 0, 1); PG8_STAGE(PG8_SA(0, 0), a2, voffA);
            PG8_BAR; PG8_WAIT_L(0); PG8_MMA(1, 0, At, B0); PG8_BAR; PG8_SCHED;
            PG8_STAGE(PG8_SB(0, 1), b2 + hstep, voffB);
            PG8_WAIT_V(6); PG8_BAR; PG8_MMA(1, 1, At, B1); PG8_BAR;
            PG8_LDB(B0, 1, 0); PG8_SCHED; PG8_LDA(At, 1, 0); PG8_STAGE(PG8_SA(0, 1), a2 + hstep, voffA);
            PG8_WAIT_L(8); PG8_BAR; PG8_WAIT_L(0); PG8_MMA(0, 0, At, B0); PG8_BAR; PG8_SCHED;
            PG8_LDB(B1, 1, 1); PG8_STAGE(PG8_SB(1, 0), b3, voffB);
            PG8_BAR; PG8_WAIT_L(0); PG8_MMA(0, 1, At, B1); PG8_BAR;
            PG8_LDA(At, 1, 1); PG8_STAGE(PG8_SA(1, 0), a3, voffA);
            PG8_BAR; PG8_WAIT_L(0); PG8_MMA(1, 0, At, B0); PG8_BAR; PG8_SCHED;
            PG8_STAGE(PG8_SB(1, 1), b3 + hstep, voffB);
            PG8_WAIT_V(6); PG8_BAR; PG8_MMA(1, 1, At, B1); PG8_BAR;
            }
        }
        if constexpr (ALIGN_EPI) { if (wr == 0) PG8_BAR; }
        if constexpr (!Epi::AFTER_DRAIN) { E(acc, cur, wr, wc, fr, fq); S.done(cur); }
        if (!has_next) break;
#pragma unroll
        for (int a = 0; a < 2; ++a)
#pragma unroll
            for (int b = 0; b < 2; ++b)
#pragma unroll
                for (int m = 0; m < 4; ++m)
#pragma unroll
                    for (int n = 0; n < 2; ++n) acc[a][b][m][n] = (f32x4){0.f, 0.f, 0.f, 0.f};
        cur = nxt; cA = nA; cB = nB; ++ui;
        if constexpr (ALIGN_EPI) { if (wr == 1) PG8_BAR; }
    }
    PG8_WAIT_V(0);
    if constexpr (!ALIGN_EPI) { if (wr == 0) PG8_BAR; }
    PG8_BAR;
    if constexpr (Epi::AFTER_DRAIN) { E.fused(acc, cur, wr, wc, fr, fq, lds, wid, lane); S.done(cur); }
#undef PG8_SA
#undef PG8_SB
#undef PG8_STAGE
#undef PG8_LDA
#undef PG8_LDB
#undef PG8_MMA
#undef PG8_WAIT_V
#undef PG8_WAIT_L
#undef PG8_BAR
#undef PG8_SCHED
}
}
namespace hy {
namespace cg = cooperative_groups;
typedef unsigned short bf16_t;
typedef unsigned u32x4 __attribute__((ext_vector_type(4)));
typedef unsigned u32x2 __attribute__((ext_vector_type(2)));
typedef float f32x4 __attribute__((ext_vector_type(4)));
constexpr int M = 16384, S = 8192, D = 1024, NL = 4;
constexpr int IN_COLS = 1824, P1W = 2048, P2W = 1536;
constexpr float EPS = 1e-6f, LOG2E = 1.4426950408889634f;
constexpr int MODW = 6 * D;
constexpr int NT = 512;
constexpr int LDS_BYTES = 147456;

__device__ __forceinline__ float bf2f(bf16_t v) { return __uint_as_float(((unsigned)v) << 16); }
__device__ __forceinline__ bf16_t f2bf(float f) { unsigned u = __float_as_uint(f); return (bf16_t)((u + 0x7fffu + ((u >> 16) & 1u)) >> 16); }
__device__ __forceinline__ unsigned pk2(float lo, float hi) { return (unsigned)f2bf(lo) | ((unsigned)f2bf(hi) << 16); }
__device__ __forceinline__ float lo16(unsigned w) { return __uint_as_float(w << 16); }
__device__ __forceinline__ float hi16(unsigned w) { return __uint_as_float(w & 0xffff0000u); }
__device__ __forceinline__ float wave_sum(float v) {
#pragma unroll
    for (int o = 1; o < 64; o <<= 1) v += __shfl_xor(v, o);
    return v;
}
__device__ __forceinline__ float gelu_tanh(float x) {
    const float k0 = 0.7978845608028654f, k1 = 0.044715f;
    float t = k0 * (x + k1 * x * x * x);
    float e = __expf(2.f * t);
    float th = 1.f - 2.f / (e + 1.f);
    return 0.5f * x * (1.f + th);
}

constexpr size_t MiB = 1ull << 20;
constexpr size_t WS_CTL = 0;
constexpr size_t WS_MOD = 1 * MiB;
constexpr size_t WS_BIAS = WS_MOD + 256 * 1024;
constexpr size_t WS_ROPE = 2 * MiB;
constexpr size_t WS_SQ = 3 * MiB;
constexpr size_t WS_WIN = 4 * MiB;
constexpr size_t WS_W2 = WS_WIN + 16 * MiB;
constexpr size_t WS_WOUT = WS_W2 + 6 * MiB;
constexpr size_t WS_WQ = WS_WOUT + 8 * MiB;
constexpr size_t WS_WGLU = WS_WQ + 16 * MiB;
constexpr size_t WS_SUBK = WS_WGLU + 1 * MiB;
constexpr size_t WS_PU = 64 * MiB;
constexpr size_t WS_PV = WS_PU + 64 * MiB;
constexpr size_t WS_PSU = WS_PV + 64 * MiB;
constexpr size_t WS_ACT = 320 * MiB;
constexpr size_t WS_H = WS_ACT;
constexpr size_t WS_P1 = WS_H + 32 * MiB;
constexpr size_t WS_QA = WS_P1 + 64 * MiB;
constexpr size_t WS_KA = WS_QA + 12 * MiB;
constexpr size_t WS_VA = WS_KA + 12 * MiB;
constexpr size_t WS_U = WS_VA + 12 * MiB;
constexpr size_t WS_CQKV = WS_U + 8 * MiB;
constexpr size_t WS_P2 = WS_CQKV + 12 * MiB;
constexpr size_t WS_QM = WS_P2 + 48 * MiB;
constexpr size_t WS_KM = WS_QM + 18 * MiB;
constexpr size_t WS_VM = WS_KM + 18 * MiB;
constexpr size_t WS_YA = WS_VM + 12 * MiB;
constexpr size_t WS_YC = WS_YA + 12 * MiB;
constexpr size_t WS_GS = WS_YC + 12 * MiB;
constexpr size_t WS_GL = WS_GS + 8 * MiB;
constexpr size_t WS_AOUT = WS_GL + 8 * MiB;
constexpr size_t WS_QP = WS_AOUT + 32 * MiB;
constexpr size_t WS_EIDX = WS_QP + 64 * MiB;
constexpr size_t WS_GATE = WS_EIDX + 8 * MiB;
constexpr size_t WS_TOPS = WS_GATE + 8 * MiB;
constexpr size_t WS_XB = WS_TOPS;
constexpr size_t WS_TOPI = WS_TOPS + 16 * MiB;
constexpr size_t WS_XST = WS_TOPI + 16 * MiB;
constexpr size_t WS_YAB = WS_XST + 128 * MiB;
constexpr size_t WS_MLB = WS_YAB + 36 * MiB;
constexpr size_t WS_LP = WS_MLB + 4 * MiB;
constexpr size_t WS_KMT = WS_LP + 4 * MiB;
constexpr size_t WS_WE = WS_KMT + 2 * MiB;
constexpr size_t WS_WC = WS_WE + 16 * MiB;
constexpr size_t WS_E = WS_WC + 16 * MiB;
constexpr size_t WS_SSQ = WS_E + 2 * MiB;
constexpr size_t WS_SSX = WS_SSQ + 1 * MiB;
constexpr size_t WS_CV = WS_SSX + 1 * MiB;
constexpr size_t WS_BB = WS_CV + 1 * MiB;
constexpr size_t WS_END = WS_BB + 1 * MiB;

struct In {
    const float *x, *c, *w_in, *w_out, *mix_gain, *norm1_gain, *norm2_gain, *w_ada, *b_ada, *rel_bias, *swa_q_gain, *swa_k_gain,
        *mla_q_lora_gain, *mla_kv_lora_gain, *w_uq, *w_ukv, *mla_q_gain, *mla_k_gain, *s5_a_re, *s5_a_im, *s5_b_re, *s5_b_im, *s5_c_re,
        *s5_c_im, *s5_d, *s5_log_dt, *w_glu, *b_glu, *peer_wq, *peer_subkeys, *peer_u, *peer_v;
};
struct Params { In in; float* out; unsigned char* ws; };

struct Ctx { int tid, lane, wave, bid, nblk; unsigned char* lds; };

__device__ __forceinline__ void gemv2_job(const Ctx& C, const float* a0, const float* a1, bool silu, const float* W, int ldw, int n0, const float* bias, float* out0, float* out1) {
    float* av = (float*)C.lds;
    float* red = av + 2 * D;
    for (int i = C.tid; i < D; i += NT) { float v0 = a0[i], v1 = a1[i]; if (silu) { v0 = v0 / (1.f + __expf(-v0)); v1 = v1 / (1.f + __expf(-v1)); } av[i] = v0; av[D + i] = v1; }
    __syncthreads();
    const int nq = C.tid & 7, ks = C.tid >> 3;
    const float* w = W + (size_t)(ks * 16) * ldw + n0 + nq * 4;
    f32x4 wv[16];
#pragma unroll
    for (int k = 0; k < 16; ++k) wv[k] = *(const f32x4*)(w + (size_t)k * ldw);
    f32x4 s0 = {0.f, 0.f, 0.f, 0.f}, s1 = {0.f, 0.f, 0.f, 0.f};
#pragma unroll
    for (int k = 0; k < 16; ++k) { s0 += av[ks * 16 + k] * wv[k]; s1 += av[D + ks * 16 + k] * wv[k]; }
#pragma unroll
    for (int j = 0; j < 4; ++j) { red[(ks * 32 + nq * 4 + j) * 2] = s0[j]; red[(ks * 32 + nq * 4 + j) * 2 + 1] = s1[j]; }
    __syncthreads();
    if (C.tid < 64) {
        const int b = C.tid >> 5, nn = C.tid & 31; float t = 0.f;
#pragma unroll 16
        for (int q = 0; q < 64; ++q) t += red[(q * 32 + nn) * 2 + b];
        if (bias) t += bias[n0 + nn];
        (b ? out1 : out0)[n0 + nn] = t;
    }
    __syncthreads();
}
__device__ __forceinline__ void ph_mod(const Ctx& C, const float* c, const float* w_ada, const float* b_ada, float* mod) {
    for (int job = C.bid; job < NL * (MODW / 32); job += C.nblk) {
        const int l = job / (MODW / 32), n0 = (job % (MODW / 32)) * 32;
        gemv2_job(C, c, c + D, true, w_ada + (size_t)l * D * MODW, MODW, n0, b_ada + l * MODW, mod + (size_t)(l * 2) * MODW, mod + (size_t)(l * 2 + 1) * MODW);
    }
}
__device__ __forceinline__ void ph_cvec(const Ctx& C, const float* wq, const float* mod, float* cv) {
    for (int job = C.bid; job < NL * 64; job += C.nblk) {
        const int l = job >> 6, n0 = (job & 63) * 32;
        gemv2_job(C, mod + (size_t)(l * 2) * MODW + 3 * D, mod + (size_t)(l * 2 + 1) * MODW + 3 * D, false, wq + (size_t)l * D * 2048, 2048, n0, nullptr, cv + (l * 2) * 2048, cv + (l * 2 + 1) * 2048);
    }
}
__device__ __forceinline__ int t5_bucket(int dist) {
    if (dist < 16) return dist;
    float df = (float)dist;
    float v = logf(df / 16.f) / 4.852030263919617f * 16.f;
    int large = 16 + (int)v;
    return large < 31 ? large : 31;
}
__device__ __forceinline__ void ph_bounds(const Ctx& C, const In& in, float* bnd) {
    if (C.bid == 0 && C.tid < NL) {
        const int l = C.tid;
        float sq = 0.f, sk = 0.f, aq = 0.f, ak = 0.f, bm = 0.f;
        for (int d = 0; d < 96; ++d) { const float gq = in.mla_q_gain[l * 96 + d], gk = in.mla_k_gain[l * 96 + d]; sq += gq * gq; sk += gk * gk; }
        for (int d = 0; d < 64; ++d) { const float gq = in.swa_q_gain[l * 64 + d], gk = in.swa_k_gain[l * 64 + d]; aq += gq * gq; ak += gk * gk; }
        for (int i = 0; i < 6 * 32; ++i) bm = fmaxf(bm, fabsf(in.rel_bias[i]));
        bnd[l * 2 + 0] = 0.10206207261596575f * LOG2E * sqrtf(sq) * sqrtf(sk) * 1.01f;
        bnd[l * 2 + 1] = (0.125f * sqrtf(aq) * sqrtf(ak) * 1.01f + bm) * LOG2E;
    }
}
__device__ __forceinline__ void ph_tables(const Ctx& C, const float* rel_bias, float* bias, float* rope) {
    for (int gid = C.bid * NT + C.tid; gid < S * 16; gid += C.nblk * NT) {
        if (gid < 3 * 6 * 132) {
            const int br = gid / (6 * 132), h = (gid / 132) % 6, j = gid % 132;
            const int dil = br == 0 ? 1 : (br == 1 ? 4 : 16);
            float v = 0.f;
            if (j <= 128) v = rel_bias[h * 32 + t5_bucket(dil * j)] * LOG2E;
            bias[gid] = v;
        }
        const int pos = gid / 16, i = gid % 16;
        const float inv = (float)pow(10000.0, -(double)(2 * i) / 32.0);
        const float ang = (float)pos * inv;
        rope[gid] = (float)cos((double)ang);
        rope[S * 16 + gid] = (float)sin((double)ang);
    }
}

struct TC { const float* src; size_t src_lstride; int ld_src; int K_src; bf16_t* dst; size_t dst_lstride; int ld_dst; int k_off; int n_rows; int n_valid; int mode; const float* kscale; int kscale_lstride; };
__device__ __forceinline__ TC get_tc(int which, const Params& P) {
    TC t; t.kscale = nullptr; t.kscale_lstride = 0; t.k_off = 0; t.mode = 0;
    unsigned char* ws = P.ws;
    switch (which) {
    case 0: t.src = P.in.w_in; t.src_lstride = (size_t)D * IN_COLS; t.ld_src = IN_COLS; t.K_src = D; t.dst = (bf16_t*)(ws + WS_WIN); t.dst_lstride = (size_t)P1W * D; t.ld_dst = D; t.n_rows = P1W; t.n_valid = IN_COLS; t.mode = 2; break;
    case 1: t.src = P.in.w_uq; t.src_lstride = 256 * 576; t.ld_src = 576; t.K_src = 256; t.dst = (bf16_t*)(ws + WS_W2); t.dst_lstride = (size_t)P2W * 384; t.ld_dst = 384; t.n_rows = 768; t.n_valid = 768; t.mode = 1; t.kscale = P.in.mla_q_lora_gain; t.kscale_lstride = 256; break;
    case 2: t.src = P.in.w_ukv; t.src_lstride = 128 * 768; t.ld_src = 768; t.K_src = 128; t.dst = (bf16_t*)(ws + WS_W2); t.dst_lstride = (size_t)P2W * 384; t.ld_dst = 384; t.k_off = 256; t.n_rows = 768; t.n_valid = 768; t.mode = 3; t.kscale = P.in.mla_kv_lora_gain; t.kscale_lstride = 128; break;
    case 3: t.src = P.in.w_out; t.src_lstride = (size_t)D * D; t.ld_src = D; t.K_src = D; t.dst = (bf16_t*)(ws + WS_WOUT); t.dst_lstride = (size_t)D * D; t.ld_dst = D; t.n_rows = D; t.n_valid = D; t.kscale = P.in.mix_gain; t.kscale_lstride = D; break;
    case 4: t.src = P.in.peer_wq; t.src_lstride = (size_t)D * 2048; t.ld_src = 2048; t.K_src = D; t.dst = (bf16_t*)(ws + WS_WQ); t.dst_lstride = (size_t)2048 * D; t.ld_dst = D; t.n_rows = 2048; t.n_valid = 2048; break;
    default: t.src = P.in.w_glu; t.src_lstride = 256 * 256; t.ld_src = 256; t.K_src = 256; t.dst = (bf16_t*)(ws + WS_WGLU); t.dst_lstride = 256 * 256; t.ld_dst = 256; t.n_rows = 256; t.n_valid = 256; break;
    }
    return t;
}
__device__ __forceinline__ void ph_tconv(const Ctx& C, const Params& P) {
    const int stid = C.tid & 255, sub = C.tid >> 8;
    constexpr int TQ = 4;
    float* tl0 = (float*)C.lds + sub * (TQ * 64 * 65);
    constexpr int C0 = 32 * 16, C1 = 12 * 4, C2 = 12 * 2, C3 = 16 * 16, C4 = 32 * 16, C5 = 4 * 4;
    constexpr int total = (C0 + C1 + C2 + C3 + C4 + C5) * NL;
    for (int j0 = C.bid * 2 * TQ; j0 < total; j0 += C.nblk * 2 * TQ) {
        bf16_t* oaddr[TQ]; bool val[TQ];
#pragma unroll
        for (int q = 0; q < TQ; ++q) {
            float* tl = tl0 + q * (64 * 65);
            const int job = j0 + sub * TQ + q; const bool valid = job < total; val[q] = valid;
            int which = 0, r = valid ? job : 0, per = C0;
            if (r >= C0 * NL) { r -= C0 * NL; which = 1; per = C1;
                if (r >= C1 * NL) { r -= C1 * NL; which = 2; per = C2;
                    if (r >= C2 * NL) { r -= C2 * NL; which = 3; per = C3;
                        if (r >= C3 * NL) { r -= C3 * NL; which = 4; per = C4;
                            if (r >= C4 * NL) { r -= C4 * NL; which = 5; per = C5; } } } } }
            const TC p = get_tc(which, P);
            const int l = r / per, rr = r % per, ntn = p.n_rows / 64, k0 = (rr / ntn) * 64;
            int n0 = (rr % ntn) * 64;
            if (which == 1 || which == 2) { const int rt = rr % ntn; n0 = (rt >> 1) * 256 + (rt & 1) * 128 + (which == 2 ? 64 : 0); }
            const float* src = p.src + (size_t)l * p.src_lstride;
            const int nq = stid & 15, n = n0 + nq * 4;
            int col;
            if (p.mode == 0) col = n < p.n_valid ? n : -1;
            else if (p.mode == 1) { const int hh = n >> 8, wc = (n >> 5) & 3, d = 32 * ((n >> 7) & 1) + (n & 31); col = wc == 0 ? hh * 96 + d : (d < 32 ? hh * 96 + 64 + d : -1); }
            else if (p.mode == 3) { const int hh = n >> 8, wc = (n >> 5) & 3, d = 32 * ((n >> 7) & 1) + (n & 31); col = hh * 128 + (wc - 2) * 64 + d; }
            else {
                const int t = n >> 8, bj = (n >> 7) & 1, wc = (n >> 5) & 3, d = 32 * bj + (n & 31), uu = 4 * t + wc;
                if (uu < 18) col = 64 * uu + d;
                else if (uu < 20) col = 1664 + 64 * (uu - 18) + d;
                else if (uu < 24) col = 1408 + 64 * (uu - 20) + d;
                else if (uu < 28) col = 1152 + 64 * (uu - 24) + d;
                else if (uu == 28 && d < 32) col = 1792 + d;
                else col = -1;
            }
            oaddr[q] = p.dst + (size_t)l * p.dst_lstride + (size_t)(n0 + (stid >> 2)) * p.ld_dst + p.k_off + k0 + (stid & 3) * 16;
            if (valid) {
#pragma unroll
                for (int i = 0; i < 4; ++i) {
                    const int kk = i * 16 + (stid >> 4), k = k0 + kk;
                    f32x4 v = {0.f, 0.f, 0.f, 0.f};
                    if (col >= 0) v = *(const f32x4*)(src + (size_t)k * p.ld_src + col);
                    if (p.kscale) v *= p.kscale[l * p.kscale_lstride + k];
                    tl[kk * 65 + nq * 4] = v[0]; tl[kk * 65 + nq * 4 + 1] = v[1]; tl[kk * 65 + nq * 4 + 2] = v[2]; tl[kk * 65 + nq * 4 + 3] = v[3];
                }
            }
        }
        __syncthreads();
#pragma unroll
        for (int q = 0; q < TQ; ++q) {
            if (val[q]) {
                const float* tl = tl0 + q * (64 * 65);
                const int nl = stid >> 2, kc = (stid & 3) * 16;
                u32x4 o0, o1;
                o0.x = pk2(tl[(kc + 0) * 65 + nl], tl[(kc + 1) * 65 + nl]); o0.y = pk2(tl[(kc + 2) * 65 + nl], tl[(kc + 3) * 65 + nl]); o0.z = pk2(tl[(kc + 4) * 65 + nl], tl[(kc + 5) * 65 + nl]); o0.w = pk2(tl[(kc + 6) * 65 + nl], tl[(kc + 7) * 65 + nl]);
                o1.x = pk2(tl[(kc + 8) * 65 + nl], tl[(kc + 9) * 65 + nl]); o1.y = pk2(tl[(kc + 10) * 65 + nl], tl[(kc + 11) * 65 + nl]); o1.z = pk2(tl[(kc + 12) * 65 + nl], tl[(kc + 13) * 65 + nl]); o1.w = pk2(tl[(kc + 14) * 65 + nl], tl[(kc + 15) * 65 + nl]);
                *(u32x4*)oaddr[q] = o0; *(u32x4*)(oaddr[q] + 8) = o1;
            }
        }
        __syncthreads();
    }
}
__device__ __forceinline__ void ph_w2zero(const Ctx& C, bf16_t* W2) {
    const u32x4 z = {0u, 0u, 0u, 0u};
    for (int i = C.bid * NT + C.tid; i < NL * P2W * 32; i += C.nblk * NT) {
        const int ch = i & 31, row = (i >> 5) % P2W, l = (i >> 5) / P2W;
        const bool qrow = ((row >> 6) & 1) == 0;
        if (qrow) { if (ch < 16) *(u32x4*)(W2 + ((size_t)l * P2W + row) * 384 + 256 + ch * 8) = z; }
        else *(u32x4*)(W2 + ((size_t)l * P2W + row) * 384 + ch * 8) = z;
    }
}
__device__ __forceinline__ void ph_cvt(const Ctx& C, const float* src, bf16_t* dst, size_t n8) {
    for (size_t i = (size_t)C.bid * NT + C.tid; i < n8; i += (size_t)C.nblk * NT) {
        const f32x4 a = *(const f32x4*)(src + i * 8), b = *(const f32x4*)(src + i * 8 + 4);
        u32x4 o; o.x = pk2(a[0], a[1]); o.y = pk2(a[2], a[3]); o.z = pk2(b[0], b[1]); o.w = pk2(b[2], b[3]);
        *(u32x4*)(dst + i * 8) = o;
    }
}

__device__ __forceinline__ void ph_normmod(const Ctx& C, const float* x, const float* gain, const float* modl, int sh_off, int sc_off, bf16_t* H, float* zero) {
    const int lane = C.lane;
    for (int m = C.bid * 8 + C.wave; m < M; m += C.nblk * 8) {
        const int b = m >> 13;
        const float* xr = x + (size_t)m * D;
        f32x4 v[4]; float ss = 0.f;
#pragma unroll
        for (int j = 0; j < 4; ++j) { v[j] = *(const f32x4*)(xr + j * 256 + lane * 4); ss += v[j][0] * v[j][0] + v[j][1] * v[j][1] + v[j][2] * v[j][2] + v[j][3] * v[j][3]; }
        const float r = rsqrtf(wave_sum(ss) * (1.f / D) + EPS);
        const float* sh = modl + b * MODW + sh_off; const float* sc = modl + b * MODW + sc_off;
#pragma unroll
        for (int j = 0; j < 4; ++j) {
            const int c0 = j * 256 + lane * 4;
            const f32x4 g = *(const f32x4*)(gain + c0), s1 = *(const f32x4*)(sc + c0), s0 = *(const f32x4*)(sh + c0);
            float o[4];
#pragma unroll
            for (int e = 0; e < 4; ++e) o[e] = v[j][e] * r * g[e] * (1.f + s1[e]) + s0[e];
            u32x2 w; w.x = pk2(o[0], o[1]); w.y = pk2(o[2], o[3]);
            *(u32x2*)(H + (size_t)m * D + c0) = w;
        }
    }
}

struct Post1 { const bf16_t* raw; const float* gq; const float* gk; const float* kgain; const float* rope; bf16_t *QA, *KA, *VA, *U, *CQKV, *KM; float* SQ; };
__device__ __forceinline__ void ph_post1(const Ctx& C, const Post1& p) {
    const int lane = C.lane;
    const float gq = p.gq[lane], gk = p.gk[lane];
    for (int m = C.bid * 8 + C.wave; m < M; m += C.nblk * 8) {
        const int pos = m & (S - 1);
        const bf16_t* r = p.raw + (size_t)m * P1W;
#pragma unroll
        for (int hh = 0; hh < 6; ++hh) {
            float v = bf2f(r[hh * 64 + lane]);
            float rr = rsqrtf(wave_sum(v * v) * (1.f / 64.f) + EPS);
            p.QA[(size_t)m * 384 + hh * 64 + lane] = f2bf(v * rr * gq * (0.125f * LOG2E));
            v = bf2f(r[384 + hh * 64 + lane]);
            rr = rsqrtf(wave_sum(v * v) * (1.f / 64.f) + EPS);
            p.KA[(size_t)m * 384 + hh * 64 + lane] = f2bf(v * rr * gk);
            p.VA[(size_t)m * 384 + hh * 64 + lane] = r[768 + hh * 64 + lane];
        }
        float ss = 0.f;
#pragma unroll
        for (int j = 0; j < 4; ++j) {
            p.U[(size_t)m * 256 + j * 64 + lane] = r[1152 + j * 64 + lane];
            const bf16_t w = r[1408 + j * 64 + lane]; const float v = bf2f(w); ss += v * v;
            p.CQKV[(size_t)m * 384 + j * 64 + lane] = w;
        }
        const float sq = rsqrtf(wave_sum(ss) * (1.f / 256.f) + EPS);
        ss = 0.f;
#pragma unroll
        for (int j = 0; j < 2; ++j) {
            const bf16_t w = r[1664 + j * 64 + lane]; const float v = bf2f(w); ss += v * v;
            p.CQKV[(size_t)m * 384 + 256 + j * 64 + lane] = w;
        }
        const float skv = rsqrtf(wave_sum(ss) * (1.f / 128.f) + EPS);
        if (lane == 0) { p.SQ[m] = sq; p.SQ[M + m] = skv; }
        {
            const int l31 = lane & 31;
            float v = lane < 32 ? bf2f(r[1792 + l31]) : 0.f;
            const float rr = rsqrtf(wave_sum(v * v) * (1.f / 32.f) + EPS);
            const float n = v * rr * p.kgain[64 + l31];
            const float pr = __shfl_xor(n, 16);
            const int i = lane & 15;
            const float cs = p.rope[pos * 16 + i], sn = p.rope[S * 16 + pos * 16 + i];
            const float o = (l31 < 16) ? (n * cs - pr * sn) : (pr * sn + n * cs);
            if (lane < 32) {
                const bf16_t ob = f2bf(o);
#pragma unroll
                for (int hh = 0; hh < 6; ++hh) p.KM[(size_t)m * 576 + hh * 96 + 64 + l31] = ob;
            }
        }
    }
}

struct Post2 { const bf16_t* raw; const float* SQ; const float* qgain; const float* kgain; const float* rope; bf16_t *QM, *KM, *VM; };
__device__ __forceinline__ void ph_post2(const Ctx& C, const Post2& p) {
    const int lane = C.lane;
    const float SCQ = 0.10206207261596575f * LOG2E;
    const int l31 = lane & 31, i = lane & 15;
    const float gqn = p.qgain[lane], gqr = p.qgain[64 + l31], gkn = p.kgain[lane];
    for (int m = C.bid * 8 + C.wave; m < M; m += C.nblk * 8) {
        const int pos = m & (S - 1);
        const bf16_t* r = p.raw + (size_t)m * P2W;
        const f32x4 pq = *(const f32x4*)(p.SQ + (size_t)m * 8); const float2 pkv = *(const float2*)(p.SQ + (size_t)m * 8 + 4);
        const float sq = rsqrtf(((pq[0] + pq[1]) + (pq[2] + pq[3])) * (1.f / 256.f) + EPS), skv = rsqrtf((pkv.x + pkv.y) * (1.f / 128.f) + EPS);
        const float cs = p.rope[pos * 16 + i], sn = p.rope[S * 16 + pos * 16 + i];
#pragma unroll
        for (int hh = 0; hh < 6; ++hh) {
            float v = sq * bf2f(r[hh * 128 + lane]);
            float rr = rsqrtf(wave_sum(v * v) * (1.f / 64.f) + EPS);
            p.QM[(size_t)m * 576 + hh * 96 + lane] = f2bf(v * rr * gqn * SCQ);
            v = lane < 32 ? sq * bf2f(r[hh * 128 + 64 + l31]) : 0.f;
            rr = rsqrtf(wave_sum(v * v) * (1.f / 32.f) + EPS);
            const float n = v * rr * gqr;
            const float pr = __shfl_xor(n, 16);
            const float o = (l31 < 16) ? (n * cs - pr * sn) : (pr * sn + n * cs);
            if (lane < 32) p.QM[(size_t)m * 576 + hh * 96 + 64 + l31] = f2bf(o * SCQ);
            v = skv * bf2f(r[768 + hh * 128 + lane]);
            rr = rsqrtf(wave_sum(v * v) * (1.f / 64.f) + EPS);
            p.KM[(size_t)m * 576 + hh * 96 + lane] = f2bf(v * rr * gkn);
            p.VM[(size_t)m * 384 + hh * 64 + lane] = f2bf(skv * bf2f(r[768 + hh * 128 + 64 + lane]));
        }
    }
}
__device__ __forceinline__ void mla_naive_job(int job, int stid, const bf16_t* Q, const bf16_t* K, const bf16_t* V, bf16_t* O) {
    const int bh = job % 12, qb = 31 - job / 12, b = bh / 6, h = bh % 6;
    const int qpos = qb * 256 + stid;
    const size_t m = (size_t)b * S + qpos;
    float q[96], o[64];
    {
        const unsigned* qp = (const unsigned*)(Q + m * 576 + h * 96);
#pragma unroll
        for (int i = 0; i < 48; ++i) { const unsigned w = qp[i]; q[2 * i] = lo16(w); q[2 * i + 1] = hi16(w); }
    }
#pragma unroll
    for (int i = 0; i < 64; ++i) o[i] = 0.f;
    float mx = -INFINITY, l = 0.f;
    const int jend = qb * 256 + 256;
    for (int j = 0; j < jend; ++j) {
        const unsigned* kp = (const unsigned*)(K + ((size_t)b * S + j) * 576 + h * 96);
        float s = 0.f;
#pragma unroll
        for (int i = 0; i < 48; ++i) { const unsigned w = kp[i]; s += q[2 * i] * lo16(w) + q[2 * i + 1] * hi16(w); }
        if (j <= qpos) {
            const float mn = fmaxf(mx, s), corr = exp2f(mx - mn), pexp = exp2f(s - mn);
            l = l * corr + pexp; mx = mn;
            const unsigned* vp = (const unsigned*)(V + ((size_t)b * S + j) * 384 + h * 64);
#pragma unroll
            for (int i = 0; i < 32; ++i) { const unsigned w = vp[i]; o[2 * i] = o[2 * i] * corr + pexp * lo16(w); o[2 * i + 1] = o[2 * i + 1] * corr + pexp * hi16(w); }
        }
    }
    const float il = 1.f / l;
    unsigned* op = (unsigned*)(O + m * 384 + h * 64);
#pragma unroll
    for (int i = 0; i < 32; ++i) op[i] = pk2(o[2 * i] * il, o[2 * i + 1] * il);
}
__device__ __forceinline__ void swa_naive_job(int job, int stid, const bf16_t* Q, const bf16_t* K, const bf16_t* V, const float* bias, bf16_t* O) {
    const int bh = job / 32, qb = job % 32, b = bh / 6, h = bh % 6;
    const int pos = qb * 256 + stid;
    const size_t m = (size_t)b * S + pos;
    float q[64], o[64];
    {
        const unsigned* qp = (const unsigned*)(Q + m * 384 + h * 64);
#pragma unroll
        for (int i = 0; i < 32; ++i) { const unsigned w = qp[i]; q[2 * i] = lo16(w); q[2 * i + 1] = hi16(w); }
    }
#pragma unroll
    for (int i = 0; i < 64; ++i) o[i] = 0.f;
    float mx = -INFINITY, l = 0.f;
    for (int br = 0; br < 3; ++br) {
        const int dil = br == 0 ? 1 : (br == 1 ? 4 : 16);
        const float* bt = bias + (br * 6 + h) * 132;
        for (int j = 0; j <= 128; ++j) {
            const int kpos = pos - j * dil;
            if (kpos < 0) break;
            const size_t km = (size_t)b * S + kpos;
            const unsigned* kp = (const unsigned*)(K + km * 384 + h * 64);
            float s = bt[j];
#pragma unroll
            for (int i = 0; i < 32; ++i) { const unsigned w = kp[i]; s += q[2 * i] * lo16(w) + q[2 * i + 1] * hi16(w); }
            const float mn = fmaxf(mx, s), corr = exp2f(mx - mn), pexp = exp2f(s - mn);
            l = l * corr + pexp; mx = mn;
            const unsigned* vp = (const unsigned*)(V + km * 384 + h * 64);
#pragma unroll
            for (int i = 0; i < 32; ++i) { const unsigned w = vp[i]; o[2 * i] = o[2 * i] * corr + pexp * lo16(w); o[2 * i + 1] = o[2 * i + 1] * corr + pexp * hi16(w); }
        }
    }
    const float il = 1.f / l;
    unsigned* op = (unsigned*)(O + m * 384 + h * 64);
#pragma unroll
    for (int i = 0; i < 32; ++i) op[i] = pk2(o[2 * i] * il, o[2 * i + 1] * il);
}
struct S5P { const float *a_re, *a_im, *b_re, *b_im, *c_re, *c_im, *d, *log_dt; };
__device__ __forceinline__ void s5_scan_job(int job, int p, const S5P& s, const bf16_t* U, float* XST) {
    const int b = job / 16, g = job % 16;
    const float dt = expf(s.log_dt[g]);
    const float are = s.a_re[g * 64 + p], aim = s.a_im[g * 64 + p];
    const float mag = expf(are * dt);
    const float lr = mag * cosf(aim * dt), li = mag * sinf(aim * dt);
    const float den = are * are + aim * aim, nr = lr - 1.f, ni = li;
    const float cr = (nr * are + ni * aim) / den, ci = (ni * are - nr * aim) / den;
    float bbr[16], bbi[16];
#pragma unroll
    for (int c = 0; c < 16; ++c) {
        const float br_ = s.b_re[(g * 64 + p) * 16 + c], bi_ = s.b_im[(g * 64 + p) * 16 + c];
        bbr[c] = cr * br_ - ci * bi_; bbi[c] = cr * bi_ + ci * br_;
    }
    float xr = 0.f, xi = 0.f;
    for (int t = 0; t < S; ++t) {
        const size_t m = (size_t)b * S + t;
        const unsigned* up = (const unsigned*)(U + m * 256 + g * 16);
        float ur = 0.f, ui = 0.f;
#pragma unroll
        for (int c2 = 0; c2 < 8; ++c2) { const unsigned w = up[c2]; const float u0 = lo16(w), u1 = hi16(w);
            ur += bbr[2 * c2] * u0 + bbr[2 * c2 + 1] * u1; ui += bbi[2 * c2] * u0 + bbi[2 * c2 + 1] * u1; }
        const float nxr = lr * xr - li * xi + ur, nxi = lr * xi + li * xr + ui;
        xr = nxr; xi = nxi;
        float2 st; st.x = xr; st.y = xi;
        *(float2*)(XST + ((m * 16 + g) * 64 + p) * 2) = st;
    }
}
struct MixP { const bf16_t *QM, *KM, *VM, *QA, *KA, *VA, *U; const float* bias; bf16_t *YC, *YA; float* XST; S5P s5; };
__device__ __forceinline__ void ph_mixers_naive(const Ctx& C, const MixP& p) {
    const int sub = C.tid >> 8, stid = C.tid & 255;
    for (int job = C.bid * 2 + sub; job < 800; job += C.nblk * 2) {
        if (job < 32) { if (stid < 64) s5_scan_job(job, stid, p.s5, p.U, p.XST); }
        else if (job < 416) mla_naive_job(job - 32, stid, p.QM, p.KM, p.VM, p.YC);
        else swa_naive_job(job - 416, stid, p.QA, p.KA, p.VA, p.bias, p.YA);
    }
}
__device__ __forceinline__ void ph_s5_out(const Ctx& C, const S5P& s, const bf16_t* U, const float* XST, bf16_t* GS) {
    for (size_t gid = (size_t)C.bid * NT + C.tid; gid < (size_t)M * 256; gid += (size_t)C.nblk * NT) {
        const size_t m = gid >> 8; const int ch = (int)(gid & 255), g = ch >> 4, c = ch & 15;
        const float* xs = XST + (m * 16 + g) * 128;
        const float* crp = s.c_re + (g * 16 + c) * 64; const float* cip = s.c_im + (g * 16 + c) * 64;
        float y = 0.f;
#pragma unroll 8
        for (int p = 0; p < 64; ++p) y += crp[p] * xs[2 * p] - cip[p] * xs[2 * p + 1];
        y += s.d[ch] * bf2f(U[m * 256 + ch]);
        GS[m * 256 + ch] = f2bf(gelu_tanh(y));
    }
}
__device__ __forceinline__ void ph_merge(const Ctx& C, const bf16_t* YA, const bf16_t* GS, const bf16_t* GL, const float* b_glu, const bf16_t* YC, bf16_t* AOUT) {
    const int lane = C.lane;
    for (size_t m = (size_t)C.bid * 8 + C.wave; m < M; m += (size_t)C.nblk * 8) {
        float v[6]; float ss = 0.f;
#pragma unroll
        for (int j = 0; j < 6; ++j) { v[j] = bf2f(YA[m * 384 + j * 64 + lane]); ss += v[j] * v[j]; }
        float r = rsqrtf(wave_sum(ss) * (1.f / 384.f) + EPS);
#pragma unroll
        for (int j = 0; j < 6; ++j) AOUT[m * D + j * 64 + lane] = f2bf(v[j] * r);
        ss = 0.f;
#pragma unroll
        for (int j = 0; j < 4; ++j) { const float g = bf2f(GS[m * 256 + j * 64 + lane]); const float z = bf2f(GL[m * 256 + j * 64 + lane]) + b_glu[j * 64 + lane];
            v[j] = g / (1.f + __expf(-z)); ss += v[j] * v[j]; }
        r = rsqrtf(wave_sum(ss) * (1.f / 256.f) + EPS);
#pragma unroll
        for (int j = 0; j < 4; ++j) AOUT[m * D + 384 + j * 64 + lane] = f2bf(v[j] * r);
        ss = 0.f;
#pragma unroll
        for (int j = 0; j < 6; ++j) { v[j] = bf2f(YC[m * 384 + j * 64 + lane]); ss += v[j] * v[j]; }
        r = rsqrtf(wave_sum(ss) * (1.f / 384.f) + EPS);
#pragma unroll
        for (int j = 0; j < 6; ++j) AOUT[m * D + 640 + j * 64 + lane] = f2bf(v[j] * r);
    }
}

__device__ __forceinline__ void ph_peer_scores(const Ctx& C, const bf16_t* QP, const bf16_t* SUBK, float* TOPS, int* TOPI) {
    if (C.wave >= 4) return;
    float* sc = (float*)C.lds + C.wave * (64 * 129);
    const int lane = C.lane;
    for (int wj = C.bid * 4 + C.wave; wj < M / 4; wj += C.nblk * 4) {
        const size_t m = (size_t)wj * 4 + (lane >> 4); const int hj = lane & 15;
        const u32x4* qp = (const u32x4*)(QP + m * 2048 + hj * 128);
        const bf16_t* sk = SUBK + (size_t)hj * 128 * 128;
        for (int key = 0; key < 128; ++key) {
            const u32x4* kp = (const u32x4*)(sk + key * 128);
            float s = 0.f;
#pragma unroll 4
            for (int d8 = 0; d8 < 16; ++d8) {
                const u32x4 a = qp[d8], bq = kp[d8];
                s += lo16(a.x) * lo16(bq.x) + hi16(a.x) * hi16(bq.x) + lo16(a.y) * lo16(bq.y) + hi16(a.y) * hi16(bq.y)
                   + lo16(a.z) * lo16(bq.z) + hi16(a.z) * hi16(bq.z) + lo16(a.w) * lo16(bq.w) + hi16(a.w) * hi16(bq.w);
            }
            sc[lane * 129 + key] = s;
        }
        for (int r = 0; r < 16; ++r) {
            float best = -INFINITY; int bi = 0;
            for (int key = 0; key < 128; ++key) { const float v = sc[lane * 129 + key]; if (v > best) { best = v; bi = key; } }
            sc[lane * 129 + bi] = -INFINITY;
            TOPS[(m * 16 + hj) * 16 + r] = best; TOPI[(m * 16 + hj) * 16 + r] = bi;
        }
    }
}
__device__ __forceinline__ void ph_peer_combine(const Ctx& C, const float* TOPS, const int* TOPI, int* EIDX, float* GATE) {
    if (C.wave >= 2) return;
    float* cand = (float*)C.lds + C.wave * (64 * 257);
    float* bs = (float*)C.lds + 2 * (64 * 257) + C.wave * (64 * 17);
    const int lane = C.lane;
    for (int wj = C.bid * 2 + C.wave; wj < M * 8 / 64; wj += C.nblk * 2) {
        const size_t mh = (size_t)wj * 64 + lane;
        const float* s1 = TOPS + (mh * 2 + 0) * 16; const float* s2 = TOPS + (mh * 2 + 1) * 16;
        const int* i1 = TOPI + (mh * 2 + 0) * 16; const int* i2 = TOPI + (mh * 2 + 1) * 16;
        for (int a = 0; a < 16; ++a) for (int b2 = 0; b2 < 16; ++b2) cand[lane * 257 + a * 16 + b2] = s1[a] + s2[b2];
        float mxv = -INFINITY;
        for (int r = 0; r < 16; ++r) {
            float best = -INFINITY; int bi = 0;
            for (int c = 0; c < 256; ++c) { const float v = cand[lane * 257 + c]; if (v > best) { best = v; bi = c; } }
            cand[lane * 257 + bi] = -INFINITY;
            bs[lane * 17 + r] = best; if (r == 0) mxv = best;
            EIDX[mh * 16 + r] = i1[bi >> 4] * 128 + i2[bi & 15];
        }
        float sum = 0.f;
        for (int r = 0; r < 16; ++r) { const float e = __expf(bs[lane * 17 + r] - mxv); bs[lane * 17 + r] = e; sum += e; }
        const float inv = 1.f / sum;
        for (int r = 0; r < 16; ++r) GATE[mh * 16 + r] = bs[lane * 17 + r] * inv;
    }
}
__device__ __forceinline__ void ph_peer_gather(const Ctx& C, const bf16_t* H, const int* EIDX, const float* GATE, const bf16_t* PU, const bf16_t* PV,
                                               const float* g2, const float* xin, float* xout) {
    const int lane = C.lane;
    for (size_t m = (size_t)C.bid * 8 + C.wave; m < M; m += (size_t)C.nblk * 8) {
        const int b = (int)(m >> 13);
        float hx[16], acc[16];
        {
            const u32x4 a = *(const u32x4*)(H + m * D + lane * 8), c = *(const u32x4*)(H + m * D + 512 + lane * 8);
            hx[0] = lo16(a.x); hx[1] = hi16(a.x); hx[2] = lo16(a.y); hx[3] = hi16(a.y); hx[4] = lo16(a.z); hx[5] = hi16(a.z); hx[6] = lo16(a.w); hx[7] = hi16(a.w);
            hx[8] = lo16(c.x); hx[9] = hi16(c.x); hx[10] = lo16(c.y); hx[11] = hi16(c.y); hx[12] = lo16(c.z); hx[13] = hi16(c.z); hx[14] = lo16(c.w); hx[15] = hi16(c.w);
        }
#pragma unroll
        for (int i = 0; i < 16; ++i) acc[i] = 0.f;
        for (int e = 0; e < 128; ++e) {
            const int idx = EIDX[m * 128 + e]; const float gt = GATE[m * 128 + e];
            const bf16_t* ur = PU + (size_t)idx * D; const bf16_t* vr = PV + (size_t)idx * D;
            const u32x4 a = *(const u32x4*)(ur + lane * 8), c = *(const u32x4*)(ur + 512 + lane * 8);
            const u32x4 va = *(const u32x4*)(vr + lane * 8), vc = *(const u32x4*)(vr + 512 + lane * 8);
            float s = hx[0] * lo16(a.x) + hx[1] * hi16(a.x) + hx[2] * lo16(a.y) + hx[3] * hi16(a.y) + hx[4] * lo16(a.z) + hx[5] * hi16(a.z) + hx[6] * lo16(a.w) + hx[7] * hi16(a.w)
                    + hx[8] * lo16(c.x) + hx[9] * hi16(c.x) + hx[10] * lo16(c.y) + hx[11] * hi16(c.y) + hx[12] * lo16(c.z) + hx[13] * hi16(c.z) + hx[14] * lo16(c.w) + hx[15] * hi16(c.w);
            s = wave_sum(s);
            const float cf = gt * gelu_tanh(s);
            acc[0] += cf * lo16(va.x); acc[1] += cf * hi16(va.x); acc[2] += cf * lo16(va.y); acc[3] += cf * hi16(va.y); acc[4] += cf * lo16(va.z); acc[5] += cf * hi16(va.z); acc[6] += cf * lo16(va.w); acc[7] += cf * hi16(va.w);
            acc[8] += cf * lo16(vc.x); acc[9] += cf * hi16(vc.x); acc[10] += cf * lo16(vc.y); acc[11] += cf * hi16(vc.y); acc[12] += cf * lo16(vc.z); acc[13] += cf * hi16(vc.z); acc[14] += cf * lo16(vc.w); acc[15] += cf * hi16(vc.w);
        }
        const float* g = g2 + b * MODW;
#pragma unroll
        for (int hlf = 0; hlf < 2; ++hlf)
#pragma unroll
            for (int q4 = 0; q4 < 2; ++q4) {
                const int c0 = hlf * 512 + lane * 8 + q4 * 4;
                const f32x4 xi = *(const f32x4*)(xin + m * D + c0), gg = *(const f32x4*)(g + c0);
                f32x4 o;
#pragma unroll
                for (int e = 0; e < 4; ++e) o[e] = xi[e] + gg[e] * acc[hlf * 8 + q4 * 4 + e];
                *(f32x4*)(xout + m * D + c0) = o;
            }
    }
}
}
namespace hy {
typedef short bf16x8 __attribute__((ext_vector_type(8)));
typedef float f32x16 __attribute__((ext_vector_type(16)));
typedef short s16x4 __attribute__((ext_vector_type(4)));
#define HY_LAS __attribute__((address_space(3)))
__device__ __forceinline__ int crow(int r, int hi) { return (r & 3) + 8 * (r >> 2) + 4 * hi; }
__device__ __forceinline__ unsigned cvtpk(float lo, float hi) { unsigned r; asm volatile("v_cvt_pk_bf16_f32 %0, %1, %2" : "=v"(r) : "v"(lo), "v"(hi)); return r; }
__device__ __forceinline__ s16x4 vtr(const HY_LAS unsigned char* p) { return __builtin_bit_cast(s16x4, __builtin_amdgcn_ds_read_tr16_b64_v4i16((HY_LAS s16x4*)p)); }
#define HY_OWIDE(o_, dst_) do { \
        const unsigned ax_ = cvtpk(o_[8 * gp] * il, o_[8 * gp + 1] * il), ay_ = cvtpk(o_[8 * gp + 2] * il, o_[8 * gp + 3] * il); \
        const unsigned bx_ = cvtpk(o_[8 * gp + 4] * il, o_[8 * gp + 5] * il), by_ = cvtpk(o_[8 * gp + 6] * il, o_[8 * gp + 7] * il); \
        const auto sx_ = __builtin_amdgcn_permlane32_swap(ax_, bx_, false, false); const auto sy_ = __builtin_amdgcn_permlane32_swap(ay_, by_, false, false); \
        *(u32x4*)(dst_) = (u32x4){sx_[0], sy_[0], sx_[1], sy_[1]}; } while (0)
#define HY_OWIDE_L(o_, dst_) do { \
        const unsigned ax_ = cvtpk(o_[8 * gp] * il, o_[8 * gp + 1] * il), ay_ = cvtpk(o_[8 * gp + 2] * il, o_[8 * gp + 3] * il); \
        const unsigned bx_ = cvtpk(o_[8 * gp + 4] * il, o_[8 * gp + 5] * il), by_ = cvtpk(o_[8 * gp + 6] * il, o_[8 * gp + 7] * il); \
        const auto sx_ = __builtin_amdgcn_permlane32_swap(ax_, bx_, false, false); const auto sy_ = __builtin_amdgcn_permlane32_swap(ay_, by_, false, false); \
        *(HY_LAS u32x4*)(dst_) = (u32x4){sx_[0], sy_[0], sx_[1], sy_[1]}; } while (0)

constexpr int AT_KP96 = 208, AT_KP64 = 144;
constexpr int AT_K0 = 0, AT_K1 = 13312, AT_V0 = 26624, AT_V1 = 34816, AT_BIAS = 43008, AT_END = 43008 + 1536;

struct AttnArgs {
    const bf16_t* Q; const bf16_t* K; const bf16_t* V;
    int qpitch, kpitch, vpitch;
    long q_row0; int q_rstride;
    long k_row0; int k_rstride;
    int q_idx0;
    int t_begin, t_end;
    const float* bias;
    bf16_t* O; int opitch;
    float* ML;  int mlpitch;
    int safe;
};

__device__ __forceinline__ void o_store_lines(HY_LAS unsigned char* L, const AttnArgs& a, const f32x16& o0, const f32x16& o1, const float il, const int wave, const int lane) {
    const int r32 = lane & 31, hi = lane >> 5;
    HY_LAS unsigned char* ob = L + wave * 4608;
    HY_LAS unsigned char* wp = ob + r32 * 144 + hi * 16;
#pragma unroll
    for (int gp = 0; gp < 2; ++gp) { HY_OWIDE_L(o0, wp + 32 * gp); HY_OWIDE_L(o1, wp + 64 + 32 * gp); }
    __builtin_amdgcn_fence(__ATOMIC_RELEASE, "wavefront");
    __builtin_amdgcn_wave_barrier();
    __builtin_amdgcn_fence(__ATOMIC_ACQUIRE, "wavefront");
    const int rr = lane >> 3, pc = lane & 7;
    bf16_t* gq = a.O + (a.q_row0 + (long)(wave * 32 + rr) * a.q_rstride) * a.opitch + pc * 8;
    const long gstep = 8L * a.q_rstride * a.opitch;
#pragma unroll
    for (int i = 0; i < 4; ++i) { const u32x4 v = *(const HY_LAS u32x4*)(ob + (rr + 8 * i) * 144 + pc * 16); *(u32x4*)(gq + i * gstep) = v; }
}
template <int MODE, int VAR = 0>
__device__ __forceinline__ void attn_unit(const Ctx& C, const AttnArgs& a) {
    constexpr int DQK = MODE == 0 ? 96 : 64, KP = MODE == 0 ? AT_KP96 : AT_KP64, NS = DQK / 16;
    HY_LAS unsigned char* L = (HY_LAS unsigned char*)C.lds;
    const int tid = C.tid, lane = C.lane, wave = C.wave, r32 = lane & 31, hi = lane >> 5;
    constexpr int KCH = DQK / 8;
    const int kr0 = tid / KCH, kc0 = tid % KCH;
    const int kr1 = (tid + 512) / KCH, kc1 = (tid + 512) % KCH;
    const bool k2 = (MODE == 0) && tid < 256;
    const int vr = tid >> 3, vc = tid & 7;
    const unsigned kdst0 = kr0 * KP + kc0 * 16, kdst1 = kr1 * KP + kc1 * 16, vdst = (vc >> 2) * 4096 + vr * 64 + (vc & 3) * 16;
    if (MODE == 1) { if (tid < 384) { const int dl = tid - 64; *(HY_LAS float*)(L + AT_BIAS + tid * 4) = (dl >= 0 && dl <= 128) ? a.bias[dl] : -INFINITY; } }
    const int qi = a.q_idx0 + wave * 32 + r32;
    bf16x8 qr[NS];
    {
        const bf16_t* qp = a.Q + (a.q_row0 + (long)(wave * 32 + r32) * a.q_rstride) * a.qpitch + hi * 8;
#pragma unroll
        for (int s = 0; s < NS; ++s) qr[s] = *(const bf16x8*)(qp + s * 16);
    }
    f32x16 o0, o1;
#pragma unroll
    for (int r = 0; r < 16; ++r) { o0[r] = 0.f; o1[r] = 0.f; }
    float m_ref = 0.f, l_run = 0.f; bool mzero = true;
    int wt_lo, wt_hi;
    {
        const int q_lo = a.q_idx0 + wave * 32, q_hi = q_lo + 31;
        if (MODE == 0) { wt_lo = a.t_begin; wt_hi = q_hi >> 6; }
        else { const int lo = q_lo - 128; wt_lo = lo < 0 ? 0 : (lo >> 6); if (wt_lo < a.t_begin) wt_lo = a.t_begin; wt_hi = q_hi >> 6; }
    }
    u32x4 sk0, sk1, sv;
    auto gload = [&](int t) {
        const long kb = a.k_row0 + (long)(t * 64) * a.k_rstride;
        sk0 = *(const u32x4*)(a.K + (kb + (long)kr0 * a.k_rstride) * a.kpitch + kc0 * 8);
        if (k2) sk1 = *(const u32x4*)(a.K + (kb + (long)kr1 * a.k_rstride) * a.kpitch + kc1 * 8);
        sv = *(const u32x4*)(a.V + (kb + (long)vr * a.k_rstride) * a.vpitch + vc * 8);
    };
    auto lstore = [&](int buf) {
        HY_LAS unsigned char* kb = L + (buf ? AT_K1 : AT_K0); HY_LAS unsigned char* vb = L + (buf ? AT_V1 : AT_V0);
        *(HY_LAS u32x4*)(kb + kdst0) = sk0;
        if (k2) *(HY_LAS u32x4*)(kb + kdst1) = sk1;
        *(HY_LAS u32x4*)(vb + vdst) = sv;
    };
    __syncthreads();
    gload(a.t_begin); lstore(0);
    __syncthreads();
    const unsigned voff = ((lane >> 4) & 1) * 32 + (lane & 3) * 8 + (4 * hi + ((lane & 15) >> 2)) * 64;
    for (int t = a.t_begin; t < a.t_end; ++t) {
        const int buf = (t - a.t_begin) & 1;
        const bool more = t + 1 < a.t_end;
        if (more && VAR != 2) gload(t + 1);
        if (t >= wt_lo && t <= wt_hi) {
            const HY_LAS unsigned char* kb = L + (buf ? AT_K1 : AT_K0); const HY_LAS unsigned char* vb = L + (buf ? AT_V1 : AT_V0);
            f32x16 p0, p1;
#pragma unroll
            for (int r = 0; r < 16; ++r) { p0[r] = 0.f; p1[r] = 0.f; }
#pragma unroll
            for (int s = 0; s < NS; ++s) {
                const bf16x8 a0 = *(const HY_LAS bf16x8*)(kb + r32 * KP + s * 32 + hi * 16);
                const bf16x8 a1 = *(const HY_LAS bf16x8*)(kb + (32 + r32) * KP + s * 32 + hi * 16);
                p0 = __builtin_amdgcn_mfma_f32_32x32x16_bf16(a0, qr[s], p0, 0, 0, 0);
                p1 = __builtin_amdgcn_mfma_f32_32x32x16_bf16(a1, qr[s], p1, 0, 0, 0);
            }
            if (MODE == 0) {
                if (t * 64 + 63 > a.q_idx0 + wave * 32) {
                    const int kbase = t * 64 + 4 * hi;
#pragma unroll
                    for (int r = 0; r < 16; ++r) { const int kj = kbase + (r & 3) + 8 * (r >> 2); if (kj > qi) p0[r] = -INFINITY; if (kj + 32 > qi) p1[r] = -INFINITY; }
                }
            } else {
                const HY_LAS float* bp = (const HY_LAS float*)(L + AT_BIAS) + (64 + qi - t * 64 - 4 * hi - 63);
#pragma unroll
                for (int r = 0; r < 16; ++r) { const int off = (r & 3) + 8 * (r >> 2); p0[r] += bp[63 - off]; p1[r] += bp[63 - 32 - off]; }
            }
            if (!mzero) {
#pragma unroll
                for (int r = 0; r < 16; ++r) { p0[r] -= m_ref; p1[r] -= m_ref; }
            }
            if (!a.safe) {
                float mx = __builtin_fmaxf(p0[0], p1[0]);
#pragma unroll
                for (int r = 1; r < 16; ++r) mx = __builtin_fmaxf(__builtin_fmaxf(mx, p0[r]), p1[r]);
                if (__builtin_expect(__any(mx > 16.f), 0)) {
                    mx = fmaxf(mx, __shfl_xor(mx, 32));
                    const float dl = fmaxf(mx, 0.f), f = __builtin_amdgcn_exp2f(-dl);
                    m_ref += dl; l_run *= f; mzero = false;
#pragma unroll
                    for (int r = 0; r < 16; ++r) { p0[r] -= dl; p1[r] -= dl; o0[r] *= f; o1[r] *= f; }
                }
            }
            float rs0 = 0.f, rs1 = 0.f;
#pragma unroll
            for (int r = 0; r < 16; ++r) { if (VAR != 1) { p0[r] = __builtin_amdgcn_exp2f(p0[r]); p1[r] = __builtin_amdgcn_exp2f(p1[r]); } rs0 += p0[r]; rs1 += p1[r]; }
            l_run += rs0 + rs1;
            u32x4 pw[4];
            pw[0] = (u32x4){cvtpk(p0[0], p0[1]), cvtpk(p0[2], p0[3]), cvtpk(p0[4], p0[5]), cvtpk(p0[6], p0[7])};
            pw[1] = (u32x4){cvtpk(p0[8], p0[9]), cvtpk(p0[10], p0[11]), cvtpk(p0[12], p0[13]), cvtpk(p0[14], p0[15])};
            pw[2] = (u32x4){cvtpk(p1[0], p1[1]), cvtpk(p1[2], p1[3]), cvtpk(p1[4], p1[5]), cvtpk(p1[6], p1[7])};
            pw[3] = (u32x4){cvtpk(p1[8], p1[9]), cvtpk(p1[10], p1[11]), cvtpk(p1[12], p1[13]), cvtpk(p1[14], p1[15])};
#pragma unroll
            for (int s = 0; s < 4; ++s) {
                const s16x4 l0 = vtr(vb + voff + s * 1024), h0 = vtr(vb + voff + s * 1024 + 512);
                const s16x4 l1 = vtr(vb + voff + 4096 + s * 1024), h1 = vtr(vb + voff + 4096 + s * 1024 + 512);
                const bf16x8 vf0 = (bf16x8){l0[0], l0[1], l0[2], l0[3], h0[0], h0[1], h0[2], h0[3]};
                const bf16x8 vf1 = (bf16x8){l1[0], l1[1], l1[2], l1[3], h1[0], h1[1], h1[2], h1[3]};
                const bf16x8 pf = __builtin_bit_cast(bf16x8, pw[s]);
                o0 = __builtin_amdgcn_mfma_f32_32x32x16_bf16(vf0, pf, o0, 0, 0, 0);
                o1 = __builtin_amdgcn_mfma_f32_32x32x16_bf16(vf1, pf, o1, 0, 0, 0);
            }
        }
        if (more && VAR != 2) lstore(buf ^ 1);
        if (VAR != 2) __syncthreads();
    }
    l_run += __shfl_xor(l_run, 32);
    const float il = 1.f / l_run;
    const long orow = a.q_row0 + (long)(wave * 32 + r32) * a.q_rstride;
    bf16_t* op = a.O + orow * a.opitch + 8 * hi;
#pragma unroll
    for (int gp = 0; gp < 2; ++gp) {
        HY_OWIDE(o0, op + 16 * gp); HY_OWIDE(o1, op + 32 + 16 * gp);
    }
    if (MODE == 1 && hi == 0) { float2 ml; ml.x = m_ref; ml.y = l_run; *(float2*)(a.ML + orow * a.mlpitch) = ml; }
}
constexpr int M2_KS = 64 * AT_KP96, M2_K = 0, M2_V = 4 * M2_KS, M2_END = M2_V + 4 * 8192;
#ifndef HY_MLA_STAGGER
#define HY_MLA_STAGGER 6
#endif
__device__ __forceinline__ void mla_unit2(const Ctx& C, const AttnArgs& a) {
    constexpr int KP = AT_KP96, NS = 6, KCH = 12;
    HY_LAS unsigned char* L = (HY_LAS unsigned char*)C.lds;
    const int tid = C.tid, lane = C.lane, wave = C.wave, r32 = lane & 31, hi = lane >> 5;
    const int kr0 = tid / KCH, kc0 = tid % KCH, kr1 = (tid + 512) / KCH, kc1 = (tid + 512) % KCH;
    const bool k2 = tid < 256;
    const int vr = tid >> 3, vc = tid & 7;
    const unsigned kdst0 = kr0 * KP + kc0 * 16, kdst1 = kr1 * KP + kc1 * 16, vdst = (vc >> 2) * 4096 + vr * 64 + (vc & 3) * 16;
    const int qi = a.q_idx0 + wave * 32 + r32;
    bf16x8 qr[NS];
    {
        const bf16_t* qp = a.Q + (a.q_row0 + (long)(wave * 32 + r32) * a.q_rstride) * a.qpitch + hi * 8;
#pragma unroll
        for (int s = 0; s < NS; ++s) qr[s] = *(const bf16x8*)(qp + s * 16);
    }
    f32x16 o0, o1;
#pragma unroll
    for (int r = 0; r < 16; ++r) { o0[r] = 0.f; o1[r] = 0.f; }
    float m_ref = 0.f, l_run = 0.f; bool mzero = true;
    const int wt_hi = (a.q_idx0 + wave * 32 + 31) >> 6;
    u32x4 sa0, sa1, sav, sb0, sb1, sbv;
#define HY_M2LOAD(S0, S1, SV, t_) do { const long kb_ = a.k_row0 + (long)((t_) * 64); \
        S0 = *(const u32x4*)(a.K + (kb_ + kr0) * a.kpitch + kc0 * 8); if (k2) S1 = *(const u32x4*)(a.K + (kb_ + kr1) * a.kpitch + kc1 * 8); \
        SV = *(const u32x4*)(a.V + (kb_ + vr) * a.vpitch + vc * 8); } while (0)
#define HY_M2STORE(S0, S1, SV, slot_) do { *(HY_LAS u32x4*)(L + M2_K + (slot_) * M2_KS + kdst0) = S0; if (k2) *(HY_LAS u32x4*)(L + M2_K + (slot_) * M2_KS + kdst1) = S1; \
        *(HY_LAS u32x4*)(L + M2_V + (slot_) * 8192 + vdst) = SV; } while (0)
    const int nstep = a.t_end >> 1;
    HY_M2LOAD(sa0, sa1, sav, 0); HY_M2LOAD(sb0, sb1, sbv, 1);
    HY_M2STORE(sa0, sa1, sav, 0); HY_M2STORE(sb0, sb1, sbv, 1);
    __syncthreads();
    const unsigned voff = ((lane >> 4) & 1) * 32 + (lane & 3) * 8 + (4 * hi + ((lane & 15) >> 2)) * 64;
#pragma unroll 1
    for (int st = 0; st < nstep; ++st) {
        const int buf = st & 1;
        if (wave >= 4) __builtin_amdgcn_s_sleep(HY_MLA_STAGGER);
        if (st + 1 < nstep) { HY_M2LOAD(sa0, sa1, sav, 2 * st + 2); HY_M2LOAD(sb0, sb1, sbv, 2 * st + 3); }
#pragma unroll
        for (int j = 0; j < 2; ++j) {
            const int t = 2 * st + j;
            if (t <= wt_hi) {
                const int slot = buf * 2 + j;
                const HY_LAS unsigned char* kb = L + M2_K + slot * M2_KS; const HY_LAS unsigned char* vb = L + M2_V + slot * 8192;
                f32x16 p0, p1;
#pragma unroll
                for (int r = 0; r < 16; ++r) { p0[r] = 0.f; p1[r] = 0.f; }
#pragma unroll
                for (int ss = 0; ss < NS; ++ss) {
                    const bf16x8 a0 = *(const HY_LAS bf16x8*)(kb + r32 * KP + ss * 32 + hi * 16);
                    const bf16x8 a1 = *(const HY_LAS bf16x8*)(kb + (32 + r32) * KP + ss * 32 + hi * 16);
                    p0 = __builtin_amdgcn_mfma_f32_32x32x16_bf16(a0, qr[ss], p0, 0, 0, 0);
                    p1 = __builtin_amdgcn_mfma_f32_32x32x16_bf16(a1, qr[ss], p1, 0, 0, 0);
                }
                if (t * 64 + 63 > a.q_idx0 + wave * 32) {
                    const int kbase = t * 64 + 4 * hi;
#pragma unroll
                    for (int r = 0; r < 16; ++r) { const int kj = kbase + (r & 3) + 8 * (r >> 2); if (kj > qi) p0[r] = -INFINITY; if (kj + 32 > qi) p1[r] = -INFINITY; }
                }
                if (!mzero) {
#pragma unroll
                    for (int r = 0; r < 16; ++r) { p0[r] -= m_ref; p1[r] -= m_ref; }
                }
                if (!a.safe) {
                    float mx = __builtin_fmaxf(p0[0], p1[0]);
#pragma unroll
                    for (int r = 1; r < 16; ++r) mx = __builtin_fmaxf(__builtin_fmaxf(mx, p0[r]), p1[r]);
                    if (__builtin_expect(__any(mx > 16.f), 0)) {
                        mx = fmaxf(mx, __shfl_xor(mx, 32));
                        const float dl = fmaxf(mx, 0.f), f = __builtin_amdgcn_exp2f(-dl);
                        m_ref += dl; l_run *= f; mzero = false;
#pragma unroll
                        for (int r = 0; r < 16; ++r) { p0[r] -= dl; p1[r] -= dl; o0[r] *= f; o1[r] *= f; }
                    }
                }
                float rs0 = 0.f, rs1 = 0.f;
#pragma unroll
                for (int r = 0; r < 16; ++r) { p0[r] = __builtin_amdgcn_exp2f(p0[r]); p1[r] = __builtin_amdgcn_exp2f(p1[r]); rs0 += p0[r]; rs1 += p1[r]; }
                l_run += rs0 + rs1;
                u32x4 pw[4];
                pw[0] = (u32x4){cvtpk(p0[0], p0[1]), cvtpk(p0[2], p0[3]), cvtpk(p0[4], p0[5]), cvtpk(p0[6], p0[7])};
                pw[1] = (u32x4){cvtpk(p0[8], p0[9]), cvtpk(p0[10], p0[11]), cvtpk(p0[12], p0[13]), cvtpk(p0[14], p0[15])};
                pw[2] = (u32x4){cvtpk(p1[0], p1[1]), cvtpk(p1[2], p1[3]), cvtpk(p1[4], p1[5]), cvtpk(p1[6], p1[7])};
                pw[3] = (u32x4){cvtpk(p1[8], p1[9]), cvtpk(p1[10], p1[11]), cvtpk(p1[12], p1[13]), cvtpk(p1[14], p1[15])};
#pragma unroll
                for (int ss = 0; ss < 4; ++ss) {
                    const s16x4 l0 = vtr(vb + voff + ss * 1024), h0 = vtr(vb + voff + ss * 1024 + 512);
                    const s16x4 l1 = vtr(vb + voff + 4096 + ss * 1024), h1 = vtr(vb + voff + 4096 + ss * 1024 + 512);
                    const bf16x8 vf0 = (bf16x8){l0[0], l0[1], l0[2], l0[3], h0[0], h0[1], h0[2], h0[3]};
                    const bf16x8 vf1 = (bf16x8){l1[0], l1[1], l1[2], l1[3], h1[0], h1[1], h1[2], h1[3]};
                    const bf16x8 pf = __builtin_bit_cast(bf16x8, pw[ss]);
                    o0 = __builtin_amdgcn_mfma_f32_32x32x16_bf16(vf0, pf, o0, 0, 0, 0);
                    o1 = __builtin_amdgcn_mfma_f32_32x32x16_bf16(vf1, pf, o1, 0, 0, 0);
                }
            }
        }
        if (st + 1 < nstep) { HY_M2STORE(sa0, sa1, sav, (buf ^ 1) * 2); HY_M2STORE(sb0, sb1, sbv, (buf ^ 1) * 2 + 1); }
        __syncthreads();
    }
    l_run += __shfl_xor(l_run, 32);
    const float il = 1.f / l_run;
    const long orow = a.q_row0 + (long)(wave * 32 + r32) * a.q_rstride;
    bf16_t* op = a.O + orow * a.opitch + 8 * hi;
#pragma unroll
    for (int gp = 0; gp < 2; ++gp) {
        HY_OWIDE(o0, op + 16 * gp); HY_OWIDE(o1, op + 32 + 16 * gp);
    }
}
constexpr int SP_KS = 64 * AT_KP64, SP_K = 0, SP_V = 4 * SP_KS, SP_BIAS = SP_V + 4 * 8192, SP_END = SP_BIAS + 1536;
__device__ __forceinline__ void swa_unit_pair(const Ctx& C, const AttnArgs& a) {
    constexpr int KP = AT_KP64, NS = 4;
    HY_LAS unsigned char* L = (HY_LAS unsigned char*)C.lds;
    const int tid = C.tid, lane = C.lane, wave = C.wave, r32 = lane & 31, hi = lane >> 5;
    const int kr0 = tid >> 3, kc0 = tid & 7, vr = tid >> 3, vc = tid & 7;
    const unsigned kdst0 = kr0 * KP + kc0 * 16, vdst = (vc >> 2) * 4096 + vr * 64 + (vc & 3) * 16;
    if (tid < 384) { const int dl = tid - 64; *(HY_LAS float*)(L + SP_BIAS + tid * 4) = (dl >= 0 && dl <= 128) ? a.bias[dl] : -INFINITY; }
    const int qi = a.q_idx0 + wave * 32 + r32;
    bf16x8 qr[NS];
    {
        const bf16_t* qp = a.Q + (a.q_row0 + (long)(wave * 32 + r32) * a.q_rstride) * a.qpitch + hi * 8;
#pragma unroll
        for (int s = 0; s < NS; ++s) qr[s] = *(const bf16x8*)(qp + s * 16);
    }
    f32x16 o0, o1;
#pragma unroll
    for (int r = 0; r < 16; ++r) { o0[r] = 0.f; o1[r] = 0.f; }
    float m_ref = 0.f, l_run = 0.f; bool mzero = true;
    const int q_lo = a.q_idx0 + wave * 32, q_hi = q_lo + 31;
    const int wt_lo = q_lo - 128 < 0 ? 0 : ((q_lo - 128) >> 6), wt_hi = q_hi >> 6;
    const int T0 = (a.q_idx0 - 128) >> 6;
    u32x4 skA, svA, skB, svB;
#define HY_SPLOAD(SK, SV, t_) do { if ((t_) >= 0) { const long kb_ = a.k_row0 + (long)((t_) * 64) * a.k_rstride; \
        SK = *(const u32x4*)(a.K + (kb_ + (long)kr0 * a.k_rstride) * a.kpitch + kc0 * 8); SV = *(const u32x4*)(a.V + (kb_ + (long)vr * a.k_rstride) * a.vpitch + vc * 8); } } while (0)
#define HY_SPSTORE(SK, SV, slot_) do { *(HY_LAS u32x4*)(L + SP_K + (slot_) * SP_KS + kdst0) = SK; *(HY_LAS u32x4*)(L + SP_V + (slot_) * 8192 + vdst) = SV; } while (0)
    HY_SPLOAD(skA, svA, T0); HY_SPLOAD(skB, svB, T0 + 3);
    HY_SPSTORE(skA, svA, 0); HY_SPSTORE(skB, svB, 1);
    __syncthreads();
    const unsigned voff = ((lane >> 4) & 1) * 32 + (lane & 3) * 8 + (4 * hi + ((lane & 15) >> 2)) * 64;
#pragma unroll 1
    for (int s = 0; s < 3; ++s) {
        const int buf = s & 1;
        if (s + 1 < 3) { HY_SPLOAD(skA, svA, T0 + s + 1); HY_SPLOAD(skB, svB, T0 + s + 4); }
        const int tA = T0 + s, tB = T0 + s + 3;
        const bool useA = tA >= wt_lo && tA <= wt_hi, useB = tB >= wt_lo && tB <= wt_hi;
        if (useA || useB) {
            const int t = useA ? tA : tB, slot = buf * 2 + (useA ? 0 : 1);
            const HY_LAS unsigned char* kb = L + SP_K + slot * SP_KS; const HY_LAS unsigned char* vb = L + SP_V + slot * 8192;
            f32x16 p0, p1;
            const HY_LAS float* bp = (const HY_LAS float*)(L + SP_BIAS) + (64 + qi - t * 64 - 4 * hi - 63);
#pragma unroll
            for (int r = 0; r < 16; ++r) { const int off = (r & 3) + 8 * (r >> 2); p0[r] = bp[63 - off]; p1[r] = bp[63 - 32 - off]; }
#pragma unroll
            for (int ss = 0; ss < NS; ++ss) {
                const bf16x8 a0 = *(const HY_LAS bf16x8*)(kb + r32 * KP + ss * 32 + hi * 16);
                const bf16x8 a1 = *(const HY_LAS bf16x8*)(kb + (32 + r32) * KP + ss * 32 + hi * 16);
                p0 = __builtin_amdgcn_mfma_f32_32x32x16_bf16(a0, qr[ss], p0, 0, 0, 0);
                p1 = __builtin_amdgcn_mfma_f32_32x32x16_bf16(a1, qr[ss], p1, 0, 0, 0);
            }
            if (!mzero) {
#pragma unroll
                for (int r = 0; r < 16; ++r) { p0[r] -= m_ref; p1[r] -= m_ref; }
            }
            if (!a.safe) {
                float mx = __builtin_fmaxf(p0[0], p1[0]);
#pragma unroll
                for (int r = 1; r < 16; ++r) mx = __builtin_fmaxf(__builtin_fmaxf(mx, p0[r]), p1[r]);
                if (__builtin_expect(__any(mx > 16.f), 0)) {
                    mx = fmaxf(mx, __shfl_xor(mx, 32));
                    const float dl = fmaxf(mx, 0.f), f = __builtin_amdgcn_exp2f(-dl);
                    m_ref += dl; l_run *= f; mzero = false;
#pragma unroll
                    for (int r = 0; r < 16; ++r) { p0[r] -= dl; p1[r] -= dl; o0[r] *= f; o1[r] *= f; }
                }
            }
            float rs0 = 0.f, rs1 = 0.f;
#pragma unroll
            for (int r = 0; r < 16; ++r) { p0[r] = __builtin_amdgcn_exp2f(p0[r]); p1[r] = __builtin_amdgcn_exp2f(p1[r]); rs0 += p0[r]; rs1 += p1[r]; }
            l_run += rs0 + rs1;
            u32x4 pw[4];
            pw[0] = (u32x4){cvtpk(p0[0], p0[1]), cvtpk(p0[2], p0[3]), cvtpk(p0[4], p0[5]), cvtpk(p0[6], p0[7])};
            pw[1] = (u32x4){cvtpk(p0[8], p0[9]), cvtpk(p0[10], p0[11]), cvtpk(p0[12], p0[13]), cvtpk(p0[14], p0[15])};
            pw[2] = (u32x4){cvtpk(p1[0], p1[1]), cvtpk(p1[2], p1[3]), cvtpk(p1[4], p1[5]), cvtpk(p1[6], p1[7])};
            pw[3] = (u32x4){cvtpk(p1[8], p1[9]), cvtpk(p1[10], p1[11]), cvtpk(p1[12], p1[13]), cvtpk(p1[14], p1[15])};
#pragma unroll
            for (int ss = 0; ss < 4; ++ss) {
                const s16x4 l0 = vtr(vb + voff + ss * 1024), h0 = vtr(vb + voff + ss * 1024 + 512);
                const s16x4 l1 = vtr(vb + voff + 4096 + ss * 1024), h1 = vtr(vb + voff + 4096 + ss * 1024 + 512);
                const bf16x8 vf0 = (bf16x8){l0[0], l0[1], l0[2], l0[3], h0[0], h0[1], h0[2], h0[3]};
                const bf16x8 vf1 = (bf16x8){l1[0], l1[1], l1[2], l1[3], h1[0], h1[1], h1[2], h1[3]};
                const bf16x8 pf = __builtin_bit_cast(bf16x8, pw[ss]);
                o0 = __builtin_amdgcn_mfma_f32_32x32x16_bf16(vf0, pf, o0, 0, 0, 0);
                o1 = __builtin_amdgcn_mfma_f32_32x32x16_bf16(vf1, pf, o1, 0, 0, 0);
            }
        }
        if (s + 1 < 3) { HY_SPSTORE(skA, svA, (buf ^ 1) * 2); HY_SPSTORE(skB, svB, (buf ^ 1) * 2 + 1); }
        __syncthreads();
    }
    l_run += __shfl_xor(l_run, 32);
    const float il = 1.f / l_run;
    const long orow = a.q_row0 + (long)(wave * 32 + r32) * a.q_rstride;
    bf16_t* op = a.O + orow * a.opitch + 8 * hi;
#pragma unroll
    for (int gp = 0; gp < 2; ++gp) {
        HY_OWIDE(o0, op + 16 * gp); HY_OWIDE(o1, op + 32 + 16 * gp);
    }
    if (hi == 0) { float2 ml; ml.x = m_ref; ml.y = l_run; *(float2*)(a.ML + orow * a.mlpitch) = ml; }
}
constexpr int SA_KS = 64 * AT_KP64, SA_K = 0, SA_V = 6 * SA_KS, SA_BIAS = SA_V + 6 * 8192, SA_END = SA_BIAS + 1536;
__device__ __forceinline__ void swa_unit_all(const Ctx& C, const AttnArgs& a) {
    constexpr int KP = AT_KP64, NS = 4;
    HY_LAS unsigned char* L = (HY_LAS unsigned char*)C.lds;
    const int tid = C.tid, lane = C.lane, wave = C.wave, r32 = lane & 31, hi = lane >> 5;
    const int kr0 = tid >> 3, kc0 = tid & 7, vr = tid >> 3, vc = tid & 7;
    const unsigned kdst0 = kr0 * KP + kc0 * 16, vdst = (vc >> 2) * 4096 + vr * 64 + (vc & 3) * 16;
    if (tid < 384) { const int dl = tid - 64; *(HY_LAS float*)(L + SA_BIAS + tid * 4) = (dl >= 0 && dl <= 128) ? a.bias[dl] : -INFINITY; }
    const int qi = a.q_idx0 + wave * 32 + r32;
    bf16x8 qr[NS];
    {
        const bf16_t* qp = a.Q + (a.q_row0 + (long)(wave * 32 + r32) * a.q_rstride) * a.qpitch + hi * 8;
#pragma unroll
        for (int s = 0; s < NS; ++s) qr[s] = *(const bf16x8*)(qp + s * 16);
    }
    f32x16 o0, o1;
#pragma unroll
    for (int r = 0; r < 16; ++r) { o0[r] = 0.f; o1[r] = 0.f; }
    float m_ref = 0.f, l_run = 0.f; bool mzero = true;
    const int q_lo = a.q_idx0 + wave * 32, q_hi = q_lo + 31;
    const int wt_lo = q_lo - 128 < 0 ? 0 : ((q_lo - 128) >> 6), wt_hi = q_hi >> 6;
    const int T0 = (a.q_idx0 - 128) >> 6;
    u32x4 sk[6], sv[6];
#pragma unroll
    for (int s = 0; s < 6; ++s) { const int t_ = T0 + s; if (t_ >= 0) { const long kb_ = a.k_row0 + (long)(t_ * 64) * a.k_rstride;
        sk[s] = *(const u32x4*)(a.K + (kb_ + (long)kr0 * a.k_rstride) * a.kpitch + kc0 * 8); sv[s] = *(const u32x4*)(a.V + (kb_ + (long)vr * a.k_rstride) * a.vpitch + vc * 8); } }
#pragma unroll
    for (int s = 0; s < 6; ++s) { if (T0 + s >= 0) { *(HY_LAS u32x4*)(L + SA_K + s * SA_KS + kdst0) = sk[s]; *(HY_LAS u32x4*)(L + SA_V + s * 8192 + vdst) = sv[s]; } }
    __syncthreads();
    const unsigned voff = ((lane >> 4) & 1) * 32 + (lane & 3) * 8 + (4 * hi + ((lane & 15) >> 2)) * 64;
#pragma unroll 1
    for (int s = 0; s < 6; ++s) {
        const int t = T0 + s;
        if (t >= wt_lo && t <= wt_hi) {
            const int slot = s;
            const HY_LAS unsigned char* kb = L + SA_K + slot * SA_KS; const HY_LAS unsigned char* vb = L + SA_V + slot * 8192;
            f32x16 p0, p1;
            const HY_LAS float* bp = (const HY_LAS float*)(L + SA_BIAS) + (64 + qi - t * 64 - 4 * hi - 63);
#pragma unroll
            for (int r = 0; r < 16; ++r) { const int off = (r & 3) + 8 * (r >> 2); p0[r] = bp[63 - off]; p1[r] = bp[63 - 32 - off]; }
#pragma unroll
            for (int ss = 0; ss < NS; ++ss) {
                const bf16x8 a0 = *(const HY_LAS bf16x8*)(kb + r32 * KP + ss * 32 + hi * 16);
                const bf16x8 a1 = *(const HY_LAS bf16x8*)(kb + (32 + r32) * KP + ss * 32 + hi * 16);
                p0 = __builtin_amdgcn_mfma_f32_32x32x16_bf16(a0, qr[ss], p0, 0, 0, 0);
                p1 = __builtin_amdgcn_mfma_f32_32x32x16_bf16(a1, qr[ss], p1, 0, 0, 0);
            }
            if (!mzero) {
#pragma unroll
                for (int r = 0; r < 16; ++r) { p0[r] -= m_ref; p1[r] -= m_ref; }
            }
            if (!a.safe) {
                float mx = __builtin_fmaxf(p0[0], p1[0]);
#pragma unroll
                for (int r = 1; r < 16; ++r) mx = __builtin_fmaxf(__builtin_fmaxf(mx, p0[r]), p1[r]);
                if (__builtin_expect(__any(mx > 16.f), 0)) {
                    mx = fmaxf(mx, __shfl_xor(mx, 32));
                    const float dl = fmaxf(mx, 0.f), f = __builtin_amdgcn_exp2f(-dl);
                    m_ref += dl; l_run *= f; mzero = false;
#pragma unroll
                    for (int r = 0; r < 16; ++r) { p0[r] -= dl; p1[r] -= dl; o0[r] *= f; o1[r] *= f; }
                }
            }
            float rs0 = 0.f, rs1 = 0.f;
#pragma unroll
            for (int r = 0; r < 16; ++r) { p0[r] = __builtin_amdgcn_exp2f(p0[r]); p1[r] = __builtin_amdgcn_exp2f(p1[r]); rs0 += p0[r]; rs1 += p1[r]; }
            l_run += rs0 + rs1;
            u32x4 pw[4];
            pw[0] = (u32x4){cvtpk(p0[0], p0[1]), cvtpk(p0[2], p0[3]), cvtpk(p0[4], p0[5]), cvtpk(p0[6], p0[7])};
            pw[1] = (u32x4){cvtpk(p0[8], p0[9]), cvtpk(p0[10], p0[11]), cvtpk(p0[12], p0[13]), cvtpk(p0[14], p0[15])};
            pw[2] = (u32x4){cvtpk(p1[0], p1[1]), cvtpk(p1[2], p1[3]), cvtpk(p1[4], p1[5]), cvtpk(p1[6], p1[7])};
            pw[3] = (u32x4){cvtpk(p1[8], p1[9]), cvtpk(p1[10], p1[11]), cvtpk(p1[12], p1[13]), cvtpk(p1[14], p1[15])};
#pragma unroll
            for (int ss = 0; ss < 4; ++ss) {
                const s16x4 l0 = vtr(vb + voff + ss * 1024), h0 = vtr(vb + voff + ss * 1024 + 512);
                const s16x4 l1 = vtr(vb + voff + 4096 + ss * 1024), h1 = vtr(vb + voff + 4096 + ss * 1024 + 512);
                const bf16x8 vf0 = (bf16x8){l0[0], l0[1], l0[2], l0[3], h0[0], h0[1], h0[2], h0[3]};
                const bf16x8 vf1 = (bf16x8){l1[0], l1[1], l1[2], l1[3], h1[0], h1[1], h1[2], h1[3]};
                const bf16x8 pf = __builtin_bit_cast(bf16x8, pw[ss]);
                o0 = __builtin_amdgcn_mfma_f32_32x32x16_bf16(vf0, pf, o0, 0, 0, 0);
                o1 = __builtin_amdgcn_mfma_f32_32x32x16_bf16(vf1, pf, o1, 0, 0, 0);
            }
        }
    }
    l_run += __shfl_xor(l_run, 32);
    const float il = 1.f / l_run;
    const long orow = a.q_row0 + (long)(wave * 32 + r32) * a.q_rstride;
    bf16_t* op = a.O + orow * a.opitch + 8 * hi;
#pragma unroll
    for (int gp = 0; gp < 2; ++gp) {
        HY_OWIDE(o0, op + 16 * gp); HY_OWIDE(o1, op + 32 + 16 * gp);
    }
    if (hi == 0) { float2 ml; ml.x = m_ref; ml.y = l_run; *(float2*)(a.ML + orow * a.mlpitch) = ml; }
}
}
namespace hy {
constexpr size_t S5_KM_L = 16 * 64 * 256, S5_WE_L = 16 * 128 * 1024, S5_WC_L = 16 * 1024 * 128;
__device__ __forceinline__ void ph_s5_lampow(const Ctx& C, const In& in, float* LP) {
    for (int gid = C.bid * NT + C.tid; gid < NL * 16 * 64 * 65; gid += C.nblk * NT) {
        const int m = gid % 65, lgp = gid / 65, lg = lgp / 64;
        const float dt = expf(in.s5_log_dt[lg]);
        const float are = in.s5_a_re[lgp], aim = in.s5_a_im[lgp];
        const float mag = expf(are * dt * (float)m), ang = aim * dt * (float)m;
        float sn, cs; sincosf(ang, &sn, &cs);
        float2 o; o.x = mag * cs; o.y = mag * sn;
        *(float2*)(LP + (size_t)gid * 2) = o;
    }
}
__device__ __forceinline__ void ph_s5_bbar(const Ctx& C, const In& in, float* BB) {
    for (int gid = C.bid * NT + C.tid; gid < NL * 16 * 64 * 16; gid += C.nblk * NT) {
        const int lgp = gid >> 4, lg = lgp >> 6;
        const float dt = expf(in.s5_log_dt[lg]);
        const float are = in.s5_a_re[lgp], aim = in.s5_a_im[lgp];
        const float mag = expf(are * dt); float sn, cs; sincosf(aim * dt, &sn, &cs);
        const float lr = mag * cs, li = mag * sn;
        const float den = are * are + aim * aim, nr = lr - 1.f, ni = li;
        const float cr = (nr * are + ni * aim) / den, ci = (ni * are - nr * aim) / den;
        const float br = in.s5_b_re[gid], bi = in.s5_b_im[gid];
        float2 o; o.x = cr * br - ci * bi; o.y = cr * bi + ci * br;
        *(float2*)(BB + (size_t)gid * 2) = o;
    }
}
__device__ __forceinline__ void ph_s5_tables(const Ctx& C, const In& in, const float* LP, const float* BB, bf16_t* KM, bf16_t* WE, bf16_t* WC) {
    float* Cs = (float*)C.lds;
    float* Bs = Cs + 2048;
    float* Ls = Bs + 2048;
    const int tid = C.tid;
    for (int job = C.bid; job < NL * 16 * 4; job += C.nblk) {
        const int lg = job >> 2, qt = job & 3;
        __syncthreads();
        if (tid < 256) { const f32x4 r4 = *(const f32x4*)(in.s5_c_re + (size_t)lg * 1024 + tid * 4), i4 = *(const f32x4*)(in.s5_c_im + (size_t)lg * 1024 + tid * 4);
            *(f32x4*)(Cs + tid * 8) = (f32x4){r4[0], i4[0], r4[1], i4[1]}; *(f32x4*)(Cs + tid * 8 + 4) = (f32x4){r4[2], i4[2], r4[3], i4[3]}; }
        *(f32x4*)(Bs + tid * 4) = *(const f32x4*)(BB + (size_t)lg * 2048 + tid * 4);
        for (int i = tid; i < 64 * 65 * 2 / 4; i += NT) *(f32x4*)(Ls + i * 4) = *(const f32x4*)(LP + (size_t)lg * 64 * 65 * 2 + i * 4);
        __syncthreads();
        {
            const int lag = qt * 16 + (tid >> 5), c = (tid >> 1) & 15, jh = tid & 1;
            float a[8];
#pragma unroll
            for (int j = 0; j < 8; ++j) a[j] = 0.f;
#pragma unroll 4
            for (int p = 0; p < 64; ++p) {
                const float2 lm = *(const float2*)(Ls + (p * 65 + lag) * 2), cc = *(const float2*)(Cs + (c * 64 + p) * 2);
                const float xr = cc.x * lm.x - cc.y * lm.y, xi = cc.x * lm.y + cc.y * lm.x;
#pragma unroll
                for (int j = 0; j < 8; j += 2) { const f32x4 b4 = *(const f32x4*)(Bs + (p * 16 + 8 * jh + j) * 2); a[j] += xr * b4[0] - xi * b4[1]; a[j + 1] += xr * b4[2] - xi * b4[3]; }
            }
            *(u32x4*)(KM + ((size_t)lg * 64 + lag) * 256 + c * 16 + 8 * jh) = (u32x4){pk2(a[0], a[1]), pk2(a[2], a[3]), pk2(a[4], a[5]), pk2(a[6], a[7])};
        }
#pragma unroll 1
        for (int it = 0; it < 4; ++it) {
            const int idx = it * NT + tid, i = idx & 63, k = qt * 32 + (idx >> 6), ri = k >> 6, p = k & 63;
            const float2 lm = *(const float2*)(Ls + (p * 65 + 63 - i) * 2);
            unsigned w[8];
#pragma unroll
            for (int cp = 0; cp < 8; ++cp) {
                const f32x4 bb = *(const f32x4*)(Bs + (p * 16 + 2 * cp) * 2);
                const float v0 = ri ? (lm.x * bb[1] + lm.y * bb[0]) : (lm.x * bb[0] - lm.y * bb[1]);
                const float v1 = ri ? (lm.x * bb[3] + lm.y * bb[2]) : (lm.x * bb[2] - lm.y * bb[3]);
                w[cp] = pk2(v0, v1);
            }
            bf16_t* o = WE + (((size_t)lg * 128 + k) * 64 + i) * 16;
            *(u32x4*)o = (u32x4){w[0], w[1], w[2], w[3]}; *(u32x4*)(o + 8) = (u32x4){w[4], w[5], w[6], w[7]};
        }
#pragma unroll 1
        for (int it = 0; it < 8; ++it) {
            const int idx = it * NT + tid, ko = idx & 15, c = (idx >> 4) & 15, j = qt * 16 + (idx >> 8), ri = ko >> 3, p0 = (ko & 7) * 8;
            unsigned w[4];
#pragma unroll
            for (int e = 0; e < 4; ++e) {
                const int p = p0 + 2 * e;
                const float2 lm0 = *(const float2*)(Ls + (p * 65 + j + 1) * 2), lm1 = *(const float2*)(Ls + ((p + 1) * 65 + j + 1) * 2);
                const f32x4 cc = *(const f32x4*)(Cs + (c * 64 + p) * 2);
                const float v0 = ri ? -(cc[0] * lm0.y + cc[1] * lm0.x) : (cc[0] * lm0.x - cc[1] * lm0.y);
                const float v1 = ri ? -(cc[2] * lm1.y + cc[3] * lm1.x) : (cc[2] * lm1.x - cc[3] * lm1.y);
                w[e] = pk2(v0, v1);
            }
            *(u32x4*)(WC + (((size_t)lg * 64 + j) * 16 + c) * 128 + ko * 8) = (u32x4){w[0], w[1], w[2], w[3]};
        }
    }
    __syncthreads();
}
__device__ __forceinline__ void ph_s5_chunk_states(const Ctx& C, const bf16_t* U, const bf16_t* WEl, float* E) {
    const int lane = C.lane, wave = C.wave, r32 = lane & 31, hi = lane >> 5;
    for (int unit = (C.nblk >= 192 ? C.bid - (C.nblk - 64) : C.bid); unit < 64; unit += C.nblk) {
        if (unit < 0) break;
        const int g = unit & 15, nb = unit >> 4, mt = wave & 3, nh = wave >> 2;
        const int n = nb * 64 + nh * 32 + r32;
        const bf16_t* ap = WEl + ((size_t)g * 128 + mt * 32 + r32) * 1024 + hi * 8;
        const bf16_t* bp = U + (size_t)n * 64 * 256 + g * 16 + hi * 8;
        f32x16 acc;
#pragma unroll
        for (int r = 0; r < 16; ++r) acc[r] = 0.f;
#pragma unroll 16
        for (int i = 0; i < 64; ++i) {
            const bf16x8 af = *(const bf16x8*)(ap + i * 16);
            const bf16x8 bf = *(const bf16x8*)(bp + (size_t)i * 256);
            acc = __builtin_amdgcn_mfma_f32_32x32x16_bf16(af, bf, acc, 0, 0, 0);
        }
        float* ep = E + ((size_t)n * 16 + g) * 128 + mt * 32 + 4 * hi;
#pragma unroll
        for (int q4 = 0; q4 < 4; ++q4) *(f32x4*)(ep + 8 * q4) = (f32x4){acc[4 * q4], acc[4 * q4 + 1], acc[4 * q4 + 2], acc[4 * q4 + 3]};
    }
}
constexpr int S5_UP = 2064;
constexpr int S5L_U = 0, S5L_KM = 32 * S5_UP, S5L_X = S5L_KM + 512 + 64 * 512, S5L_XP = 272, S5L_END = S5L_X + 32 * S5L_XP;
struct S5U { const bf16_t* U; const bf16_t* KMl; const bf16_t* WCl; const float* E; const float* LP; const float* dskip; bf16_t* GS; int layer; int var; };
__device__ __forceinline__ void s5_unit(const Ctx& C, const S5U& a, int unit) {
    HY_LAS unsigned char* L = (HY_LAS unsigned char*)C.lds;
    const int tid = C.tid, lane = C.lane, wave = C.wave, r32 = lane & 31, hi = lane >> 5;
    const int g = unit & 15, blk = unit >> 4;
    const int b = blk >> 2, n0 = (blk & 3) * 32, nglob0 = b * 128 + n0;
#pragma unroll
    for (int i = 0; i < 8; ++i) {
        const int c = tid + i * 512, n = c >> 7, tk = (c >> 1) & 63, hf = c & 1;
        const u32x4 v = *(const u32x4*)(a.U + ((size_t)(nglob0 + n) * 64 + tk) * 256 + g * 16 + hf * 8);
        *(HY_LAS u32x4*)(L + S5L_U + n * S5_UP + tk * 32 + hf * 16) = v;
    }
#pragma unroll
    for (int i = 0; i < 4; ++i) {
        const int c = tid + i * 512;
        const u32x4 v = *(const u32x4*)(a.KMl + (size_t)g * 16384 + c * 8);
        *(HY_LAS u32x4*)(L + S5L_KM + 512 + c * 16) = v;
    }
    if (tid < 32) { unsigned zz = 0u; asm volatile("" : "+v"(zz)); *(HY_LAS u32x4*)(L + S5L_KM + tid * 16) = (u32x4){zz, zz, zz, zz}; }
    f32x4 ddv[2];
#pragma unroll
    for (int e = 0; e < 2; ++e) ddv[e] = *(const f32x4*)(a.dskip + g * 16 + 8 * e + 4 * hi);
    bf16x8 wc[8];
    {
        const bf16_t* wp = a.WCl + ((size_t)g * 1024 + wave * 32 + r32) * 128 + hi * 8;
#pragma unroll
        for (int s = 0; s < 8; ++s) wc[s] = *(const bf16x8*)(wp + s * 16);
    }
    if (a.var != 2) {
        const int p = lane, lgp = (a.layer * 16 + g) * 64 + p;
        const float2 lam = *(const float2*)(a.LP + ((size_t)lgp * 65 + 64) * 2);
        const int nw = (n0 + 32) >> 4;
        float sr[16], si[16];
        if (wave < nw) {
            const float* ep = a.E + ((size_t)(b * 128) * 16 + g) * 128 + p;
            const int nb = wave * 16;
            float er[16], ei[16];
#pragma unroll
            for (int j = 0; j < 16; ++j) { er[j] = ep[(size_t)(nb + j) * 2048]; ei[j] = ep[(size_t)(nb + j) * 2048 + 64]; }
            float xr = 0.f, xi = 0.f;
#pragma unroll
            for (int j = 0; j < 16; ++j) {
                sr[j] = xr; si[j] = xi;
                const float nr = lam.x * xr - lam.y * xi + er[j], ni = lam.x * xi + lam.y * xr + ei[j];
                xr = nr; xi = ni;
            }
            *(HY_LAS float*)(L + S5L_END + (wave * 64 + p) * 8) = xr; *(HY_LAS float*)(L + S5L_END + (wave * 64 + p) * 8 + 4) = xi;
        }
        __syncthreads();
        if (wave < nw && wave * 16 >= n0) {
            float2 l16 = lam;
#pragma unroll
            for (int k = 0; k < 4; ++k) { const float qr_ = l16.x * l16.x - l16.y * l16.y, qi_ = 2.f * l16.x * l16.y; l16.x = qr_; l16.y = qi_; }
            float cr = 0.f, ci = 0.f;
            for (int v = 0; v < wave; ++v) {
                const float tx = *(const HY_LAS float*)(L + S5L_END + (v * 64 + p) * 8), ty = *(const HY_LAS float*)(L + S5L_END + (v * 64 + p) * 8 + 4);
                const float nr = l16.x * cr - l16.y * ci + tx, ni = l16.x * ci + l16.y * cr + ty;
                cr = nr; ci = ni;
            }
            float pr = 1.f, pi = 0.f;
#pragma unroll
            for (int j = 0; j < 16; ++j) {
                const float xr = sr[j] + pr * cr - pi * ci, xi = si[j] + pr * ci + pi * cr;
                const int row = wave * 16 + j - n0;
                *(HY_LAS bf16_t*)(L + S5L_X + row * S5L_XP + p * 2) = f2bf(xr);
                *(HY_LAS bf16_t*)(L + S5L_X + row * S5L_XP + (64 + p) * 2) = f2bf(xi);
                const float npr = pr * lam.x - pi * lam.y, npi = pr * lam.y + pi * lam.x;
                pr = npr; pi = npi;
            }
        }
    }
    __syncthreads();
    const float dsk0 = 0.f; (void)dsk0;
#pragma unroll 1
    for (int q = 0; q < 4; ++q) {
        const int mt = q == 0 ? wave : (q == 1 ? 15 - wave : (q == 2 ? 16 + wave : 31 - wave));
        f32x16 acc;
#pragma unroll
        for (int r = 0; r < 16; ++r) acc[r] = 0.f;
        bf16x8 wn[8];
#pragma unroll
        for (int s = 0; s < 8; ++s) wn[s] = wc[s];
        if (q < 3) {
            const int mtn = q == 0 ? 15 - wave : (q == 1 ? 16 + wave : 31 - wave);
            const bf16_t* wp = a.WCl + ((size_t)g * 1024 + mtn * 32 + r32) * 128 + hi * 8;
#pragma unroll
            for (int s = 0; s < 8; ++s) wn[s] = *(const bf16x8*)(wp + s * 16);
        }
#pragma unroll
        for (int s = 0; s < 8; ++s) {
            const bf16x8 bf = *(const HY_LAS bf16x8*)(L + S5L_X + r32 * S5L_XP + s * 32 + hi * 16);
            acc = __builtin_amdgcn_mfma_f32_32x32x16_bf16(wc[s], bf, acc, 0, 0, 0);
        }
        const int iend = (a.var == 1) ? 0 : 2 * mt + 2;
#pragma unroll 4
        for (int i = 0; i < iend; ++i) {
            const bf16x8 af = *(const HY_LAS bf16x8*)(L + S5L_KM + 512 + (2 * mt - i) * 512 + r32 * 32 + hi * 16);
            const bf16x8 bf = *(const HY_LAS bf16x8*)(L + S5L_U + r32 * S5_UP + i * 32 + hi * 16);
            acc = __builtin_amdgcn_mfma_f32_32x32x16_bf16(af, bf, acc, 0, 0, 0);
        }
#pragma unroll
        for (int qp = 0; qp < 2; ++qp) {
            const int j = 2 * mt + qp;
            u32x2 w[2];
#pragma unroll
            for (int e = 0; e < 2; ++e) {
                const int q4 = 2 * qp + e, c0 = 8 * e + 4 * hi;
                const u32x2 uu = *(const HY_LAS u32x2*)(L + S5L_U + r32 * S5_UP + j * 32 + c0 * 2);
                const f32x4 dd = ddv[e];
                const float y0 = acc[4 * q4] + dd[0] * lo16(uu.x), y1 = acc[4 * q4 + 1] + dd[1] * hi16(uu.x), y2 = acc[4 * q4 + 2] + dd[2] * lo16(uu.y), y3 = acc[4 * q4 + 3] + dd[3] * hi16(uu.y);
                w[e].x = pk2(gelu_tanh(y0), gelu_tanh(y1)); w[e].y = pk2(gelu_tanh(y2), gelu_tanh(y3));
            }
            const auto sx = __builtin_amdgcn_permlane32_swap(w[0].x, w[1].x, false, false); const auto sy = __builtin_amdgcn_permlane32_swap(w[0].y, w[1].y, false, false);
            *(u32x4*)(a.GS + ((size_t)(nglob0 + r32) * 64 + j) * 256 + g * 16 + 8 * hi) = (u32x4){sx[0], sy[0], sx[1], sy[1]};
        }
#pragma unroll
        for (int s = 0; s < 8; ++s) wc[s] = wn[s];
    }
}
}
namespace hy {
struct MixQ { const bf16_t *QM, *KM, *VM, *QA, *KA, *VA; const float* bias; bf16_t *YC, *YAB; float* MLB; S5U s5; unsigned* counter; int lo, hi; const float* bnd; int var;
              const float *cu, *cv; unsigned char *du, *dv; float *su, *sv; };
__device__ __forceinline__ void ph_cvt_fp4(const Ctx& C, const float* src, unsigned char* dst, float* scale, int nrows);
__device__ __forceinline__ void ph_mixers(const Ctx& C, const MixQ& p) {
    HY_LAS int* slot = (HY_LAS int*)((HY_LAS unsigned char*)C.lds + LDS_BYTES - 64);
    constexpr int N_MLA = 384, N_S5 = 128, N_SWA = 1152, TOTAL = N_S5 + N_MLA + N_SWA;
    int nxt = 0;
    bool cvt_done = false;
    if (C.tid == 0) nxt = (int)atomicAdd(p.counter, 1u);
    for (;;) {
        if (C.tid == 0) *slot = nxt;
        __syncthreads();
        const int it = *slot + p.lo;
        __syncthreads();
        const bool last = it >= (p.hi < TOTAL ? p.hi : TOTAL);
        if (!last) {
        const bool ahead = it >= N_MLA && it < TOTAL - 256;
        if (ahead && C.tid == 0) nxt = (int)atomicAdd(p.counter, 1u);
        Ctx Cu = C; { int t_ = C.tid; asm volatile("" : "+v"(t_)); Cu.tid = t_; Cu.lane = t_ & 63; }
        if (it >= N_MLA && it < N_MLA + N_S5) s5_unit(Cu, p.s5, it - N_MLA);
        else if (it < N_MLA) {
            const int i = it, qb = 31 - i / 12, bh = i % 12, b = bh / 6, h = bh % 6;
            AttnArgs a;
            a.Q = p.QM + h * 96; a.K = p.KM + h * 96; a.V = p.VM + h * 64; a.qpitch = 576; a.kpitch = 576; a.vpitch = 384;
            a.q_row0 = (long)b * S + qb * 256; a.q_rstride = 1; a.k_row0 = (long)b * S; a.k_rstride = 1; a.q_idx0 = qb * 256;
            a.t_begin = 0; a.t_end = (qb + 1) * 4; a.bias = nullptr; a.O = p.YC + h * 64; a.opitch = 384; a.ML = nullptr; a.mlpitch = 0; a.safe = p.bnd[0] < 64.f;
            if (p.var == 0) mla_unit2(Cu, a);
#if HY_PROBE == 21
            else attn_unit<0, 1>(C, a);
#elif HY_PROBE == 22
            else attn_unit<0, 2>(C, a);
#endif
        } else {
            const int i = it - N_S5 - N_MLA, bh = i / 96, u = i % 96, b = bh / 6, h = bh % 6;
            int br, r, qbk, dil;
            if (u < 32) { br = 0; dil = 1; r = 0; qbk = u; }
            else if (u < 64) { br = 1; dil = 4; r = (u - 32) >> 3; qbk = (u - 32) & 7; }
            else { br = 2; dil = 16; r = (u - 64) >> 1; qbk = (u - 64) & 1; }
            const int m0 = qbk * 256;
            AttnArgs a;
            a.Q = p.QA + h * 64; a.K = p.KA + h * 64; a.V = p.VA + h * 64; a.qpitch = 384; a.kpitch = 384; a.vpitch = 384;
            a.q_row0 = (long)b * S + r + (long)m0 * dil; a.q_rstride = dil; a.k_row0 = (long)b * S + r; a.k_rstride = dil; a.q_idx0 = m0;
            a.t_begin = m0 >= 128 ? (m0 - 128) >> 6 : 0; a.t_end = (m0 + 256) >> 6; a.bias = p.bias + (br * 6 + h) * 132;
            a.O = p.YAB + (size_t)br * M * 384 + h * 64; a.opitch = 384; a.ML = p.MLB + ((size_t)br * M * 6 + h) * 2; a.mlpitch = 12; a.safe = p.bnd[1] < 64.f;
            swa_unit_pair(Cu, a);
        }
        if (!ahead && C.tid == 0) nxt = (int)atomicAdd(p.counter, 1u);
        }
        if (!cvt_done && p.cv) {
            cvt_done = true;
            Ctx Cc = C; { int t_ = C.tid; asm volatile("" : "+v"(t_)); Cc.lane = t_ & 63; }
#pragma unroll 1
            for (int tb = p.cu ? 0 : 1; tb < 2; ++tb) ph_cvt_fp4(Cc, tb ? p.cv : p.cu, tb ? p.dv : p.du, tb ? p.sv : p.su, 16384);
        }
        if (last) break;
    }
}
struct MergeIn { u32x4 y0, y1, y2, gs, gl, yc; float2 a0, a1, a2; };
template <bool S5 = true>
__device__ __forceinline__ void merge_load(MergeIn& d, int lane, size_t m, const bf16_t* YAB, const float* MLB, const bf16_t* GS, const bf16_t* GL, const bf16_t* YC) {
    if (lane < 48) {
        const int j = lane >> 3;
        d.y0 = *(const u32x4*)(YAB + ((size_t)0 * M + m) * 384 + lane * 8); d.y1 = *(const u32x4*)(YAB + ((size_t)1 * M + m) * 384 + lane * 8); d.y2 = *(const u32x4*)(YAB + ((size_t)2 * M + m) * 384 + lane * 8);
        d.a0 = *(const float2*)(MLB + ((size_t)0 * M + m) * 12 + j * 2); d.a1 = *(const float2*)(MLB + ((size_t)1 * M + m) * 12 + j * 2); d.a2 = *(const float2*)(MLB + ((size_t)2 * M + m) * 12 + j * 2);
        d.yc = *(const u32x4*)(YC + m * 384 + lane * 8);
    }
    if (S5 && lane >= 32) { d.gs = *(const u32x4*)(GS + m * 256 + (lane - 32) * 8); d.gl = *(const u32x4*)(GL + m * 256 + (lane - 32) * 8); }
}
template <bool S5 = true>
__device__ __forceinline__ void merge_token(const MergeIn& d, int lane, size_t m, const float (&bg)[8], bf16_t* AOUT) {
    float va[8], vs[8], vc[8]; float sa = 0.f, sg = 0.f, sc = 0.f;
    if (lane < 48) {
        const float mm = fmaxf(d.a0.x, fmaxf(d.a1.x, d.a2.x));
        const float w0 = exp2f(d.a0.x - mm) * d.a0.y, w1 = exp2f(d.a1.x - mm) * d.a1.y, w2 = exp2f(d.a2.x - mm) * d.a2.y;
        const float iw = 1.f / (w0 + w1 + w2);
#pragma unroll
        for (int k = 0; k < 4; ++k) {
            va[2 * k] = (w0 * lo16(d.y0[k]) + w1 * lo16(d.y1[k]) + w2 * lo16(d.y2[k])) * iw; va[2 * k + 1] = (w0 * hi16(d.y0[k]) + w1 * hi16(d.y1[k]) + w2 * hi16(d.y2[k])) * iw;
            vc[2 * k] = lo16(d.yc[k]); vc[2 * k + 1] = hi16(d.yc[k]);
            sa += va[2 * k] * va[2 * k] + va[2 * k + 1] * va[2 * k + 1]; sc += vc[2 * k] * vc[2 * k] + vc[2 * k + 1] * vc[2 * k + 1];
        }
    }
    if (S5 && lane >= 32) {
#pragma unroll
        for (int k = 0; k < 4; ++k) {
            const float z0 = lo16(d.gl[k]) + bg[2 * k], z1 = hi16(d.gl[k]) + bg[2 * k + 1];
            vs[2 * k] = lo16(d.gs[k]) / (1.f + __expf(-z0)); vs[2 * k + 1] = hi16(d.gs[k]) / (1.f + __expf(-z1));
            sg += vs[2 * k] * vs[2 * k] + vs[2 * k + 1] * vs[2 * k + 1];
        }
    }
    sa = wave_sum(sa); if (S5) sg = wave_sum(sg); sc = wave_sum(sc);
    const float ra = rsqrtf(sa * (1.f / 384.f) + EPS), rg = rsqrtf(sg * (1.f / 256.f) + EPS), rc = rsqrtf(sc * (1.f / 384.f) + EPS);
    if (lane < 48) {
        u32x4 w;
        w.x = pk2(va[0] * ra, va[1] * ra); w.y = pk2(va[2] * ra, va[3] * ra); w.z = pk2(va[4] * ra, va[5] * ra); w.w = pk2(va[6] * ra, va[7] * ra);
        *(u32x4*)(AOUT + m * D + lane * 8) = w;
        w.x = pk2(vc[0] * rc, vc[1] * rc); w.y = pk2(vc[2] * rc, vc[3] * rc); w.z = pk2(vc[4] * rc, vc[5] * rc); w.w = pk2(vc[6] * rc, vc[7] * rc);
        *(u32x4*)(AOUT + m * D + 640 + lane * 8) = w;
    }
    if (S5 && lane >= 32) {
        u32x4 w;
        w.x = pk2(vs[0] * rg, vs[1] * rg); w.y = pk2(vs[2] * rg, vs[3] * rg); w.z = pk2(vs[4] * rg, vs[5] * rg); w.w = pk2(vs[6] * rg, vs[7] * rg);
        *(u32x4*)(AOUT + m * D + 384 + (lane - 32) * 8) = w;
    }
}
__device__ __forceinline__ void ph_merge2(const Ctx& C, const bf16_t* YAB, const float* MLB, const bf16_t* GS, const bf16_t* GL, const float* b_glu, const bf16_t* YC, bf16_t* AOUT) {
    const int lane = C.lane;
    float bg[8];
    { const int c = lane >= 32 ? (lane - 32) * 8 : 0; const f32x4 b0 = *(const f32x4*)(b_glu + c), b1 = *(const f32x4*)(b_glu + c + 4);
#pragma unroll
      for (int k = 0; k < 4; ++k) { bg[k] = b0[k]; bg[4 + k] = b1[k]; } }
    const size_t stride = (size_t)C.nblk * 8;
    for (size_t m = (size_t)C.bid * 8 + C.wave; m < M; m += 2 * stride) {
        MergeIn d0, d1;
        merge_load(d0, lane, m, YAB, MLB, GS, GL, YC);
        const bool two = m + stride < M;
        if (two) merge_load(d1, lane, m + stride, YAB, MLB, GS, GL, YC);
        merge_token(d0, lane, m, bg, AOUT);
        if (two) merge_token(d1, lane, m + stride, bg, AOUT);
    }
}
constexpr int MG_P = 528, MG_SS = 64 * MG_P;
__device__ __forceinline__ void ph_merge3(const Ctx& C, const bf16_t* YAB, const float* MLB, const bf16_t* GS, const bf16_t* WG, const float* b_glu, const bf16_t* YC, bf16_t* AOUT) {
    HY_LAS unsigned char* L = (HY_LAS unsigned char*)C.lds;
    const int tid = C.tid, lane = C.lane, wave = C.wave, r32 = lane & 31, hi = lane >> 5;
    float bg[8];
#pragma unroll
    for (int k = 0; k < 8; ++k) bg[k] = 0.f;
    for (int u = C.bid; u < M / 64; u += C.nblk) {
        const size_t m0 = (size_t)u * 64;
        __syncthreads();
#pragma unroll
        for (int i = 0; i < 4; ++i) {
            const int c = tid + i * 512, row = c >> 5, cc = c & 31;
            const u32x4 v = *(const u32x4*)(GS + (m0 + row) * 256 + cc * 8);
            *(HY_LAS u32x4*)(L + row * MG_P + cc * 16) = v;
        }
        bf16x8 wf[16];
        { const bf16_t* wp = WG + (size_t)(wave * 32 + r32) * 256 + hi * 8;
#pragma unroll
          for (int s = 0; s < 16; ++s) wf[s] = *(const bf16x8*)(wp + s * 16); }
        MergeIn d0, d1;
        const size_t mw = m0 + wave * 8;
        merge_load<false>(d0, lane, mw, YAB, MLB, GS, GS, YC);
        merge_load<false>(d1, lane, mw + 1, YAB, MLB, GS, GS, YC);
        __syncthreads();
        f32x16 acc0, acc1;
#pragma unroll
        for (int r = 0; r < 16; ++r) { acc0[r] = 0.f; acc1[r] = 0.f; }
#pragma unroll
        for (int s = 0; s < 16; ++s) {
            const bf16x8 b0 = *(const HY_LAS bf16x8*)(L + r32 * MG_P + s * 32 + hi * 16);
            const bf16x8 b1 = *(const HY_LAS bf16x8*)(L + (32 + r32) * MG_P + s * 32 + hi * 16);
            acc0 = __builtin_amdgcn_mfma_f32_32x32x16_bf16(wf[s], b0, acc0, 0, 0, 0);
            acc1 = __builtin_amdgcn_mfma_f32_32x32x16_bf16(wf[s], b1, acc1, 0, 0, 0);
        }
        float ss0 = 0.f, ss1 = 0.f;
#pragma unroll
        for (int q = 0; q < 4; ++q) {
            const int n0 = wave * 32 + 8 * q + 4 * hi;
            const f32x4 bb = *(const f32x4*)(b_glu + n0);
            const u32x2 g0 = *(const HY_LAS u32x2*)(L + r32 * MG_P + n0 * 2), g1 = *(const HY_LAS u32x2*)(L + (32 + r32) * MG_P + n0 * 2);
            const float ga[4] = {lo16(g0.x), hi16(g0.x), lo16(g0.y), hi16(g0.y)}, gb[4] = {lo16(g1.x), hi16(g1.x), lo16(g1.y), hi16(g1.y)};
#pragma unroll
            for (int i = 0; i < 4; ++i) {
                const float va = ga[i] / (1.f + __expf(-(acc0[4 * q + i] + bb[i]))), vb = gb[i] / (1.f + __expf(-(acc1[4 * q + i] + bb[i])));
                acc0[4 * q + i] = va; acc1[4 * q + i] = vb; ss0 += va * va; ss1 += vb * vb;
            }
        }
        ss0 += __shfl_xor(ss0, 32); ss1 += __shfl_xor(ss1, 32);
        if (hi == 0) { *(HY_LAS float*)(L + MG_SS + (wave * 64 + r32) * 4) = ss0; *(HY_LAS float*)(L + MG_SS + (wave * 64 + 32 + r32) * 4) = ss1; }
        __syncthreads();
        float t0 = 0.f, t1 = 0.f;
#pragma unroll
        for (int w = 0; w < 8; ++w) { t0 += *(const HY_LAS float*)(L + MG_SS + (w * 64 + r32) * 4); t1 += *(const HY_LAS float*)(L + MG_SS + (w * 64 + 32 + r32) * 4); }
        const float r0 = rsqrtf(t0 * (1.f / 256.f) + EPS), r1 = rsqrtf(t1 * (1.f / 256.f) + EPS);
#pragma unroll
        for (int qp = 0; qp < 2; ++qp) {
            const int nb = wave * 32 + 16 * qp + 8 * hi;
            u32x2 a0, a1, b0, b1;
            a0.x = pk2(acc0[8 * qp] * r0, acc0[8 * qp + 1] * r0); a0.y = pk2(acc0[8 * qp + 2] * r0, acc0[8 * qp + 3] * r0);
            b0.x = pk2(acc0[8 * qp + 4] * r0, acc0[8 * qp + 5] * r0); b0.y = pk2(acc0[8 * qp + 6] * r0, acc0[8 * qp + 7] * r0);
            a1.x = pk2(acc1[8 * qp] * r1, acc1[8 * qp + 1] * r1); a1.y = pk2(acc1[8 * qp + 2] * r1, acc1[8 * qp + 3] * r1);
            b1.x = pk2(acc1[8 * qp + 4] * r1, acc1[8 * qp + 5] * r1); b1.y = pk2(acc1[8 * qp + 6] * r1, acc1[8 * qp + 7] * r1);
            const auto x0 = __builtin_amdgcn_permlane32_swap(a0.x, b0.x, false, false), y0 = __builtin_amdgcn_permlane32_swap(a0.y, b0.y, false, false);
            const auto x1 = __builtin_amdgcn_permlane32_swap(a1.x, b1.x, false, false), y1 = __builtin_amdgcn_permlane32_swap(a1.y, b1.y, false, false);
            *(u32x4*)(AOUT + (m0 + r32) * D + 384 + nb) = (u32x4){x0[0], y0[0], x0[1], y0[1]};
            *(u32x4*)(AOUT + (m0 + 32 + r32) * D + 384 + nb) = (u32x4){x1[0], y1[0], x1[1], y1[1]};
        }
        merge_token<false>(d0, lane, mw, bg, AOUT);
        merge_token<false>(d1, lane, mw + 1, bg, AOUT);
#pragma unroll 1
        for (int t = 2; t < 8; t += 2) {
            merge_load<false>(d0, lane, mw + t, YAB, MLB, GS, GS, YC);
            merge_load<false>(d1, lane, mw + t + 1, YAB, MLB, GS, GS, YC);
            merge_token<false>(d0, lane, mw + t, bg, AOUT);
            merge_token<false>(d1, lane, mw + t + 1, bg, AOUT);
        }
    }
}
}
namespace hy {
#define HY_CE(a, b) { const int _mx = max(a, b), _mn = min(a, b); a = _mx; b = _mn; }
__device__ __forceinline__ void sort16_desc(int (&v)[16]) {
    HY_CE(v[0], v[13]); HY_CE(v[1], v[12]); HY_CE(v[2], v[15]); HY_CE(v[3], v[14]); HY_CE(v[4], v[8]); HY_CE(v[5], v[6]); HY_CE(v[7], v[11]); HY_CE(v[9], v[10]);
    HY_CE(v[0], v[5]); HY_CE(v[1], v[7]); HY_CE(v[2], v[9]); HY_CE(v[3], v[4]); HY_CE(v[6], v[13]); HY_CE(v[8], v[14]); HY_CE(v[10], v[15]); HY_CE(v[11], v[12]);
    HY_CE(v[0], v[1]); HY_CE(v[2], v[3]); HY_CE(v[4], v[5]); HY_CE(v[6], v[8]); HY_CE(v[7], v[9]); HY_CE(v[10], v[11]); HY_CE(v[12], v[13]); HY_CE(v[14], v[15]);
    HY_CE(v[0], v[2]); HY_CE(v[1], v[3]); HY_CE(v[4], v[10]); HY_CE(v[5], v[11]); HY_CE(v[6], v[7]); HY_CE(v[8], v[9]); HY_CE(v[12], v[14]); HY_CE(v[13], v[15]);
    HY_CE(v[1], v[2]); HY_CE(v[3], v[12]); HY_CE(v[4], v[6]); HY_CE(v[5], v[7]); HY_CE(v[8], v[10]); HY_CE(v[9], v[11]); HY_CE(v[13], v[14]);
    HY_CE(v[1], v[4]); HY_CE(v[2], v[6]); HY_CE(v[5], v[8]); HY_CE(v[7], v[10]); HY_CE(v[9], v[13]); HY_CE(v[11], v[14]);
    HY_CE(v[2], v[4]); HY_CE(v[3], v[6]); HY_CE(v[9], v[12]); HY_CE(v[11], v[13]);
    HY_CE(v[3], v[5]); HY_CE(v[6], v[8]); HY_CE(v[7], v[9]); HY_CE(v[10], v[12]);
    HY_CE(v[3], v[4]); HY_CE(v[5], v[6]); HY_CE(v[7], v[8]); HY_CE(v[9], v[10]); HY_CE(v[11], v[12]);
    HY_CE(v[6], v[7]); HY_CE(v[8], v[9]);
}
__device__ __forceinline__ void bitonic_merge16_desc(int (&v)[16]) {
#pragma unroll
    for (int j = 8; j > 0; j >>= 1)
#pragma unroll
        for (int i = 0; i < 16; ++i) { if ((i & j) == 0) { HY_CE(v[i], v[i | j]); } }
}
__device__ __forceinline__ void merge_top16(int (&a)[16], const int (&b)[16]) {
#pragma unroll
    for (int i = 0; i < 16; ++i) a[i] = max(a[i], b[15 - i]);
    bitonic_merge16_desc(a);
}
constexpr float TK_BIAS = 8.f;
__device__ __forceinline__ int f2ord(float f) { return __float_as_int(f); }
__device__ __forceinline__ float ord2f(int s) { return __int_as_float(s); }
__device__ __forceinline__ int xlane32(int v) { return __shfl_xor(v, 32); }

constexpr int PA_SKP = 272;
constexpr int PA_TILE = 128 * PA_SKP;

__device__ __forceinline__ void top16_of_scores(const f32x16 (&acc)[4], int hi, int (&out)[16]) {
    int g[16];
#pragma unroll
    for (int mt = 0; mt < 4; ++mt) {
#pragma unroll
        for (int r = 0; r < 16; ++r) { const int key = 32 * mt + (r & 3) + 8 * (r >> 2) + 4 * hi; g[r] = (f2ord(acc[mt][r]) & ~127) | key; }
        sort16_desc(g);
        if (mt == 0) {
#pragma unroll
            for (int r = 0; r < 16; ++r) out[r] = g[r];
        } else merge_top16(out, g);
    }
    int pb[16];
#pragma unroll
    for (int r = 0; r < 16; ++r) pb[r] = xlane32(out[r]);
    merge_top16(out, pb);
}

__device__ __forceinline__ void ph_peer_topk(const Ctx& C, const bf16_t* QP, const bf16_t* SUBK, int* EIDX, float* GATE) {
    HY_LAS unsigned char* L = (HY_LAS unsigned char*)C.lds;
    const int tid = C.tid, lane = C.lane, wave = C.wave, r32 = lane & 31, hi = lane >> 5;
    int staged = -1;
    pg8::StaticOrder So; So.init(M, 2048, C.nblk, C.bid); pg8::Unit tu;
    for (int ui = 0; So.next(ui, tu); ++ui) {
        const int tt = tu.pm, h = tu.pn;
        const size_t m = (size_t)tt * 256 + wave * 32 + r32;
        if (h != staged) {
            __syncthreads();
#pragma unroll
            for (int i = 0; i < 8; ++i) {
                const int c = tid + i * 512, j = c >> 11, row = (c >> 4) & 127, ch = c & 15;
                const u32x4 v = *(const u32x4*)(SUBK + ((size_t)(h * 2 + j) * 128 + row) * 128 + ch * 8);
                *(HY_LAS u32x4*)(L + j * PA_TILE + row * PA_SKP + ch * 16) = v;
            }
            __syncthreads();
            staged = h;
        }
        int s1[16], s2[16];
#pragma unroll
        for (int j = 0; j < 2; ++j) {
            f32x16 acc[4];
#pragma unroll
            for (int mt = 0; mt < 4; ++mt)
#pragma unroll
                for (int r = 0; r < 16; ++r) acc[mt][r] = TK_BIAS;
            const bf16_t* qp = QP + m * 2048 + (h * 2 + j) * 128 + hi * 8;
#pragma unroll
            for (int s = 0; s < 8; ++s) {
                const bf16x8 qf = *(const bf16x8*)(qp + s * 16);
#pragma unroll
                for (int mt = 0; mt < 4; ++mt) {
                    const bf16x8 kf = *(const HY_LAS bf16x8*)(L + j * PA_TILE + (mt * 32 + r32) * PA_SKP + s * 32 + hi * 16);
                    acc[mt] = __builtin_amdgcn_mfma_f32_32x32x16_bf16(kf, qf, acc[mt], 0, 0, 0);
                }
            }
            if (j == 0) top16_of_scores(acc, hi, s1); else top16_of_scores(acc, hi, s2);
        }
        float x[16], y[16];
#pragma unroll
        for (int r = 0; r < 16; ++r) { const int xs = hi ? s2[r] : s1[r], ys = hi ? s1[r] : s2[r]; x[r] = ord2f(xs & ~127); y[r] = ord2f(ys & ~127); }
        int ca[16], cb[16];
        {
            int n = 0;
#pragma unroll
            for (int a = 0; a < 16; ++a)
#pragma unroll
                for (int b = a; b < 16; ++b) {
                    if ((a + 1) * (b + 1) <= 16) {
                        const float sum = x[a] + y[b];
                        const int id0 = a * 16 + b, id1 = b * 16 + a;
                        int key = (f2ord(sum) & ~255) | (hi ? id1 : id0);
                        if (a == b && hi) key = (int)0x80000000;
                        if (n < 16) ca[n] = key; else cb[n - 16] = key;
                        ++n;
                    }
                }
#pragma unroll
            for (int i = 27 - 16; i < 16; ++i) cb[i] = (int)0x80000000;
        }
        sort16_desc(ca); sort16_desc(cb); merge_top16(ca, cb);
        {
            int pb[16];
#pragma unroll
            for (int r = 0; r < 16; ++r) pb[r] = xlane32(ca[r]);
            merge_top16(ca, pb);
        }
        unsigned t1[4], t2[4];
#pragma unroll
        for (int q4 = 0; q4 < 4; ++q4) {
            t1[q4] = (unsigned)(s1[4 * q4] & 127) | ((unsigned)(s1[4 * q4 + 1] & 127) << 8) | ((unsigned)(s1[4 * q4 + 2] & 127) << 16) | ((unsigned)(s1[4 * q4 + 3] & 127) << 24);
            t2[q4] = (unsigned)(s2[4 * q4] & 127) | ((unsigned)(s2[4 * q4 + 1] & 127) << 8) | ((unsigned)(s2[4 * q4 + 2] & 127) << 16) | ((unsigned)(s2[4 * q4 + 3] & 127) << 24);
        }
        float e[16]; float sum = 0.f; const float mxv = ord2f(ca[0] & ~255);
#pragma unroll
        for (int r = 0; r < 16; ++r) { e[r] = __expf(ord2f(ca[r] & ~255) - mxv); sum += e[r]; }
        const float inv = 1.f / sum;
        int eo[8]; float go[8];
#pragma unroll
        for (int r = 0; r < 8; ++r) {
            const int cid = (hi ? ca[r + 8] : ca[r]) & 255, a = cid >> 4, b = cid & 15;
            const unsigned la = __builtin_amdgcn_perm(t1[1], t1[0], 0x0c0c0c00u | (a & 7)), ha = __builtin_amdgcn_perm(t1[3], t1[2], 0x0c0c0c00u | (a & 7));
            const unsigned lb = __builtin_amdgcn_perm(t2[1], t2[0], 0x0c0c0c00u | (b & 7)), hb = __builtin_amdgcn_perm(t2[3], t2[2], 0x0c0c0c00u | (b & 7));
            const unsigned i1 = (a & 8) ? ha : la, i2 = (b & 8) ? hb : lb;
            eo[r] = (int)(i1 * 128u + i2);
            go[r] = (hi ? e[r + 8] : e[r]) * inv;
        }
        int* ep = EIDX + m * 128 + h * 16 + hi * 8; float* gp = GATE + m * 128 + h * 16 + hi * 8;
        *(u32x4*)ep = (u32x4){(unsigned)eo[0], (unsigned)eo[1], (unsigned)eo[2], (unsigned)eo[3]}; *(u32x4*)(ep + 4) = (u32x4){(unsigned)eo[4], (unsigned)eo[5], (unsigned)eo[6], (unsigned)eo[7]};
        *(f32x4*)gp = (f32x4){go[0], go[1], go[2], go[3]}; *(f32x4*)(gp + 4) = (f32x4){go[4], go[5], go[6], go[7]};
    }
}
}
namespace hy {
typedef float f32x2 __attribute__((ext_vector_type(2)));
__device__ __forceinline__ void ph_cvt_fp4(const Ctx& C, const float* src, unsigned char* dst, float* scale, int nrows) {
    const int lane = C.lane;
    const int stride = C.nblk * 32;
    int row0 = (C.bid * 8 + C.wave) * 4;
    f32x4 v[4][4], w[4][4];
    if (row0 < nrows) {
#pragma unroll
        for (int rr = 0; rr < 4; ++rr)
#pragma unroll
            for (int j = 0; j < 4; ++j) v[rr][j] = __builtin_nontemporal_load((const f32x4*)(src + (size_t)(row0 + rr) * 1024 + j * 256 + lane * 4));
    }
    for (; row0 < nrows; row0 += stride) {
        const int nxt = row0 + stride;
        if (nxt < nrows) {
#pragma unroll
            for (int rr = 0; rr < 4; ++rr)
#pragma unroll
                for (int j = 0; j < 4; ++j) w[rr][j] = __builtin_nontemporal_load((const f32x4*)(src + (size_t)(nxt + rr) * 1024 + j * 256 + lane * 4));
        }
#pragma unroll
        for (int rr = 0; rr < 4; ++rr) {
            float am = 0.f;
#pragma unroll
            for (int j = 0; j < 4; ++j) am = fmaxf(am, fmaxf(fmaxf(fabsf(v[rr][j][0]), fabsf(v[rr][j][1])), fmaxf(fabsf(v[rr][j][2]), fabsf(v[rr][j][3]))));
#pragma unroll
            for (int o = 1; o < 64; o <<= 1) am = fmaxf(am, __shfl_xor(am, o));
            const float sc = am > 0.f ? am * (1.f / 6.f) : 1.f, inv = am > 0.f ? 6.f / am : 1.f;
            if (lane == 0) scale[row0 + rr] = sc;
#pragma unroll
            for (int j = 0; j < 4; ++j) {
                unsigned q = 0u;
                q = __builtin_amdgcn_cvt_scalef32_pk_fp4_f32(q, v[rr][j][0] * inv, v[rr][j][1] * inv, 1.0f, 0);
                q = __builtin_amdgcn_cvt_scalef32_pk_fp4_f32(q, v[rr][j][2] * inv, v[rr][j][3] * inv, 1.0f, 1);
                *(unsigned short*)(dst + (size_t)(row0 + rr) * 512 + j * 128 + lane * 2) = (unsigned short)q;
            }
        }
#pragma unroll
        for (int rr = 0; rr < 4; ++rr)
#pragma unroll
            for (int j = 0; j < 4; ++j) v[rr][j] = w[rr][j];
    }
}
__device__ __forceinline__ float dot16_fp4(const float (&h)[16], const u32x2 r) {
    float s = 0.f;
#pragma unroll
    for (int w = 0; w < 2; ++w) {
        const f32x2 a = __builtin_amdgcn_cvt_scalef32_pk_f32_fp4(r[w], 1.0f, 0), b = __builtin_amdgcn_cvt_scalef32_pk_f32_fp4(r[w], 1.0f, 1),
                    c = __builtin_amdgcn_cvt_scalef32_pk_f32_fp4(r[w], 1.0f, 2), d = __builtin_amdgcn_cvt_scalef32_pk_f32_fp4(r[w], 1.0f, 3);
        s += h[8 * w] * a[0] + h[8 * w + 1] * a[1] + h[8 * w + 2] * b[0] + h[8 * w + 3] * b[1] + h[8 * w + 4] * c[0] + h[8 * w + 5] * c[1] + h[8 * w + 6] * d[0] + h[8 * w + 7] * d[1];
    }
    return s;
}
__device__ __forceinline__ void axpy16_fp4(f32x2 (&acc2)[8], const float cf, const u32x2 r) {
    const f32x2 c2 = {cf, cf};
#pragma unroll
    for (int w = 0; w < 2; ++w) {
        acc2[4 * w] = __builtin_elementwise_fma(c2, __builtin_amdgcn_cvt_scalef32_pk_f32_fp4(r[w], 1.0f, 0), acc2[4 * w]);
        acc2[4 * w + 1] = __builtin_elementwise_fma(c2, __builtin_amdgcn_cvt_scalef32_pk_f32_fp4(r[w], 1.0f, 1), acc2[4 * w + 1]);
        acc2[4 * w + 2] = __builtin_elementwise_fma(c2, __builtin_amdgcn_cvt_scalef32_pk_f32_fp4(r[w], 1.0f, 2), acc2[4 * w + 2]);
        acc2[4 * w + 3] = __builtin_elementwise_fma(c2, __builtin_amdgcn_cvt_scalef32_pk_f32_fp4(r[w], 1.0f, 3), acc2[4 * w + 3]);
    }
}
__device__ __forceinline__ float dot32_fp4(const f32x2 (&h2)[16], const u32x4 r) {
    f32x2 s2 = {0.f, 0.f};
#pragma unroll
    for (int w = 0; w < 4; ++w) {
        s2 = __builtin_elementwise_fma(h2[4 * w], __builtin_amdgcn_cvt_scalef32_pk_f32_fp4(r[w], 1.0f, 0), s2);
        s2 = __builtin_elementwise_fma(h2[4 * w + 1], __builtin_amdgcn_cvt_scalef32_pk_f32_fp4(r[w], 1.0f, 1), s2);
        s2 = __builtin_elementwise_fma(h2[4 * w + 2], __builtin_amdgcn_cvt_scalef32_pk_f32_fp4(r[w], 1.0f, 2), s2);
        s2 = __builtin_elementwise_fma(h2[4 * w + 3], __builtin_amdgcn_cvt_scalef32_pk_f32_fp4(r[w], 1.0f, 3), s2);
    }
    return s2[0] + s2[1];
}
__device__ __forceinline__ void axpy32_fp4(float (&acc)[32], const float cf, const u32x4 r) {
#pragma unroll
    for (int w = 0; w < 4; ++w) {
        const f32x2 a = __builtin_amdgcn_cvt_scalef32_pk_f32_fp4(r[w], 1.0f, 0), b = __builtin_amdgcn_cvt_scalef32_pk_f32_fp4(r[w], 1.0f, 1),
                    c = __builtin_amdgcn_cvt_scalef32_pk_f32_fp4(r[w], 1.0f, 2), d = __builtin_amdgcn_cvt_scalef32_pk_f32_fp4(r[w], 1.0f, 3);
        acc[8 * w] += cf * a[0]; acc[8 * w + 1] += cf * a[1]; acc[8 * w + 2] += cf * b[0]; acc[8 * w + 3] += cf * b[1];
        acc[8 * w + 4] += cf * c[0]; acc[8 * w + 5] += cf * c[1]; acc[8 * w + 6] += cf * d[0]; acc[8 * w + 7] += cf * d[1];
    }
}
struct GatherP { bf16_t* H; const int* EIDX; const float* GATE; const unsigned char* U8; const float* SU; const unsigned char* V8; const float* SV; const float* g2; const bf16_t* xinb; float* xout; bf16_t* xoutb;
                 const float* SSX; const float* sh2;
                 const float* ngain; const float* nmod; int var; };
__device__ __forceinline__ void ph_peer_gather2(const Ctx& C, const GatherP& P) {
    HY_LAS float* coefL = (HY_LAS float*)((HY_LAS unsigned char*)C.lds) + C.wave * 128;
    const size_t mstep = (size_t)C.nblk * 8;
    size_t m = (size_t)C.bid * 8 + C.wave;
    int nidx0 = 0, nidx1 = 0, pidx0 = 0, pidx1 = 0; float nsu0 = 0.f, nsu1 = 0.f, ngv0 = 0.f, ngv1 = 0.f;
    if (m < M) {
        const int l0 = C.lane;
        nidx0 = P.EIDX[m * 128 + l0]; nidx1 = P.EIDX[m * 128 + 64 + l0];
        nsu0 = P.SU[nidx0]; nsu1 = P.SU[nidx1];
        ngv0 = P.GATE[m * 128 + l0] * P.SV[nidx0]; ngv1 = P.GATE[m * 128 + 64 + l0] * P.SV[nidx1];
        if (m + mstep < M) { pidx0 = P.EIDX[(m + mstep) * 128 + l0]; pidx1 = P.EIDX[(m + mstep) * 128 + 64 + l0]; }
    }
    for (; m < M; m += mstep) {
        unsigned ones_ = ~0u; asm volatile("" : "+s"(ones_));
        const int lane = (int)__builtin_amdgcn_mbcnt_hi(ones_, __builtin_amdgcn_mbcnt_lo(ones_, 0u));
        const int l31 = lane & 31, hh = lane >> 5;
        const int b4 = (lane >> 4) & 1, b3 = (lane >> 3) & 1, b2 = (lane >> 2) & 1, b1 = (lane >> 1) & 1;
        const int ie = 8 * b4 + 4 * b3 + 2 * b2 + b1;
        const int b = (int)(m >> 13);
        const int idx0 = nidx0, idx1 = nidx1; const float su0 = nsu0, su1 = nsu1, gv0 = ngv0, gv1 = ngv1;
        if (m + mstep < M) {
            const size_t mn = m + mstep;
            nidx0 = pidx0; nidx1 = pidx1;
            nsu0 = P.SU[nidx0]; nsu1 = P.SU[nidx1];
            ngv0 = P.GATE[mn * 128 + lane] * P.SV[nidx0]; ngv1 = P.GATE[mn * 128 + 64 + lane] * P.SV[nidx1];
            if (mn + mstep < M) { pidx0 = P.EIDX[(mn + mstep) * 128 + lane]; pidx1 = P.EIDX[(mn + mstep) * 128 + 64 + lane]; }
        }
        {
            f32x2 h[16];
            {
                const bf16_t* hp = P.H + m * D + l31 * 32;
                const f32x4 s0 = *(const f32x4*)(P.SSX + m * 16), s1 = *(const f32x4*)(P.SSX + m * 16 + 4), s2 = *(const f32x4*)(P.SSX + m * 16 + 8), s3 = *(const f32x4*)(P.SSX + m * 16 + 12);
                const float tot = (((s0[0] + s0[1]) + (s0[2] + s0[3])) + ((s1[0] + s1[1]) + (s1[2] + s1[3]))) + (((s2[0] + s2[1]) + (s2[2] + s2[3])) + ((s3[0] + s3[1]) + (s3[2] + s3[3])));
                const float r = rsqrtf(tot * (1.f / D) + EPS);
                const float* sh = P.sh2 + b * MODW + l31 * 32;
#pragma unroll
                for (int q = 0; q < 4; ++q) {
                    const u32x4 a = *(const u32x4*)(hp + q * 8); const f32x4 sa = *(const f32x4*)(sh + q * 8), sb = *(const f32x4*)(sh + q * 8 + 4);
                    h[q * 4] = (f32x2){lo16(a.x) * r + sa[0], hi16(a.x) * r + sa[1]}; h[q * 4 + 1] = (f32x2){lo16(a.y) * r + sa[2], hi16(a.y) * r + sa[3]};
                    h[q * 4 + 2] = (f32x2){lo16(a.z) * r + sb[0], hi16(a.z) * r + sb[1]}; h[q * 4 + 3] = (f32x2){lo16(a.w) * r + sb[2], hi16(a.w) * r + sb[3]};
                }
            }
#pragma unroll 1
            for (int bt = 0; bt < (P.var == 1 ? 0 : 4); ++bt) {
                const int idxv = bt < 2 ? idx0 : idx1;
                u32x4 rows[16];
#pragma unroll
                for (int i = 0; i < 16; ++i) {
                    const int e = __builtin_amdgcn_ds_bpermute(((bt & 1) * 32 + 2 * i + hh) * 4, idxv);
                    rows[i] = *(const u32x4*)(P.U8 + (unsigned)(e * 512 + l31 * 16));
                }
                float p[16];
#pragma unroll
                for (int i = 0; i < 16; ++i) { asm volatile("" : "+v"(rows[i]));
                    p[i] = dot32_fp4(h, rows[i]); }
                float q8[8], q4[4], q2[2];
#pragma unroll
                for (int i = 0; i < 8; ++i) { const float snd = b4 ? p[i] : p[i + 8], kp = b4 ? p[i + 8] : p[i]; q8[i] = kp + __shfl_xor(snd, 16); }
#pragma unroll
                for (int i = 0; i < 4; ++i) { const float snd = b3 ? q8[i] : q8[i + 4], kp = b3 ? q8[i + 4] : q8[i]; q4[i] = kp + __shfl_xor(snd, 8); }
#pragma unroll
                for (int i = 0; i < 2; ++i) { const float snd = b2 ? q4[i] : q4[i + 2], kp = b2 ? q4[i + 2] : q4[i]; q2[i] = kp + __shfl_xor(snd, 4); }
                float tot; { const float snd = b1 ? q2[0] : q2[1], kp = b1 ? q2[1] : q2[0]; tot = kp + __shfl_xor(snd, 2); }
                tot += __shfl_xor(tot, 1);
                const int kk = (bt & 1) * 32 + 2 * ie + hh;
                const float suk = __int_as_float(__builtin_amdgcn_ds_bpermute(kk * 4, __float_as_int(bt < 2 ? su0 : su1)));
                const float gvk = __int_as_float(__builtin_amdgcn_ds_bpermute(kk * 4, __float_as_int(bt < 2 ? gv0 : gv1)));
                const float cf = gvk * gelu_tanh(tot * suk);
                if ((lane & 1) == 0) coefL[bt * 32 + 2 * ie + hh] = cf;
            }
        }
        f32x2 acc2[8];
#pragma unroll
        for (int i = 0; i < 8; ++i) acc2[i] = (f32x2){0.f, 0.f};
#pragma unroll 1
        for (int bt = 0; bt < (P.var == 2 ? 0 : 4); ++bt) {
            const int idxv = bt < 2 ? idx0 : idx1;
            u32x2 rows[32];
#pragma unroll
            for (int i = 0; i < 32; ++i) {
                const int e = __builtin_amdgcn_ds_bpermute(((bt & 1) * 32 + i) * 4, idxv);
                rows[i] = *(const u32x2*)(P.V8 + (unsigned)(e * 512 + lane * 8));
            }
#pragma unroll
            for (int i = 0; i < 32; ++i) { asm volatile("" : "+v"(rows[i])); axpy16_fp4(acc2, coefL[bt * 32 + i], rows[i]); }
        }
        float acc[16];
#pragma unroll
        for (int i = 0; i < 8; ++i) { acc[2 * i] = acc2[i][0]; acc[2 * i + 1] = acc2[i][1]; }
        int le = lane; asm volatile("" : "+v"(le));
        const float* g = P.g2 + b * MODW + le * 16;
        float ss = 0.f;
        {
            const u32x4 xa = *(const u32x4*)(P.xinb + m * D + le * 16), xb = *(const u32x4*)(P.xinb + m * D + le * 16 + 8);
            const float xi[16] = {lo16(xa.x), hi16(xa.x), lo16(xa.y), hi16(xa.y), lo16(xa.z), hi16(xa.z), lo16(xa.w), hi16(xa.w), lo16(xb.x), hi16(xb.x), lo16(xb.y), hi16(xb.y), lo16(xb.z), hi16(xb.z), lo16(xb.w), hi16(xb.w)};
#pragma unroll
            for (int q4i = 0; q4i < 4; ++q4i) {
                const f32x4 gg = *(const f32x4*)(g + q4i * 4);
#pragma unroll
                for (int e = 0; e < 4; ++e) { const float o = xi[q4i * 4 + e] + gg[e] * acc[q4i * 4 + e]; acc[q4i * 4 + e] = o; ss += o * o; }
            }
            if (P.xoutb) {
                *(u32x4*)(P.xoutb + m * D + le * 16) = (u32x4){pk2(acc[0], acc[1]), pk2(acc[2], acc[3]), pk2(acc[4], acc[5]), pk2(acc[6], acc[7])};
                *(u32x4*)(P.xoutb + m * D + le * 16 + 8) = (u32x4){pk2(acc[8], acc[9]), pk2(acc[10], acc[11]), pk2(acc[12], acc[13]), pk2(acc[14], acc[15])};
            } else {
#pragma unroll
                for (int q4i = 0; q4i < 4; ++q4i) *(f32x4*)(P.xout + m * D + le * 16 + q4i * 4) = (f32x4){acc[q4i * 4], acc[q4i * 4 + 1], acc[q4i * 4 + 2], acc[q4i * 4 + 3]};
            }
        }
        if (P.ngain) {
            const float r1 = rsqrtf(wave_sum(ss) * (1.f / D) + EPS);
            const float* gn = P.ngain + le * 16; const float* shn = P.nmod + b * MODW + le * 16; const float* scn = P.nmod + b * MODW + D + le * 16;
            unsigned w[8];
#pragma unroll
            for (int q4i = 0; q4i < 4; ++q4i) {
                const f32x4 g4 = *(const f32x4*)(gn + q4i * 4), s4 = *(const f32x4*)(scn + q4i * 4), h4 = *(const f32x4*)(shn + q4i * 4);
                float o[4];
#pragma unroll
                for (int e = 0; e < 4; ++e) o[e] = acc[q4i * 4 + e] * r1 * g4[e] * (1.f + s4[e]) + h4[e];
                w[q4i * 2] = pk2(o[0], o[1]); w[q4i * 2 + 1] = pk2(o[2], o[3]);
            }
            *(u32x4*)(P.H + m * D + le * 16) = (u32x4){w[0], w[1], w[2], w[3]}; *(u32x4*)(P.H + m * D + le * 16 + 8) = (u32x4){w[4], w[5], w[6], w[7]};
        }
    }
}
__device__ __forceinline__ void ph_peer_gather4(const Ctx& C, const GatherP& P) {
    HY_LAS float* coefL = (HY_LAS float*)((HY_LAS unsigned char*)C.lds) + C.wave * 128;
    const size_t mstep = (size_t)C.nblk * 8;
    size_t m = (size_t)C.bid * 8 + C.wave;
    int nidx0 = 0, nidx1 = 0, pidx0 = 0, pidx1 = 0; float nsu0 = 0.f, nsu1 = 0.f, ngv0 = 0.f, ngv1 = 0.f;
    if (m < M) {
        const int l0 = C.lane;
        nidx0 = P.EIDX[m * 128 + l0]; nidx1 = P.EIDX[m * 128 + 64 + l0];
        nsu0 = P.SU[nidx0]; nsu1 = P.SU[nidx1];
        ngv0 = P.GATE[m * 128 + l0] * P.SV[nidx0]; ngv1 = P.GATE[m * 128 + 64 + l0] * P.SV[nidx1];
        if (m + mstep < M) { pidx0 = P.EIDX[(m + mstep) * 128 + l0]; pidx1 = P.EIDX[(m + mstep) * 128 + 64 + l0]; }
    }
    u32x4 hpre[4]; f32x4 spre[4];
    if (m < M) {
        const bf16_t* hp0 = P.H + m * D + (C.lane & 31) * 32;
#pragma unroll
        for (int q = 0; q < 4; ++q) { hpre[q] = *(const u32x4*)(hp0 + q * 8); spre[q] = *(const f32x4*)(P.SSX + m * 16 + q * 4); }
    }
    for (; m < M; m += mstep) {
        unsigned ones_ = ~0u; asm volatile("" : "+s"(ones_));
        const int lane = (int)__builtin_amdgcn_mbcnt_hi(ones_, __builtin_amdgcn_mbcnt_lo(ones_, 0u));
        const int l31 = lane & 31, hh = lane >> 5;
        const int b4 = (lane >> 4) & 1, b3 = (lane >> 3) & 1, b2 = (lane >> 2) & 1, b1 = (lane >> 1) & 1;
        const int ie = 8 * b4 + 4 * b3 + 2 * b2 + b1;
        const int b = (int)(m >> 13);
        const int idx0 = nidx0, idx1 = nidx1; const float su0 = nsu0, su1 = nsu1, gv0 = ngv0, gv1 = ngv1;
        if (m + mstep < M) {
            const size_t mn = m + mstep;
            nidx0 = pidx0; nidx1 = pidx1;
            nsu0 = P.SU[nidx0]; nsu1 = P.SU[nidx1];
            ngv0 = P.GATE[mn * 128 + lane] * P.SV[nidx0]; ngv1 = P.GATE[mn * 128 + 64 + lane] * P.SV[nidx1];
            if (mn + mstep < M) { pidx0 = P.EIDX[(mn + mstep) * 128 + lane]; pidx1 = P.EIDX[(mn + mstep) * 128 + 64 + lane]; }
        }
        {
            f32x2 h[16];
            {
                const f32x4 s0 = spre[0], s1 = spre[1], s2 = spre[2], s3 = spre[3];
                const float tot = (((s0[0] + s0[1]) + (s0[2] + s0[3])) + ((s1[0] + s1[1]) + (s1[2] + s1[3]))) + (((s2[0] + s2[1]) + (s2[2] + s2[3])) + ((s3[0] + s3[1]) + (s3[2] + s3[3])));
                const float r = rsqrtf(tot * (1.f / D) + EPS);
                const float* sh = P.sh2 + b * MODW + l31 * 32;
#pragma unroll
                for (int q = 0; q < 4; ++q) {
                    const u32x4 a = hpre[q]; const f32x4 sa = *(const f32x4*)(sh + q * 8), sb = *(const f32x4*)(sh + q * 8 + 4);
                    h[q * 4] = (f32x2){lo16(a.x) * r + sa[0], hi16(a.x) * r + sa[1]}; h[q * 4 + 1] = (f32x2){lo16(a.y) * r + sa[2], hi16(a.y) * r + sa[3]};
                    h[q * 4 + 2] = (f32x2){lo16(a.z) * r + sb[0], hi16(a.z) * r + sb[1]}; h[q * 4 + 3] = (f32x2){lo16(a.w) * r + sb[2], hi16(a.w) * r + sb[3]};
                }
            }
#pragma unroll 1
            for (int bt = 0; bt < (P.var == 1 ? 0 : 4); ++bt) {
                const int idxv = bt < 2 ? idx0 : idx1;
                u32x4 rows[16];
#pragma unroll
                for (int i = 0; i < 16; ++i) {
                    const int e0 = __builtin_amdgcn_readlane(idxv, (bt & 1) * 32 + 2 * i), e1 = __builtin_amdgcn_readlane(idxv, (bt & 1) * 32 + 2 * i + 1);
                    const int e = hh ? e1 : e0;
                    rows[i] = *(const u32x4*)(P.U8 + (unsigned)(e * 512 + l31 * 16));
                }
                float p[16];
#pragma unroll
                for (int i = 0; i < 16; ++i) { asm volatile("" : "+v"(rows[i]));
                    p[i] = dot32_fp4(h, rows[i]); }
                float q8[8], q4[4], q2[2];
#pragma unroll
                for (int i = 0; i < 8; ++i) { const float snd = b4 ? p[i] : p[i + 8], kp = b4 ? p[i + 8] : p[i]; q8[i] = kp + __shfl_xor(snd, 16); }
#pragma unroll
                for (int i = 0; i < 4; ++i) { const float snd = b3 ? q8[i] : q8[i + 4], kp = b3 ? q8[i + 4] : q8[i]; q4[i] = kp + __shfl_xor(snd, 8); }
#pragma unroll
                for (int i = 0; i < 2; ++i) { const float snd = b2 ? q4[i] : q4[i + 2], kp = b2 ? q4[i + 2] : q4[i]; q2[i] = kp + __shfl_xor(snd, 4); }
                float tot; { const float snd = b1 ? q2[0] : q2[1], kp = b1 ? q2[1] : q2[0]; tot = kp + __shfl_xor(snd, 2); }
                tot += __shfl_xor(tot, 1);
                const int kk = (bt & 1) * 32 + 2 * ie + hh;
                const float suk = __int_as_float(__builtin_amdgcn_ds_bpermute(kk * 4, __float_as_int(bt < 2 ? su0 : su1)));
                const float gvk = __int_as_float(__builtin_amdgcn_ds_bpermute(kk * 4, __float_as_int(bt < 2 ? gv0 : gv1)));
                const float cf = gvk * gelu_tanh(tot * suk);
                if ((lane & 1) == 0) coefL[bt * 32 + 2 * ie + hh] = cf;
            }
        }
        f32x2 acc2[8];
#pragma unroll
        for (int i = 0; i < 8; ++i) acc2[i] = (f32x2){0.f, 0.f};
        int le = lane; asm volatile("" : "+v"(le));
        const u32x4 xa = *(const u32x4*)(P.xinb + m * D + le * 16), xb = *(const u32x4*)(P.xinb + m * D + le * 16 + 8);
        if (m + mstep < M) {
            const bf16_t* hpn = P.H + (m + mstep) * D + l31 * 32;
#pragma unroll
            for (int q = 0; q < 4; ++q) { hpre[q] = *(const u32x4*)(hpn + q * 8); spre[q] = *(const f32x4*)(P.SSX + (m + mstep) * 16 + q * 4); }
        }
        const float cfa = coefL[lane], cfb = coefL[64 + lane];
        {
            u32x2 ra[32], rb[32];
#define HY_VLOAD(R, bt_) do { const int idxv_ = (bt_) < 2 ? idx0 : idx1; _Pragma("unroll") for (int i = 0; i < 32; ++i) { const int e = __builtin_amdgcn_readlane(idxv_, ((bt_) & 1) * 32 + i); \
                R[i] = *(const u32x2*)(P.V8 + (unsigned)(e * 512 + lane * 8)); } } while (0)
#define HY_VCOMP(R, bt_) do { const int cfv_ = __float_as_int((bt_) < 2 ? cfa : cfb); _Pragma("unroll") for (int i = 0; i < 32; ++i) { asm volatile("" : "+v"(R[i])); \
                axpy16_fp4(acc2, __int_as_float(__builtin_amdgcn_readlane(cfv_, ((bt_) & 1) * 32 + i)), R[i]); } } while (0)
            HY_VLOAD(ra, 0); HY_VLOAD(rb, 1);
            HY_VCOMP(ra, 0); HY_VLOAD(ra, 2);
            HY_VCOMP(rb, 1); HY_VLOAD(rb, 3);
            HY_VCOMP(ra, 2); HY_VCOMP(rb, 3);
#undef HY_VLOAD
#undef HY_VCOMP
        }
        float acc[16];
#pragma unroll
        for (int i = 0; i < 8; ++i) { acc[2 * i] = acc2[i][0]; acc[2 * i + 1] = acc2[i][1]; }
        const float* g = P.g2 + b * MODW + le * 16;
        float ss = 0.f;
        {
            const float xi[16] = {lo16(xa.x), hi16(xa.x), lo16(xa.y), hi16(xa.y), lo16(xa.z), hi16(xa.z), lo16(xa.w), hi16(xa.w), lo16(xb.x), hi16(xb.x), lo16(xb.y), hi16(xb.y), lo16(xb.z), hi16(xb.z), lo16(xb.w), hi16(xb.w)};
#pragma unroll
            for (int q4i = 0; q4i < 4; ++q4i) {
                const f32x4 gg = *(const f32x4*)(g + q4i * 4);
#pragma unroll
                for (int e = 0; e < 4; ++e) { const float o = xi[q4i * 4 + e] + gg[e] * acc[q4i * 4 + e]; acc[q4i * 4 + e] = o; ss += o * o; }
            }
            if (P.xoutb) {
                *(u32x4*)(P.xoutb + m * D + le * 16) = (u32x4){pk2(acc[0], acc[1]), pk2(acc[2], acc[3]), pk2(acc[4], acc[5]), pk2(acc[6], acc[7])};
                *(u32x4*)(P.xoutb + m * D + le * 16 + 8) = (u32x4){pk2(acc[8], acc[9]), pk2(acc[10], acc[11]), pk2(acc[12], acc[13]), pk2(acc[14], acc[15])};
            } else {
#pragma unroll
                for (int q4i = 0; q4i < 4; ++q4i) *(f32x4*)(P.xout + m * D + le * 16 + q4i * 4) = (f32x4){acc[q4i * 4], acc[q4i * 4 + 1], acc[q4i * 4 + 2], acc[q4i * 4 + 3]};
            }
        }
        if (P.ngain) {
            const float r1 = rsqrtf(wave_sum(ss) * (1.f / D) + EPS);
            const float* gn = P.ngain + le * 16; const float* shn = P.nmod + b * MODW + le * 16; const float* scn = P.nmod + b * MODW + D + le * 16;
            unsigned w[8];
#pragma unroll
            for (int q4i = 0; q4i < 4; ++q4i) {
                const f32x4 g4 = *(const f32x4*)(gn + q4i * 4), s4 = *(const f32x4*)(scn + q4i * 4), h4 = *(const f32x4*)(shn + q4i * 4);
                float o[4];
#pragma unroll
                for (int e = 0; e < 4; ++e) o[e] = acc[q4i * 4 + e] * r1 * g4[e] * (1.f + s4[e]) + h4[e];
                w[q4i * 2] = pk2(o[0], o[1]); w[q4i * 2 + 1] = pk2(o[2], o[3]);
            }
            *(u32x4*)(P.H + m * D + le * 16) = (u32x4){w[0], w[1], w[2], w[3]}; *(u32x4*)(P.H + m * D + le * 16 + 8) = (u32x4){w[4], w[5], w[6], w[7]};
        }
    }
}
typedef int v8i_t __attribute__((ext_vector_type(8)));
__device__ __forceinline__ void ph_peer_gather5(const Ctx& C, const GatherP& P) {
    HY_LAS unsigned char* hL = (HY_LAS unsigned char*)C.lds + 8192 + C.wave * 12288;
    HY_LAS unsigned char* scL = hL + 1024;
    HY_LAS float* dotL = (HY_LAS float*)(hL + 2048);
    HY_LAS unsigned char* tL = hL + 3072;
    const size_t mstep = (size_t)C.nblk * 8;
    size_t m = (size_t)C.bid * 8 + C.wave;
    int nidx0 = 0, nidx1 = 0, pidx0 = 0, pidx1 = 0; float nsu0 = 0.f, nsu1 = 0.f, ngv0 = 0.f, ngv1 = 0.f;
    if (m < M) {
        const int l0 = C.lane;
        nidx0 = P.EIDX[m * 128 + l0]; nidx1 = P.EIDX[m * 128 + 64 + l0];
        nsu0 = P.SU[nidx0]; nsu1 = P.SU[nidx1];
        ngv0 = P.GATE[m * 128 + l0] * P.SV[nidx0]; ngv1 = P.GATE[m * 128 + 64 + l0] * P.SV[nidx1];
        if (m + mstep < M) { pidx0 = P.EIDX[(m + mstep) * 128 + l0]; pidx1 = P.EIDX[(m + mstep) * 128 + 64 + l0]; }
    }
    u32x4 hpre[4]; f32x4 spre[4];
    if (m < M) {
        const bf16_t* hp0 = P.H + m * D + (C.lane & 31) * 32;
#pragma unroll
        for (int q = 0; q < 4; ++q) { hpre[q] = *(const u32x4*)(hp0 + q * 8); spre[q] = *(const f32x4*)(P.SSX + m * 16 + q * 4); }
    }
    for (; m < M; m += mstep) {
        unsigned ones_ = ~0u; asm volatile("" : "+s"(ones_));
        const int lane = (int)__builtin_amdgcn_mbcnt_hi(ones_, __builtin_amdgcn_mbcnt_lo(ones_, 0u));
        const int l31 = lane & 31, hh = lane >> 5;
        const int b4 = (lane >> 4) & 1, b3 = (lane >> 3) & 1, b2 = (lane >> 2) & 1, b1 = (lane >> 1) & 1;
        const int ie = 8 * b4 + 4 * b3 + 2 * b2 + b1;
        const int b = (int)(m >> 13);
        const int idx0 = nidx0, idx1 = nidx1; const float su0 = nsu0, su1 = nsu1, gv0 = ngv0, gv1 = ngv1;
        if (m + mstep < M) {
            const size_t mn = m + mstep;
            nidx0 = pidx0; nidx1 = pidx1;
            nsu0 = P.SU[nidx0]; nsu1 = P.SU[nidx1];
            ngv0 = P.GATE[mn * 128 + lane] * P.SV[nidx0]; ngv1 = P.GATE[mn * 128 + 64 + lane] * P.SV[nidx1];
            if (mn + mstep < M) { pidx0 = P.EIDX[(mn + mstep) * 128 + lane]; pidx1 = P.EIDX[(mn + mstep) * 128 + 64 + lane]; }
        }
        {
            f32x2 h[16];
            {
                const f32x4 s0 = spre[0], s1 = spre[1], s2 = spre[2], s3 = spre[3];
                const float tot = (((s0[0] + s0[1]) + (s0[2] + s0[3])) + ((s1[0] + s1[1]) + (s1[2] + s1[3]))) + (((s2[0] + s2[1]) + (s2[2] + s2[3])) + ((s3[0] + s3[1]) + (s3[2] + s3[3])));
                const float r = rsqrtf(tot * (1.f / D) + EPS);
                const float* sh = P.sh2 + b * MODW + l31 * 32;
#pragma unroll
                for (int q = 0; q < 4; ++q) {
                    const u32x4 a = hpre[q]; const f32x4 sa = *(const f32x4*)(sh + q * 8), sb = *(const f32x4*)(sh + q * 8 + 4);
                    h[q * 4] = (f32x2){lo16(a.x) * r + sa[0], hi16(a.x) * r + sa[1]}; h[q * 4 + 1] = (f32x2){lo16(a.y) * r + sa[2], hi16(a.y) * r + sa[3]};
                    h[q * 4 + 2] = (f32x2){lo16(a.z) * r + sb[0], hi16(a.z) * r + sb[1]}; h[q * 4 + 3] = (f32x2){lo16(a.w) * r + sb[2], hi16(a.w) * r + sb[3]};
                }
            }
            {
                float hv[32];
#pragma unroll
                for (int i = 0; i < 16; ++i) { hv[2 * i] = h[i][0]; hv[2 * i + 1] = h[i][1]; }
                unsigned q1[4], q2[4]; int e1, e2;
                {
                    float mx = 0.f;
#pragma unroll
                    for (int i = 0; i < 32; ++i) mx = fmaxf(mx, fabsf(hv[i]));
                    const int bb = __float_as_int(mx * (1.f / 6.f)); int e = ((bb >> 23) & 255) - 127 + ((bb & 0x7fffff) ? 1 : 0); e = e < -100 ? -100 : (e > 100 ? 100 : e); e1 = e;
                    const float inv = __int_as_float((127 - e) << 23), sc = __int_as_float((127 + e) << 23);
#pragma unroll
                    for (int j = 0; j < 4; ++j) { unsigned q = 0u;
                        q = __builtin_amdgcn_cvt_scalef32_pk_fp4_f32(q, hv[8 * j] * inv, hv[8 * j + 1] * inv, 1.0f, 0); q = __builtin_amdgcn_cvt_scalef32_pk_fp4_f32(q, hv[8 * j + 2] * inv, hv[8 * j + 3] * inv, 1.0f, 1);
                        q = __builtin_amdgcn_cvt_scalef32_pk_fp4_f32(q, hv[8 * j + 4] * inv, hv[8 * j + 5] * inv, 1.0f, 2); q = __builtin_amdgcn_cvt_scalef32_pk_fp4_f32(q, hv[8 * j + 6] * inv, hv[8 * j + 7] * inv, 1.0f, 3);
                        q1[j] = q;
#pragma unroll
                        for (int pp = 0; pp < 4; ++pp) { f32x2 d;
                            if (pp == 0) d = __builtin_amdgcn_cvt_scalef32_pk_f32_fp4(q, 1.0f, 0); else if (pp == 1) d = __builtin_amdgcn_cvt_scalef32_pk_f32_fp4(q, 1.0f, 1);
                            else if (pp == 2) d = __builtin_amdgcn_cvt_scalef32_pk_f32_fp4(q, 1.0f, 2); else d = __builtin_amdgcn_cvt_scalef32_pk_f32_fp4(q, 1.0f, 3);
                            hv[8 * j + 2 * pp] -= d[0] * sc; hv[8 * j + 2 * pp + 1] -= d[1] * sc; }
                    }
                }
                {
                    float mx = 0.f;
#pragma unroll
                    for (int i = 0; i < 32; ++i) mx = fmaxf(mx, fabsf(hv[i]));
                    const int bb = __float_as_int(mx * (1.f / 6.f)); int e = ((bb >> 23) & 255) - 127 + ((bb & 0x7fffff) ? 1 : 0); e = e < -100 ? -100 : (e > 100 ? 100 : e); e2 = e;
                    const float inv = __int_as_float((127 - e) << 23);
#pragma unroll
                    for (int j = 0; j < 4; ++j) { unsigned q = 0u;
                        q = __builtin_amdgcn_cvt_scalef32_pk_fp4_f32(q, hv[8 * j] * inv, hv[8 * j + 1] * inv, 1.0f, 0); q = __builtin_amdgcn_cvt_scalef32_pk_fp4_f32(q, hv[8 * j + 2] * inv, hv[8 * j + 3] * inv, 1.0f, 1);
                        q = __builtin_amdgcn_cvt_scalef32_pk_fp4_f32(q, hv[8 * j + 4] * inv, hv[8 * j + 5] * inv, 1.0f, 2); q = __builtin_amdgcn_cvt_scalef32_pk_fp4_f32(q, hv[8 * j + 6] * inv, hv[8 * j + 7] * inv, 1.0f, 3);
                        q2[j] = q; }
                }
                if (hh == 0) {
                    *(HY_LAS u32x4*)(hL + l31 * 16) = (u32x4){q1[0], q1[1], q1[2], q1[3]}; *(HY_LAS u32x4*)(hL + 512 + l31 * 16) = (u32x4){q2[0], q2[1], q2[2], q2[3]};
                    scL[(l31 & 3) * 8 + (l31 >> 2)] = (unsigned char)(127 + e1); scL[32 + (l31 & 3) * 8 + (l31 >> 2)] = (unsigned char)(127 + e2);
                }
            }
            {
                const int li = lane & 15, kb = lane >> 4;
                const HY_LAS unsigned char* bp = hL + (li == 1 ? 512 : 0) + kb * 16;
                u32x4 Bv[8];
#pragma unroll
                for (int sl = 0; sl < 8; ++sl) Bv[sl] = *(const HY_LAS u32x4*)(bp + sl * 64);
                const u32x2 scb = *(const HY_LAS u32x2*)(scL + (li == 1 ? 32 : 0) + kb * 8);
#pragma unroll 1
                for (int gb = 0; gb < 2; ++gb) {
                    const int idxv = gb ? idx1 : idx0;
                    u32x4 rows[32];
#pragma unroll
                    for (int i = 0; i < 32; ++i) {
                        const int e0 = __builtin_amdgcn_readlane(idxv, 2 * i), e1 = __builtin_amdgcn_readlane(idxv, 2 * i + 1);
                        const int e = hh ? e1 : e0;
                        rows[i] = *(const u32x4*)(P.U8 + (unsigned)(e * 512 + l31 * 16));
                    }
#pragma unroll
                    for (int q = 0; q < 4; ++q) {
#pragma unroll
                        for (int i = 0; i < 8; ++i) { asm volatile("" : "+v"(rows[8 * q + i])); *(HY_LAS u32x4*)(tL + l31 * 272 + (2 * i + hh) * 16) = rows[8 * q + i]; }
                        f32x4 acc = {0.f, 0.f, 0.f, 0.f};
#pragma unroll
                        for (int sl = 0; sl < 8; ++sl) {
                            const u32x4 av = *(const HY_LAS u32x4*)(tL + (4 * sl + kb) * 272 + li * 16);
                            const v8i_t A = {(int)av.x, (int)av.y, (int)av.z, (int)av.w, 0, 0, 0, 0};
                            const v8i_t B = {(int)Bv[sl].x, (int)Bv[sl].y, (int)Bv[sl].z, (int)Bv[sl].w, 0, 0, 0, 0};
                            if (sl == 0) acc = __builtin_amdgcn_mfma_scale_f32_16x16x128_f8f6f4(A, B, acc, 4, 4, 0, 127, 0, (int)scb.x);
                            else if (sl == 1) acc = __builtin_amdgcn_mfma_scale_f32_16x16x128_f8f6f4(A, B, acc, 4, 4, 0, 127, 1, (int)scb.x);
                            else if (sl == 2) acc = __builtin_amdgcn_mfma_scale_f32_16x16x128_f8f6f4(A, B, acc, 4, 4, 0, 127, 2, (int)scb.x);
                            else if (sl == 3) acc = __builtin_amdgcn_mfma_scale_f32_16x16x128_f8f6f4(A, B, acc, 4, 4, 0, 127, 3, (int)scb.x);
                            else if (sl == 4) acc = __builtin_amdgcn_mfma_scale_f32_16x16x128_f8f6f4(A, B, acc, 4, 4, 0, 127, 0, (int)scb.y);
                            else if (sl == 5) acc = __builtin_amdgcn_mfma_scale_f32_16x16x128_f8f6f4(A, B, acc, 4, 4, 0, 127, 1, (int)scb.y);
                            else if (sl == 6) acc = __builtin_amdgcn_mfma_scale_f32_16x16x128_f8f6f4(A, B, acc, 4, 4, 0, 127, 2, (int)scb.y);
                            else acc = __builtin_amdgcn_mfma_scale_f32_16x16x128_f8f6f4(A, B, acc, 4, 4, 0, 127, 3, (int)scb.y);
                        }
                        if (li < 2) *(HY_LAS f32x4*)(dotL + li * 128 + gb * 64 + q * 16 + 4 * kb) = acc;
                    }
                }
            }
        }
        f32x2 acc2[8];
#pragma unroll
        for (int i = 0; i < 8; ++i) acc2[i] = (f32x2){0.f, 0.f};
        int le = lane; asm volatile("" : "+v"(le));
        const u32x4 xa = *(const u32x4*)(P.xinb + m * D + le * 16), xb = *(const u32x4*)(P.xinb + m * D + le * 16 + 8);
        if (m + mstep < M) {
            const bf16_t* hpn = P.H + (m + mstep) * D + l31 * 32;
#pragma unroll
            for (int q = 0; q < 4; ++q) { hpre[q] = *(const u32x4*)(hpn + q * 8); spre[q] = *(const f32x4*)(P.SSX + (m + mstep) * 16 + q * 4); }
        }
        const float cfa = gv0 * gelu_tanh((dotL[lane] + dotL[128 + lane]) * su0), cfb = gv1 * gelu_tanh((dotL[64 + lane] + dotL[192 + lane]) * su1);
        {
            u32x2 ra[32], rb[32];
#define HY_VLOAD(R, bt_) do { const int idxv_ = (bt_) < 2 ? idx0 : idx1; _Pragma("unroll") for (int i = 0; i < 32; ++i) { const int e = __builtin_amdgcn_readlane(idxv_, ((bt_) & 1) * 32 + i); \
                R[i] = *(const u32x2*)(P.V8 + (unsigned)(e * 512 + lane * 8)); } } while (0)
#define HY_VCOMP(R, bt_) do { const int cfv_ = __float_as_int((bt_) < 2 ? cfa : cfb); _Pragma("unroll") for (int i = 0; i < 32; ++i) { asm volatile("" : "+v"(R[i])); \
                axpy16_fp4(acc2, __int_as_float(__builtin_amdgcn_readlane(cfv_, ((bt_) & 1) * 32 + i)), R[i]); } } while (0)
            HY_VLOAD(ra, 0); HY_VLOAD(rb, 1);
            HY_VCOMP(ra, 0); HY_VLOAD(ra, 2);
            HY_VCOMP(rb, 1); HY_VLOAD(rb, 3);
            HY_VCOMP(ra, 2); HY_VCOMP(rb, 3);
#undef HY_VLOAD
#undef HY_VCOMP
        }
        float acc[16];
#pragma unroll
        for (int i = 0; i < 8; ++i) { acc[2 * i] = acc2[i][0]; acc[2 * i + 1] = acc2[i][1]; }
        const float* g = P.g2 + b * MODW + le * 16;
        float ss = 0.f;
        {
            const float xi[16] = {lo16(xa.x), hi16(xa.x), lo16(xa.y), hi16(xa.y), lo16(xa.z), hi16(xa.z), lo16(xa.w), hi16(xa.w), lo16(xb.x), hi16(xb.x), lo16(xb.y), hi16(xb.y), lo16(xb.z), hi16(xb.z), lo16(xb.w), hi16(xb.w)};
#pragma unroll
            for (int q4i = 0; q4i < 4; ++q4i) {
                const f32x4 gg = *(const f32x4*)(g + q4i * 4);
#pragma unroll
                for (int e = 0; e < 4; ++e) { const float o = xi[q4i * 4 + e] + gg[e] * acc[q4i * 4 + e]; acc[q4i * 4 + e] = o; ss += o * o; }
            }
            if (P.xoutb) {
                *(u32x4*)(P.xoutb + m * D + le * 16) = (u32x4){pk2(acc[0], acc[1]), pk2(acc[2], acc[3]), pk2(acc[4], acc[5]), pk2(acc[6], acc[7])};
                *(u32x4*)(P.xoutb + m * D + le * 16 + 8) = (u32x4){pk2(acc[8], acc[9]), pk2(acc[10], acc[11]), pk2(acc[12], acc[13]), pk2(acc[14], acc[15])};
            } else {
#pragma unroll
                for (int q4i = 0; q4i < 4; ++q4i) *(f32x4*)(P.xout + m * D + le * 16 + q4i * 4) = (f32x4){acc[q4i * 4], acc[q4i * 4 + 1], acc[q4i * 4 + 2], acc[q4i * 4 + 3]};
            }
        }
        if (P.ngain) {
            const float r1 = rsqrtf(wave_sum(ss) * (1.f / D) + EPS);
            const float* gn = P.ngain + le * 16; const float* shn = P.nmod + b * MODW + le * 16; const float* scn = P.nmod + b * MODW + D + le * 16;
            unsigned w[8];
#pragma unroll
            for (int q4i = 0; q4i < 4; ++q4i) {
                const f32x4 g4 = *(const f32x4*)(gn + q4i * 4), s4 = *(const f32x4*)(scn + q4i * 4), h4 = *(const f32x4*)(shn + q4i * 4);
                float o[4];
#pragma unroll
                for (int e = 0; e < 4; ++e) o[e] = acc[q4i * 4 + e] * r1 * g4[e] * (1.f + s4[e]) + h4[e];
                w[q4i * 2] = pk2(o[0], o[1]); w[q4i * 2 + 1] = pk2(o[2], o[3]);
            }
            *(u32x4*)(P.H + m * D + le * 16) = (u32x4){w[0], w[1], w[2], w[3]}; *(u32x4*)(P.H + m * D + le * 16 + 8) = (u32x4){w[4], w[5], w[6], w[7]};
        }
    }
}
__device__ __forceinline__ void ph_peer_gather3(const Ctx& C, const GatherP& P) {
    HY_LAS float* coefW = (HY_LAS float*)((HY_LAS unsigned char*)C.lds) + C.wave * 2048;
    HY_LAS int* idsW = (HY_LAS int*)(coefW + 1024);
    const size_t mstep = (size_t)C.nblk * 8;
#pragma unroll 1
    for (size_t mbase = (size_t)C.bid * 8 + C.wave; mbase < M; mbase += 8 * mstep) {
    size_t m = mbase;
    int nidx0 = 0, nidx1 = 0, pidx0 = 0, pidx1 = 0; float nsu0 = 0.f, nsu1 = 0.f, ngv0 = 0.f, ngv1 = 0.f;
    {
        const int l0 = C.lane;
        nidx0 = P.EIDX[m * 128 + l0]; nidx1 = P.EIDX[m * 128 + 64 + l0];
        nsu0 = P.SU[nidx0]; nsu1 = P.SU[nidx1];
        ngv0 = P.GATE[m * 128 + l0] * P.SV[nidx0]; ngv1 = P.GATE[m * 128 + 64 + l0] * P.SV[nidx1];
        if (m + mstep < M) { pidx0 = P.EIDX[(m + mstep) * 128 + l0]; pidx1 = P.EIDX[(m + mstep) * 128 + 64 + l0]; }
    }
    int nk = 0;
#pragma unroll 1
    for (int k = 0; k < 8 && m < M; ++k, m += mstep) {
        HY_LAS float* coefL = coefW + k * 128;
        nk = k + 1;
        unsigned ones_ = ~0u; asm volatile("" : "+s"(ones_));
        const int lane = (int)__builtin_amdgcn_mbcnt_hi(ones_, __builtin_amdgcn_mbcnt_lo(ones_, 0u));
        const int l31 = lane & 31, hh = lane >> 5;
        const int b4 = (lane >> 4) & 1, b3 = (lane >> 3) & 1, b2 = (lane >> 2) & 1, b1 = (lane >> 1) & 1;
        const int ie = 8 * b4 + 4 * b3 + 2 * b2 + b1;
        const int b = (int)(m >> 13);
        const int idx0 = nidx0, idx1 = nidx1; const float su0 = nsu0, su1 = nsu1, gv0 = ngv0, gv1 = ngv1;
        if (m + mstep < M) {
            const size_t mn = m + mstep;
            nidx0 = pidx0; nidx1 = pidx1;
            nsu0 = P.SU[nidx0]; nsu1 = P.SU[nidx1];
            ngv0 = P.GATE[mn * 128 + lane] * P.SV[nidx0]; ngv1 = P.GATE[mn * 128 + 64 + lane] * P.SV[nidx1];
            if (mn + mstep < M) { pidx0 = P.EIDX[(mn + mstep) * 128 + lane]; pidx1 = P.EIDX[(mn + mstep) * 128 + 64 + lane]; }
        }
        idsW[k * 128 + lane] = idx0; idsW[k * 128 + 64 + lane] = idx1;
        {
            f32x2 h[16];
            {
                const bf16_t* hp = P.H + m * D + l31 * 32;
                const f32x4 s0 = *(const f32x4*)(P.SSX + m * 16), s1 = *(const f32x4*)(P.SSX + m * 16 + 4), s2 = *(const f32x4*)(P.SSX + m * 16 + 8), s3 = *(const f32x4*)(P.SSX + m * 16 + 12);
                const float tot = (((s0[0] + s0[1]) + (s0[2] + s0[3])) + ((s1[0] + s1[1]) + (s1[2] + s1[3]))) + (((s2[0] + s2[1]) + (s2[2] + s2[3])) + ((s3[0] + s3[1]) + (s3[2] + s3[3])));
                const float r = rsqrtf(tot * (1.f / D) + EPS);
                const float* sh = P.sh2 + b * MODW + l31 * 32;
#pragma unroll
                for (int q = 0; q < 4; ++q) {
                    const u32x4 a = *(const u32x4*)(hp + q * 8); const f32x4 sa = *(const f32x4*)(sh + q * 8), sb = *(const f32x4*)(sh + q * 8 + 4);
                    h[q * 4] = (f32x2){lo16(a.x) * r + sa[0], hi16(a.x) * r + sa[1]}; h[q * 4 + 1] = (f32x2){lo16(a.y) * r + sa[2], hi16(a.y) * r + sa[3]};
                    h[q * 4 + 2] = (f32x2){lo16(a.z) * r + sb[0], hi16(a.z) * r + sb[1]}; h[q * 4 + 3] = (f32x2){lo16(a.w) * r + sb[2], hi16(a.w) * r + sb[3]};
                }
            }
#pragma unroll 1
            for (int bt = 0; bt < (P.var == 1 ? 0 : 4); ++bt) {
                const int idxv = bt < 2 ? idx0 : idx1;
                u32x4 rows[16];
#pragma unroll
                for (int i = 0; i < 16; ++i) {
                    const int e = __builtin_amdgcn_ds_bpermute(((bt & 1) * 32 + 2 * i + hh) * 4, idxv);
                    rows[i] = *(const u32x4*)(P.U8 + (unsigned)(e * 512 + l31 * 16));
                }
                float p[16];
#pragma unroll
                for (int i = 0; i < 16; ++i) { asm volatile("" : "+v"(rows[i]));
                    p[i] = dot32_fp4(h, rows[i]); }
                float q8[8], q4[4], q2[2];
#pragma unroll
                for (int i = 0; i < 8; ++i) { const float snd = b4 ? p[i] : p[i + 8], kp = b4 ? p[i + 8] : p[i]; q8[i] = kp + __shfl_xor(snd, 16); }
#pragma unroll
                for (int i = 0; i < 4; ++i) { const float snd = b3 ? q8[i] : q8[i + 4], kp = b3 ? q8[i + 4] : q8[i]; q4[i] = kp + __shfl_xor(snd, 8); }
#pragma unroll
                for (int i = 0; i < 2; ++i) { const float snd = b2 ? q4[i] : q4[i + 2], kp = b2 ? q4[i + 2] : q4[i]; q2[i] = kp + __shfl_xor(snd, 4); }
                float tot; { const float snd = b1 ? q2[0] : q2[1], kp = b1 ? q2[1] : q2[0]; tot = kp + __shfl_xor(snd, 2); }
                tot += __shfl_xor(tot, 1);
                const int kk = (bt & 1) * 32 + 2 * ie + hh;
                const float suk = __int_as_float(__builtin_amdgcn_ds_bpermute(kk * 4, __float_as_int(bt < 2 ? su0 : su1)));
                const float gvk = __int_as_float(__builtin_amdgcn_ds_bpermute(kk * 4, __float_as_int(bt < 2 ? gv0 : gv1)));
                const float cf = gvk * gelu_tanh(tot * suk);
                if ((lane & 1) == 0) coefL[bt * 32 + 2 * ie + hh] = cf;
            }
        }
    }
    m = mbase;
#pragma unroll 1
    for (int k = 0; k < nk; ++k, m += mstep) {
        HY_LAS float* coefL = coefW + k * 128;
        unsigned ones_ = ~0u; asm volatile("" : "+s"(ones_));
        const int lane = (int)__builtin_amdgcn_mbcnt_hi(ones_, __builtin_amdgcn_mbcnt_lo(ones_, 0u));
        const int b = (int)(m >> 13);
        const int idx0 = idsW[k * 128 + lane], idx1 = idsW[k * 128 + 64 + lane];
        f32x2 acc2[8];
#pragma unroll
        for (int i = 0; i < 8; ++i) acc2[i] = (f32x2){0.f, 0.f};
#pragma unroll 1
        for (int bt = 0; bt < (P.var == 2 ? 0 : 4); ++bt) {
            const int idxv = bt < 2 ? idx0 : idx1;
            u32x2 rows[32];
#pragma unroll
            for (int i = 0; i < 32; ++i) {
                const int e = __builtin_amdgcn_ds_bpermute(((bt & 1) * 32 + i) * 4, idxv);
                rows[i] = *(const u32x2*)(P.V8 + (unsigned)(e * 512 + lane * 8));
            }
#pragma unroll
            for (int i = 0; i < 32; ++i) { asm volatile("" : "+v"(rows[i])); axpy16_fp4(acc2, coefL[bt * 32 + i], rows[i]); }
        }
        float acc[16];
#pragma unroll
        for (int i = 0; i < 8; ++i) { acc[2 * i] = acc2[i][0]; acc[2 * i + 1] = acc2[i][1]; }
        int le = lane; asm volatile("" : "+v"(le));
        const float* g = P.g2 + b * MODW + le * 16;
        float ss = 0.f;
        {
            const u32x4 xa = *(const u32x4*)(P.xinb + m * D + le * 16), xb = *(const u32x4*)(P.xinb + m * D + le * 16 + 8);
            const float xi[16] = {lo16(xa.x), hi16(xa.x), lo16(xa.y), hi16(xa.y), lo16(xa.z), hi16(xa.z), lo16(xa.w), hi16(xa.w), lo16(xb.x), hi16(xb.x), lo16(xb.y), hi16(xb.y), lo16(xb.z), hi16(xb.z), lo16(xb.w), hi16(xb.w)};
#pragma unroll
            for (int q4i = 0; q4i < 4; ++q4i) {
                const f32x4 gg = *(const f32x4*)(g + q4i * 4);
#pragma unroll
                for (int e = 0; e < 4; ++e) { const float o = xi[q4i * 4 + e] + gg[e] * acc[q4i * 4 + e]; acc[q4i * 4 + e] = o; ss += o * o; }
            }
            if (P.xoutb) {
                *(u32x4*)(P.xoutb + m * D + le * 16) = (u32x4){pk2(acc[0], acc[1]), pk2(acc[2], acc[3]), pk2(acc[4], acc[5]), pk2(acc[6], acc[7])};
                *(u32x4*)(P.xoutb + m * D + le * 16 + 8) = (u32x4){pk2(acc[8], acc[9]), pk2(acc[10], acc[11]), pk2(acc[12], acc[13]), pk2(acc[14], acc[15])};
            } else {
#pragma unroll
                for (int q4i = 0; q4i < 4; ++q4i) *(f32x4*)(P.xout + m * D + le * 16 + q4i * 4) = (f32x4){acc[q4i * 4], acc[q4i * 4 + 1], acc[q4i * 4 + 2], acc[q4i * 4 + 3]};
            }
        }
        if (P.ngain) {
            const float r1 = rsqrtf(wave_sum(ss) * (1.f / D) + EPS);
            const float* gn = P.ngain + le * 16; const float* shn = P.nmod + b * MODW + le * 16; const float* scn = P.nmod + b * MODW + D + le * 16;
            unsigned w[8];
#pragma unroll
            for (int q4i = 0; q4i < 4; ++q4i) {
                const f32x4 g4 = *(const f32x4*)(gn + q4i * 4), s4 = *(const f32x4*)(scn + q4i * 4), h4 = *(const f32x4*)(shn + q4i * 4);
                float o[4];
#pragma unroll
                for (int e = 0; e < 4; ++e) o[e] = acc[q4i * 4 + e] * r1 * g4[e] * (1.f + s4[e]) + h4[e];
                w[q4i * 2] = pk2(o[0], o[1]); w[q4i * 2 + 1] = pk2(o[2], o[3]);
            }
            *(u32x4*)(P.H + m * D + le * 16) = (u32x4){w[0], w[1], w[2], w[3]}; *(u32x4*)(P.H + m * D + le * 16 + 8) = (u32x4){w[4], w[5], w[6], w[7]};
        }
    }
    }
}
}
namespace hy {
struct EpiGen {
    static constexpr bool PERM = true, AFTER_DRAIN = false;
    int mode; int ldc; bf16_t* O; const float* xin; const bf16_t* xinb; bf16_t* xoutb; const float* gate; unsigned char* ws; const float *p0, *p1, *p2;
    __device__ __forceinline__ void operator()(const pg8::f32x4 (&acc)[2][2][4][2], const pg8::Unit& u, int wr, int wc, int fr_, int fq_) const {
        int fr = fr_, fq = fq_; asm volatile("" : "+v"(fr), "+v"(fq));
        const int row0 = u.pm * 256 + wr * 64 + fr, col0 = u.pn * 256 + wc * 32 + 8 * fq;
        if (mode == 0) {
#pragma unroll
            for (int ai = 0; ai < 2; ++ai)
#pragma unroll
                for (int m = 0; m < 4; ++m) { bf16_t* rowp = O + (size_t)(row0 + ai * 128 + m * 16) * ldc + col0;
#pragma unroll
                    for (int bj = 0; bj < 2; ++bj) { const pg8::f32x4 v0 = acc[ai][bj][m][0], v1 = acc[ai][bj][m][1];
                        u32x4 w; w.x = pg8::cvt_pk_bf16(v0[0], v0[1]); w.y = pg8::cvt_pk_bf16(v0[2], v0[3]); w.z = pg8::cvt_pk_bf16(v1[0], v1[1]); w.w = pg8::cvt_pk_bf16(v1[2], v1[3]);
                        *(u32x4*)(rowp + bj * 128) = w; } }
        } else if (mode == 2) {
            const int uu = 4 * u.pn + wc;
            if (uu > 28) return;
            bf16_t* dst; int pitch, cb; float osc = 1.f; const float* gn = nullptr;
            if (uu < 6) { dst = (bf16_t*)(ws + WS_QA); pitch = 384; cb = 64 * uu; gn = p0; osc = 0.125f * LOG2E; }
            else if (uu < 12) { dst = (bf16_t*)(ws + WS_KA); pitch = 384; cb = 64 * (uu - 6); gn = p1; }
            else if (uu < 18) { dst = (bf16_t*)(ws + WS_VA); pitch = 384; cb = 64 * (uu - 12); }
            else if (uu < 20) { dst = (bf16_t*)(ws + WS_CQKV); pitch = 384; cb = 256 + 64 * (uu - 18); }
            else if (uu < 24) { dst = (bf16_t*)(ws + WS_CQKV); pitch = 384; cb = 64 * (uu - 20); }
            else if (uu < 28) { dst = (bf16_t*)(ws + WS_U); pitch = 256; cb = 64 * (uu - 24); }
            else { dst = (bf16_t*)(ws + WS_KM); pitch = 576; cb = 64; }
            pg8::f32x4 gv[2][2];
#pragma unroll
            for (int bj = 0; bj < 2; ++bj)
#pragma unroll
                for (int n = 0; n < 2; ++n) gv[bj][n] = gn ? *(const pg8::f32x4*)(gn + 32 * bj + 8 * fq + 4 * n) * osc : (pg8::f32x4){1.f, 1.f, 1.f, 1.f};
            float* ssq = (float*)(ws + WS_SSQ) + (uu < 20 ? 4 + (uu - 18) : (uu - 20));
#pragma unroll
            for (int ai = 0; ai < 2; ++ai)
#pragma unroll
                for (int m = 0; m < 4; ++m) {
                    const int row = row0 + ai * 128 + m * 16;
                    pg8::f32x4 v[2][2];
#pragma unroll
                    for (int bj = 0; bj < 2; ++bj)
#pragma unroll
                        for (int n = 0; n < 2; ++n) v[bj][n] = acc[ai][bj][m][n];
                    if (uu < 12 || (uu >= 18 && uu < 24)) {
                        float ss = 0.f;
#pragma unroll
                        for (int bj = 0; bj < 2; ++bj)
#pragma unroll
                            for (int n = 0; n < 2; ++n) ss += v[bj][n][0] * v[bj][n][0] + v[bj][n][1] * v[bj][n][1] + v[bj][n][2] * v[bj][n][2] + v[bj][n][3] * v[bj][n][3];
                        ss += __shfl_xor(ss, 16); ss += __shfl_xor(ss, 32);
                        if (uu < 12) { const float r = rsqrtf(ss * (1.f / 64.f) + EPS);
#pragma unroll
                            for (int bj = 0; bj < 2; ++bj)
#pragma unroll
                                for (int n = 0; n < 2; ++n) v[bj][n] = v[bj][n] * r * gv[bj][n]; }
                        else if (fq == 0) ssq[(size_t)row * 8] = ss;
                    }
                    if (uu < 28) {
#pragma unroll
                        for (int bj = 0; bj < 2; ++bj) {
                            u32x4 w; w.x = pg8::cvt_pk_bf16(v[bj][0][0], v[bj][0][1]); w.y = pg8::cvt_pk_bf16(v[bj][0][2], v[bj][0][3]); w.z = pg8::cvt_pk_bf16(v[bj][1][0], v[bj][1][1]); w.w = pg8::cvt_pk_bf16(v[bj][1][2], v[bj][1][3]);
                            *(u32x4*)(dst + (size_t)row * pitch + cb + 32 * bj + 8 * fq) = w;
                        }
                    } else {
                        float ss = 0.f;
#pragma unroll
                        for (int n = 0; n < 2; ++n) ss += v[0][n][0] * v[0][n][0] + v[0][n][1] * v[0][n][1] + v[0][n][2] * v[0][n][2] + v[0][n][3] * v[0][n][3];
                        ss += __shfl_xor(ss, 16); ss += __shfl_xor(ss, 32);
                        const float r = rsqrtf(ss * (1.f / 32.f) + EPS);
                        const int pos = row & (S - 1), i0 = 8 * (fq & 1);
                        const float* rp = (const float*)(ws + WS_ROPE) + pos * 16 + i0;
                        float o[8];
#pragma unroll
                        for (int n = 0; n < 2; ++n) {
                            const pg8::f32x4 kg = *(const pg8::f32x4*)(p2 + 64 + 8 * fq + 4 * n);
                            const pg8::f32x4 cs = *(const pg8::f32x4*)(rp + 4 * n), sn = *(const pg8::f32x4*)(rp + S * 16 + 4 * n);
#pragma unroll
                            for (int e = 0; e < 4; ++e) {
                                const float nv = v[0][n][e] * r * kg[e];
                                const float pr = __shfl_xor(nv, 32);
                                o[4 * n + e] = (fq < 2) ? (nv * cs[e] - pr * sn[e]) : (pr * sn[e] + nv * cs[e]);
                            }
                        }
                        u32x4 w; w.x = pg8::cvt_pk_bf16(o[0], o[1]); w.y = pg8::cvt_pk_bf16(o[2], o[3]); w.z = pg8::cvt_pk_bf16(o[4], o[5]); w.w = pg8::cvt_pk_bf16(o[6], o[7]);
#pragma unroll
                        for (int hh = 0; hh < 6; ++hh) *(u32x4*)(dst + (size_t)row * pitch + hh * 96 + cb + 8 * fq) = w;
                    }
                }
        } else if (mode == 3) {
            const int h = u.pn, kind = wc;
            const float SCQ = 0.10206207261596575f * LOG2E;
            const float* gn = kind == 0 ? p0 : (kind == 1 ? p0 + 64 : p1);
            pg8::f32x4 gv[2][2];
#pragma unroll
            for (int bj = 0; bj < 2; ++bj)
#pragma unroll
                for (int n = 0; n < 2; ++n) gv[bj][n] = (kind == 3 || (kind == 1 && bj == 1)) ? (pg8::f32x4){1.f, 1.f, 1.f, 1.f} : *(const pg8::f32x4*)(gn + 32 * bj + 8 * fq + 4 * n);
            bf16_t* dst; int pitch, cb;
            if (kind < 2) { dst = (bf16_t*)(ws + WS_QM); pitch = 576; cb = h * 96 + kind * 64; }
            else if (kind == 2) { dst = (bf16_t*)(ws + WS_KM); pitch = 576; cb = h * 96; }
            else { dst = (bf16_t*)(ws + WS_VM); pitch = 384; cb = h * 64; }
            const float* ssqp = (const float*)(ws + WS_SSQ);
#pragma unroll
            for (int ai = 0; ai < 2; ++ai)
#pragma unroll
                for (int m = 0; m < 4; ++m) {
                    const int row = row0 + ai * 128 + m * 16;
                    const pg8::f32x4 pq = *(const pg8::f32x4*)(ssqp + (size_t)row * 8); const float2 pkv = *(const float2*)(ssqp + (size_t)row * 8 + 4);
                    const float sc = kind < 2 ? rsqrtf(((pq[0] + pq[1]) + (pq[2] + pq[3])) * (1.f / 256.f) + EPS) : rsqrtf((pkv.x + pkv.y) * (1.f / 128.f) + EPS);
                    pg8::f32x4 v[2][2];
#pragma unroll
                    for (int bj = 0; bj < 2; ++bj)
#pragma unroll
                        for (int n = 0; n < 2; ++n) v[bj][n] = acc[ai][bj][m][n] * sc;
                    if (kind != 3) {
                        float ss = 0.f;
#pragma unroll
                        for (int bj = 0; bj < 2; ++bj)
#pragma unroll
                            for (int n = 0; n < 2; ++n) if (kind != 1 || bj == 0) ss += v[bj][n][0] * v[bj][n][0] + v[bj][n][1] * v[bj][n][1] + v[bj][n][2] * v[bj][n][2] + v[bj][n][3] * v[bj][n][3];
                        ss += __shfl_xor(ss, 16); ss += __shfl_xor(ss, 32);
                        const float r = rsqrtf(ss * (kind == 1 ? (1.f / 32.f) : (1.f / 64.f)) + EPS) * (kind < 2 ? SCQ : 1.f);
#pragma unroll
                        for (int bj = 0; bj < 2; ++bj)
#pragma unroll
                            for (int n = 0; n < 2; ++n) v[bj][n] = v[bj][n] * r * gv[bj][n];
                    }
                    if (kind == 1) {
                        const int pos = row & (S - 1), i0 = 8 * (fq & 1);
                        const float* rp = (const float*)(ws + WS_ROPE) + pos * 16 + i0;
                        float o[8];
#pragma unroll
                        for (int n = 0; n < 2; ++n) {
                            const pg8::f32x4 cs = *(const pg8::f32x4*)(rp + 4 * n), sn = *(const pg8::f32x4*)(rp + S * 16 + 4 * n);
#pragma unroll
                            for (int e = 0; e < 4; ++e) { const float nv = v[0][n][e]; const float pr = __shfl_xor(nv, 32); o[4 * n + e] = (fq < 2) ? (nv * cs[e] - pr * sn[e]) : (pr * sn[e] + nv * cs[e]); }
                        }
                        u32x4 w; w.x = pg8::cvt_pk_bf16(o[0], o[1]); w.y = pg8::cvt_pk_bf16(o[2], o[3]); w.z = pg8::cvt_pk_bf16(o[4], o[5]); w.w = pg8::cvt_pk_bf16(o[6], o[7]);
                        *(u32x4*)(dst + (size_t)row * pitch + cb + 8 * fq) = w;
                    } else {
#pragma unroll
                        for (int bj = 0; bj < 2; ++bj) {
                            u32x4 w; w.x = pg8::cvt_pk_bf16(v[bj][0][0], v[bj][0][1]); w.y = pg8::cvt_pk_bf16(v[bj][0][2], v[bj][0][3]); w.z = pg8::cvt_pk_bf16(v[bj][1][0], v[bj][1][1]); w.w = pg8::cvt_pk_bf16(v[bj][1][2], v[bj][1][3]);
                            *(u32x4*)(dst + (size_t)row * pitch + cb + 32 * bj + 8 * fq) = w;
                        }
                    }
                }
        } else if (mode == 4) {
            const float* cv = p0 + ((u.pm * 256) >> 13) * 2048;
            const float* ssx = (const float*)(ws + WS_SSX);
            pg8::f32x4 c0[2], c1[2];
#pragma unroll
            for (int bj = 0; bj < 2; ++bj) { c0[bj] = *(const pg8::f32x4*)(cv + col0 + bj * 128); c1[bj] = *(const pg8::f32x4*)(cv + col0 + bj * 128 + 4); }
#pragma unroll
            for (int ai = 0; ai < 2; ++ai)
#pragma unroll
                for (int m = 0; m < 4; ++m) {
                    const int row = row0 + ai * 128 + m * 16;
                    const pg8::f32x4 s0 = *(const pg8::f32x4*)(ssx + (size_t)row * 16), s1 = *(const pg8::f32x4*)(ssx + (size_t)row * 16 + 4), s2 = *(const pg8::f32x4*)(ssx + (size_t)row * 16 + 8), s3 = *(const pg8::f32x4*)(ssx + (size_t)row * 16 + 12);
                    const float tot = (((s0[0] + s0[1]) + (s0[2] + s0[3])) + ((s1[0] + s1[1]) + (s1[2] + s1[3]))) + (((s2[0] + s2[1]) + (s2[2] + s2[3])) + ((s3[0] + s3[1]) + (s3[2] + s3[3])));
                    const float r = rsqrtf(tot * (1.f / D) + EPS);
                    bf16_t* rowp = O + (size_t)row * ldc + col0;
#pragma unroll
                    for (int bj = 0; bj < 2; ++bj) { const pg8::f32x4 v0 = acc[ai][bj][m][0] * r + c0[bj], v1 = acc[ai][bj][m][1] * r + c1[bj];
                        u32x4 w; w.x = pg8::cvt_pk_bf16(v0[0], v0[1]); w.y = pg8::cvt_pk_bf16(v0[2], v0[3]); w.z = pg8::cvt_pk_bf16(v1[0], v1[1]); w.w = pg8::cvt_pk_bf16(v1[2], v1[3]);
                        *(u32x4*)(rowp + bj * 128) = w; }
                }
        } else {
            const int b = (u.pm * 256) >> 13;
            const float* g = gate + b * MODW; const float* sc2 = p1 + b * MODW;
            float* ssx = (float*)(ws + WS_SSX) + u.pn * 4 + wc;
            bf16_t* A2 = (bf16_t*)(ws + WS_H);
            pg8::f32x4 g0[2], g1[2], w0[2], w1[2];
#pragma unroll
            for (int bj = 0; bj < 2; ++bj) {
                const int col = col0 + bj * 128;
                g0[bj] = *(const pg8::f32x4*)(g + col); g1[bj] = *(const pg8::f32x4*)(g + col + 4);
                w0[bj] = *(const pg8::f32x4*)(p0 + col) * (*(const pg8::f32x4*)(sc2 + col) + 1.f); w1[bj] = *(const pg8::f32x4*)(p0 + col + 4) * (*(const pg8::f32x4*)(sc2 + col + 4) + 1.f);
            }
#pragma unroll
            for (int ai = 0; ai < 2; ++ai)
#pragma unroll
                for (int m = 0; m < 4; ++m) {
                    const int row = row0 + ai * 128 + m * 16; float ss = 0.f;
#pragma unroll
                    for (int bj = 0; bj < 2; ++bj) {
                        const size_t off = (size_t)row * D + col0 + bj * 128;
                        pg8::f32x4 xi0, xi1;
                        if (xin) { xi0 = *(const pg8::f32x4*)(xin + off); xi1 = *(const pg8::f32x4*)(xin + off + 4); }
                        else { const u32x4 xb = *(const u32x4*)(xinb + off); xi0 = (pg8::f32x4){lo16(xb.x), hi16(xb.x), lo16(xb.y), hi16(xb.y)}; xi1 = (pg8::f32x4){lo16(xb.z), hi16(xb.z), lo16(xb.w), hi16(xb.w)}; }
                        const pg8::f32x4 x0 = xi0 + g0[bj] * acc[ai][bj][m][0], x1 = xi1 + g1[bj] * acc[ai][bj][m][1];
                        { u32x4 xw; xw.x = pg8::cvt_pk_bf16(x0[0], x0[1]); xw.y = pg8::cvt_pk_bf16(x0[2], x0[3]); xw.z = pg8::cvt_pk_bf16(x1[0], x1[1]); xw.w = pg8::cvt_pk_bf16(x1[2], x1[3]); *(u32x4*)(xoutb + off) = xw; }
                        ss += (x0[0] * x0[0] + x0[1] * x0[1]) + (x0[2] * x0[2] + x0[3] * x0[3]) + (x1[0] * x1[0] + x1[1] * x1[1]) + (x1[2] * x1[2] + x1[3] * x1[3]);
                        const pg8::f32x4 a0 = x0 * w0[bj], a1 = x1 * w1[bj];
                        u32x4 w; w.x = pg8::cvt_pk_bf16(a0[0], a0[1]); w.y = pg8::cvt_pk_bf16(a0[2], a0[3]); w.z = pg8::cvt_pk_bf16(a1[0], a1[1]); w.w = pg8::cvt_pk_bf16(a1[2], a1[3]);
                        *(u32x4*)(A2 + off) = w;
                    }
                    ss += __shfl_xor(ss, 16); ss += __shfl_xor(ss, 32);
                    if (fq == 0) ssx[(size_t)row * 16] = ss;
                }
        }
    }
};

#ifndef HY_PROBE
#define HY_PROBE 0
#endif
#define HY_PROBE_REPS(s) (((HY_PROBE >= 40 && HY_PROBE < 50 && (s) == 8) || (HY_PROBE >= 100 && (s) == HY_PROBE - 100) || ((HY_PROBE == 2 || HY_PROBE == 7 || HY_PROBE == 8 || HY_PROBE == 9 || HY_PROBE == 20 || HY_PROBE == 21 || HY_PROBE == 22) && (s) == 2) || \
                          (HY_PROBE == 3 && (s) == 8) || (HY_PROBE == 4 && (s) == 7) || (HY_PROBE == 5 && ((s) == 0 || (s) == 1 || (s) == 3 || (s) == 6)) || (HY_PROBE == 6 && (s) == 4)) ? 2 : 1)
#define GSYNC() do { XcdBarrier b_; b_.bar = WSP(unsigned, WS_CTL) + 4096; b_.x = xb_xcc_id(); b_.st = (volatile LAS unsigned*)((HY_LAS unsigned char*)lds + LDS_BYTES - 32); xcd_barrier(b_, HY_TID()); } while (0)
constexpr int NSTEP = 9;

__global__ void __launch_bounds__(NT, 2) k_fwd(Params P) {
    extern __shared__ __attribute__((aligned(16))) unsigned char lds[];
    cg::grid_group grid = cg::this_grid();
    const int wave0 = __builtin_amdgcn_readfirstlane(threadIdx.x >> 6);
#define HY_TID() ({ unsigned o_ = ~0u; asm volatile("" : "+s"(o_)); wave0 * 64 + (int)__builtin_amdgcn_mbcnt_hi(o_, __builtin_amdgcn_mbcnt_lo(o_, 0u)); })
    Ctx C0; C0.tid = HY_TID(); C0.lane = C0.tid & 63; C0.wave = wave0; C0.bid = blockIdx.x; C0.nblk = gridDim.x; C0.lds = lds;
    const In& in = P.in;
    unsigned char* ws = P.ws; float* out = P.out;
    if (C0.tid < 8) ((HY_LAS unsigned*)((HY_LAS unsigned char*)lds + LDS_BYTES - 32))[C0.tid] = 0u;
    __syncthreads();
#define WSP(T, off) ((T*)(ws + (off)))

    for (int prep = 0; prep < (HY_PROBE == 1 ? 2 : 1); ++prep) {
    const Ctx& C = C0;
    if (C.bid == 0) { for (int i = C.tid; i < 8192; i += NT) WSP(unsigned, WS_CTL)[i] = 0u; }
    for (int q = 0; q < (HY_PROBE == 13 ? 2 : 1); ++q)
    ph_mod(C, in.c, in.w_ada, in.b_ada, WSP(float, WS_MOD));
    ph_tables(C, in.rel_bias, WSP(float, WS_BIAS), WSP(float, WS_ROPE));
    ph_bounds(C, in, WSP(float, WS_BIAS) + 4096);
    ph_w2zero(C, WSP(bf16_t, WS_W2));
    for (int q = 0; q < (HY_PROBE == 11 ? 2 : 1); ++q)
    ph_tconv(C, P);
    ph_cvt(C, in.peer_subkeys, WSP(bf16_t, WS_SUBK), (size_t)NL * 16 * 128 * 128 / 8);
    ph_s5_lampow(C, in, WSP(float, WS_LP));
    ph_s5_bbar(C, in, WSP(float, WS_BB));
    }
    grid.sync();
    (void)xcd_barrier_post(WSP(unsigned, WS_CTL) + 4096, (volatile LAS unsigned*)((HY_LAS unsigned char*)lds + LDS_BYTES - 32), HY_TID());
    for (int prep = 0; prep < ((HY_PROBE == 1 || HY_PROBE == 10) ? 2 : 1); ++prep)
    { ph_s5_tables(C0, in, WSP(float, WS_LP), WSP(float, WS_BB), WSP(bf16_t, WS_KMT), WSP(bf16_t, WS_WE), WSP(bf16_t, WS_WC));
      ph_cvec(C0, in.peer_wq, WSP(float, WS_MOD), WSP(float, WS_CV));
      ph_normmod(C0, in.x, in.norm1_gain, WSP(float, WS_MOD), 0, D, WSP(bf16_t, WS_H), nullptr); }
    GSYNC();

    for (int step = 0; step < NL * NSTEP; ++step) {
        const int l = step / NSTEP, s = step % NSTEP;
        if (s == 3 || s == 7) continue;
        const int nrep = HY_PROBE_REPS(s);
        for (int rep = 0; rep < nrep; ++rep) {
#define HY_MKCTX() Ctx C; { int t = HY_TID(), bq = blockIdx.x; asm volatile("" : "+v"(t), "+s"(bq)); C.tid = t; C.lane = t & 63; C.wave = __builtin_amdgcn_readfirstlane(t >> 6); C.bid = bq; C.nblk = gridDim.x; C.lds = lds; }
        const float* modl = WSP(float, WS_MOD) + (size_t)l * 2 * MODW;
        const bf16_t* gA = nullptr; const bf16_t* gB = nullptr; int gN = 0, gK = 0; EpiGen ge; ge.mode = 0; ge.ldc = 0; ge.O = nullptr; ge.xin = nullptr; ge.xinb = nullptr; ge.xoutb = nullptr; ge.gate = nullptr; ge.ws = ws; ge.p0 = nullptr; ge.p1 = nullptr; ge.p2 = nullptr;
        switch (s) {
        case 0: gA = WSP(bf16_t, WS_H); gB = WSP(bf16_t, WS_WIN) + (size_t)l * P1W * D; gN = P1W; gK = D; ge.mode = 2; ge.p0 = in.swa_q_gain + l * 64; ge.p1 = in.swa_k_gain + l * 64; ge.p2 = in.mla_k_gain + l * 96; break;
        case 1: gA = WSP(bf16_t, WS_CQKV); gB = WSP(bf16_t, WS_W2) + (size_t)l * P2W * 384; gN = P2W; gK = 384; ge.mode = 3; ge.p0 = in.mla_q_gain + l * 96; ge.p1 = in.mla_k_gain + l * 96; break;
        case 2: { HY_MKCTX(); MixQ mp; mp.QM = WSP(bf16_t, WS_QM); mp.KM = WSP(bf16_t, WS_KM); mp.VM = WSP(bf16_t, WS_VM); mp.QA = WSP(bf16_t, WS_QA); mp.KA = WSP(bf16_t, WS_KA); mp.VA = WSP(bf16_t, WS_VA);
                  mp.bias = WSP(float, WS_BIAS); mp.YC = WSP(bf16_t, WS_YC); mp.YAB = WSP(bf16_t, WS_YAB); mp.MLB = WSP(float, WS_MLB);
                  mp.s5.U = WSP(bf16_t, WS_U); mp.s5.KMl = WSP(bf16_t, WS_KMT) + (size_t)l * S5_KM_L; mp.s5.WCl = WSP(bf16_t, WS_WC) + (size_t)l * S5_WC_L; mp.s5.E = WSP(float, WS_E); mp.s5.LP = WSP(float, WS_LP);
                  mp.s5.dskip = in.s5_d + l * 256; mp.s5.GS = WSP(bf16_t, WS_GS); mp.s5.layer = l; mp.s5.var = 0;
                  mp.counter = WSP(unsigned, WS_CTL) + 64 * (l * 4 + rep);
                  mp.lo = 0; mp.hi = 1 << 30; mp.bnd = WSP(float, WS_BIAS) + 4096 + l * 2;
                  mp.var = 0;
                  if (rep + 1 < nrep && (HY_PROBE == 20 || HY_PROBE == 21 || HY_PROBE == 22)) { mp.lo = 0; mp.hi = 384; mp.YC = WSP(bf16_t, WS_P1); mp.var = HY_PROBE == 20 ? 0 : 1; }
                  if (rep + 1 < nrep) { if (HY_PROBE == 7) { mp.lo = 0; mp.hi = 384; } else if (HY_PROBE == 8) { mp.lo = 512; mp.hi = 1664; } else if (HY_PROBE == 9) { mp.lo = 384; mp.hi = 512; } }
                  mp.cu = C.nblk == 256 ? nullptr : in.peer_u + (size_t)l * 16384 * 1024; mp.du = WSP(unsigned char, WS_PU) + (size_t)l * 16384 * 512; mp.su = WSP(float, WS_PSU) + l * 16384;
                  mp.cv = in.peer_v + (size_t)l * 16384 * 1024; mp.dv = WSP(unsigned char, WS_PV) + (size_t)l * 16384 * 512; mp.sv = WSP(float, WS_PSU) + NL * 16384 + l * 16384;
                  ph_mixers(C, mp); } break;
        case 3: gA = WSP(bf16_t, WS_GS); gB = WSP(bf16_t, WS_WGLU) + (size_t)l * 65536; gN = 256; gK = 256; ge.O = WSP(bf16_t, WS_GL); ge.ldc = 256; break;
        case 4: { HY_MKCTX(); ph_merge3(C, WSP(bf16_t, WS_YAB), WSP(float, WS_MLB), WSP(bf16_t, WS_GS), WSP(bf16_t, WS_WGLU) + (size_t)l * 65536, in.b_glu + l * 256, WSP(bf16_t, WS_YC), WSP(bf16_t, WS_AOUT)); } break;
        case 5: gA = WSP(bf16_t, WS_AOUT); gB = WSP(bf16_t, WS_WOUT) + (size_t)l * D * D; gN = D; gK = D; ge.mode = 1; ge.xin = l == 0 ? in.x : nullptr; ge.xinb = WSP(bf16_t, WS_XB); ge.xoutb = WSP(bf16_t, WS_XB); ge.gate = modl + 2 * D; ge.p0 = in.norm2_gain + l * D; ge.p1 = modl + 4 * D; break;
        case 6: gA = WSP(bf16_t, WS_H); gB = WSP(bf16_t, WS_WQ) + (size_t)l * 2048 * D; gN = 2048; gK = D; ge.mode = 4; ge.O = WSP(bf16_t, WS_QP); ge.ldc = 2048; ge.p0 = WSP(float, WS_CV) + (size_t)l * 2 * 2048; break;
        case 7: break;
        case 8: { HY_MKCTX(); GatherP gp; gp.H = WSP(bf16_t, WS_H); gp.EIDX = WSP(int, WS_EIDX); gp.GATE = WSP(float, WS_GATE); gp.U8 = WSP(unsigned char, WS_PU) + (size_t)l * 16384 * 512; gp.SU = WSP(float, WS_PSU) + l * 16384;
                  gp.V8 = WSP(unsigned char, WS_PV) + (size_t)l * 16384 * 512; gp.SV = WSP(float, WS_PSU) + (NL + l) * 16384; gp.g2 = modl + 5 * D; gp.xinb = WSP(bf16_t, WS_XB); gp.xout = (rep + 1 < nrep) ? WSP(float, WS_P1) : out; gp.xoutb = (l + 1 < NL) ? ((rep + 1 < nrep) ? WSP(bf16_t, WS_P1) : WSP(bf16_t, WS_XB)) : nullptr;
                  gp.SSX = WSP(float, WS_SSX); gp.sh2 = modl + 3 * D; gp.ngain = (l + 1 < NL && rep + 1 == nrep) ? in.norm1_gain + (l + 1) * D : nullptr; gp.nmod = modl + 2 * MODW;
                  gp.var = (rep + 1 < nrep && HY_PROBE >= 40 && HY_PROBE < 50) ? HY_PROBE - 40 : 0;
#ifdef HY_GSUB
                  { Ctx C3 = C; if ((C.bid & 3) == 3) { C3.bid = 1 << 20; } else { C3.bid = C.bid - (C.bid >> 2); } C3.nblk = 192; ph_peer_gather2(C3, gp); }
#else
                  ph_peer_gather5(C, gp);
#endif
                  } break;
        default: break;
        }
        if (gA) {
            HY_MKCTX();
            pg8::Gemm g; g.A = gA; g.Bt = gB; g.M = M; g.N = gN; g.K = gK;
            pg8::StaticOrder So; So.init(M, gN, C.nblk, C.bid);
            pg8::gemm_phase<EpiGen, pg8::StaticOrder, true, true>((PG8_LAS unsigned char*)C.lds, g, So, ge, C.tid);
        }
        if (s == 6) { HY_MKCTX(); asm volatile("s_waitcnt vmcnt(0)" ::: "memory"); __syncthreads();
            ph_peer_topk(C, WSP(bf16_t, WS_QP), WSP(bf16_t, WS_SUBK) + (size_t)l * 16 * 128 * 128, WSP(int, WS_EIDX), WSP(float, WS_GATE)); }
        if (s == 1) { HY_MKCTX(); ph_s5_chunk_states(C, WSP(bf16_t, WS_U), WSP(bf16_t, WS_WE) + (size_t)l * S5_WE_L, WSP(float, WS_E));
            if (C.nblk == 256 && C.bid >= 128 && C.bid < 192) { Ctx Cc = C; Cc.bid = C.bid - 128; Cc.nblk = 64;
                ph_cvt_fp4(Cc, in.peer_u + (size_t)l * 16384 * 1024, WSP(unsigned char, WS_PU) + (size_t)l * 16384 * 512, WSP(float, WS_PSU) + l * 16384, 16384); } }
        if (rep + 1 < nrep) GSYNC();
        }
        GSYNC();
    }
}
}

extern "C" void kernel_launch(void* const* d_in, const int* in_sizes, int n_in, void* d_out, int out_size, void* d_ws, size_t ws_size, hipStream_t stream) {
    using namespace hy;
    static int grid_blocks = 0;
    if (grid_blocks == 0) {
        if (n_in != 32 || out_size != M * D || ws_size < WS_END) { fprintf(stderr, "kernel_launch: unexpected problem (n_in %d out %d ws %zu)\n", n_in, out_size, ws_size); grid_blocks = -1; return; }
        (void)hipFuncSetAttribute((const void*)k_fwd, hipFuncAttributeMaxDynamicSharedMemorySize, LDS_BYTES);
        int dev = 0, cus = 0, per_cu = 0;
        (void)hipGetDevice(&dev);
        (void)hipDeviceGetAttribute(&cus, hipDeviceAttributeMultiprocessorCount, dev);
        (void)hipOccupancyMaxActiveBlocksPerMultiprocessor(&per_cu, (const void*)k_fwd, NT, LDS_BYTES);
        if (per_cu < 1) { fprintf(stderr, "kernel_launch: occupancy query says %d blocks/CU\n", per_cu); per_cu = 1; }
        grid_blocks = cus;
        fprintf(stderr, "kernel_launch: cus %d per_cu %d grid %d\n", cus, per_cu, grid_blocks);
    }
    if (grid_blocks < 0) return;
    Params P; memset(&P, 0, sizeof(P));
    { const float** p = (const float**)&P.in; for (int i = 0; i < 32; ++i) p[i] = (const float*)d_in[i]; }
    P.out = (float*)d_out; P.ws = (unsigned char*)d_ws;
    void* args[] = {&P};
    hipError_t e = hipLaunchCooperativeKernel((const void*)k_fwd, dim3(grid_blocks), dim3(NT), args, LDS_BYTES, stream);
    if (e != hipSuccess) fprintf(stderr, "cooperative launch failed: %s (grid %d)\n", hipGetErrorString(e), grid_blocks);
}
```
